# Optimizing an MI355X kernel written in HIP

```python
import math
import jax, jax.numpy as jnp
from jax import lax
import numpy as np

D_MODEL = 2048
BATCH = 2
SEQ = 16384
DEPTH = 1

HEAD_DIM = 128
MOBA_HEADS = D_MODEL // (2 * HEAD_DIM)
MOBA_BLOCK = 256
MOBA_TOPK = 3
MOBA_Q_CHUNK = 64
DIFF_HEADS = D_MODEL // (4 * HEAD_DIM)
DIFF_V_DIM = 2 * HEAD_DIM
DIFF_Q_BLOCK = 128
ROT_DIM = HEAD_DIM // 4
ROPE_THETA = 500000.0
D_FF = 4 * D_MODEL
PLE_DIM = 256
NORM_EPS = 1e-6
MOBA_WIDTH = MOBA_HEADS * HEAD_DIM
DIFF_QK_WIDTH = DIFF_HEADS * 2 * HEAD_DIM
DIFF_V_WIDTH = DIFF_HEADS * DIFF_V_DIM
IN_WIDTH = 3 * MOBA_WIDTH + 2 * DIFF_QK_WIDTH + DIFF_V_WIDTH + 2 * D_MODEL

kernel_name = "hybrid_moba_diffattn_gated_block"

F32 = jnp.float32


def rmsnorm(x, g):
    xf = x.astype(F32)
    y = xf * lax.rsqrt(jnp.mean(xf * xf, axis=-1, keepdims=True) + NORM_EPS)
    return (y * g.astype(F32)).astype(x.dtype)


def partial_rope(x, pos_f):
    half = ROT_DIM // 2
    inv_freq = 1.0 / (ROPE_THETA ** (jnp.arange(half, dtype=F32) * 2.0 / ROT_DIM))
    ang = pos_f[:, None] * inv_freq[None, :]
    cos, sin = jnp.cos(ang), jnp.sin(ang)
    xf = x.astype(F32)
    x1 = xf[..., :half]
    x2 = xf[..., half:ROT_DIM]
    out = jnp.concatenate([x1 * cos - x2 * sin, x2 * cos + x1 * sin, xf[..., ROT_DIM:]], axis=-1)
    return out.astype(x.dtype)


def moba_attention(q, k, v):
    B, H, S, Dh = q.shape
    nb = -(-S // MOBA_BLOCK)
    topk = min(MOBA_TOPK, nb)
    pad = nb * MOBA_BLOCK - S
    k_p = jnp.pad(k, ((0, 0), (0, 0), (0, pad), (0, 0)))
    v_p = jnp.pad(v, ((0, 0), (0, 0), (0, pad), (0, 0)))
    k_blk = k_p.reshape(B, H, nb, MOBA_BLOCK, Dh)
    v_blk = v_p.reshape(B, H, nb, MOBA_BLOCK, Dh)
    k_mean = jnp.mean(k_blk.astype(F32), axis=3)
    nc = S // MOBA_Q_CHUNK
    q_ch = jnp.moveaxis(q.reshape(B, H, nc, MOBA_Q_CHUNK, Dh), 2, 0)
    bi = jnp.arange(B)[:, None, None, None]
    hi = jnp.arange(H)[None, :, None, None]
    blk_ids = jnp.arange(nb)
    scale = Dh ** -0.5

    def chunk(args):
        ci, qc = args
        q_start = ci * MOBA_Q_CHUNK
        cur = q_start // MOBA_BLOCK
        gate = jnp.einsum('bhqd,bhnd->bhqn', qc.astype(F32), k_mean)
        gate = jnp.where(blk_ids < cur, gate, -jnp.inf)
        _, idx = lax.top_k(gate, topk)
        valid = idx < cur
        k_sel = k_blk[bi, hi, idx]
        v_sel = v_blk[bi, hi, idx]
        s_sel = jnp.einsum('bhqd,bhqjkd->bhqjk', qc, k_sel).astype(F32) * scale
        s_sel = jnp.where(valid[..., None], s_sel, -jnp.inf)
        s_sel = s_sel.reshape(B, H, MOBA_Q_CHUNK, topk * MOBA_BLOCK)
        own0 = cur * MOBA_BLOCK
        k_own = lax.dynamic_slice_in_dim(k_p, own0, MOBA_BLOCK, axis=2)
        v_own = lax.dynamic_slice_in_dim(v_p, own0, MOBA_BLOCK, axis=2)
        s_own = jnp.einsum('bhqd,bhkd->bhqk', qc, k_own).astype(F32) * scale
        q_pos = q_start + jnp.arange(MOBA_Q_CHUNK)
        k_pos = own0 + jnp.arange(MOBA_BLOCK)
        s_own = jnp.where(k_pos[None, :] <= q_pos[:, None], s_own, -jnp.inf)
        probs = jax.nn.softmax(jnp.concatenate([s_sel, s_own], axis=-1), axis=-1).astype(v.dtype)
        p_sel = probs[..., :topk * MOBA_BLOCK].reshape(B, H, MOBA_Q_CHUNK, topk, MOBA_BLOCK)
        p_own = probs[..., topk * MOBA_BLOCK:]
        return (jnp.einsum('bhqjk,bhqjkd->bhqd', p_sel, v_sel)
                + jnp.einsum('bhqk,bhkd->bhqd', p_own, v_own))

    out = lax.map(chunk, (jnp.arange(nc), q_ch))
    return jnp.moveaxis(out, 0, 2).reshape(B, H, S, Dh)


def diff_attention(q, k, v, lam, sub_g, lambda_init):
    B, H, _, S, Dh = q.shape
    nq = S // DIFF_Q_BLOCK
    q_bl = jnp.moveaxis(q.reshape(B, H, 2, nq, DIFF_Q_BLOCK, Dh), 3, 0)
    k_pos = jnp.arange(S)
    scale = Dh ** -0.5

    def block(args):
        bidx, qb = args
        s = jnp.einsum('bhcqd,bhckd->bhcqk', qb, k).astype(F32) * scale
        q_pos = bidx * DIFF_Q_BLOCK + jnp.arange(DIFF_Q_BLOCK)
        s = jnp.where(k_pos[None, :] <= q_pos[:, None], s, -jnp.inf)
        pr = jax.nn.softmax(s, axis=-1)
        attn = (pr[:, :, 0] - lam * pr[:, :, 1]).astype(v.dtype)
        return jnp.einsum('bhqk,bhkd->bhqd', attn, v)

    out = lax.map(block, (jnp.arange(nq), q_bl))
    out = jnp.moveaxis(out, 0, 2).reshape(B, H, S, DIFF_V_DIM)
    return (rmsnorm(out, sub_g) * (1.0 - lambda_init)).astype(v.dtype)


def setup_inputs(seed: int = 0) -> dict:
    key = jax.random.key(seed)
    ks = jax.random.split(key, 24)
    n = lambda k_, shape, s: jax.random.normal(k_, shape, F32) * s
    gain = lambda k_, dim: 1.0 + 0.02 * jax.random.normal(k_, (DEPTH, dim), F32)
    return {
        "x": n(ks[0], (BATCH, SEQ, D_MODEL), 1.0),
        "p": n(ks[1], (DEPTH, BATCH, SEQ, PLE_DIM), 1.0),
        "w_in": n(ks[2], (DEPTH, D_MODEL, IN_WIDTH), D_MODEL ** -0.5),
        "w_br_moba": n(ks[3], (DEPTH, MOBA_WIDTH, D_MODEL), MOBA_WIDTH ** -0.5),
        "w_br_diff": n(ks[4], (DEPTH, DIFF_V_WIDTH, D_MODEL), DIFF_V_WIDTH ** -0.5),
        "w_out": n(ks[5], (DEPTH, D_MODEL, D_MODEL), D_MODEL ** -0.5),
        "lambda_q1": n(ks[6], (DEPTH, HEAD_DIM), 0.1),
        "lambda_k1": n(ks[7], (DEPTH, HEAD_DIM), 0.1),
        "lambda_q2": n(ks[8], (DEPTH, HEAD_DIM), 0.1),
        "lambda_k2": n(ks[9], (DEPTH, HEAD_DIM), 0.1),
        "diff_subln_g": gain(ks[10], DIFF_V_DIM),
        "g_mix_pre": gain(ks[11], D_MODEL),
        "g_mix_post": gain(ks[12], D_MODEL),
        "w_up": n(ks[13], (DEPTH, D_MODEL, D_FF), D_MODEL ** -0.5),
        "w_down": n(ks[14], (DEPTH, D_FF, D_MODEL), D_FF ** -0.5),
        "g_mlp_pre": gain(ks[15], D_MODEL),
        "g_mlp_post": gain(ks[16], D_MODEL),
        "w_ple_proj": n(ks[17], (DEPTH, PLE_DIM, D_MODEL), PLE_DIM ** -0.5),
        "w_ple_gate": n(ks[18], (DEPTH, D_MODEL, D_MODEL), D_MODEL ** -0.5),
        "g_ple_pre": gain(ks[19], D_MODEL),
        "g_ple_post": gain(ks[20], D_MODEL),
    }


def reference(x, p, w_in, w_br_moba, w_br_diff, w_out, lambda_q1, lambda_k1, lambda_q2, lambda_k2,
              diff_subln_g, g_mix_pre, g_mix_post, w_up, w_down, g_mlp_pre, g_mlp_post,
              w_ple_proj, w_ple_gate, g_ple_pre, g_ple_post):
    B, S, _ = x.shape
    pos_f = jnp.arange(S, dtype=F32)
    widths = [MOBA_WIDTH, MOBA_WIDTH, MOBA_WIDTH, DIFF_QK_WIDTH, DIFF_QK_WIDTH, DIFF_V_WIDTH, D_MODEL]
    split_points = [int(v) for v in np.cumsum(widths)]
    h = x
    for i in range(DEPTH):
        lambda_init = 0.8 - 0.6 * math.exp(-0.3 * i)
        u = rmsnorm(h, g_mix_pre[i])
        proj = u @ w_in[i]
        qa, ka, va, qb, kb, vb, ga, gb = jnp.split(proj, split_points, axis=-1)
        to_heads = lambda t: t.reshape(B, S, MOBA_HEADS, HEAD_DIM).transpose(0, 2, 1, 3)
        qa = partial_rope(to_heads(qa), pos_f)
        ka = partial_rope(to_heads(ka), pos_f)
        va = to_heads(va)
        oa = moba_attention(qa, ka, va)
        to_sub = lambda t: t.reshape(B, S, DIFF_HEADS, 2, HEAD_DIM).transpose(0, 2, 3, 1, 4)
        qb = partial_rope(to_sub(qb), pos_f)
        kb = partial_rope(to_sub(kb), pos_f)
        vb = vb.reshape(B, S, DIFF_HEADS, DIFF_V_DIM).transpose(0, 2, 1, 3)
        lam = (jnp.exp(jnp.sum(lambda_q1[i].astype(F32) * lambda_k1[i].astype(F32)))
               - jnp.exp(jnp.sum(lambda_q2[i].astype(F32) * lambda_k2[i].astype(F32)))
               + lambda_init)
        ob = diff_attention(qb, kb, vb, lam, diff_subln_g[i], lambda_init)
        ya = oa.transpose(0, 2, 1, 3).reshape(B, S, MOBA_WIDTH) @ w_br_moba[i]
        yb = ob.transpose(0, 2, 1, 3).reshape(B, S, DIFF_V_WIDTH) @ w_br_diff[i]
        mixed = jax.nn.sigmoid(ga) * ya + jax.nn.sigmoid(gb) * yb
        h = h + rmsnorm(mixed @ w_out[i], g_mix_post[i])
        u2 = rmsnorm(h, g_mlp_pre[i])
        ff = jnp.square(jax.nn.relu(u2 @ w_up[i])) @ w_down[i]
        h = h + rmsnorm(ff, g_mlp_post[i])
        gate = jax.nn.sigmoid(rmsnorm(h, g_ple_pre[i]) @ w_ple_gate[i])
        e = (p[i] @ w_ple_proj[i]) * gate
        h = h + rmsnorm(e, g_ple_post[i])
    return h
```

```cpp
#include <hip/hip_runtime.h>
#include <hip/hip_bf16.h>
#include <cstdio>
#include <cstdint>
#include <cmath>
namespace pg8 {
#define PG8_LAS __attribute__((address_space(3)))
typedef unsigned short bf16_t;
typedef short bf16x8 __attribute__((ext_vector_type(8)));
typedef float f32x4 __attribute__((ext_vector_type(4)));
typedef unsigned u32x4 __attribute__((ext_vector_type(4)));
constexpr int BM = 256, BK = 64, HALF = 128, HTB = HALF * BK * 2  , STAGE_BYTES = 8 * HTB, NXCD = 8, WGM = 8;

__host__ __device__ __forceinline__ int lds_byte(int r, int c) { const int st = (r >> 4) * 2 + (c >> 5), rr = r & 15, cc = c & 31, ob = rr * 64 + cc * 2; return st * 1024 + (ob ^ (((ob >> 9) & 1) << 5)); }
__host__ __device__ __forceinline__ void stage_rc(int b, int& R, int& C) { const int st = b / 1024, sb = b % 1024, swz = sb ^ (((sb >> 9) & 1) << 5); R = (st >> 1) * 16 + swz / 64; C = (st & 1) * 32 + (swz % 64) / 2; }
__host__ __device__ __forceinline__ int perm32(int rho) { const int n = rho >> 4, i = rho & 15; return 8 * (i >> 2) + 4 * n + (i & 3); }

struct Unit { int pm, pn; };
struct Gemm { const bf16_t* A; const bf16_t* Bt; int M, N, K; };

struct StaticOrder {
    int nM, nN, nwg, G, c;
    __host__ __device__ void init(int M, int N, int G_, int c_) { nM = M / BM; nN = N / BM; nwg = nM * nN; G = G_; c = c_; }
    __host__ __device__ bool next(int i, Unit& u) const {
        const long L = (long)i * G + c; if (L >= nwg) return false;
        int wgid = (int)L; { const int q = nwg / NXCD, r = nwg % NXCD, xcd = wgid % NXCD, off = wgid / NXCD; wgid = (xcd < r ? xcd * (q + 1) : r * (q + 1) + (xcd - r) * q) + off; }
        const int nig = WGM * nN, gid = wgid / nig, fm = gid * WGM, gsz = (nM - fm) < WGM ? (nM - fm) : WGM;
        u.pm = fm + ((wgid % nig) % gsz); u.pn = (wgid % nig) / gsz; return true;
    }
    __device__ __forceinline__ void a_ready(const Unit&) const {}
    __device__ __forceinline__ void done(const Unit&) const {}
};

typedef float f32x2_c __attribute__((ext_vector_type(2))); typedef __bf16 bf16x2_c __attribute__((ext_vector_type(2)));
__device__ __forceinline__ unsigned cvt_pk_bf16(float lo, float hi) { f32x2_c v = {lo, hi}; bf16x2_c b = __builtin_convertvector(v, bf16x2_c); return __builtin_bit_cast(unsigned, b); }
typedef float f32x2 __attribute__((ext_vector_type(2)));
__device__ __forceinline__ f32x2 gelu_pk(f32x2 v) {
    const f32x2 av = __builtin_elementwise_abs(v), d = av * 0.2316418882f + 1.0f;
    f32x2 t; t.x = __builtin_amdgcn_rcpf(d.x); t.y = __builtin_amdgcn_rcpf(d.y);
    f32x2 q = t * 0.5307027145f + (-0.7265760135f); q = q * t + 0.7107068705f; q = q * t + (-0.142248368f); q = q * t + 0.127414796f; q = q * t;
    const f32x2 s = (v * v) * (-0.72134752044f);
    f32x2 e; e.x = __builtin_amdgcn_exp2f(s.x); e.y = __builtin_amdgcn_exp2f(s.y);
    const f32x2 m = v * (q * e), r = v - m;
    f32x2 o; o.x = v.x < 0.f ? m.x : r.x; o.y = v.y < 0.f ? m.y : r.y; return o;
}

template <int ACT  > struct EpiBf16 {
    static constexpr bool PERM = true, AFTER_DRAIN = false; static_assert(ACT == 0 || ACT == 1, "EpiBf16: ACT is 0 (none) or 1 (gelu_pk)");
    bf16_t* O; int ldc; const float* bias; int split_cols; size_t split_stride; float scale0;
    __device__ __forceinline__ void operator()(const f32x4 (&acc)[2][2][4][2], const Unit& u, int wr, int wc, int fr, int fq) const {
        const int row0 = u.pm * BM + wr * 64 + fr; int colt = u.pn * BM; bf16_t* base = O;
        float sc = 1.f; if (split_cols) { const int t = colt / split_cols; base += (size_t)t * split_stride; colt -= t * split_cols; if (t == 0) sc = scale0; }
        const int col0 = colt + wc * 32 + 8 * fq, bcol0 = u.pn * BM + wc * 32 + 8 * fq;
        f32x4 bv[2][2];
#pragma unroll
        for (int bj = 0; bj < 2; ++bj)
#pragma unroll
            for (int n = 0; n < 2; ++n) bv[bj][n] = bias ? *(const f32x4*)(bias + bcol0 + bj * HALF + 4 * n) : (f32x4){0.f, 0.f, 0.f, 0.f};
#pragma unroll
        for (int ai = 0; ai < 2; ++ai)
#pragma unroll
            for (int m = 0; m < 4; ++m) { bf16_t* rowp = base + (size_t)(row0 + ai * HALF + m * 16) * ldc + col0;
#pragma unroll
                for (int bj = 0; bj < 2; ++bj) { f32x4 v0 = acc[ai][bj][m][0] + bv[bj][0], v1 = acc[ai][bj][m][1] + bv[bj][1];
                    if (ACT == 1) { f32x2 a = gelu_pk((f32x2){v0[0], v0[1]}), b = gelu_pk((f32x2){v0[2], v0[3]}), c = gelu_pk((f32x2){v1[0], v1[1]}), d = gelu_pk((f32x2){v1[2], v1[3]});
                        v0 = (f32x4){a.x, a.y, b.x, b.y}; v1 = (f32x4){c.x, c.y, d.x, d.y}; }
                    v0 = v0 * sc; v1 = v1 * sc; u32x4 w; w.x = cvt_pk_bf16(v0[0], v0[1]); w.y = cvt_pk_bf16(v0[2], v0[3]); w.z = cvt_pk_bf16(v1[0], v1[1]); w.w = cvt_pk_bf16(v1[2], v1[3]);
                    *(u32x4*)(rowp + bj * HALF) = w; } }
    }
};

template <class Epi, class Sched, bool ALIGN_EPI = false, bool SP2 = false, bool MID = false>
__device__ __forceinline__ void gemm_phase(PG8_LAS unsigned char* lds, const Gemm g, const Sched& S, const Epi& E) {
    const int tid = threadIdx.x, wid = __builtin_amdgcn_readfirstlane(tid >> 6), lane = tid & 63, wr = wid >> 2, wc = wid & 3, fr = lane & 15, fq = lane >> 4;
    const int K = g.K, nt = K / BK;
    unsigned voffA[2], voffB[2];
#pragma unroll
    for (int i = 0; i < 2; ++i) { int R, C; stage_rc(tid * 16 + i * 8192, R, C); const int Rb = Epi::PERM ? ((R & ~31) + perm32(R & 31)) : R;
        voffA[i] = (unsigned)(R * K + C) * 2u; voffB[i] = (unsigned)(Rb * K + C) * 2u; }
    const size_t kstep = (size_t)(BK * 2);
    const size_t hstep = (size_t)HALF * K * 2;
    const size_t tstep = 2 * hstep;
    const unsigned ldsw = (unsigned)wid * 1024u;
    const int aoff = lds_byte(wr * 64 + fr, fq * 8), boff = lds_byte(wc * 32 + fr, fq * 8);
#define PG8_SA(b, h) (((b) * 2 + (h)) * HTB)
#define PG8_SB(b, h) ((4 + (b) * 2 + (h)) * HTB)
#define PG8_STAGE(bufoff, gbase, voff) do { _Pragma("unroll") for (int _i = 0; _i < 2; ++_i) \
        __builtin_amdgcn_global_load_lds((const unsigned*)((const char*)(gbase) + (voff)[_i]), (PG8_LAS unsigned*)(lds + (bufoff) + ldsw + _i * 8192), 16, 0, 0); } while (0)
#define PG8_LDA(dst, b, h) do { _Pragma("unroll") for (int m = 0; m < 4; ++m) _Pragma("unroll") for (int k = 0; k < 2; ++k) dst[m][k] = *(const PG8_LAS bf16x8*)(lds + PG8_SA(b, h) + aoff + m * 2048 + k * 1024); } while (0)
#define PG8_LDB(dst, b, h) do { _Pragma("unroll") for (int n = 0; n < 2; ++n) _Pragma("unroll") for (int k = 0; k < 2; ++k) dst[n][k] = *(const PG8_LAS bf16x8*)(lds + PG8_SB(b, h) + boff + n * 2048 + k * 1024); } while (0)
#define PG8_MMA(ai, bj, At, Bt) do { __builtin_amdgcn_s_setprio(1); _Pragma("unroll") for (int m = 0; m < 4; ++m) _Pragma("unroll") for (int n = 0; n < 2; ++n) _Pragma("unroll") for (int k = 0; k < 2; ++k) \
        acc[ai][bj][m][n] = __builtin_amdgcn_mfma_f32_16x16x32_bf16(Bt[n][k], At[m][k], acc[ai][bj][m][n], 0, 0, 0); __builtin_amdgcn_s_setprio(0); } while (0)
#define PG8_WAIT_V(n) asm volatile("s_waitcnt vmcnt(" #n ")" ::: "memory")
#define PG8_WAIT_L(n) asm volatile("s_waitcnt lgkmcnt(" #n ")" ::: "memory")
#define PG8_BAR __builtin_amdgcn_s_barrier()
#define PG8_SCHED __builtin_amdgcn_sched_barrier(0)
    Unit cur, nxt; int ui = 0;
    if (!S.next(0, cur)) return;
    f32x4 acc[2][2][4][2];
#pragma unroll
    for (int a = 0; a < 2; ++a)
#pragma unroll
        for (int b = 0; b < 2; ++b)
#pragma unroll
            for (int m = 0; m < 4; ++m)
#pragma unroll
                for (int n = 0; n < 2; ++n) acc[a][b][m][n] = (f32x4){0.f, 0.f, 0.f, 0.f};
    bf16x8 At[4][2], B0[2][2], B1[2][2];
    const char* cA = (const char*)g.A + (size_t)cur.pm * tstep; const char* cB = (const char*)g.Bt + (size_t)cur.pn * tstep;
    S.a_ready(cur);
    if constexpr (SP2) {
        PG8_STAGE(PG8_SB(0, 0), cB, voffB); PG8_STAGE(PG8_SB(0, 1), cB + hstep, voffB); PG8_STAGE(PG8_SA(0, 0), cA, voffA); PG8_STAGE(PG8_SA(0, 1), cA + hstep, voffA);
        if (wr == 1) PG8_BAR;
        PG8_WAIT_V(2); PG8_BAR;
        PG8_STAGE(PG8_SB(1, 0), cB + kstep, voffB); PG8_STAGE(PG8_SA(1, 0), cA + kstep, voffA); PG8_STAGE(PG8_SB(1, 1), cB + hstep + kstep, voffB);
        PG8_WAIT_V(6); PG8_BAR;
    } else {
        PG8_STAGE(PG8_SB(0, 0), cB, voffB); PG8_STAGE(PG8_SA(0, 0), cA, voffA); PG8_STAGE(PG8_SB(0, 1), cB + hstep, voffB); PG8_STAGE(PG8_SA(0, 1), cA + hstep, voffA);
        if (wr == 1) PG8_BAR;
        PG8_WAIT_V(4); PG8_BAR;
        PG8_STAGE(PG8_SB(1, 0), cB + kstep, voffB); PG8_STAGE(PG8_SA(1, 0), cA + kstep, voffA); PG8_STAGE(PG8_SB(1, 1), cB + hstep + kstep, voffB);
        PG8_WAIT_V(6); PG8_BAR;
    }
    for (;;) {
        const bool has_next = S.next(ui + 1, nxt);
        const char* nA = has_next ? (const char*)g.A + (size_t)nxt.pm * tstep : cA; const char* nB = has_next ? (const char*)g.Bt + (size_t)nxt.pn * tstep : cB;
        for (int t = 0; t < nt; t += 2) {
            const bool last = (t == nt - 2);
            if constexpr (MID) { if (t == Epi::MID_T) { PG8_SCHED; E.mid(acc, cur, wr, wc, fr, fq); PG8_SCHED; } }
            const char* a1 = cA + (size_t)(t + 1) * kstep;
            const char* a2 = last ? nA : cA + (size_t)(t + 2) * kstep; const char* b2 = last ? nB : cB + (size_t)(t + 2) * kstep;
            const char* a3 = a2 + kstep; const char* b3 = b2 + kstep;
            if (last && has_next) S.a_ready(nxt);
            if constexpr (SP2) {
            PG8_LDB(B0, 0, 0); PG8_LDB(B1, 0, 1); PG8_SCHED; PG8_LDA(At, 0, 0); PG8_STAGE(PG8_SA(1, 1), a1 + hstep, voffA);
            PG8_WAIT_V(8); PG8_WAIT_L(0); PG8_BAR; PG8_MMA(0, 0, At, B0); PG8_MMA(0, 1, At, B1); PG8_BAR; PG8_SCHED;
            PG8_LDA(At, 0, 1); PG8_STAGE(PG8_SB(0, 0), b2, voffB); PG8_STAGE(PG8_SB(0, 1), b2 + hstep, voffB); PG8_STAGE(PG8_SA(0, 0), a2, voffA);
            PG8_WAIT_V(8); PG8_WAIT_L(0); PG8_BAR; PG8_MMA(1, 0, At, B0); PG8_MMA(1, 1, At, B1); PG8_BAR; PG8_SCHED;
            PG8_LDB(B0, 1, 0); PG8_LDB(B1, 1, 1); PG8_SCHED; PG8_LDA(At, 1, 0); PG8_STAGE(PG8_SA(0, 1), a2 + hstep, voffA);
            PG8_WAIT_V(8); PG8_WAIT_L(0); PG8_BAR; PG8_MMA(0, 0, At, B0); PG8_MMA(0, 1, At, B1); PG8_BAR; PG8_SCHED;
            PG8_LDA(At, 1, 1); PG8_STAGE(PG8_SB(1, 0), b3, voffB); PG8_STAGE(PG8_SB(1, 1), b3 + hstep, voffB); PG8_STAGE(PG8_SA(1, 0), a3, voffA);
            PG8_WAIT_V(8); PG8_WAIT_L(0); PG8_BAR; PG8_MMA(1, 0, At, B0); PG8_MMA(1, 1, At, B1); PG8_BAR; PG8_SCHED;
            } else {
            PG8_LDB(B0, 0, 0); PG8_SCHED; PG8_LDA(At, 0, 0); PG8_STAGE(PG8_SA(1, 1), a1 + hstep, voffA);
            PG8_WAIT_L(8); PG8_BAR; PG8_WAIT_L(0); PG8_MMA(0, 0, At, B0); PG8_BAR; PG8_SCHED;
            PG8_LDB(B1, 0, 1); PG8_STAGE(PG8_SB(0, 0), b2, voffB);
            PG8_BAR; PG8_WAIT_L(0); PG8_MMA(0, 1, At, B1); PG8_BAR;
            PG8_LDA(At, 0, 1); PG8_STAGE(PG8_SA(0, 0), a2, voffA);
            PG8_BAR; PG8_WAIT_L(0); PG8_MMA(1, 0, At, B0); PG8_BAR; PG8_SCHED;
            PG8_STAGE(PG8_SB(0, 1), b2 + hstep, voffB);
            PG8_WAIT_V(6); PG8_BAR; PG8_MMA(1, 1, At, B1); PG8_BAR;
            PG8_LDB(B0, 1, 0); PG8_SCHED; PG8_LDA(At, 1, 0); PG8_STAGE(PG8_SA(0, 1), a2 + hstep, voffA);
            PG8_WAIT_L(8); PG8_BAR; PG8_WAIT_L(0); PG8_MMA(0, 0, At, B0); PG8_BAR; PG8_SCHED;
            PG8_LDB(B1, 1, 1); PG8_STAGE(PG8_SB(1, 0), b3, voffB);
            PG8_BAR; PG8_WAIT_L(0); PG8_MMA(0, 1, At, B1); PG8_BAR;
            PG8_LDA(At, 1, 1); PG8_STAGE(PG8_SA(1, 0), a3, voffA);
            PG8_BAR; PG8_WAIT_L(0); PG8_MMA(1, 0, At, B0); PG8_BAR; PG8_SCHED;
            PG8_STAGE(PG8_SB(1, 1), b3 + hstep, voffB);
            PG8_WAIT_V(6); PG8_BAR; PG8_MMA(1, 1, At, B1); PG8_BAR;
            }
        }
        if constexpr (ALIGN_EPI) { if (wr == 0) PG8_BAR; }
        if constexpr (!Epi::AFTER_DRAIN) { E(acc, cur, wr, wc, fr, fq); S.done(cur); }
        if (!has_next) break;
#pragma unroll
        for (int a = 0; a < 2; ++a)
#pragma unroll
            for (int b = 0; b < 2; ++b)
#pragma unroll
                for (int m = 0; m < 4; ++m)
#pragma unroll
                    for (int n = 0; n < 2; ++n) acc[a][b][m][n] = (f32x4){0.f, 0.f, 0.f, 0.f};
        cur = nxt; cA = nA; cB = nB; ++ui;
        if constexpr (ALIGN_EPI) { if (wr == 1) PG8_BAR; }
    }
    PG8_WAIT_V(0);
    if constexpr (!ALIGN_EPI) { if (wr == 0) PG8_BAR; }
    PG8_BAR;
    if constexpr (Epi::AFTER_DRAIN) { E.fused(acc, cur, wr, wc, fr, fq, lds, wid, lane); S.done(cur); }
#undef PG8_SA
#undef PG8_SB
#undef PG8_STAGE
#undef PG8_LDA
#undef PG8_LDB
#undef PG8_MMA
#undef PG8_WAIT_V
#undef PG8_WAIT_L
#undef PG8_BAR
#undef PG8_SCHED
}
}
namespace swa {
constexpr int D = 128;
constexpr float THR = 8.f;
constexpr bool WSKIP = false;
constexpr float SCALE = 0.08838834764831845f;
constexpr int NW = 8, QBLK = 32, KVBLK = 64, QB = NW * QBLK;
constexpr int SHM_V = KVBLK * D * 2, SHM_K = KVBLK * D * 2;
constexpr int MSLOT_OFF = 2 * SHM_V + 2 * SHM_K + NW * 64 * 4, QLDS_OFF = MSLOT_OFF + 4096;
constexpr int LDS_BYTES = QLDS_OFF + NW * 8192;

using bf16 = __hip_bfloat16;
typedef short bf16x8 __attribute__((ext_vector_type(8)));
typedef short s16x4 __attribute__((ext_vector_type(4)));
typedef float f32x16 __attribute__((ext_vector_type(16)));
typedef float f32x4 __attribute__((ext_vector_type(4)));
typedef unsigned u32x4 __attribute__((ext_vector_type(4)));
template <class A, class Bt> struct same_t { static constexpr bool v = false; };
template <class A> struct same_t<A, A> { static constexpr bool v = true; };

#define KSWZ(row, colB) ((row) * 256 + ((colB) ^ (((row) & 7) << 4)))
#define SBAR() __builtin_amdgcn_sched_barrier(0)
__device__ __forceinline__ int v_st(int k, int c) { const int kk = (k & ~0xC) | ((k & 4) << 1) | ((k & 8) >> 1); return ((kk >> 3) * 4 + (c >> 5)) * 512 + ((kk & 7) * 32 + (c & 31)) * 2; }
__device__ __forceinline__ int v_rd_base(int lane) { return ((lane & 3) << 3) | (((lane >> 2) & 3) << 6) | (((lane >> 4) & 1) << 5) | (((lane >> 5) & 1) << 8); }
constexpr int v_rd_off(int d0, int ks, int half) { return d0 * 512 + ks * 4096 + half * 2048; }
__device__ __forceinline__ int crow(int r, int hi) { return (r & 3) + 8 * (r >> 2) + 4 * hi; }
typedef float f32x2_c __attribute__((ext_vector_type(2))); typedef __bf16 bf16x2_c __attribute__((ext_vector_type(2)));
__device__ __forceinline__ unsigned cvtpk(float lo, float hi) { f32x2_c v = {lo, hi}; bf16x2_c b = __builtin_convertvector(v, bf16x2_c); return __builtin_bit_cast(unsigned, b); }
__device__ __forceinline__ bf16x8 pack8(f32x4 a, f32x4 b) {
    u32x4 w = {cvtpk(a[0], a[1]), cvtpk(a[2], a[3]), cvtpk(b[0], b[1]), cvtpk(b[2], b[3])};
    return *reinterpret_cast<bf16x8*>(&w);
}
template <class T> __device__ __forceinline__ bf16x8 load8(const T* p) {
    if constexpr (same_t<T, float>::v) { return pack8(*(const f32x4*)p, *(const f32x4*)(p + 4)); }
    else { return *reinterpret_cast<const bf16x8*>(p); }
}
__device__ __forceinline__ void mask_tile(f32x16& p0, f32x16& p1, int dq, unsigned W) {
    const float NEG = -__builtin_inff();
#pragma unroll
    for (int r = 0; r < 16; ++r) {
        const int c = (r & 3) + 8 * (r >> 2);
        if ((unsigned)(dq - c) >= W) p0[r] = NEG;
        if ((unsigned)(dq - c - 32) >= W) p1[r] = NEG;
    }
}
__device__ __forceinline__ void partialSM(f32x16& p0, f32x16& p1, float& m_reg, float& mn, float& alpha) {
    float pmax = p0[0]; for (int r = 1; r < 16; ++r) pmax = fmaxf(pmax, p0[r]); for (int r = 0; r < 16; ++r) pmax = fmaxf(pmax, p1[r]);
    { auto rr = __builtin_amdgcn_permlane32_swap(__float_as_uint(pmax), __float_as_uint(pmax), false, false);
      pmax = fmaxf(__uint_as_float(rr[0]), __uint_as_float(rr[1])); }
    constexpr float C2 = 1.4426950408889634f * SCALE;
    if (__builtin_expect(__all((pmax - m_reg) * SCALE <= THR), 1)) { mn = m_reg; alpha = 1.f; }
    else { mn = fmaxf(m_reg, pmax); alpha = __builtin_amdgcn_exp2f((m_reg - mn) * C2); m_reg = mn; }
    const float mnL = -mn * C2;
    for (int r = 0; r < 16; ++r) p0[r] = fmaf(p0[r], C2, mnL); for (int r = 0; r < 16; ++r) p1[r] = fmaf(p1[r], C2, mnL);
    for (int r = 0; r < 16; ++r) p0[r] = __builtin_amdgcn_exp2f(p0[r]);
}
__device__ __forceinline__ void finishSM(f32x16& p0, f32x16& p1, float alpha, float& l_reg, bf16x8& pa0, bf16x8& pa1, bf16x8& pa2, bf16x8& pa3) {
    for (int r = 0; r < 16; ++r) p1[r] = __builtin_amdgcn_exp2f(p1[r]);
    float ps = 0; for (int r = 0; r < 16; ++r) ps += p0[r]; for (int r = 0; r < 16; ++r) ps += p1[r];
    { auto rr = __builtin_amdgcn_permlane32_swap(__float_as_uint(ps), __float_as_uint(ps), false, false);
      ps = __uint_as_float(rr[0]) + __uint_as_float(rr[1]); }
    l_reg = l_reg * alpha + ps;
#define PK4(P, B_, OUT) do { unsigned a0 = cvtpk(P[B_+0], P[B_+1]), a1 = cvtpk(P[B_+2], P[B_+3]);                          \
        unsigned b0 = cvtpk(P[B_+4], P[B_+5]), b1 = cvtpk(P[B_+6], P[B_+7]);                                             \
        auto r0 = __builtin_amdgcn_permlane32_swap(a0, b0, false, false); auto r1 = __builtin_amdgcn_permlane32_swap(a1, b1, false, false); \
        u32x4 w = {r0[0], r1[0], r0[1], r1[1]}; OUT = *reinterpret_cast<bf16x8*>(&w); } while (0)
    PK4(p0, 0, pa0); PK4(p0, 8, pa1); PK4(p1, 0, pa2); PK4(p1, 8, pa3);
#undef PK4
}
template <int KB, bool SK>
__device__ __forceinline__ void qkt(f32x16& p0, f32x16& p1, const char* K_lds, int r32, int hi, const char* qlds, bool act) {
    if (SK && !act) { const float NEG = -__builtin_inff();
#pragma unroll
        for (int r = 0; r < 16; ++r) { p0[r] = NEG; p1[r] = NEG; } return; }
    p0 = f32x16{}; p1 = f32x16{};
    const char* kb[4];
#pragma unroll
    for (int dd = 0; dd < 4; ++dd) kb[dd] = K_lds + KB * SHM_K + KSWZ(r32, (dd * 16 + hi * 8) * 2);
#pragma unroll
    for (int d0 = 0; d0 < 8; ++d0) { const char* a = kb[d0 & 3] + (d0 >> 2) * 128;
        bf16x8 b0 = *reinterpret_cast<const bf16x8*>(a);
        bf16x8 b1 = *reinterpret_cast<const bf16x8*>(a + 32 * 256);
        const bf16x8 qf = *reinterpret_cast<const bf16x8*>(qlds + d0 * 1024);
        p0 = __builtin_amdgcn_mfma_f32_32x32x16_bf16(b0, qf, p0, 0, 0, 0);
        p1 = __builtin_amdgcn_mfma_f32_32x32x16_bf16(b1, qf, p1, 0, 0, 0); }
}
template <int VB, bool SK>
__device__ __forceinline__ void pv_tile(f32x16* o, int vb0, bf16x8 pa0, bf16x8 pa1, bf16x8 pa2, bf16x8 pa3, bool act) {
    if (SK && !act) return;
#define TRRD(dst, off) asm volatile("ds_read_b64_tr_b16 %0, %1 offset:%2" : "=&v"(dst) : "v"(vb0), "i"(off) : "memory")
#define PV_D0(d0) do { s16x4 l0, l1, l2, l3, h0, h1, h2, h3; constexpr int b_ = VB * SHM_V + v_rd_off(d0, 0, 0);     \
        TRRD(l0, b_); TRRD(h0, b_ + 2048); TRRD(l1, b_ + 4096); TRRD(h1, b_ + 6144); TRRD(l2, b_ + 8192); TRRD(h2, b_ + 10240); TRRD(l3, b_ + 12288); TRRD(h3, b_ + 14336); \
        asm volatile("s_waitcnt lgkmcnt(0)" ::: "memory"); SBAR();                 \
        o[d0] = __builtin_amdgcn_mfma_f32_32x32x16_bf16(pa0, (bf16x8){l0[0], l0[1], l0[2], l0[3], h0[0], h0[1], h0[2], h0[3]}, o[d0], 0, 0, 0);   \
        o[d0] = __builtin_amdgcn_mfma_f32_32x32x16_bf16(pa1, (bf16x8){l1[0], l1[1], l1[2], l1[3], h1[0], h1[1], h1[2], h1[3]}, o[d0], 0, 0, 0);   \
        o[d0] = __builtin_amdgcn_mfma_f32_32x32x16_bf16(pa2, (bf16x8){l2[0], l2[1], l2[2], l2[3], h2[0], h2[1], h2[2], h2[3]}, o[d0], 0, 0, 0);   \
        o[d0] = __builtin_amdgcn_mfma_f32_32x32x16_bf16(pa3, (bf16x8){l3[0], l3[1], l3[2], l3[3], h3[0], h3[1], h3[2], h3[3]}, o[d0], 0, 0, 0); } while (0)
    PV_D0(0); PV_D0(1); PV_D0(2); PV_D0(3);
#undef PV_D0
#undef TRRD
}

template <class TIn, class TOut> struct BlockRef { const TIn* Q; const TIn* K; const TIn* V; TOut* O; int P0; int ldo; const int* rows; const int* dst; float* stat; };
template <class TIn> struct Seam {
    bf16x8 qr[8];
    bf16x8 st_v0, st_v1, st_k0, st_k1; f32x4 sf0, sf1, sf2, sf3;
    f32x4 tq[16];
};
__device__ __forceinline__ int swa_jlo(int P0, int W) { const int lowk = P0 - W + 1; return lowk > 0 ? lowk / KVBLK : 0; }
#define ROW(p, k0, rr) ((p) + (size_t)((k0) + (rr)) * D + sc)
#define VMW() asm volatile("s_waitcnt vmcnt(0)" ::: "memory")
#define VMWN(n) asm volatile("s_waitcnt vmcnt(%0)" :: "i"(n) : "memory")
#define SLOAD_H(Kp, Vp, k0) do { S.st_v0 = load8<TIn>(ROW(Vp, k0, sr)); S.st_v1 = load8<TIn>(ROW(Vp, k0, 32 + sr));              \
                         S.st_k0 = load8<TIn>(ROW(Kp, k0, sr)); S.st_k1 = load8<TIn>(ROW(Kp, k0, 32 + sr)); } while (0)
#define SWRITE_HK(bf) do { *(bf16x8*)(K_lds + (bf) * SHM_K + kws) = S.st_k0; *(bf16x8*)(K_lds + (bf) * SHM_K + kws + 32 * 256) = S.st_k1; } while (0)
#define SWRITE_HV(bf) do { *(bf16x8*)(V_lds + (bf) * SHM_V + vst0) = S.st_v0; *(bf16x8*)(V_lds + (bf) * SHM_V + vst1) = S.st_v1; } while (0)
#define SWRITE_H(bf) do { SWRITE_HV(bf); SWRITE_HK(bf); } while (0)
#define SLOAD_F(p, k0) do { S.sf0 = *(const f32x4*)ROW(p, k0, sr); S.sf1 = *(const f32x4*)(ROW(p, k0, sr) + 4);                \
                            S.sf2 = *(const f32x4*)ROW(p, k0, 32 + sr); S.sf3 = *(const f32x4*)(ROW(p, k0, 32 + sr) + 4); } while (0)
#define SWRITE_KF(bf) do { *(bf16x8*)(K_lds + (bf) * SHM_K + kws) = pack8(S.sf0, S.sf1); *(bf16x8*)(K_lds + (bf) * SHM_K + kws + 32 * 256) = pack8(S.sf2, S.sf3); } while (0)
#define SWRITE_VF(bf) do { *(bf16x8*)(V_lds + (bf) * SHM_V + vst0) = pack8(S.sf0, S.sf1); *(bf16x8*)(V_lds + (bf) * SHM_V + vst1) = pack8(S.sf2, S.sf3); } while (0)
template <class TIn, class TOut>
__device__ __forceinline__ void causal_swa_prime(const BlockRef<TIn, TOut>& cur, int W, char* lds, Seam<TIn>& S) {
    constexpr bool F32 = same_t<TIn, float>::v;
    const int tid = threadIdx.x, wid = __builtin_amdgcn_readfirstlane(tid >> 6), lane = tid & 63, r32 = lane & 31, hi = lane >> 5;
    const int sr = tid >> 4, sc = (tid & 15) * 8, kws = KSWZ(sr, sc * 2); char* K_lds = lds + 2 * SHM_V;
    const int kb0 = swa_jlo(cur.P0, W) * KVBLK;
    { const size_t qrow_ = cur.rows ? (size_t)cur.rows[wid * QBLK + r32] : (size_t)(wid * QBLK + r32);
      for (int d0 = 0; d0 < 8; ++d0) S.qr[d0] = load8<TIn>(cur.Q + qrow_ * D + d0 * 16 + hi * 8); }
    if constexpr (F32) { SLOAD_F((const float*)cur.K, kb0); VMW(); SWRITE_KF(0); SBAR(); SLOAD_F((const float*)cur.V, kb0); }
    else { SLOAD_H(cur.K, cur.V, kb0); VMW(); SWRITE_HK(0); }
    __syncthreads();
}
template <class TIn, class TOut>
__device__ __forceinline__ void causal_swa_block(const BlockRef<TIn, TOut>& cur, const BlockRef<TIn, TOut>& nxt, int skv, int W, char* lds, Seam<TIn>& S) {
    constexpr bool F32 = same_t<TIn, float>::v;
    const int tid = threadIdx.x, wid = __builtin_amdgcn_readfirstlane(tid >> 6), lane = tid & 63, r32 = lane & 31, hi = lane >> 5;
    const int j_lo = swa_jlo(cur.P0, W);
    int j_hi = (cur.P0 + QB - 1) / KVBLK + 1; if (j_hi > skv / KVBLK) j_hi = skv / KVBLK;
    const int NT = j_hi - j_lo;
    const int kbn = swa_jlo(nxt.P0, W) * KVBLK;
    const int qlo = cur.P0 + wid * QBLK, qm = qlo + r32 - 4 * hi;
    char* V_lds = lds; char* K_lds = lds + 2 * SHM_V;
    float* ws = (float*)(lds + 2 * SHM_V + 2 * SHM_K) + wid * 64; float* li_l = ws, * al_l = ws + 32;
    float m_reg = -1e30f, l_reg = 0; f32x16 o[4] = {};
    const int sr = tid >> 4, sc = (tid & 15) * 8, vst0 = v_st(sr, sc), vst1 = v_st(32 + sr, sc), kws = KSWZ(sr, sc * 2);
    const int vb0 = (int)(uintptr_t)V_lds + v_rd_base(lane);
    const TIn* Kh = cur.K; const TIn* Vh = cur.V;
    char* qlds = lds + QLDS_OFF + wid * 8192 + lane * 16;
#pragma unroll
    for (int d0 = 0; d0 < 8; ++d0) *reinterpret_cast<bf16x8*>(qlds + d0 * 1024) = S.qr[d0];
#define RESC(a) do { if (__any((a) < 1.f)) { if (hi == 0) al_l[r32] = (a); asm volatile("s_waitcnt lgkmcnt(0)" ::: "memory");              \
                     for (int d_ = 0; d_ < 4; ++d_) for (int r = 0; r < 16; ++r) o[d_][r] *= al_l[crow(r, hi)]; } } while (0)
#define KBASE(t) ((j_lo + (t)) * KVBLK)
#define ACT(t) (KBASE(t) <= qlo + QBLK - 1 && KBASE(t) + KVBLK - 1 >= qlo - W + 1)
#define MASKT(P0_, P1_, t) do { const int kb_ = KBASE(t); if ((!SK || ACT(t)) && (kb_ + KVBLK - 1 > qlo || kb_ <= qlo + QBLK - 1 - W)) mask_tile(P0_, P1_, qm - kb_, (unsigned)W); } while (0)
    constexpr int NQL = F32 ? 16 : 8;
    constexpr bool SK = WSKIP && !F32;
#define SEAM_K0() do { VMWN(NQL); if constexpr (F32) { SWRITE_KF(0); SBAR(); SLOAD_F((const float*)nxt.V, kbn); } else { SWRITE_HK(0); } SBAR(); } while (0)
    f32x16 pA0, pA1, pB0, pB1; float mnA, mnB, alA, alB; bf16x8 pa0, pa1, pa2, pa3;
    if constexpr (F32) { VMW(); SWRITE_VF(0); SBAR(); } else { SWRITE_HV(0); SBAR(); }
    if (NT > 1) { if constexpr (F32) SLOAD_F((const float*)Kh, KBASE(1)); else SLOAD_H(Kh, Vh, KBASE(1)); }
    SBAR(); qkt<0, SK>(pA0, pA1, K_lds, r32, hi, qlds, ACT(0));
    if constexpr (F32) { if (NT > 1) { VMW(); SWRITE_KF(1); SBAR(); SLOAD_F((const float*)Vh, KBASE(1)); } }
    MASKT(pA0, pA1, 0); partialSM(pA0, pA1, m_reg, mnA, alA);
    if (NT > 1) { VMW(); if constexpr (F32) { SWRITE_VF(1); SBAR(); if (NT > 2) SLOAD_F((const float*)Kh, KBASE(2)); } else SWRITE_H(1); }
    __syncthreads();
#define HALF_STEP(PX0, PX1, mnX, alX, PY0, PY1, alY, t, KB, VB, SB) do {                                                      \
        SBAR(); qkt<KB, SK>(PX0, PX1, K_lds, r32, hi, qlds, ACT(t));                                             \
        finishSM(PY0, PY1, alY, l_reg, pa0, pa1, pa2, pa3); SBAR();                                                           \
        if ((t) + 1 < NT) { if constexpr (F32) { VMW(); SWRITE_KF(SB); SBAR(); SLOAD_F((const float*)Vh, KBASE((t) + 1)); }  \
                            else { SLOAD_H(Kh, Vh, KBASE((t) + 1)); } SBAR(); }                                               \
        pv_tile<VB, SK>(o, vb0, pa0, pa1, pa2, pa3, ACT((t) - 1)); MASKT(PX0, PX1, (t)); partialSM(PX0, PX1, m_reg, mnX, alX);                                        \
        __syncthreads();                                                                                                      \
        if ((t) + 1 < NT) { VMW(); if constexpr (F32) { SWRITE_VF(SB); SBAR(); if ((t) + 2 < NT) SLOAD_F((const float*)Kh, KBASE((t) + 2)); } \
                            else { SWRITE_H(SB); } }                                                                          \
        RESC(alX); __syncthreads(); } while (0)
    for (int t = 1; t + 1 < NT; t += 2) {
        HALF_STEP(pB0, pB1, mnB, alB, pA0, pA1, alA, t, 1, 0, 0);
        HALF_STEP(pA0, pA1, mnA, alA, pB0, pB1, alB, t + 1, 0, 1, 1);
    }
    const bool even = (NT & 1) == 0;
    if (even) { SBAR(); qkt<1, SK>(pB0, pB1, K_lds, r32, hi, qlds, ACT(NT - 1)); SBAR(); }
#define QROW(e) (nxt.Q + (size_t)(wid * QBLK + r32) * D + ((e) >> 1) * 16 + hi * 8 + ((e) & 1) * 4)
    if constexpr (F32) { SLOAD_F((const float*)nxt.K, kbn); SBAR();
#pragma unroll
        for (int e = 0; e < 8; ++e) S.tq[e] = *(const f32x4*)QROW(e); }
    else { const size_t qrown_ = nxt.rows ? (size_t)nxt.rows[wid * QBLK + r32] : (size_t)(wid * QBLK + r32);
        SLOAD_H(nxt.K, nxt.V, kbn); SBAR();
#pragma unroll
        for (int d0 = 0; d0 < 8; ++d0) S.qr[d0] = load8<TIn>(nxt.Q + qrown_ * D + d0 * 16 + hi * 8); }
    SBAR();
    finishSM(pA0, pA1, alA, l_reg, pa0, pa1, pa2, pa3); SBAR();
    if constexpr (F32) {
#pragma unroll
        for (int e = 8; e < 16; ++e) S.tq[e] = *(const f32x4*)QROW(e); SBAR(); }
#undef QROW
    pv_tile<0, SK>(o, vb0, pa0, pa1, pa2, pa3, ACT(even ? NT - 2 : NT - 1));
    if (even) { MASKT(pB0, pB1, NT - 1); partialSM(pB0, pB1, m_reg, mnB, alB); __syncthreads(); RESC(alB);
        finishSM(pB0, pB1, alB, l_reg, pa0, pa1, pa2, pa3); SBAR(); pv_tile<1, SK>(o, vb0, pa0, pa1, pa2, pa3, ACT(NT - 1)); }
    SBAR(); SEAM_K0();
    if (hi == 0) li_l[r32] = l_reg; asm volatile("s_waitcnt lgkmcnt(0)" ::: "memory");
    float rli[16];
#pragma unroll
    for (int r = 0; r < 16; ++r) rli[r] = __builtin_amdgcn_rcpf(li_l[crow(r, hi)]);
    if (cur.dst) {
        { const int dme_ = cur.dst[wid * QBLK + r32]; if (hi == 0 && dme_ >= 0) { float2 st_; st_.x = m_reg; st_.y = l_reg; *(float2*)(cur.stat + 2 * (size_t)dme_) = st_; } }
#pragma unroll
        for (int r = 0; r < 16; ++r) { const int di_ = cur.dst[wid * QBLK + crow(r, hi)];
#pragma unroll
            for (int d0 = 0; d0 < 4; ++d0) { const float v = o[d0][r] * rli[r]; const float vn = __shfl_xor(v, 1);
                if ((r32 & 1) == 0 && di_ >= 0) *(unsigned*)(cur.O + (size_t)di_ * 128 + d0 * 32 + r32) = cvtpk(v, vn); } }
    } else {
    int ld_ = cur.ldo; asm volatile("" : "+s"(ld_));
    TOut* Ow = cur.O + (size_t)(wid * QBLK) * ld_;
#pragma unroll
    for (int r = 0; r < 16; ++r) { const unsigned ro = (unsigned)crow(r, hi) * (unsigned)ld_ + (unsigned)r32;
#pragma unroll
        for (int d0 = 0; d0 < 4; ++d0) { const float v = o[d0][r] * rli[r];
            if constexpr (same_t<TOut, float>::v) { Ow[ro + d0 * 32] = v; }
            else { const float vn = __shfl_xor(v, 1);
                   if ((r32 & 1) == 0) *(unsigned*)(Ow + ro + d0 * 32) = cvtpk(v, vn); } } }
    }
    if constexpr (F32) {
#pragma unroll
        for (int d0 = 0; d0 < 8; ++d0) S.qr[d0] = pack8(S.tq[2 * d0], S.tq[2 * d0 + 1]); }
    __syncthreads();
#undef RESC
#undef KBASE
#undef ACT
#undef MASKT
#undef SEAM_K0
#undef HALF_STEP
}
#undef ROW
#undef VMW
#undef VMWN
#undef SLOAD_H
#undef SWRITE_HK
#undef SWRITE_HV
#undef SWRITE_H
#undef SLOAD_F
#undef SWRITE_KF
#undef SWRITE_VF

}
#include <hip/hip_cooperative_groups.h>
namespace cg = cooperative_groups;

constexpr int NWAVES = 8;
#ifndef MK_ONE_LAUNCH
#define MK_ONE_LAUNCH 1
#endif
constexpr int BATCH = 2, SEQ = 16384, T = BATCH * SEQ, DM = 2048, INW = 10240, DFF = 8192, PLE = 256;
constexpr int NH8 = 8;
constexpr float NORM_EPS = 1e-6f;
constexpr float LAMBDA_INIT = 0.2f;
constexpr int NPHASE = 19;

constexpr size_t MiB = 1u << 20;
constexpr size_t WS_ROPE = 1 * MiB;
constexpr size_t WS_KMEAN = 3 * MiB;
constexpr size_t WS_CNT = 0, WS_NBLK = 8192, WS_TAB = 65536;
constexpr size_t WS_BAR = 131072, WS_BAR_BYTES = 16384;
constexpr size_t WS_SEL = 4 * MiB;
constexpr int LSTR = 65536 + SEQ;
constexpr size_t WS_ROWL = 986 * MiB, WS_DSTL = 992 * MiB;
constexpr size_t WS_STATS = 1000 * MiB;
constexpr size_t WS_TOP = 1008 * MiB;
constexpr size_t WS_WIN = 8 * MiB, WS_WA = 48 * MiB, WS_WB = 52 * MiB, WS_WOUT = 56 * MiB, WS_WUP = 64 * MiB, WS_WDN = 96 * MiB, WS_WPG = 128 * MiB, WS_WPP = 136 * MiB;
constexpr size_t WS_PB = 138 * MiB;
constexpr size_t WS_XN = 154 * MiB;
constexpr size_t WS_OB = 154 * MiB;
constexpr size_t WS_QKV = 282 * MiB;
constexpr size_t SEC_ELEMS = (size_t)T * 1024;
constexpr size_t WS_SG = 666 * MiB;
constexpr size_t WS_OA = 922 * MiB;
constexpr size_t WS_MIX = 282 * MiB;
constexpr size_t WS_HID = 282 * MiB;
constexpr size_t WS_G3 = 282 * MiB;
constexpr size_t WS_XN3 = 410 * MiB;
constexpr size_t WS_Y = 794 * MiB;
constexpr size_t WS_END = 986 * MiB;
static_assert(WS_HID + (size_t)T * DFF * 2 <= WS_Y && WS_Y + (size_t)T * DM * 2 <= WS_OA && WS_OA + (size_t)T * 1024 * 2 == WS_END, "ws map");

constexpr int RING_BYTES = 131072, LDS_BYTES = 147456;

#define GAS __attribute__((address_space(1)))
#define LAS __attribute__((address_space(3)))
typedef unsigned short bf16;
typedef unsigned v4u __attribute__((ext_vector_type(4)));
typedef unsigned v2u __attribute__((ext_vector_type(2)));
typedef float f32x4 __attribute__((ext_vector_type(4)));
#define LDS_WAIT() asm volatile("s_waitcnt lgkmcnt(0)" ::: "memory")
__device__ __forceinline__ unsigned f2bf(float f) { unsigned u = __builtin_bit_cast(unsigned, f); return (u + 0x7fffu + ((u >> 16) & 1u)) >> 16; }
__device__ __forceinline__ unsigned pk2(float lo, float hi) { return f2bf(lo) | (f2bf(hi) << 16); }
__device__ __forceinline__ float bflo(unsigned w) { return __uint_as_float(w << 16); }
__device__ __forceinline__ float bfhi(unsigned w) { return __uint_as_float(w & 0xffff0000u); }
__device__ __forceinline__ float wave_sum(float v) {
#pragma unroll
    for (int o = 1; o < 64; o <<= 1) v += __shfl_xor(v, o);
    return v;
}
template <class Tv> __device__ __forceinline__ Tv ntload(const Tv* p) { return __builtin_nontemporal_load(p); }
template <class Tv> __device__ __forceinline__ void ntstore(Tv v, Tv* p) { __builtin_nontemporal_store(v, p); }
__device__ __forceinline__ float sigmoidf_(float x) { return __builtin_amdgcn_rcpf(1.0f + __expf(-x)); }

namespace pg8 {
template <int MODE> struct EpiT {
    static constexpr bool PERM = true, AFTER_DRAIN = false;
    bf16_t* O; int ldo; const bf16_t* G; int ldg;
    __device__ __forceinline__ void operator()(const f32x4 (&acc)[2][2][4][2], const Unit& u, int wr, int wc, int fr, int fq) const {
        const int row0 = u.pm * BM + wr * 64 + fr, col0 = u.pn * BM + wc * 32 + 8 * fq;
#pragma unroll
        for (int ai = 0; ai < 2; ++ai)
#pragma unroll
            for (int m = 0; m < 4; ++m) { const size_t r = (size_t)(row0 + ai * HALF + m * 16);
#pragma unroll
                for (int bj = 0; bj < 2; ++bj) { f32x4 v0 = acc[ai][bj][m][0], v1 = acc[ai][bj][m][1]; const int c = col0 + bj * HALF;
                    if (MODE == 1) {
#pragma unroll
                        for (int e = 0; e < 4; ++e) { float a = fmaxf(v0[e], 0.f), b = fmaxf(v1[e], 0.f); v0[e] = a * a; v1[e] = b * b; } }
                    if (MODE == 2) {
#pragma unroll
                        for (int e = 0; e < 4; ++e) { v0[e] = sigmoidf_(v0[e]); v1[e] = sigmoidf_(v1[e]); } }
                    if (MODE == 3 || MODE == 4) { const u32x4 g = *(const u32x4*)(G + r * ldg + c);
                        v0[0] *= bflo(g.x); v0[1] *= bfhi(g.x); v0[2] *= bflo(g.y); v0[3] *= bfhi(g.y); v1[0] *= bflo(g.z); v1[1] *= bfhi(g.z); v1[2] *= bflo(g.w); v1[3] *= bfhi(g.w); }
                    if (MODE == 4) { const u32x4 g = *(const u32x4*)(O + r * ldo + c);
                        v0[0] += bflo(g.x); v0[1] += bfhi(g.x); v0[2] += bflo(g.y); v0[3] += bfhi(g.y); v1[0] += bflo(g.z); v1[1] += bfhi(g.z); v1[2] += bflo(g.w); v1[3] += bfhi(g.w); }
                    u32x4 w; w.x = cvt_pk_bf16(v0[0], v0[1]); w.y = cvt_pk_bf16(v0[2], v0[3]); w.z = cvt_pk_bf16(v1[0], v1[1]); w.w = cvt_pk_bf16(v1[2], v1[3]);
                    *(u32x4*)(O + r * ldo + c) = w; } }
    }
};
struct EpiGate2 {
    static constexpr bool PERM = true, AFTER_DRAIN = false; static constexpr int MID_T = 16;
    bf16_t* O; const bf16_t* SGp;
    __device__ __forceinline__ void mid(f32x4 (&acc)[2][2][4][2], const Unit& u, int wr, int wc, int fr, int fq) const {
        int row0 = u.pm * BM + wr * 64 + fr; const int col0 = u.pn * BM + wc * 32 + 8 * fq;
        asm volatile("" : "+v"(row0));
        const bf16_t* gp = SGp + (size_t)row0 * 4096 + col0;
#pragma unroll
        for (int ai = 0; ai < 2; ++ai)
#pragma unroll
            for (int m = 0; m < 4; ++m) { const int ro = (ai * HALF + m * 16) * 4096;
#pragma unroll
                for (int bj = 0; bj < 2; ++bj) { const u32x4 a = *(const u32x4*)(gp + ro + bj * HALF), b = *(const u32x4*)(gp + ro + bj * HALF + 2048);
                    f32x4& v0 = acc[ai][bj][m][0]; f32x4& v1 = acc[ai][bj][m][1];
                    v0[0] *= bflo(a.x) * __builtin_amdgcn_rcpf(bflo(b.x)); v0[1] *= bfhi(a.x) * __builtin_amdgcn_rcpf(bfhi(b.x)); v0[2] *= bflo(a.y) * __builtin_amdgcn_rcpf(bflo(b.y)); v0[3] *= bfhi(a.y) * __builtin_amdgcn_rcpf(bfhi(b.y));
                    v1[0] *= bflo(a.z) * __builtin_amdgcn_rcpf(bflo(b.z)); v1[1] *= bfhi(a.z) * __builtin_amdgcn_rcpf(bfhi(b.z)); v1[2] *= bflo(a.w) * __builtin_amdgcn_rcpf(bflo(b.w)); v1[3] *= bfhi(a.w) * __builtin_amdgcn_rcpf(bfhi(b.w)); }
                if (m == 3) asm volatile("" ::: "memory"); }
    }
    __device__ __forceinline__ void operator()(const f32x4 (&acc)[2][2][4][2], const Unit& u, int wr, int wc, int fr, int fq) const {
        int row0 = u.pm * BM + wr * 64 + fr; const int col0 = u.pn * BM + wc * 32 + 8 * fq;
        asm volatile("" : "+v"(row0));
        const bf16_t* gp = SGp + (size_t)row0 * 4096 + 2048 + col0; bf16_t* op = O + (size_t)row0 * 2048 + col0;
#pragma unroll
        for (int ai = 0; ai < 2; ++ai)
#pragma unroll
            for (int m = 0; m < 4; ++m) { const int rr = ai * HALF + m * 16;
#pragma unroll
                for (int bj = 0; bj < 2; ++bj) { const u32x4 b = *(const u32x4*)(gp + rr * 4096 + bj * HALF); const f32x4 v0 = acc[ai][bj][m][0], v1 = acc[ai][bj][m][1];
                    u32x4 w; w.x = cvt_pk_bf16(v0[0] * bflo(b.x), v0[1] * bfhi(b.x)); w.y = cvt_pk_bf16(v0[2] * bflo(b.y), v0[3] * bfhi(b.y)); w.z = cvt_pk_bf16(v1[0] * bflo(b.z), v1[1] * bfhi(b.z)); w.w = cvt_pk_bf16(v1[2] * bflo(b.w), v1[3] * bfhi(b.w));
                    *(u32x4*)(op + rr * 2048 + bj * HALF) = w; } }
    }
};
struct EpiPle {
    static constexpr bool PERM = true, AFTER_DRAIN = false; static constexpr int MID_T = 32;
    bf16_t* O; bf16_t* Gp;
    __device__ __forceinline__ void mid(f32x4 (&acc)[2][2][4][2], const Unit& u, int wr, int wc, int fr, int fq) const {
        int row0 = u.pm * BM + wr * 64 + fr; const int col0 = u.pn * BM + wc * 32 + 8 * fq;
        asm volatile("" : "+v"(row0));
        bf16_t* gp = Gp + (size_t)row0 * 2048 + col0;
#pragma unroll
        for (int ai = 0; ai < 2; ++ai)
#pragma unroll
            for (int m = 0; m < 4; ++m) { const int rr = ai * HALF + m * 16;
#pragma unroll
                for (int bj = 0; bj < 2; ++bj) { f32x4& v0 = acc[ai][bj][m][0]; f32x4& v1 = acc[ai][bj][m][1];
                    u32x4 w; w.x = cvt_pk_bf16(sigmoidf_(v0[0]), sigmoidf_(v0[1])); w.y = cvt_pk_bf16(sigmoidf_(v0[2]), sigmoidf_(v0[3])); w.z = cvt_pk_bf16(sigmoidf_(v1[0]), sigmoidf_(v1[1])); w.w = cvt_pk_bf16(sigmoidf_(v1[2]), sigmoidf_(v1[3]));
                    *(u32x4*)(gp + rr * 2048 + bj * HALF) = w; v0 = (f32x4){0.f, 0.f, 0.f, 0.f}; v1 = (f32x4){0.f, 0.f, 0.f, 0.f}; } }
    }
    __device__ __forceinline__ void operator()(const f32x4 (&acc)[2][2][4][2], const Unit& u, int wr, int wc, int fr, int fq) const {
        int row0 = u.pm * BM + wr * 64 + fr; const int col0 = u.pn * BM + wc * 32 + 8 * fq;
        asm volatile("" : "+v"(row0));
        const bf16_t* gp = Gp + (size_t)row0 * 2048 + col0; bf16_t* op = O + (size_t)row0 * 2048 + col0;
#pragma unroll
        for (int ai = 0; ai < 2; ++ai)
#pragma unroll
            for (int m = 0; m < 4; ++m) { const int rr = ai * HALF + m * 16;
#pragma unroll
                for (int bj = 0; bj < 2; ++bj) { const u32x4 b = *(const u32x4*)(gp + rr * 2048 + bj * HALF); const f32x4 v0 = acc[ai][bj][m][0], v1 = acc[ai][bj][m][1];
                    u32x4 w; w.x = cvt_pk_bf16(v0[0] * bflo(b.x), v0[1] * bfhi(b.x)); w.y = cvt_pk_bf16(v0[2] * bflo(b.y), v0[3] * bfhi(b.y)); w.z = cvt_pk_bf16(v1[0] * bflo(b.z), v1[1] * bfhi(b.z)); w.w = cvt_pk_bf16(v1[2] * bflo(b.w), v1[3] * bfhi(b.w));
                    *(u32x4*)(op + rr * 2048 + bj * HALF) = w; } }
    }
};
struct EpiInProj {
    static constexpr bool PERM = true, AFTER_DRAIN = false;
    bf16_t* QKV; bf16_t* SG; const float* rope; float* km;
    __device__ __forceinline__ void operator()(const f32x4 (&acc)[2][2][4][2], const Unit& u, int wr, int wc, int fr, int fq) const {
        const int pn = u.pn, row0 = u.pm * BM + wr * 64 + fr;
        if (pn < 24) {
            const int sec = pn >> 2; const bool rot = (sec != 2) && (sec != 5) && (wc == 0);
            const int b = (u.pm * BM) / SEQ;
            const float sgn = (fq < 2) ? -1.f : 1.f;
            f32x4 ks[2][2] = {{(f32x4){0.f, 0.f, 0.f, 0.f}, (f32x4){0.f, 0.f, 0.f, 0.f}}, {(f32x4){0.f, 0.f, 0.f, 0.f}, (f32x4){0.f, 0.f, 0.f, 0.f}}};
#pragma unroll
            for (int ai = 0; ai < 2; ++ai)
#pragma unroll
                for (int m = 0; m < 4; ++m) { const int r = row0 + ai * HALF + m * 16, pos = r - b * SEQ;
                    f32x4 c0 = (f32x4){1.f, 1.f, 1.f, 1.f}, c1 = c0, s0 = (f32x4){0.f, 0.f, 0.f, 0.f}, s1 = s0;
                    if (rot) { const float* rp = rope + (size_t)pos * 32 + 8 * (fq & 1); c0 = *(const f32x4*)rp; c1 = *(const f32x4*)(rp + 4); s0 = *(const f32x4*)(rp + 16) * sgn; s1 = *(const f32x4*)(rp + 20) * sgn; }
#pragma unroll
                    for (int bj = 0; bj < 2; ++bj) { const int h8 = (pn & 3) * 2 + bj; f32x4 v0 = acc[ai][bj][m][0], v1 = acc[ai][bj][m][1];
                        if (rot) { f32x4 o0, o1;
#pragma unroll
                            for (int e = 0; e < 4; ++e) { o0[e] = __shfl_xor(v0[e], 32); o1[e] = __shfl_xor(v1[e], 32); }
                            v0 = v0 * c0 + o0 * s0; v1 = v1 * c1 + o1 * s1; }
                        if (sec == 1) { ks[bj][0] += v0; ks[bj][1] += v1; }
                        bf16_t* dst = QKV + (size_t)sec * SEC_ELEMS + ((size_t)(b * NH8 + h8) * SEQ + pos) * 128 + wc * 32 + 8 * fq;
                        u32x4 w; w.x = cvt_pk_bf16(v0[0], v0[1]); w.y = cvt_pk_bf16(v0[2], v0[3]); w.z = cvt_pk_bf16(v1[0], v1[1]); w.w = cvt_pk_bf16(v1[2], v1[3]);
                        *(u32x4*)dst = w; } }
            if (sec == 1) {
                const int blk = u.pm - b * (SEQ / 256);
#pragma unroll
                for (int bj = 0; bj < 2; ++bj)
#pragma unroll
                    for (int n = 0; n < 2; ++n)
#pragma unroll
                        for (int e = 0; e < 4; ++e) { float v = ks[bj][n][e]; v += __shfl_xor(v, 1); v += __shfl_xor(v, 2); v += __shfl_xor(v, 4); v += __shfl_xor(v, 8);
                            if (fr == 0) atomicAdd(km + ((size_t)((b * NH8 + (pn & 3) * 2 + bj) * 64 + blk)) * 128 + wc * 32 + 8 * fq + 4 * n + e, v * (1.0f / 256.0f)); }
            }
        } else {
            const int col0 = (pn - 24) * BM + wc * 32 + 8 * fq;
#pragma unroll
            for (int ai = 0; ai < 2; ++ai)
#pragma unroll
                for (int m = 0; m < 4; ++m) { bf16_t* rowp = SG + (size_t)(row0 + ai * HALF + m * 16) * 4096 + col0;
#pragma unroll
                    for (int bj = 0; bj < 2; ++bj) { const f32x4 v0 = acc[ai][bj][m][0], v1 = acc[ai][bj][m][1];
                        u32x4 w; w.x = cvt_pk_bf16(sigmoidf_(v0[0]), sigmoidf_(v0[1])); w.y = cvt_pk_bf16(sigmoidf_(v0[2]), sigmoidf_(v0[3])); w.z = cvt_pk_bf16(sigmoidf_(v1[0]), sigmoidf_(v1[1])); w.w = cvt_pk_bf16(sigmoidf_(v1[2]), sigmoidf_(v1[3]));
                        *(u32x4*)(rowp + bj * HALF) = w; } }
        }
    }
};
}

#define XB_TMO      128
#define XB_XCNT(j)  (256  + 64 * (j))
#define XB_XSUB(j)  (1280 + 64 * (j))
#define XB_XGEN(j)  (2304 + 64 * (j))
#define XB_TOP      3328
#define XB_TOPGEN   3392
#define XCD_BAR_WORDS 3456
#define XB_SPIN_CAP (1u << 18)

__device__ __forceinline__ unsigned xb_ld(unsigned* p)              { return __hip_atomic_load(p, __ATOMIC_RELAXED, __HIP_MEMORY_SCOPE_AGENT); }
__device__ __forceinline__ unsigned xb_add(unsigned* p, unsigned v) { return __hip_atomic_fetch_add(p, v, __ATOMIC_RELAXED, __HIP_MEMORY_SCOPE_AGENT); }
__device__ __forceinline__ unsigned xb_xcc_id() { return (unsigned)__builtin_amdgcn_s_getreg((3 << 11) | 20) & 0xFu; }
#define XB_SPIN(cond, bar) do { unsigned _sp = 0; while (cond) { __builtin_amdgcn_s_sleep(1); \
    if ((++_sp & 255u) == 0u) { if (xb_ld(&(bar)[XB_TMO])) break; if (_sp > XB_SPIN_CAP) { atomicAdd(&(bar)[XB_TMO], 1u); break; } } } } while (0)

struct XcdBarrier {
    unsigned* bar; unsigned x;
    volatile LAS unsigned* st;
};

__device__ __forceinline__ XcdBarrier xcd_barrier_post(unsigned* bar, volatile LAS unsigned* st) {
    XcdBarrier b; b.bar = bar; b.x = xb_xcc_id(); b.st = st;
    if (threadIdx.x == 0) (void)xb_add(&bar[XB_XCNT(b.x)], 1u);
    return b;
}
__device__ __forceinline__ void xcd_barrier_complete(unsigned* bar, unsigned x, unsigned& nloc, unsigned& nx) {
    const unsigned G = gridDim.x * gridDim.y * gridDim.z;
    unsigned sum, cnt, mine, sp = 0u;
    for (;;) {
        sum = 0u; cnt = 0u; mine = 0u;
#pragma unroll
        for (unsigned j = 0; j < 16; ++j) { const unsigned c = xb_ld(&bar[XB_XCNT(j)]); sum += c; cnt += (c > 0u) ? 1u : 0u; mine = (j == x) ? c : mine; }
        if (sum == G) break;
        __builtin_amdgcn_s_sleep(1);
        if ((++sp & 255u) == 0u) { if (xb_ld(&bar[XB_TMO])) break; if (sp > XB_SPIN_CAP) { atomicAdd(&bar[XB_TMO], 1u); break; } }
    }
    nloc = mine > 0u ? mine : 1u; nx = cnt > 0u ? cnt : 1u;
}

__device__ __forceinline__ void xcd_barrier(const XcdBarrier& b) {
    asm volatile("s_waitcnt vmcnt(0)" ::: "memory");
    __syncthreads();
    if (threadIdx.x == 0) {
        unsigned* bar = b.bar;
        __builtin_amdgcn_s_waitcnt(0);
        unsigned nloc = b.st[0], nx = b.st[1];
        if (nloc == 0u) { xcd_barrier_complete(bar, b.x, nloc, nx); b.st[0] = nloc; b.st[1] = nx; }
        const unsigned old = xb_add(&bar[XB_XSUB(b.x)], 1u);
        const unsigned gen = old / nloc;
        if (old + 1u == (gen + 1u) * nloc) {
            __builtin_amdgcn_fence(__ATOMIC_RELEASE, "agent");
            asm volatile("s_waitcnt vmcnt(0)" ::: "memory");
            const unsigned og = xb_add(&bar[XB_TOP], 1u);
            const unsigned tg = og / nx;
            if (og + 1u == (tg + 1u) * nx) xb_add(&bar[XB_TOPGEN], 1u);
            else XB_SPIN(xb_ld(&bar[XB_TOPGEN]) == tg, bar);
            __builtin_amdgcn_fence(__ATOMIC_ACQUIRE, "agent");
            xb_add(&bar[XB_XGEN(b.x)], 1u);
            asm volatile("s_waitcnt vmcnt(0)" ::: "memory");
        } else {
            XB_SPIN(xb_ld(&bar[XB_XGEN(b.x)]) == gen, bar);
            __builtin_amdgcn_fence(__ATOMIC_ACQUIRE, "agent");
            asm volatile("s_waitcnt vmcnt(0)" ::: "memory");
        }
    }
    __syncthreads();
}

struct Args { const float* in[21]; float* out; unsigned char* ws; int ph_lo, ph_hi, coop, pad; };

__device__ __forceinline__ void p0_transpose_item(const float* W, int K, int N, bf16* WT, LAS float* scr, int item, int lane, int ldt = 0) {
    if (ldt == 0) ldt = K;
    const int nblk = N / 64, kb = item / nblk, nb = item % nblk, k0 = 64 * kb, n0 = 64 * nb;
    const int lr = lane >> 4, lc = (lane & 15) * 4;
    f32x4 v[16];
#pragma unroll
    for (int i = 0; i < 16; ++i) v[i] = ntload((const f32x4*)(W + (size_t)(k0 + 4 * i + lr) * N + n0 + lc));
#pragma unroll
    for (int i = 0; i < 16; ++i) { LAS float* d = scr + (4 * i + lr) * 65 + lc; d[0] = v[i].x; d[1] = v[i].y; d[2] = v[i].z; d[3] = v[i].w; }
    LDS_WAIT(); asm volatile("" ::: "memory");
    const int c = lane & 7;
#pragma unroll
    for (int j = 0; j < 8; ++j) { const int n = (lane >> 3) + 8 * j; const LAS float* sp = scr + (8 * c) * 65 + n;
        v4u o; o.x = pk2(sp[0 * 65], sp[1 * 65]); o.y = pk2(sp[2 * 65], sp[3 * 65]); o.z = pk2(sp[4 * 65], sp[5 * 65]); o.w = pk2(sp[6 * 65], sp[7 * 65]);
        *(GAS v4u*)(WT + (size_t)(n0 + n) * ldt + k0 + 8 * c) = o; }
    LDS_WAIT(); asm volatile("" ::: "memory");
}
__device__ __forceinline__ void rms_row_to_bf16(const float* xrow, const float* g, bf16* orow, int lane) {
    f32x4 v[8]; float s = 0.f;
#pragma unroll
    for (int j = 0; j < 4; ++j) { const float* p = xrow + j * 512 + lane * 8; v[2 * j] = ntload((const f32x4*)p); v[2 * j + 1] = ntload((const f32x4*)(p + 4)); }
#pragma unroll
    for (int j = 0; j < 8; ++j) s += (v[j].x * v[j].x + v[j].y * v[j].y) + (v[j].z * v[j].z + v[j].w * v[j].w);
    const float rstd = 1.0f / sqrtf(wave_sum(s) * (1.f / DM) + NORM_EPS);
#pragma unroll
    for (int j = 0; j < 4; ++j) { const float* gp = g + j * 512 + lane * 8; const f32x4 g0 = *(const f32x4*)gp, g1 = *(const f32x4*)(gp + 4); const f32x4 a = v[2 * j] * rstd * g0, b = v[2 * j + 1] * rstd * g1;
        v4u o; o.x = pk2(a.x, a.y); o.y = pk2(a.z, a.w); o.z = pk2(b.x, b.y); o.w = pk2(b.z, b.w); *(v4u*)(orow + j * 512 + lane * 8) = o; }
}
__device__ __forceinline__ void row_pass(const bf16* Y, const float* base, const float* gA, float* outh, const float* gB, bf16* xn, int gw, int NGW, int lane, int ldx = DM, const float* pin = nullptr) {
    for (int row0 = gw; row0 < T; row0 += 2 * NGW) {
        f32x4 h[2][8]; v4u yw[2][4];
#pragma unroll
        for (int k = 0; k < 2; ++k)
#pragma unroll
            for (int j = 0; j < 4; ++j) { const size_t off = (size_t)(row0 + k * NGW) * DM + j * 512 + lane * 8; yw[k][j] = ntload((const v4u*)(Y + off));
                h[k][2 * j] = ntload((const f32x4*)(base + off)); h[k][2 * j + 1] = ntload((const f32x4*)(base + off + 4)); }
#pragma unroll
        for (int k = 0; k < 2; ++k) { const int row = row0 + k * NGW;
            f32x4 y[8]; float s = 0.f;
#pragma unroll
            for (int j = 0; j < 4; ++j) { const v4u w = yw[k][j]; y[2 * j] = (f32x4){bflo(w.x), bfhi(w.x), bflo(w.y), bfhi(w.y)}; y[2 * j + 1] = (f32x4){bflo(w.z), bfhi(w.z), bflo(w.w), bfhi(w.w)}; }
#pragma unroll
            for (int j = 0; j < 8; ++j) s += (y[j].x * y[j].x + y[j].y * y[j].y) + (y[j].z * y[j].z + y[j].w * y[j].w);
            const float r1 = 1.0f / sqrtf(wave_sum(s) * (1.f / DM) + NORM_EPS); float s2 = 0.f;
#pragma unroll
            for (int j = 0; j < 4; ++j) { const int c = j * 512 + lane * 8; const f32x4 g0 = *(const f32x4*)(gA + c), g1 = *(const f32x4*)(gA + c + 4);
                h[k][2 * j] = h[k][2 * j] + y[2 * j] * r1 * g0; h[k][2 * j + 1] = h[k][2 * j + 1] + y[2 * j + 1] * r1 * g1;
                ntstore(h[k][2 * j], (f32x4*)(outh + (size_t)row * DM + c)); ntstore(h[k][2 * j + 1], (f32x4*)(outh + (size_t)row * DM + c + 4)); }
            if (xn) {
#pragma unroll
                for (int j = 0; j < 8; ++j) s2 += (h[k][j].x * h[k][j].x + h[k][j].y * h[k][j].y) + (h[k][j].z * h[k][j].z + h[k][j].w * h[k][j].w);
                const float r2 = 1.0f / sqrtf(wave_sum(s2) * (1.f / DM) + NORM_EPS);
#pragma unroll
                for (int j = 0; j < 4; ++j) { const int c = j * 512 + lane * 8; const f32x4 g0 = *(const f32x4*)(gB + c), g1 = *(const f32x4*)(gB + c + 4); const f32x4 a = h[k][2 * j] * r2 * g0, b = h[k][2 * j + 1] * r2 * g1;
                    v4u o; o.x = pk2(a.x, a.y); o.y = pk2(a.z, a.w); o.z = pk2(b.x, b.y); o.w = pk2(b.z, b.w); *(v4u*)(xn + (size_t)row * ldx + c) = o; }
                if (pin) { const f32x4 pv = *(const f32x4*)(pin + (size_t)row * PLE + lane * 4); v2u o; o.x = pk2(pv.x, pv.y); o.y = pk2(pv.z, pv.w); *(v2u*)(xn + (size_t)row * ldx + DM + lane * 4) = o; }
            }
        }
    }
}

typedef swa::BlockRef<swa::bf16, swa::bf16> ABlock;
__device__ __forceinline__ ABlock attn_ref(int head, int qb, unsigned char* ws, float* dout) {
    const swa::bf16* QKVs = (const swa::bf16*)(ws + WS_QKV); ABlock r;
    const int b = head >> 4, hd = (head >> 2) & 3, c = (head >> 1) & 1, j = head & 1; const int sh = b * NH8 + hd * 2 + c, vh = b * NH8 + hd * 2 + j;
    r.Q = QKVs + 3 * SEC_ELEMS + ((size_t)sh * SEQ + (size_t)qb * 256) * 128; r.K = QKVs + 4 * SEC_ELEMS + (size_t)sh * SEQ * 128; r.V = QKVs + 5 * SEC_ELEMS + (size_t)vh * SEQ * 128;
    r.O = (swa::bf16*)dout + ((size_t)b * SEQ + (size_t)qb * 256) * 4096 + hd * 512 + c * 256 + j * 128;
    r.ldo = 4096; r.rows = nullptr; r.dst = nullptr; r.stat = nullptr; r.P0 = qb * 256;
    return r;
}
constexpr int MOBA_PER = 320, MOBA_ITEMS = 16 * MOBA_PER;
__device__ __forceinline__ bool moba_valid(int L, const int* nblk) { const int bh = L / MOBA_PER, k = L - bh * MOBA_PER; return k >= 256 || k < nblk[bh]; }
__device__ __forceinline__ int moba_next(int L, int G, const int* nblk) { do { L += G; } while (L < MOBA_ITEMS && !moba_valid(L, nblk)); return L; }
__device__ __forceinline__ ABlock moba_ref(int L, unsigned char* ws, float* dout) {
    const swa::bf16* QKVs = (const swa::bf16*)(ws + WS_QKV); ABlock r;
    const int bh = L / MOBA_PER, k = L - bh * MOBA_PER; int j, lp, p0;
    if (k < 256) { const int2 t = ((const int2*)(ws + WS_TAB))[bh * 256 + k]; j = t.x; lp = t.y; p0 = 256; } else { j = k - 256; lp = 65536 + j * 256; p0 = 0; }
    r.Q = QKVs + (size_t)bh * SEQ * 128; r.K = QKVs + 1 * SEC_ELEMS + ((size_t)bh * SEQ + (size_t)j * 256) * 128; r.V = QKVs + 2 * SEC_ELEMS + ((size_t)bh * SEQ + (size_t)j * 256) * 128;
    r.O = (swa::bf16*)dout; r.ldo = 128; r.rows = (const int*)(ws + WS_ROWL) + (size_t)bh * LSTR + lp; r.dst = (const int*)(ws + WS_DSTL) + (size_t)bh * LSTR + lp; r.stat = (float*)(ws + WS_STATS); r.P0 = p0;
    return r;
}

__global__ void __launch_bounds__(NWAVES * 64, 2) mk_fwd(Args args) {
    extern __shared__ __attribute__((aligned(16))) unsigned char lds[];
    LAS unsigned char* L = (LAS unsigned char*)lds;
    const int tid = threadIdx.x, lane = tid & 63, wave = __builtin_amdgcn_readfirstlane(tid >> 6);
    const int G = gridDim.x, bx = blockIdx.x;
    const int vcu = (G % 8 == 0) ? (bx % 8) * (G / 8) + bx / 8 : bx;
    const int gw = vcu * NWAVES + wave, NGW = G * NWAVES;
    unsigned char* ws = args.ws;
#define x_in (args.in[0])
#define p_in (args.in[1])
#define Win_t ((bf16*)(ws + WS_WIN))
#define Wa_t ((bf16*)(ws + WS_WA))
#define Wb_t ((bf16*)(ws + WS_WB))
#define Wout_t ((bf16*)(ws + WS_WOUT))
#define Wup_t ((bf16*)(ws + WS_WUP))
#define Wdn_t ((bf16*)(ws + WS_WDN))
#define Wpg_t ((bf16*)(ws + WS_WPG))
#define Wpp_t ((bf16*)(ws + WS_WPP))
#define XN ((bf16*)(ws + WS_XN))
#define PB ((bf16*)(ws + WS_PB))
#define QKV ((bf16*)(ws + WS_QKV))
#define SG ((bf16*)(ws + WS_SG))
#define OAB ((bf16*)(ws + WS_XN))
#define MIX ((bf16*)(ws + WS_MIX))
#define HID ((bf16*)(ws + WS_HID))
#define G3 ((bf16*)(ws + WS_G3))
#define Y ((bf16*)(ws + WS_Y))
#define rope ((float*)(ws + WS_ROPE))
#define kmean ((float*)(ws + WS_KMEAN))
#define out (args.out)
    const int lo = args.ph_lo, hi = args.ph_hi;
#define IN(k) (lo <= (k) && (k) < hi)
#define SEAM(k) do { if (IN(k) && IN((k) + 1)) { if (args.coop) { if ((k) == 0) { asm volatile("s_waitcnt vmcnt(0) lgkmcnt(0)" ::: "memory"); cg::this_grid().sync(); } else { xcd_barrier(xbar); } } } } while (0)
    volatile LAS unsigned* bst = (volatile LAS unsigned*)(L + LDS_BYTES - 64);
    if (tid < 2) bst[tid] = 0u;
    __syncthreads();
    XcdBarrier xbar; xbar.bar = (unsigned*)(ws + WS_BAR); xbar.x = 0; xbar.st = bst;
    if (args.coop) xbar = xcd_barrier_post((unsigned*)(ws + WS_BAR), bst);

    if (IN(0)) {
        LAS float* scr = (LAS float*)(L + wave * 16896);
        constexpr int I_IN = (DM / 64) * (INW / 64), I_BR = (1024 / 64) * (DM / 64), I_OUT = (DM / 64) * (DM / 64), I_UP = (DM / 64) * (DFF / 64), I_DN = (DFF / 64) * (DM / 64), I_PP = (PLE / 64) * (DM / 64);
        constexpr int NITEMS = I_IN + 2 * I_BR + I_OUT + I_UP + I_DN + I_OUT + I_PP;
        for (int it = gw; it < NITEMS; it += NGW) {
            int r = it;
            if (r < I_IN) { p0_transpose_item(args.in[2], DM, INW, Win_t, scr, r, lane); continue; } r -= I_IN;
            if (r < I_BR) { p0_transpose_item(args.in[3], 1024, DM, Wa_t, scr, r, lane, 2048); continue; } r -= I_BR;
            if (r < I_BR) { p0_transpose_item(args.in[4], 1024, DM, Wa_t + 1024, scr, r, lane, 2048); continue; } r -= I_BR;
            if (r < I_OUT) { p0_transpose_item(args.in[5], DM, DM, Wout_t, scr, r, lane); continue; } r -= I_OUT;
            if (r < I_UP) { p0_transpose_item(args.in[13], DM, DFF, Wup_t, scr, r, lane); continue; } r -= I_UP;
            if (r < I_DN) { p0_transpose_item(args.in[14], DFF, DM, Wdn_t, scr, r, lane); continue; } r -= I_DN;
            if (r < I_OUT) { p0_transpose_item(args.in[18], DM, DM, Wpg_t, scr, r, lane, DM + PLE); continue; } r -= I_OUT;
            p0_transpose_item(args.in[17], PLE, DM, Wpg_t + DM, scr, r, lane, DM + PLE);
        }
        for (int m = gw; m < T; m += NGW) rms_row_to_bf16(x_in + (size_t)m * DM, args.in[11], XN + (size_t)m * DM, lane);
        if (bx == 0) { for (int i = tid; i < 16 * 64 + 16; i += 512) { if (i < 1024) ((int*)(ws + WS_CNT))[i] = 0; else ((int*)(ws + WS_NBLK))[i - 1024] = 0; } }
        for (int i = bx * 512 + tid; i < 16 * 64 * 128; i += G * 512) kmean[i] = 0.f;
        for (int i = bx * 512 + tid; i < SEQ * 16; i += G * 512) { const int pos = i >> 4, k = i & 15;
            double fr_ = 1.0; for (int j_ = 0; j_ < k; ++j_) fr_ *= 0.4403666026717805;
            const float angf = (float)pos * (float)fr_; const double a = (double)angf;
            const double TWO_PI = 6.283185307179586476925286766559; double q = __builtin_rint(a / TWO_PI); double r = a - q * TWO_PI;
            const double r2 = r * r; double sn = 1.0, cs = 1.0;
            sn = 1.0 - r2 / (22.0 * 23.0); sn = 1.0 - r2 / (20.0 * 21.0) * sn; sn = 1.0 - r2 / (18.0 * 19.0) * sn; sn = 1.0 - r2 / (16.0 * 17.0) * sn; sn = 1.0 - r2 / (14.0 * 15.0) * sn; sn = 1.0 - r2 / (12.0 * 13.0) * sn;
            sn = 1.0 - r2 / (10.0 * 11.0) * sn; sn = 1.0 - r2 / (8.0 * 9.0) * sn; sn = 1.0 - r2 / (6.0 * 7.0) * sn; sn = 1.0 - r2 / (4.0 * 5.0) * sn; sn = 1.0 - r2 / (2.0 * 3.0) * sn; sn = r * sn;
            cs = 1.0 - r2 / (21.0 * 22.0); cs = 1.0 - r2 / (19.0 * 20.0) * cs; cs = 1.0 - r2 / (17.0 * 18.0) * cs; cs = 1.0 - r2 / (15.0 * 16.0) * cs; cs = 1.0 - r2 / (13.0 * 14.0) * cs; cs = 1.0 - r2 / (11.0 * 12.0) * cs;
            cs = 1.0 - r2 / (9.0 * 10.0) * cs; cs = 1.0 - r2 / (7.0 * 8.0) * cs; cs = 1.0 - r2 / (5.0 * 6.0) * cs; cs = 1.0 - r2 / (3.0 * 4.0) * cs; cs = 1.0 - r2 / (1.0 * 2.0) * cs;
            rope[(size_t)pos * 32 + k] = (float)cs; rope[(size_t)pos * 32 + 16 + k] = (float)sn; }
    }
    SEAM(0);
    if (IN(1)) {
        pg8::Gemm g{XN, Win_t, T, INW, DM}; pg8::StaticOrder S; S.init(T, INW, G, bx);
        pg8::EpiInProj E{QKV, SG, (const float*)rope, kmean};
        pg8::gemm_phase<pg8::EpiInProj, pg8::StaticOrder, true, true>(L, g, S, E);
    }
    SEAM(1);
    if (IN(3)) {
        LAS float* km = (LAS float*)L;
        const bf16* QA = QKV;
        for (int u = vcu; u < 16 * 64; u += G) {
            const int bh = u & 15, qb = u >> 4;
            __syncthreads();
            for (int i = tid; i < qb * 128 / 4; i += 512) *(LAS f32x4*)(km + i * 4) = *(const f32x4*)(kmean + (size_t)bh * 64 * 128 + i * 4);
            __syncthreads();
            const int row = tid >> 1, half = tid & 1;
            const bf16* qp = QA + ((size_t)bh * SEQ + (size_t)qb * 256 + row) * 128 + half * 64;
            float q[64];
#pragma unroll
            for (int i = 0; i < 8; ++i) { const v4u w = *(const v4u*)(qp + i * 8);
                q[8 * i + 0] = bflo(w.x); q[8 * i + 1] = bfhi(w.x); q[8 * i + 2] = bflo(w.y); q[8 * i + 3] = bfhi(w.y); q[8 * i + 4] = bflo(w.z); q[8 * i + 5] = bfhi(w.z); q[8 * i + 6] = bflo(w.w); q[8 * i + 7] = bfhi(w.w); }
            float g0 = -__builtin_inff(), g1 = g0, g2 = g0; int i0 = -1, i1 = -1, i2 = -1;
            for (int n = 0; n < qb; ++n) {
                const LAS float* kp = km + n * 128 + half * 64; float s = 0.f;
#pragma unroll
                for (int i = 0; i < 16; ++i) { const f32x4 kv = *(const LAS f32x4*)(kp + 4 * i); s += q[4 * i] * kv.x + q[4 * i + 1] * kv.y + q[4 * i + 2] * kv.z + q[4 * i + 3] * kv.w; }
                s += __shfl_xor(s, 1);
                if (s > g0) { g2 = g1; i2 = i1; g1 = g0; i1 = i0; g0 = s; i0 = n; }
                else if (s > g1) { g2 = g1; i2 = i1; g1 = s; i1 = n; }
                else if (s > g2) { g2 = s; i2 = n; }
            }
            if (half == 0) {
                const int grow = qb * 256 + row; int s0 = -1, s1 = -1, s2 = -1; int* cnt = (int*)(ws + WS_CNT) + bh * 64; float2* stt = (float2*)(ws + WS_STATS);
                float2 none; none.x = -1e30f; none.y = 0.f;
                if (i0 >= 0) s0 = atomicAdd(cnt + i0, 1); else stt[(size_t)(bh * 4 + 0) * SEQ + grow] = none;
                if (i1 >= 0) s1 = atomicAdd(cnt + i1, 1); else stt[(size_t)(bh * 4 + 1) * SEQ + grow] = none;
                if (i2 >= 0) s2 = atomicAdd(cnt + i2, 1); else stt[(size_t)(bh * 4 + 2) * SEQ + grow] = none;
                int4 rec; rec.x = (i0 & 255) | ((i1 & 255) << 8) | ((i2 & 255) << 16); rec.y = s0; rec.z = s1; rec.w = s2;
                ((int4*)(ws + WS_SEL))[(size_t)bh * SEQ + grow] = rec; }
        }
        __syncthreads();
    }
    SEAM(3);
    if (IN(4)) {
        LAS int* cn = (LAS int*)L; LAS int* offs = cn + 64;
        int* ROWL = (int*)(ws + WS_ROWL); int* DSTL = (int*)(ws + WS_DSTL);
        for (int u = vcu; u < 16 * 64; u += G) {
            const int bh = u & 15, chunk = u >> 4;
            __syncthreads();
            if (tid < 64) cn[tid] = ((const int*)(ws + WS_CNT))[bh * 64 + tid];
            __syncthreads();
            if (tid == 0) { int a = 0; for (int j = 0; j < 64; ++j) { offs[j] = a; a += (cn[j] + 255) & ~255; } offs[64] = a; }
            __syncthreads();
            int* rl = ROWL + (size_t)bh * LSTR; int* dl = DSTL + (size_t)bh * LSTR;
            if (tid < 256) { const int row = chunk * 256 + tid; const int4 rec = ((const int4*)(ws + WS_SEL))[(size_t)bh * SEQ + row];
                const int j0 = rec.x & 255, j1 = (rec.x >> 8) & 255, j2 = (rec.x >> 16) & 255;
                if (j0 != 255) { const int gp = offs[j0] + rec.y; rl[gp] = row; dl[gp] = (bh * 4 + 0) * SEQ + row; }
                if (j1 != 255) { const int gp = offs[j1] + rec.z; rl[gp] = row; dl[gp] = (bh * 4 + 1) * SEQ + row; }
                if (j2 != 255) { const int gp = offs[j2] + rec.w; rl[gp] = row; dl[gp] = (bh * 4 + 2) * SEQ + row; }
                rl[65536 + row] = row; dl[65536 + row] = (bh * 4 + 3) * SEQ + row; }
            if (chunk == 0) {
                for (int idx = tid; idx < 64 * 256; idx += 512) { const int j = idx >> 8, c = cn[j], pos = c + (idx & 255);
                    if (pos < ((c + 255) & ~255)) { rl[offs[j] + pos] = 0; dl[offs[j] + pos] = -1; } }
                if (tid == 0) { int k = 0; int2* tab = (int2*)(ws + WS_TAB) + bh * 256;
                    for (int j = 0; j < 64; ++j) { const int nb = (cn[j] + 255) >> 8; for (int b_ = 0; b_ < nb; ++b_) { if (k < 256) { int2 t; t.x = j; t.y = offs[j] + 256 * b_; tab[k] = t; } ++k; } }
                    ((int*)(ws + WS_NBLK))[bh] = k < 256 ? k : 256; }
            }
        }
        __syncthreads();
    }
    SEAM(4);
    if (IN(5)) {
        const int* nblk = (const int*)(ws + WS_NBLK);
        int Lc = vcu; if (!moba_valid(Lc, nblk)) Lc = moba_next(Lc, G, nblk);
        if (Lc < MOBA_ITEMS) {
            ABlock cur = moba_ref(Lc, ws, out);
            swa::Seam<swa::bf16> S;
            swa::causal_swa_prime<swa::bf16, swa::bf16>(cur, SEQ, (char*)lds, S);
            for (;;) {
                const int Ln = moba_next(Lc, G, nblk); const bool last = Ln >= MOBA_ITEMS;
                ABlock nxt = cur; if (!last) nxt = moba_ref(Ln, ws, out);
                swa::causal_swa_block<swa::bf16, swa::bf16>(cur, nxt, 256, SEQ, (char*)lds, S);
                if (last) break;
                cur = nxt; Lc = Ln;
            }
        }
        __syncthreads();
    }
    SEAM(5);
    if (IN(6)) {
        const float2* stt = (const float2*)(ws + WS_STATS); const bf16* PART = (const bf16*)out; constexpr float C2 = 1.4426950408889634f * 0.08838834764831845f;
        for (int u0 = gw; u0 < 16 * SEQ; u0 += 4 * NGW) {
            float2 st[4][4]; unsigned pw[4][4];
#pragma unroll
            for (int k = 0; k < 4; ++k) { const int u = u0 + k * NGW, bh = u >> 14, row = u & (SEQ - 1);
#pragma unroll
                for (int s_ = 0; s_ < 4; ++s_) { const size_t di = (size_t)(bh * 4 + s_) * SEQ + row; st[k][s_] = stt[di]; pw[k][s_] = ntload((const unsigned*)(PART + di * 128 + lane * 2)); } }
#pragma unroll
            for (int k = 0; k < 4; ++k) { const int u = u0 + k * NGW, bh = u >> 14, row = u & (SEQ - 1);
                float M = -1e30f;
#pragma unroll
                for (int s_ = 0; s_ < 4; ++s_) if (st[k][s_].y > 0.f) M = fmaxf(M, st[k][s_].x);
                float a0 = 0.f, a1 = 0.f, den = 0.f;
#pragma unroll
                for (int s_ = 0; s_ < 4; ++s_) { const bool ok = st[k][s_].y > 0.f; const float w = ok ? st[k][s_].y * __builtin_amdgcn_exp2f((st[k][s_].x - M) * C2) : 0.f;
                    a0 += ok ? w * bflo(pw[k][s_]) : 0.f; a1 += ok ? w * bfhi(pw[k][s_]) : 0.f; den += w; }
                const float inv = 1.0f / den;
                *(unsigned*)(OAB + ((size_t)(bh >> 3) * SEQ + row) * 2048 + (bh & 7) * 128 + lane * 2) = pk2(a0 * inv, a1 * inv); } }
    }
    SEAM(6);
    if (IN(7)) {
        constexpr int NITEM = 32 * 32;
        int Lc = vcu;
        if (Lc < NITEM) {
            int head = Lc >> 5, xx = Lc & 31, pass = 0;
            ABlock cur = attn_ref(head, xx, ws, out);
            swa::Seam<swa::bf16> S;
            swa::causal_swa_prime<swa::bf16, swa::bf16>(cur, SEQ, (char*)lds, S);
            for (;;) {
                const bool more_pass = pass == 0, more_item = Lc + G < NITEM, last = !more_pass && !more_item;
                int headn = head, xn = xx, passn = pass + 1, Ln = Lc;
                if (!more_pass) { passn = 0; Ln = more_item ? Lc + G : Lc; headn = Ln >> 5; xn = Ln & 31; }
                const int qbn = passn ? 63 - xn : xn;
                ABlock nxt = cur;
                if (!last) nxt = attn_ref(headn, qbn, ws, out);
                swa::causal_swa_block<swa::bf16, swa::bf16>(cur, nxt, SEQ, SEQ, (char*)lds, S);
                if (last) break;
                cur = nxt; head = headn; xx = xn; pass = passn; Lc = Ln;
            }
        }
        __syncthreads();
    }
    SEAM(7);
    if (IN(8)) {
        float lam;
        { const float* q1 = args.in[6]; const float* k1 = args.in[7]; const float* q2 = args.in[8]; const float* k2 = args.in[9];
          const float s1 = wave_sum(q1[lane] * k1[lane] + q1[lane + 64] * k1[lane + 64]), s2 = wave_sum(q2[lane] * k2[lane] + q2[lane + 64] * k2[lane + 64]);
          lam = __expf(s1) - __expf(s2) + LAMBDA_INIT; }
        const bf16* AD = (const bf16*)out; const float* sg = args.in[10];
        const f32x4 gg = *(const f32x4*)(sg + lane * 4);
        for (int u0 = gw; u0 < T * 4; u0 += 4 * NGW) {
            v2u w0[4], w1[4];
#pragma unroll
            for (int k = 0; k < 4; ++k) { const int u = u0 + k * NGW, t = u >> 2, hd = u & 3; const bf16* a = AD + (size_t)t * 4096 + hd * 512 + lane * 4; w0[k] = ntload((const v2u*)a); w1[k] = ntload((const v2u*)(a + 256)); }
#pragma unroll
            for (int k = 0; k < 4; ++k) { const int u = u0 + k * NGW, t = u >> 2, hd = u & 3;
                f32x4 d; d.x = bflo(w0[k].x) - lam * bflo(w1[k].x); d.y = bfhi(w0[k].x) - lam * bfhi(w1[k].x); d.z = bflo(w0[k].y) - lam * bflo(w1[k].y); d.w = bfhi(w0[k].y) - lam * bfhi(w1[k].y);
                const float ss = wave_sum((d.x * d.x + d.y * d.y) + (d.z * d.z + d.w * d.w));
                const float r = (1.0f - LAMBDA_INIT) / sqrtf(ss * (1.f / 256.f) + NORM_EPS);
                v2u o; o.x = pk2(d.x * r * gg.x, d.y * r * gg.y); o.y = pk2(d.z * r * gg.z, d.w * r * gg.w);
                *(v2u*)(OAB + (size_t)t * 2048 + 1024 + hd * 256 + lane * 4) = o; } }
    }
    SEAM(8);
    if (IN(9)) { pg8::Gemm g{OAB, Wa_t, T, DM, 2048}; pg8::StaticOrder S; S.init(T, DM, G, bx); pg8::EpiGate2 E{MIX, SG};
        pg8::gemm_phase<pg8::EpiGate2, pg8::StaticOrder, true, true, true>(L, g, S, E); }
    SEAM(9);
    if (IN(11)) { pg8::Gemm g{MIX, Wout_t, T, DM, DM}; pg8::StaticOrder S; S.init(T, DM, G, bx); pg8::EpiT<0> E{Y, DM, nullptr, 0};
        pg8::gemm_phase<pg8::EpiT<0>, pg8::StaticOrder, true, true>(L, g, S, E); }
    SEAM(11);
    if (IN(12)) row_pass(Y, x_in, args.in[12], out, args.in[15], XN, gw, NGW, lane);
    SEAM(12);
    if (IN(13)) { pg8::Gemm g{XN, Wup_t, T, DFF, DM}; pg8::StaticOrder S; S.init(T, DFF, G, bx); pg8::EpiT<1> E{HID, DFF, nullptr, 0};
        pg8::gemm_phase<pg8::EpiT<1>, pg8::StaticOrder, true, true>(L, g, S, E); }
    SEAM(13);
    if (IN(14)) { pg8::Gemm g{HID, Wdn_t, T, DM, DFF}; pg8::StaticOrder S; S.init(T, DM, G, bx); pg8::EpiT<0> E{Y, DM, nullptr, 0};
        pg8::gemm_phase<pg8::EpiT<0>, pg8::StaticOrder, true, true>(L, g, S, E); }
    SEAM(14);
    if (IN(15)) row_pass(Y, out, args.in[16], out, args.in[19], (bf16*)(ws + WS_XN3), gw, NGW, lane, DM + PLE, p_in);
    SEAM(15);
    if (IN(16)) { pg8::Gemm g{(bf16*)(ws + WS_XN3), Wpg_t, T, DM, DM + PLE}; pg8::StaticOrder S; S.init(T, DM, G, bx); pg8::EpiPle E{Y, G3};
        pg8::gemm_phase<pg8::EpiPle, pg8::StaticOrder, true, true, true>(L, g, S, E); }
    SEAM(17);
    if (IN(18)) row_pass(Y, out, args.in[20], out, nullptr, nullptr, gw, NGW, lane);
#undef IN
#undef SEAM
#undef x_in
#undef p_in
#undef Win_t
#undef Wa_t
#undef Wb_t
#undef Wout_t
#undef Wup_t
#undef Wdn_t
#undef Wpg_t
#undef Wpp_t
#undef XN
#undef PB
#undef QKV
#undef SG
#undef OAB
#undef MIX
#undef HID
#undef G3
#undef Y
#undef rope
#undef kmean
#undef out
}

extern "C" void kernel_launch(void* const* d_in, const int* in_sizes, int n_in, void* d_out, int out_size, void* d_ws, size_t ws_size, hipStream_t stream) {
    static int grid = 0;
    if (grid == 0) {
        if (n_in != 21 || out_size != T * DM || ws_size < WS_TOP) { fprintf(stderr, "kernel_launch: unexpected shapes n_in %d out %d ws %zu\n", n_in, out_size, ws_size); grid = -1; return; }
        int dev = 0, cus = 0, per_cu = 0;
        (void)hipGetDevice(&dev); (void)hipDeviceGetAttribute(&cus, hipDeviceAttributeMultiprocessorCount, dev);
        if (hipFuncSetAttribute((const void*)mk_fwd, hipFuncAttributeMaxDynamicSharedMemorySize, LDS_BYTES) != hipSuccess) { fprintf(stderr, "kernel_launch: hipFuncSetAttribute failed\n"); grid = -1; return; }
        if (hipOccupancyMaxActiveBlocksPerMultiprocessor(&per_cu, (const void*)mk_fwd, NWAVES * 64, LDS_BYTES) != hipSuccess || per_cu < 1) { fprintf(stderr, "kernel_launch: occupancy query says %d\n", per_cu); per_cu = 1; }
        (void)hipGetLastError();
        grid = cus * 1;
        if (grid <= 0) grid = 256;
    }
    if (grid < 0) return;
    (void)hipMemsetAsync((unsigned char*)d_ws + WS_BAR, 0, WS_BAR_BYTES, stream);
    Args a{};
    for (int i = 0; i < 21; ++i) a.in[i] = (const float*)d_in[i];
    a.out = (float*)d_out; a.ws = (unsigned char*)d_ws;
#if MK_ONE_LAUNCH
    a.ph_lo = 0; a.ph_hi = NPHASE; a.coop = 1;
    void* kargs[] = {&a};
    hipError_t e = hipLaunchCooperativeKernel((const void*)mk_fwd, dim3(grid), dim3(NWAVES * 64), kargs, LDS_BYTES, stream);
    if (e != hipSuccess) fprintf(stderr, "cooperative launch failed: %s (grid %d)\n", hipGetErrorString(e), grid);
#else
    for (int ph = 0; ph < NPHASE; ++ph) { a.ph_lo = ph; a.ph_hi = ph + 1; a.coop = 0;
        hipLaunchKernelGGL(mk_fwd, dim3(grid), dim3(NWAVES * 64), LDS_BYTES, stream, a); }
#endif
}
```

```cpp
#include <hip/hip_runtime.h>
#include <hip/hip_bf16.h>
#include <cstdio>
#include <cstdint>
#include <cmath>
namespace pg8 {
#define PG8_LAS __attribute__((address_space(3)))
typedef unsigned short bf16_t;
typedef short bf16x8 __attribute__((ext_vector_type(8)));
typedef float f32x4 __attribute__((ext_vector_type(4)));
typedef unsigned u32x4 __attribute__((ext_vector_type(4)));
constexpr int BM = 256, BK = 64, HALF = 128, HTB = HALF * BK * 2  , STAGE_BYTES = 8 * HTB, NXCD = 8, WGM = 8;

__host__ __device__ __forceinline__ int lds_byte(int r, int c) { const int st = (r >> 4) * 2 + (c >> 5), rr = r & 15, cc = c & 31, ob = rr * 64 + cc * 2; return st * 1024 + (ob ^ (((ob >> 9) & 1) << 5)); }
__host__ __device__ __forceinline__ void stage_rc(int b, int& R, int& C) { const int st = b / 1024, sb = b % 1024, swz = sb ^ (((sb >> 9) & 1) << 5); R = (st >> 1) * 16 + swz / 64; C = (st & 1) * 32 + (swz % 64) / 2; }
__host__ __device__ __forceinline__ int perm32(int rho) { const int n = rho >> 4, i = rho & 15; return 8 * (i >> 2) + 4 * n + (i & 3); }

struct Unit { int pm, pn; };
struct Gemm { const bf16_t* A; const bf16_t* Bt; int M, N, K; };

struct StaticOrder {
    int nM, nN, nwg, G, c;
    __host__ __device__ void init(int M, int N, int G_, int c_) { nM = M / BM; nN = N / BM; nwg = nM * nN; G = G_; c = c_; }
    __host__ __device__ bool next(int i, Unit& u) const {
        const long L = (long)i * G + c; if (L >= nwg) return false;
        int wgid = (int)L; { const int q = nwg / NXCD, r = nwg % NXCD, xcd = wgid % NXCD, off = wgid / NXCD; wgid = (xcd < r ? xcd * (q + 1) : r * (q + 1) + (xcd - r) * q) + off; }
        const int nig = WGM * nN, gid = wgid / nig, fm = gid * WGM, gsz = (nM - fm) < WGM ? (nM - fm) : WGM;
        u.pm = fm + ((wgid % nig) % gsz); u.pn = (wgid % nig) / gsz; return true;
    }
    __device__ __forceinline__ void a_ready(const Unit&) const {}
    __device__ __forceinline__ void done(const Unit&) const {}
};

typedef float f32x2_c __attribute__((ext_vector_type(2))); typedef __bf16 bf16x2_c __attribute__((ext_vector_type(2)));
__device__ __forceinline__ unsigned cvt_pk_bf16(float lo, float hi) { f32x2_c v = {lo, hi}; bf16x2_c b = __builtin_convertvector(v, bf16x2_c); return __builtin_bit_cast(unsigned, b); }
typedef float f32x2 __attribute__((ext_vector_type(2)));
__device__ __forceinline__ f32x2 gelu_pk(f32x2 v) {
    const f32x2 av = __builtin_elementwise_abs(v), d = av * 0.2316418882f + 1.0f;
    f32x2 t; t.x = __builtin_amdgcn_rcpf(d.x); t.y = __builtin_amdgcn_rcpf(d.y);
    f32x2 q = t * 0.5307027145f + (-0.7265760135f); q = q * t + 0.7107068705f; q = q * t + (-0.142248368f); q = q * t + 0.127414796f; q = q * t;
    const f32x2 s = (v * v) * (-0.72134752044f);
    f32x2 e; e.x = __builtin_amdgcn_exp2f(s.x); e.y = __builtin_amdgcn_exp2f(s.y);
    const f32x2 m = v * (q * e), r = v - m;
    f32x2 o; o.x = v.x < 0.f ? m.x : r.x; o.y = v.y < 0.f ? m.y : r.y; return o;
}

template <int ACT  > struct EpiBf16 {
    static constexpr bool PERM = true, AFTER_DRAIN = false; static_assert(ACT == 0 || ACT == 1, "EpiBf16: ACT is 0 (none) or 1 (gelu_pk)");
    bf16_t* O; int ldc; const float* bias; int split_cols; size_t split_stride; float scale0;
    __device__ __forceinline__ void operator()(const f32x4 (&acc)[2][2][4][2], const Unit& u, int wr, int wc, int fr, int fq) const {
        const int row0 = u.pm * BM + wr * 64 + fr; int colt = u.pn * BM; bf16_t* base = O;
        float sc = 1.f; if (split_cols) { const int t = colt / split_cols; base += (size_t)t * split_stride; colt -= t * split_cols; if (t == 0) sc = scale0; }
        const int col0 = colt + wc * 32 + 8 * fq, bcol0 = u.pn * BM + wc * 32 + 8 * fq;
        f32x4 bv[2][2];
#pragma unroll
        for (int bj = 0; bj < 2; ++bj)
#pragma unroll
            for (int n = 0; n < 2; ++n) bv[bj][n] = bias ? *(const f32x4*)(bias + bcol0 + bj * HALF + 4 * n) : (f32x4){0.f, 0.f, 0.f, 0.f};
#pragma unroll
        for (int ai = 0; ai < 2; ++ai)
#pragma unroll
            for (int m = 0; m < 4; ++m) { bf16_t* rowp = base + (size_t)(row0 + ai * HALF + m * 16) * ldc + col0;
#pragma unroll
                for (int bj = 0; bj < 2; ++bj) { f32x4 v0 = acc[ai][bj][m][0] + bv[bj][0], v1 = acc[ai][bj][m][1] + bv[bj][1];
                    if (ACT == 1) { f32x2 a = gelu_pk((f32x2){v0[0], v0[1]}), b = gelu_pk((f32x2){v0[2], v0[3]}), c = gelu_pk((f32x2){v1[0], v1[1]}), d = gelu_pk((f32x2){v1[2], v1[3]});
                        v0 = (f32x4){a.x, a.y, b.x, b.y}; v1 = (f32x4){c.x, c.y, d.x, d.y}; }
                    v0 = v0 * sc; v1 = v1 * sc; u32x4 w; w.x = cvt_pk_bf16(v0[0], v0[1]); w.y = cvt_pk_bf16(v0[2], v0[3]); w.z = cvt_pk_bf16(v1[0], v1[1]); w.w = cvt_pk_bf16(v1[2], v1[3]);
                    *(u32x4*)(rowp + bj * HALF) = w; } }
    }
};

template <class Epi, class Sched, bool ALIGN_EPI = false, bool SP2 = false, bool MID = false>
__device__ __forceinline__ void gemm_phase(PG8_LAS unsigned char* lds, const Gemm g, const Sched& S, const Epi& E) {
    const int tid = threadIdx.x, wid = __builtin_amdgcn_readfirstlane(tid >> 6), lane = tid & 63, wr = wid >> 2, wc = wid & 3, fr = lane & 15, fq = lane >> 4;
    const int K = g.K, nt = K / BK;
    unsigned voffA[2], voffB[2];
#pragma unroll
    for (int i = 0; i < 2; ++i) { int R, C; stage_rc(tid * 16 + i * 8192, R, C); const int Rb = Epi::PERM ? ((R & ~31) + perm32(R & 31)) : R;
        voffA[i] = (unsigned)(R * K + C) * 2u; voffB[i] = (unsigned)(Rb * K + C) * 2u; }
    const size_t kstep = (size_t)(BK * 2);
    const size_t hstep = (size_t)HALF * K * 2;
    const size_t tstep = 2 * hstep;
    const unsigned ldsw = (unsigned)wid * 1024u;
    const int aoff = lds_byte(wr * 64 + fr, fq * 8), boff = lds_byte(wc * 32 + fr, fq * 8);
#define PG8_SA(b, h) (((b) * 2 + (h)) * HTB)
#define PG8_SB(b, h) ((4 + (b) * 2 + (h)) * HTB)
#define PG8_STAGE(bufoff, gbase, voff) do { _Pragma("unroll") for (int _i = 0; _i < 2; ++_i) \
        __builtin_amdgcn_global_load_lds((const unsigned*)((const char*)(gbase) + (voff)[_i]), (PG8_LAS unsigned*)(lds + (bufoff) + ldsw + _i * 8192), 16, 0, 0); } while (0)
#define PG8_LDA(dst, b, h) do { _Pragma("unroll") for (int m = 0; m < 4; ++m) _Pragma("unroll") for (int k = 0; k < 2; ++k) dst[m][k] = *(const PG8_LAS bf16x8*)(lds + PG8_SA(b, h) + aoff + m * 2048 + k * 1024); } while (0)
#define PG8_LDB(dst, b, h) do { _Pragma("unroll") for (int n = 0; n < 2; ++n) _Pragma("unroll") for (int k = 0; k < 2; ++k) dst[n][k] = *(const PG8_LAS bf16x8*)(lds + PG8_SB(b, h) + boff + n * 2048 + k * 1024); } while (0)
#define PG8_MMA(ai, bj, At, Bt) do { __builtin_amdgcn_s_setprio(1); _Pragma("unroll") for (int m = 0; m < 4; ++m) _Pragma("unroll") for (int n = 0; n < 2; ++n) _Pragma("unroll") for (int k = 0; k < 2; ++k) \
        acc[ai][bj][m][n] = __builtin_amdgcn_mfma_f32_16x16x32_bf16(Bt[n][k], At[m][k], acc[ai][bj][m][n], 0, 0, 0); __builtin_amdgcn_s_setprio(0); } while (0)
#define PG8_WAIT_V(n) asm volatile("s_waitcnt vmcnt(" #n ")" ::: "memory")
#define PG8_WAIT_L(n) asm volatile("s_waitcnt lgkmcnt(" #n ")" ::: "memory")
#define PG8_BAR __builtin_amdgcn_s_barrier()
#define PG8_SCHED __builtin_amdgcn_sched_barrier(0)
    Unit cur, nxt; int ui = 0;
    if (!S.next(0, cur)) return;
    f32x4 acc[2][2][4][2];
#pragma unroll
    for (int a = 0; a < 2; ++a)
#pragma unroll
        for (int b = 0; b < 2; ++b)
#pragma unroll
            for (int m = 0; m < 4; ++m)
#pragma unroll
                for (int n = 0; n < 2; ++n) acc[a][b][m][n] = (f32x4){0.f, 0.f, 0.f, 0.f};
    bf16x8 At[4][2], B0[2][2], B1[2][2];
    const char* cA = (const char*)g.A + (size_t)cur.pm * tstep; const char* cB = (const char*)g.Bt + (size_t)cur.pn * tstep;
    S.a_ready(cur);
    if constexpr (SP2) {
        PG8_STAGE(PG8_SB(0, 0), cB, voffB); PG8_STAGE(PG8_SB(0, 1), cB + hstep, voffB); PG8_STAGE(PG8_SA(0, 0), cA, voffA); PG8_STAGE(PG8_SA(0, 1), cA + hstep, voffA);
        if (wr == 1) PG8_BAR;
        PG8_WAIT_V(2); PG8_BAR;
        PG8_STAGE(PG8_SB(1, 0), cB + kstep, voffB); PG8_STAGE(PG8_SA(1, 0), cA + kstep, voffA); PG8_STAGE(PG8_SB(1, 1), cB + hstep + kstep, voffB);
        PG8_WAIT_V(6); PG8_BAR;
    } else {
        PG8_STAGE(PG8_SB(0, 0), cB, voffB); PG8_STAGE(PG8_SA(0, 0), cA, voffA); PG8_STAGE(PG8_SB(0, 1), cB + hstep, voffB); PG8_STAGE(PG8_SA(0, 1), cA + hstep, voffA);
        if (wr == 1) PG8_BAR;
        PG8_WAIT_V(4); PG8_BAR;
        PG8_STAGE(PG8_SB(1, 0), cB + kstep, voffB); PG8_STAGE(PG8_SA(1, 0), cA + kstep, voffA); PG8_STAGE(PG8_SB(1, 1), cB + hstep + kstep, voffB);
        PG8_WAIT_V(6); PG8_BAR;
    }
    for (;;) {
        const bool has_next = S.next(ui + 1, nxt);
        const char* nA = has_next ? (const char*)g.A + (size_t)nxt.pm * tstep : cA; const char* nB = has_next ? (const char*)g.Bt + (size_t)nxt.pn * tstep : cB;
        for (int t = 0; t < nt; t += 2) {
            const bool last = (t == nt - 2);
            if constexpr (MID) { if (t == Epi::MID_T) { PG8_SCHED; E.mid(acc, cur, wr, wc, fr, fq); PG8_SCHED; } }
            const char* a1 = cA + (size_t)(t + 1) * kstep;
            const char* a2 = last ? nA : cA + (size_t)(t + 2) * kstep; const char* b2 = last ? nB : cB + (size_t)(t + 2) * kstep;
            const char* a3 = a2 + kstep; const char* b3 = b2 + kstep;
            if (last && has_next) S.a_ready(nxt);
            if constexpr (SP2) {
            PG8_LDB(B0, 0, 0); PG8_LDB(B1, 0, 1); PG8_SCHED; PG8_LDA(At, 0, 0); PG8_STAGE(PG8_SA(1, 1), a1 + hstep, voffA);
            PG8_WAIT_V(8); PG8_WAIT_L(0); PG8_BAR; PG8_MMA(0, 0, At, B0); PG8_MMA(0, 1, At, B1); PG8_BAR; PG8_SCHED;
            PG8_LDA(At, 0, 1); PG8_STAGE(PG8_SB(0, 0), b2, voffB); PG8_STAGE(PG8_SB(0, 1), b2 + hstep, voffB); PG8_STAGE(PG8_SA(0, 0), a2, voffA);
            PG8_WAIT_V(8); PG8_WAIT_L(0); PG8_BAR; PG8_MMA(1, 0, At, B0); PG8_MMA(1, 1, At, B1); PG8_BAR; PG8_SCHED;
            PG8_LDB(B0, 1, 0); PG8_LDB(B1, 1, 1); PG8_SCHED; PG8_LDA(At, 1, 0); PG8_STAGE(PG8_SA(0, 1), a2 + hstep, voffA);
            PG8_WAIT_V(8); PG8_WAIT_L(0); PG8_BAR; PG8_MMA(0, 0, At, B0); PG8_MMA(0, 1, At, B1); PG8_BAR; PG8_SCHED;
            PG8_LDA(At, 1, 1); PG8_STAGE(PG8_SB(1, 0), b3, voffB); PG8_STAGE(PG8_SB(1, 1), b3 + hstep, voffB); PG8_STAGE(PG8_SA(1, 0), a3, voffA);
            PG8_WAIT_V(8); PG8_WAIT_L(0); PG8_BAR; PG8_MMA(1, 0, At, B0); PG8_MMA(1, 1, At, B1); PG8_BAR; PG8_SCHED;
            } else {
            PG8_LDB(B0, 0, 0); PG8_SCHED; PG8_LDA(At, 0, 0); PG8_STAGE(PG8_SA(1, 1), a1 + hstep, voffA);
            PG8_WAIT_L(8); PG8_BAR; PG8_WAIT_L(0); PG8_MMA(0, 0, At, B0); PG8_BAR; PG8_SCHED;
            PG8_LDB(B1, 0, 1); PG8_STAGE(PG8_SB(0, 0), b2, voffB);
            PG8_BAR; PG8_WAIT_L(0); PG8_MMA(0, 1, At, B1); PG8_BAR;
            PG8_LDA(At, 0, 1); PG8_STAGE(PG8_SA(0, 0), a2, voffA);
            PG8_BAR; PG8_WAIT_L(0); PG8_MMA(1, 0, At, B0); PG8_BAR; PG8_SCHED;
            PG8_STAGE(PG8_SB(0, 1), b2 + hstep, voffB);
            PG8_WAIT_V(6); PG8_BAR; PG8_MMA(1, 1, At, B1); PG8_BAR;
            PG8_LDB(B0, 1, 0); PG8_SCHED; PG8_LDA(At, 1, 0); PG8_STAGE(PG8_SA(0, 1), a2 + hstep, voffA);
            PG8_WAIT_L(8); PG8_BAR; PG8_WAIT_L(0); PG8_MMA(0, 0, At, B0); PG8_BAR; PG8_SCHED;
            PG8_LDB(B1, 1, 1); PG8_STAGE(PG8_SB(1, 0), b3, voffB);
            PG8_BAR; PG8_WAIT_L(0); PG8_MMA(0, 1, At, B1); PG8_BAR;
            PG8_LDA(At, 1, 1); PG8_STAGE(PG8_SA(1, 0), a3, voffA);
            PG8_BAR; PG8_WAIT_L(0); PG8_MMA(1, 0, At, B0); PG8_BAR; PG8_SCHED;
            PG8_STAGE(PG8_SB(1, 1), b3 + hstep, voffB);
            PG8_WAIT_V(6); PG8_BAR; PG8_MMA(1, 1, At, B1); PG8_BAR;
            }
        }
        if constexpr (ALIGN_EPI) { if (wr == 0) PG8_BAR; }
        if constexpr (!Epi::AFTER_DRAIN) { E(acc, cur, wr, wc, fr, fq); S.done(cur); }
        if (!has_next) break;
#pragma unroll
        for (int a = 0; a < 2; ++a)
#pragma unroll
            for (int b = 0; b < 2; ++b)
#pragma unroll
                for (int m = 0; m < 4; ++m)
#pragma unroll
                    for (int n = 0; n < 2; ++n) acc[a][b][m][n] = (f32x4){0.f, 0.f, 0.f, 0.f};
        cur = nxt; cA = nA; cB = nB; ++ui;
        if constexpr (ALIGN_EPI) { if (wr == 1) PG8_BAR; }
    }
    PG8_WAIT_V(0);
    if constexpr (!ALIGN_EPI) { if (wr == 0) PG8_BAR; }
    PG8_BAR;
    if constexpr (Epi::AFTER_DRAIN) { E.fused(acc, cur, wr, wc, fr, fq, lds, wid, lane); S.done(cur); }
#undef PG8_SA
#undef PG8_SB
#undef PG8_STAGE
#undef PG8_LDA
#undef PG8_LDB
#undef PG8_MMA
#undef PG8_WAIT_V
#undef PG8_WAIT_L
#undef PG8_BAR
#undef PG8_SCHED
}
}
namespace swa {
constexpr int D = 128;
constexpr float THR = 8.f;
constexpr bool WSKIP = false;
constexpr float SCALE = 0.08838834764831845f;
constexpr int NW = 8, QBLK = 32, KVBLK = 64, QB = NW * QBLK;
constexpr int SHM_V = KVBLK * D * 2, SHM_K = KVBLK * D * 2;
constexpr int MSLOT_OFF = 2 * SHM_V + 2 * SHM_K + NW * 64 * 4, QLDS_OFF = MSLOT_OFF + 4096;
constexpr int LDS_BYTES = QLDS_OFF + NW * 8192;

using bf16 = __hip_bfloat16;
typedef short bf16x8 __attribute__((ext_vector_type(8)));
typedef short s16x4 __attribute__((ext_vector_type(4)));
typedef float f32x16 __attribute__((ext_vector_type(16)));
typedef float f32x4 __attribute__((ext_vector_type(4)));
typedef unsigned u32x4 __attribute__((ext_vector_type(4)));
template <class A, class Bt> struct same_t { static constexpr bool v = false; };
template <class A> struct same_t<A, A> { static constexpr bool v = true; };

#define KSWZ(row, colB) ((row) * 256 + ((colB) ^ (((row) & 7) << 4)))
#define SBAR() __builtin_amdgcn_sched_barrier(0)
__device__ __forceinline__ int v_st(int k, int c) { const int kk = (k & ~0xC) | ((k & 4) << 1) | ((k & 8) >> 1); return ((kk >> 3) * 4 + (c >> 5)) * 512 + ((kk & 7) * 32 + (c & 31)) * 2; }
__device__ __forceinline__ int v_rd_base(int lane) { return ((lane & 3) << 3) | (((lane >> 2) & 3) << 6) | (((lane >> 4) & 1) << 5) | (((lane >> 5) & 1) << 8); }
constexpr int v_rd_off(int d0, int ks, int half) { return d0 * 512 + ks * 4096 + half * 2048; }
__device__ __forceinline__ int crow(int r, int hi) { return (r & 3) + 8 * (r >> 2) + 4 * hi; }
typedef float f32x2_c __attribute__((ext_vector_type(2))); typedef __bf16 bf16x2_c __attribute__((ext_vector_type(2)));
__device__ __forceinline__ unsigned cvtpk(float lo, float hi) { f32x2_c v = {lo, hi}; bf16x2_c b = __builtin_convertvector(v, bf16x2_c); return __builtin_bit_cast(unsigned, b); }
__device__ __forceinline__ bf16x8 pack8(f32x4 a, f32x4 b) {
    u32x4 w = {cvtpk(a[0], a[1]), cvtpk(a[2], a[3]), cvtpk(b[0], b[1]), cvtpk(b[2], b[3])};
    return *reinterpret_cast<bf16x8*>(&w);
}
template <class T> __device__ __forceinline__ bf16x8 load8(const T* p) {
    if constexpr (same_t<T, float>::v) { return pack8(*(const f32x4*)p, *(const f32x4*)(p + 4)); }
    else { return *reinterpret_cast<const bf16x8*>(p); }
}
__device__ __forceinline__ void mask_tile(f32x16& p0, f32x16& p1, int dq, unsigned W) {
    const float NEG = -__builtin_inff();
#pragma unroll
    for (int r = 0; r < 16; ++r) {
        const int c = (r & 3) + 8 * (r >> 2);
        if ((unsigned)(dq - c) >= W) p0[r] = NEG;
        if ((unsigned)(dq - c - 32) >= W) p1[r] = NEG;
    }
}
__device__ __forceinline__ void partialSM(f32x16& p0, f32x16& p1, float& m_reg, float& mn, float& alpha) {
    float pmax = p0[0]; for (int r = 1; r < 16; ++r) pmax = fmaxf(pmax, p0[r]); for (int r = 0; r < 16; ++r) pmax = fmaxf(pmax, p1[r]);
    { auto rr = __builtin_amdgcn_permlane32_swap(__float_as_uint(pmax), __float_as_uint(pmax), false, false);
      pmax = fmaxf(__uint_as_float(rr[0]), __uint_as_float(rr[1])); }
    constexpr float C2 = 1.4426950408889634f * SCALE;
    if (__builtin_expect(__all((pmax - m_reg) * SCALE <= THR), 1)) { mn = m_reg; alpha = 1.f; }
    else { mn = fmaxf(m_reg, pmax); alpha = __builtin_amdgcn_exp2f((m_reg - mn) * C2); m_reg = mn; }
    const float mnL = -mn * C2;
    for (int r = 0; r < 16; ++r) p0[r] = fmaf(p0[r], C2, mnL); for (int r = 0; r < 16; ++r) p1[r] = fmaf(p1[r], C2, mnL);
    for (int r = 0; r < 16; ++r) p0[r] = __builtin_amdgcn_exp2f(p0[r]);
}
__device__ __forceinline__ void finishSM(f32x16& p0, f32x16& p1, float alpha, float& l_reg, bf16x8& pa0, bf16x8& pa1, bf16x8& pa2, bf16x8& pa3) {
    for (int r = 0; r < 16; ++r) p1[r] = __builtin_amdgcn_exp2f(p1[r]);
    float ps = 0; for (int r = 0; r < 16; ++r) ps += p0[r]; for (int r = 0; r < 16; ++r) ps += p1[r];
    { auto rr = __builtin_amdgcn_permlane32_swap(__float_as_uint(ps), __float_as_uint(ps), false, false);
      ps = __uint_as_float(rr[0]) + __uint_as_float(rr[1]); }
    l_reg = l_reg * alpha + ps;
#define PK4(P, B_, OUT) do { unsigned a0 = cvtpk(P[B_+0], P[B_+1]), a1 = cvtpk(P[B_+2], P[B_+3]);                          \
        unsigned b0 = cvtpk(P[B_+4], P[B_+5]), b1 = cvtpk(P[B_+6], P[B_+7]);                                             \
        auto r0 = __builtin_amdgcn_permlane32_swap(a0, b0, false, false); auto r1 = __builtin_amdgcn_permlane32_swap(a1, b1, false, false); \
        u32x4 w = {r0[0], r1[0], r0[1], r1[1]}; OUT = *reinterpret_cast<bf16x8*>(&w); } while (0)
    PK4(p0, 0, pa0); PK4(p0, 8, pa1); PK4(p1, 0, pa2); PK4(p1, 8, pa3);
#undef PK4
}
template <int KB, bool SK>
__device__ __forceinline__ void qkt(f32x16& p0, f32x16& p1, const char* K_lds, int r32, int hi, const bf16x8* qr, bool act) {
    if (SK && !act) { const float NEG = -__builtin_inff();
#pragma unroll
        for (int r = 0; r < 16; ++r) { p0[r] = NEG; p1[r] = NEG; } return; }
    p0 = f32x16{}; p1 = f32x16{};
    const char* kb[4];
#pragma unroll
    for (int dd = 0; dd < 4; ++dd) kb[dd] = K_lds + KB * SHM_K + KSWZ(r32, (dd * 16 + hi * 8) * 2);
#pragma unroll
    for (int d0 = 0; d0 < 8; ++d0) { const char* a = kb[d0 & 3] + (d0 >> 2) * 128;
        bf16x8 b0 = *reinterpret_cast<const bf16x8*>(a);
        bf16x8 b1 = *reinterpret_cast<const bf16x8*>(a + 32 * 256);
        const bf16x8 qf = qr[d0];
        p0 = __builtin_amdgcn_mfma_f32_32x32x16_bf16(b0, qf, p0, 0, 0, 0);
        p1 = __builtin_amdgcn_mfma_f32_32x32x16_bf16(b1, qf, p1, 0, 0, 0); }
}
template <int VB, bool SK>
__device__ __forceinline__ void pv_tile(f32x16* o, int vb0, bf16x8 pa0, bf16x8 pa1, bf16x8 pa2, bf16x8 pa3, bool act) {
    if (SK && !act) return;
#define TRRD(dst, off) asm volatile("ds_read_b64_tr_b16 %0, %1 offset:%2" : "=&v"(dst) : "v"(vb0), "i"(off) : "memory")
#define PV_D0(d0) do { s16x4 l0, l1, l2, l3, h0, h1, h2, h3; constexpr int b_ = VB * SHM_V + v_rd_off(d0, 0, 0);     \
        TRRD(l0, b_); TRRD(h0, b_ + 2048); TRRD(l1, b_ + 4096); TRRD(h1, b_ + 6144); TRRD(l2, b_ + 8192); TRRD(h2, b_ + 10240); TRRD(l3, b_ + 12288); TRRD(h3, b_ + 14336); \
        asm volatile("s_waitcnt lgkmcnt(0)" ::: "memory"); SBAR();                 \
        o[d0] = __builtin_amdgcn_mfma_f32_32x32x16_bf16(pa0, (bf16x8){l0[0], l0[1], l0[2], l0[3], h0[0], h0[1], h0[2], h0[3]}, o[d0], 0, 0, 0);   \
        o[d0] = __builtin_amdgcn_mfma_f32_32x32x16_bf16(pa1, (bf16x8){l1[0], l1[1], l1[2], l1[3], h1[0], h1[1], h1[2], h1[3]}, o[d0], 0, 0, 0);   \
        o[d0] = __builtin_amdgcn_mfma_f32_32x32x16_bf16(pa2, (bf16x8){l2[0], l2[1], l2[2], l2[3], h2[0], h2[1], h2[2], h2[3]}, o[d0], 0, 0, 0);   \
        o[d0] = __builtin_amdgcn_mfma_f32_32x32x16_bf16(pa3, (bf16x8){l3[0], l3[1], l3[2], l3[3], h3[0], h3[1], h3[2], h3[3]}, o[d0], 0, 0, 0); } while (0)
    PV_D0(0); PV_D0(1); PV_D0(2); PV_D0(3);
#undef PV_D0
#undef TRRD
}

template <class TIn, class TOut> struct BlockRef { const TIn* Q; const TIn* K; const TIn* V; TOut* O; int P0; int ldo; const int* rows; const int* dst; float* stat; };
template <class TIn> struct Seam {
    bf16x8 qr[8];
    bf16x8 st_v0, st_v1, st_k0, st_k1; f32x4 sf0, sf1, sf2, sf3;
    f32x4 tq[16];
};
__device__ __forceinline__ int swa_jlo(int P0, int W) { const int lowk = P0 - W + 1; return lowk > 0 ? lowk / KVBLK : 0; }
#define ROW(p, k0, rr) ((p) + (unsigned)(((k0) + (rr)) * D + sc))
#define VMW() asm volatile("s_waitcnt vmcnt(0)" ::: "memory")
#define VMWN(n) asm volatile("s_waitcnt vmcnt(%0)" :: "i"(n) : "memory")
#define SLOAD_H(Kp, Vp, k0) do { S.st_v0 = load8<TIn>(ROW(Vp, k0, sr)); S.st_v1 = load8<TIn>(ROW(Vp, k0, 32 + sr));              \
                         S.st_k0 = load8<TIn>(ROW(Kp, k0, sr)); S.st_k1 = load8<TIn>(ROW(Kp, k0, 32 + sr)); } while (0)
#define SWRITE_HK(bf) do { *(bf16x8*)(K_lds + (bf) * SHM_K + kws) = S.st_k0; *(bf16x8*)(K_lds + (bf) * SHM_K + kws + 32 * 256) = S.st_k1; } while (0)
#define SWRITE_HV(bf) do { *(bf16x8*)(V_lds + (bf) * SHM_V + vst0) = S.st_v0; *(bf16x8*)(V_lds + (bf) * SHM_V + vst1) = S.st_v1; } while (0)
#define SWRITE_H(bf) do { SWRITE_HV(bf); SWRITE_HK(bf); } while (0)
#define SLOAD_F(p, k0) do { S.sf0 = *(const f32x4*)ROW(p, k0, sr); S.sf1 = *(const f32x4*)(ROW(p, k0, sr) + 4);                \
                            S.sf2 = *(const f32x4*)ROW(p, k0, 32 + sr); S.sf3 = *(const f32x4*)(ROW(p, k0, 32 + sr) + 4); } while (0)
#define SWRITE_KF(bf) do { *(bf16x8*)(K_lds + (bf) * SHM_K + kws) = pack8(S.sf0, S.sf1); *(bf16x8*)(K_lds + (bf) * SHM_K + kws + 32 * 256) = pack8(S.sf2, S.sf3); } while (0)
#define SWRITE_VF(bf) do { *(bf16x8*)(V_lds + (bf) * SHM_V + vst0) = pack8(S.sf0, S.sf1); *(bf16x8*)(V_lds + (bf) * SHM_V + vst1) = pack8(S.sf2, S.sf3); } while (0)
template <class TIn, class TOut>
__device__ __forceinline__ void causal_swa_prime(const BlockRef<TIn, TOut>& cur, int W, char* lds, Seam<TIn>& S) {
    constexpr bool F32 = same_t<TIn, float>::v;
    const int tid = threadIdx.x, wid = __builtin_amdgcn_readfirstlane(tid >> 6), lane = tid & 63, r32 = lane & 31, hi = lane >> 5;
    const int sr = tid >> 4, sc = (tid & 15) * 8, kws = KSWZ(sr, sc * 2); char* K_lds = lds + 2 * SHM_V;
    const int kb0 = swa_jlo(cur.P0, W) * KVBLK;
    for (int d0 = 0; d0 < 8; ++d0) S.qr[d0] = load8<TIn>(cur.Q + (size_t)(wid * QBLK + r32) * D + d0 * 16 + hi * 8);
    if constexpr (F32) { SLOAD_F((const float*)cur.K, kb0); VMW(); SWRITE_KF(0); SBAR(); SLOAD_F((const float*)cur.V, kb0); }
    else { SLOAD_H(cur.K, cur.V, kb0); VMW(); SWRITE_HK(0); }
    __syncthreads();
}
template <class TIn, class TOut>
__device__ __forceinline__ void causal_swa_block(const BlockRef<TIn, TOut>& cur, const BlockRef<TIn, TOut>& nxt, int skv, int W, char* lds, Seam<TIn>& S) {
    constexpr bool F32 = same_t<TIn, float>::v;
    const int tid = threadIdx.x, wid = __builtin_amdgcn_readfirstlane(tid >> 6), lane = tid & 63, r32 = lane & 31, hi = lane >> 5;
    const int j_lo = swa_jlo(cur.P0, W);
    int j_hi = (cur.P0 + QB - 1) / KVBLK + 1; if (j_hi > skv / KVBLK) j_hi = skv / KVBLK;
    const int NT = j_hi - j_lo;
    const int kbn = swa_jlo(nxt.P0, W) * KVBLK;
    const int qlo = cur.P0 + wid * QBLK, qm = qlo + r32 - 4 * hi;
    char* V_lds = lds; char* K_lds = lds + 2 * SHM_V;
    float* ws = (float*)(lds + 2 * SHM_V + 2 * SHM_K) + wid * 64; float* li_l = ws, * al_l = ws + 32;
    float m_reg = -1e30f, l_reg = 0; f32x16 o[4] = {};
    const int sr = tid >> 4, sc = (tid & 15) * 8, vst0 = v_st(sr, sc), vst1 = v_st(32 + sr, sc), kws = KSWZ(sr, sc * 2);
    const int vb0 = (int)(uintptr_t)V_lds + v_rd_base(lane);
    const TIn* Kh = cur.K; const TIn* Vh = cur.V;
#define RESC(a) do { if (__any((a) < 1.f)) { if (hi == 0) al_l[r32] = (a); asm volatile("s_waitcnt lgkmcnt(0)" ::: "memory");              \
                     for (int d_ = 0; d_ < 4; ++d_) for (int r = 0; r < 16; ++r) o[d_][r] *= al_l[crow(r, hi)]; } } while (0)
#define KBASE(t) ((j_lo + (t)) * KVBLK)
#define ACT(t) (KBASE(t) <= qlo + QBLK - 1 && KBASE(t) + KVBLK - 1 >= qlo - W + 1)
#define MASKT(P0_, P1_, t) do { const int kb_ = KBASE(t); if ((!SK || ACT(t)) && (kb_ + KVBLK - 1 > qlo || kb_ <= qlo + QBLK - 1 - W)) mask_tile(P0_, P1_, qm - kb_, (unsigned)W); } while (0)
    constexpr int NQL = F32 ? 16 : 8;
    constexpr bool SK = WSKIP && !F32;
#define SEAM_K0() do { VMWN(NQL); if constexpr (F32) { SWRITE_KF(0); SBAR(); SLOAD_F((const float*)nxt.V, kbn); } else { SWRITE_HK(0); } SBAR(); } while (0)
    f32x16 pA0, pA1, pB0, pB1; float mnA, mnB, alA, alB; bf16x8 pa0, pa1, pa2, pa3;
    if constexpr (F32) { VMW(); SWRITE_VF(0); SBAR(); } else { SWRITE_HV(0); SBAR(); }
    if (NT > 1) { if constexpr (F32) SLOAD_F((const float*)Kh, KBASE(1)); else SLOAD_H(Kh, Vh, KBASE(1)); }
    SBAR(); qkt<0, SK>(pA0, pA1, K_lds, r32, hi, S.qr, ACT(0));
    if constexpr (F32) { if (NT > 1) { VMW(); SWRITE_KF(1); SBAR(); SLOAD_F((const float*)Vh, KBASE(1)); } }
    MASKT(pA0, pA1, 0); partialSM(pA0, pA1, m_reg, mnA, alA);
    if (NT > 1) { VMW(); if constexpr (F32) { SWRITE_VF(1); SBAR(); if (NT > 2) SLOAD_F((const float*)Kh, KBASE(2)); } else SWRITE_H(1); }
    __syncthreads();
#define HALF_STEP(PX0, PX1, mnX, alX, PY0, PY1, alY, t, KB, VB, SB) do {                                                      \
        SBAR(); qkt<KB, SK>(PX0, PX1, K_lds, r32, hi, S.qr, ACT(t));                                             \
        finishSM(PY0, PY1, alY, l_reg, pa0, pa1, pa2, pa3); SBAR();                                                           \
        if ((t) + 1 < NT) { if constexpr (F32) { VMW(); SWRITE_KF(SB); SBAR(); SLOAD_F((const float*)Vh, KBASE((t) + 1)); }  \
                            else { SLOAD_H(Kh, Vh, KBASE((t) + 1)); } SBAR(); }                                               \
        pv_tile<VB, SK>(o, vb0, pa0, pa1, pa2, pa3, ACT((t) - 1)); MASKT(PX0, PX1, (t)); partialSM(PX0, PX1, m_reg, mnX, alX);                                        \
        __syncthreads();                                                                                                      \
        if ((t) + 1 < NT) { VMW(); if constexpr (F32) { SWRITE_VF(SB); SBAR(); if ((t) + 2 < NT) SLOAD_F((const float*)Kh, KBASE((t) + 2)); } \
                            else { SWRITE_H(SB); } }                                                                          \
        RESC(alX); __syncthreads(); } while (0)
    for (int t = 1; t + 1 < NT; t += 2) {
        HALF_STEP(pB0, pB1, mnB, alB, pA0, pA1, alA, t, 1, 0, 0);
        HALF_STEP(pA0, pA1, mnA, alA, pB0, pB1, alB, t + 1, 0, 1, 1);
    }
    const bool even = (NT & 1) == 0;
    if (even) { SBAR(); qkt<1, SK>(pB0, pB1, K_lds, r32, hi, S.qr, ACT(NT - 1)); SBAR(); }
#define QROW(e) (nxt.Q + (size_t)(wid * QBLK + r32) * D + ((e) >> 1) * 16 + hi * 8 + ((e) & 1) * 4)
    if constexpr (F32) { SLOAD_F((const float*)nxt.K, kbn); SBAR();
#pragma unroll
        for (int e = 0; e < 8; ++e) S.tq[e] = *(const f32x4*)QROW(e); }
    else { const size_t qrown_ = (size_t)(wid * QBLK + r32);
        SLOAD_H(nxt.K, nxt.V, kbn); SBAR();
#pragma unroll
        for (int d0 = 0; d0 < 8; ++d0) S.qr[d0] = load8<TIn>(nxt.Q + qrown_ * D + d0 * 16 + hi * 8); }
    SBAR();
    finishSM(pA0, pA1, alA, l_reg, pa0, pa1, pa2, pa3); SBAR();
    if constexpr (F32) {
#pragma unroll
        for (int e = 8; e < 16; ++e) S.tq[e] = *(const f32x4*)QROW(e); SBAR(); }
#undef QROW
    pv_tile<0, SK>(o, vb0, pa0, pa1, pa2, pa3, ACT(even ? NT - 2 : NT - 1));
    if (even) { MASKT(pB0, pB1, NT - 1); partialSM(pB0, pB1, m_reg, mnB, alB); __syncthreads(); RESC(alB);
        finishSM(pB0, pB1, alB, l_reg, pa0, pa1, pa2, pa3); SBAR(); pv_tile<1, SK>(o, vb0, pa0, pa1, pa2, pa3, ACT(NT - 1)); }
    SBAR(); SEAM_K0();
    if (hi == 0) li_l[r32] = l_reg; asm volatile("s_waitcnt lgkmcnt(0)" ::: "memory");
    float rli[16];
#pragma unroll
    for (int r = 0; r < 16; ++r) rli[r] = __builtin_amdgcn_rcpf(li_l[crow(r, hi)]);
    {
    int ld_ = cur.ldo; asm volatile("" : "+s"(ld_));
    TOut* Ow = cur.O + (size_t)(wid * QBLK) * ld_;
#pragma unroll
    for (int r = 0; r < 16; ++r) { const unsigned ro = (unsigned)crow(r, hi) * (unsigned)ld_ + (unsigned)r32;
#pragma unroll
        for (int d0 = 0; d0 < 4; ++d0) { const float v = o[d0][r] * rli[r];
            if constexpr (same_t<TOut, float>::v) { Ow[ro + d0 * 32] = v; }
            else { const float vn = __shfl_xor(v, 1);
                   if ((r32 & 1) == 0) *(unsigned*)(Ow + ro + d0 * 32) = cvtpk(v, vn); } } }
    }
    if constexpr (F32) {
#pragma unroll
        for (int d0 = 0; d0 < 8; ++d0) S.qr[d0] = pack8(S.tq[2 * d0], S.tq[2 * d0 + 1]); }
    __syncthreads();
#undef RESC
#undef KBASE
#undef ACT
#undef MASKT
#undef SEAM_K0
#undef HALF_STEP
}
#undef ROW
#undef VMW
#undef VMWN
#undef SLOAD_H
#undef SWRITE_HK
#undef SWRITE_HV
#undef SWRITE_H
#undef SLOAD_F
#undef SWRITE_KF
#undef SWRITE_VF


template <int KB>
__device__ __forceinline__ void qkt_r(f32x16& p0, f32x16& p1, const char* K_lds, int r32, int hi, const bf16x8* qr) {
    p0 = f32x16{}; p1 = f32x16{};
    const char* kb[4];
#pragma unroll
    for (int dd = 0; dd < 4; ++dd) kb[dd] = K_lds + KB * SHM_K + KSWZ(r32, (dd * 16 + hi * 8) * 2);
#pragma unroll
    for (int d0 = 0; d0 < 8; ++d0) { const char* a = kb[d0 & 3] + (d0 >> 2) * 128;
        bf16x8 b0 = *reinterpret_cast<const bf16x8*>(a);
        bf16x8 b1 = *reinterpret_cast<const bf16x8*>(a + 32 * 256);
        p0 = __builtin_amdgcn_mfma_f32_32x32x16_bf16(b0, qr[d0], p0, 0, 0, 0);
        p1 = __builtin_amdgcn_mfma_f32_32x32x16_bf16(b1, qr[d0], p1, 0, 0, 0); }
}
constexpr int MOBA_LDS_BYTES = 4 * SHM_V + 4 * SHM_K + NW * 64 * 4;
__device__ __forceinline__ void moba_block(const BlockRef<bf16, bf16>& cur, char* lds) {
    const int tid = threadIdx.x, wid = __builtin_amdgcn_readfirstlane(tid >> 6), lane = tid & 63, r32 = lane & 31, hi = lane >> 5;
    char* V_lds = lds; char* K_lds = lds + 4 * SHM_V;
    float* wsc = (float*)(lds + 4 * SHM_V + 4 * SHM_K) + wid * 64; float* li_l = wsc, * al_l = wsc + 32;
    const int sr = tid >> 4, sc = (tid & 15) * 8, vst0 = v_st(sr, sc), vst1 = v_st(32 + sr, sc), kws = KSWZ(sr, sc * 2);
    const int vb0 = (int)(uintptr_t)V_lds + v_rd_base(lane);
    bf16x8 qr[8];
    { const size_t qrow = (size_t)cur.rows[wid * QBLK + r32];
#pragma unroll
      for (int d0 = 0; d0 < 8; ++d0) qr[d0] = load8<bf16>(cur.Q + qrow * D + d0 * 16 + hi * 8); }
    bf16x8 sk0[4], sk1[4], sv0[4], sv1[4];
#pragma unroll
    for (int t = 0; t < 4; ++t) { const bf16* kp = cur.K + (size_t)(t * KVBLK + sr) * D + sc; const bf16* vp = cur.V + (size_t)(t * KVBLK + sr) * D + sc;
        sk0[t] = load8<bf16>(kp); sk1[t] = load8<bf16>(kp + 32 * D); sv0[t] = load8<bf16>(vp); sv1[t] = load8<bf16>(vp + 32 * D); }
    __syncthreads();
#pragma unroll
    for (int t = 0; t < 4; ++t) { *(bf16x8*)(K_lds + t * SHM_K + kws) = sk0[t]; *(bf16x8*)(K_lds + t * SHM_K + kws + 32 * 256) = sk1[t];
        *(bf16x8*)(V_lds + t * SHM_V + vst0) = sv0[t]; *(bf16x8*)(V_lds + t * SHM_V + vst1) = sv1[t]; }
    __syncthreads();
    float m_reg = -1e30f, l_reg = 0; f32x16 o[4] = {};
    const bool causal = cur.P0 == 0; const int qlo = wid * QBLK, qm = qlo + r32 - 4 * hi;
    f32x16 p0, p1; float mn, al; bf16x8 pa0, pa1, pa2, pa3;
#define RESCM(a) do { if (__any((a) < 1.f)) { if (hi == 0) al_l[r32] = (a); asm volatile("s_waitcnt lgkmcnt(0)" ::: "memory");              \
                      for (int d_ = 0; d_ < 4; ++d_) for (int r = 0; r < 16; ++r) o[d_][r] *= al_l[crow(r, hi)]; } } while (0)
#define MT(t) do { SBAR(); qkt_r<t>(p0, p1, K_lds, r32, hi, qr); if (causal && (t) * KVBLK + KVBLK - 1 > qlo) mask_tile(p0, p1, qm - (t) * KVBLK, 1u << 30);   \
        partialSM(p0, p1, m_reg, mn, al); RESCM(al); finishSM(p0, p1, al, l_reg, pa0, pa1, pa2, pa3); SBAR(); pv_tile<t, false>(o, vb0, pa0, pa1, pa2, pa3, true); } while (0)
    MT(0); MT(1); MT(2); MT(3);
#undef MT
#undef RESCM
    if (hi == 0) li_l[r32] = l_reg; asm volatile("s_waitcnt lgkmcnt(0)" ::: "memory");
    float rli[16];
#pragma unroll
    for (int r = 0; r < 16; ++r) rli[r] = __builtin_amdgcn_rcpf(li_l[crow(r, hi)]);
    { const int dme_ = cur.dst[wid * QBLK + r32]; if (hi == 0 && dme_ >= 0) { float2 st_; st_.x = m_reg; st_.y = l_reg; *(float2*)(cur.stat + 2 * (size_t)dme_) = st_; } }
#pragma unroll
    for (int r = 0; r < 16; ++r) { const int di_ = cur.dst[wid * QBLK + crow(r, hi)];
#pragma unroll
        for (int d0 = 0; d0 < 4; ++d0) { const float v = o[d0][r] * rli[r]; const float vn = __shfl_xor(v, 1);
            if ((r32 & 1) == 0 && di_ >= 0) *(unsigned*)(cur.O + (size_t)di_ * 128 + d0 * 32 + r32) = cvtpk(v, vn); } }
}
}
#include <hip/hip_cooperative_groups.h>
namespace cg = cooperative_groups;

constexpr int NWAVES = 8;
#ifndef MK_ONE_LAUNCH
#define MK_ONE_LAUNCH 1
#endif
constexpr int BATCH = 2, SEQ = 16384, T = BATCH * SEQ, DM = 2048, INW = 10240, DFF = 8192, PLE = 256;
constexpr int NH8 = 8;
constexpr float NORM_EPS = 1e-6f;
constexpr float LAMBDA_INIT = 0.2f;
constexpr int NPHASE = 19;

constexpr size_t MiB = 1u << 20;
constexpr size_t WS_ROPE = 1 * MiB;
constexpr size_t WS_KMEAN = 3 * MiB;
constexpr size_t WS_CNT = 0, WS_NBLK = 8192, WS_TAB = 65536;
constexpr size_t WS_BAR = 131072, WS_BAR_BYTES = 16384;
constexpr size_t WS_SEL = 4 * MiB;
constexpr int LSTR = 65536 + SEQ;
constexpr size_t WS_ROWL = 986 * MiB, WS_DSTL = 992 * MiB;
constexpr size_t WS_STATS = 1000 * MiB;
constexpr size_t WS_TOP = 1008 * MiB;
constexpr size_t WS_WIN = 8 * MiB, WS_WA = 48 * MiB, WS_WB = 52 * MiB, WS_WOUT = 56 * MiB, WS_WUP = 64 * MiB, WS_WDN = 96 * MiB, WS_WPG = 128 * MiB, WS_WPP = 136 * MiB;
constexpr size_t WS_PB = 138 * MiB;
constexpr size_t WS_XN = 154 * MiB;
constexpr size_t WS_OB = 154 * MiB;
constexpr size_t WS_QKV = 282 * MiB;
constexpr size_t SEC_ELEMS = (size_t)T * 1024;
constexpr size_t WS_SG = 666 * MiB;
constexpr size_t WS_OA = 922 * MiB;
constexpr size_t WS_MIX = 282 * MiB;
constexpr size_t WS_HID = 282 * MiB;
constexpr size_t WS_G3 = 282 * MiB;
constexpr size_t WS_XN3 = 410 * MiB;
constexpr size_t WS_Y = 794 * MiB;
constexpr size_t WS_END = 986 * MiB;
static_assert(WS_HID + (size_t)T * DFF * 2 <= WS_Y && WS_Y + (size_t)T * DM * 2 <= WS_OA && WS_OA + (size_t)T * 1024 * 2 == WS_END, "ws map");

constexpr int RING_BYTES = 131072, LDS_BYTES = 147456;

#define GAS __attribute__((address_space(1)))
#define LAS __attribute__((address_space(3)))
typedef unsigned short bf16;
typedef unsigned v4u __attribute__((ext_vector_type(4)));
typedef unsigned v2u __attribute__((ext_vector_type(2)));
typedef float f32x4 __attribute__((ext_vector_type(4)));
#define LDS_WAIT() asm volatile("s_waitcnt lgkmcnt(0)" ::: "memory")
__device__ __forceinline__ unsigned f2bf(float f) { unsigned u = __builtin_bit_cast(unsigned, f); return (u + 0x7fffu + ((u >> 16) & 1u)) >> 16; }
__device__ __forceinline__ unsigned pk2(float lo, float hi) { return f2bf(lo) | (f2bf(hi) << 16); }
__device__ __forceinline__ float bflo(unsigned w) { return __uint_as_float(w << 16); }
__device__ __forceinline__ float bfhi(unsigned w) { return __uint_as_float(w & 0xffff0000u); }
__device__ __forceinline__ float wave_sum(float v) {
#pragma unroll
    for (int o = 1; o < 64; o <<= 1) v += __shfl_xor(v, o);
    return v;
}
template <class Tv> __device__ __forceinline__ Tv ntload(const Tv* p) { return __builtin_nontemporal_load(p); }
template <class Tv> __device__ __forceinline__ void ntstore(Tv v, Tv* p) { __builtin_nontemporal_store(v, p); }
__device__ __forceinline__ float sigmoidf_(float x) { return __builtin_amdgcn_rcpf(1.0f + __expf(-x)); }

namespace pg8 {
template <int MODE> struct EpiT {
    static constexpr bool PERM = true, AFTER_DRAIN = false;
    bf16_t* O; int ldo; const bf16_t* G; int ldg;
    __device__ __forceinline__ void operator()(const f32x4 (&acc)[2][2][4][2], const Unit& u, int wr, int wc, int fr, int fq) const {
        const int row0 = u.pm * BM + wr * 64 + fr, col0 = u.pn * BM + wc * 32 + 8 * fq;
#pragma unroll
        for (int ai = 0; ai < 2; ++ai)
#pragma unroll
            for (int m = 0; m < 4; ++m) { const size_t r = (size_t)(row0 + ai * HALF + m * 16);
#pragma unroll
                for (int bj = 0; bj < 2; ++bj) { f32x4 v0 = acc[ai][bj][m][0], v1 = acc[ai][bj][m][1]; const int c = col0 + bj * HALF;
                    if (MODE == 1) {
#pragma unroll
                        for (int e = 0; e < 4; ++e) { float a = fmaxf(v0[e], 0.f), b = fmaxf(v1[e], 0.f); v0[e] = a * a; v1[e] = b * b; } }
                    if (MODE == 2) {
#pragma unroll
                        for (int e = 0; e < 4; ++e) { v0[e] = sigmoidf_(v0[e]); v1[e] = sigmoidf_(v1[e]); } }
                    if (MODE == 3 || MODE == 4) { const u32x4 g = *(const u32x4*)(G + r * ldg + c);
                        v0[0] *= bflo(g.x); v0[1] *= bfhi(g.x); v0[2] *= bflo(g.y); v0[3] *= bfhi(g.y); v1[0] *= bflo(g.z); v1[1] *= bfhi(g.z); v1[2] *= bflo(g.w); v1[3] *= bfhi(g.w); }
                    if (MODE == 4) { const u32x4 g = *(const u32x4*)(O + r * ldo + c);
                        v0[0] += bflo(g.x); v0[1] += bfhi(g.x); v0[2] += bflo(g.y); v0[3] += bfhi(g.y); v1[0] += bflo(g.z); v1[1] += bfhi(g.z); v1[2] += bflo(g.w); v1[3] += bfhi(g.w); }
                    u32x4 w; w.x = cvt_pk_bf16(v0[0], v0[1]); w.y = cvt_pk_bf16(v0[2], v0[3]); w.z = cvt_pk_bf16(v1[0], v1[1]); w.w = cvt_pk_bf16(v1[2], v1[3]);
                    *(u32x4*)(O + r * ldo + c) = w; } }
    }
};
struct EpiGate2 {
    static constexpr bool PERM = true, AFTER_DRAIN = false; static constexpr int MID_T = 16;
    bf16_t* O; const bf16_t* SGp;
    __device__ __forceinline__ void mid(f32x4 (&acc)[2][2][4][2], const Unit& u, int wr, int wc, int fr, int fq) const {
        int row0 = u.pm * BM + wr * 64 + fr; const int col0 = u.pn * BM + wc * 32 + 8 * fq;
        asm volatile("" : "+v"(row0));
        const bf16_t* gp = SGp + (size_t)row0 * 4096 + col0;
#pragma unroll
        for (int ai = 0; ai < 2; ++ai)
#pragma unroll
            for (int m = 0; m < 4; ++m) { const int ro = (ai * HALF + m * 16) * 4096;
#pragma unroll
                for (int bj = 0; bj < 2; ++bj) { const u32x4 a = *(const u32x4*)(gp + ro + bj * HALF), b = *(const u32x4*)(gp + ro + bj * HALF + 2048);
                    f32x4& v0 = acc[ai][bj][m][0]; f32x4& v1 = acc[ai][bj][m][1];
                    v0[0] *= bflo(a.x) * __builtin_amdgcn_rcpf(bflo(b.x)); v0[1] *= bfhi(a.x) * __builtin_amdgcn_rcpf(bfhi(b.x)); v0[2] *= bflo(a.y) * __builtin_amdgcn_rcpf(bflo(b.y)); v0[3] *= bfhi(a.y) * __builtin_amdgcn_rcpf(bfhi(b.y));
                    v1[0] *= bflo(a.z) * __builtin_amdgcn_rcpf(bflo(b.z)); v1[1] *= bfhi(a.z) * __builtin_amdgcn_rcpf(bfhi(b.z)); v1[2] *= bflo(a.w) * __builtin_amdgcn_rcpf(bflo(b.w)); v1[3] *= bfhi(a.w) * __builtin_amdgcn_rcpf(bfhi(b.w)); }
                if (m == 3) asm volatile("" ::: "memory"); }
    }
    __device__ __forceinline__ void operator()(const f32x4 (&acc)[2][2][4][2], const Unit& u, int wr, int wc, int fr, int fq) const {
        int row0 = u.pm * BM + wr * 64 + fr; const int col0 = u.pn * BM + wc * 32 + 8 * fq;
        asm volatile("" : "+v"(row0));
        const bf16_t* gp = SGp + (size_t)row0 * 4096 + 2048 + col0; bf16_t* op = O + (size_t)row0 * 2048 + col0;
#pragma unroll
        for (int ai = 0; ai < 2; ++ai)
#pragma unroll
            for (int m = 0; m < 4; ++m) { const int rr = ai * HALF + m * 16;
#pragma unroll
                for (int bj = 0; bj < 2; ++bj) { const u32x4 b = *(const u32x4*)(gp + rr * 4096 + bj * HALF); const f32x4 v0 = acc[ai][bj][m][0], v1 = acc[ai][bj][m][1];
                    u32x4 w; w.x = cvt_pk_bf16(v0[0] * bflo(b.x), v0[1] * bfhi(b.x)); w.y = cvt_pk_bf16(v0[2] * bflo(b.y), v0[3] * bfhi(b.y)); w.z = cvt_pk_bf16(v1[0] * bflo(b.z), v1[1] * bfhi(b.z)); w.w = cvt_pk_bf16(v1[2] * bflo(b.w), v1[3] * bfhi(b.w));
                    *(u32x4*)(op + rr * 2048 + bj * HALF) = w; } }
    }
};
struct EpiPle {
    static constexpr bool PERM = true, AFTER_DRAIN = false; static constexpr int MID_T = 32;
    bf16_t* O; bf16_t* Gp;
    __device__ __forceinline__ void mid(f32x4 (&acc)[2][2][4][2], const Unit& u, int wr, int wc, int fr, int fq) const {
        int row0 = u.pm * BM + wr * 64 + fr; const int col0 = u.pn * BM + wc * 32 + 8 * fq;
        asm volatile("" : "+v"(row0));
        bf16_t* gp = Gp + (size_t)row0 * 2048 + col0;
#pragma unroll
        for (int ai = 0; ai < 2; ++ai)
#pragma unroll
            for (int m = 0; m < 4; ++m) { const int rr = ai * HALF + m * 16;
#pragma unroll
                for (int bj = 0; bj < 2; ++bj) { f32x4& v0 = acc[ai][bj][m][0]; f32x4& v1 = acc[ai][bj][m][1];
                    u32x4 w; w.x = cvt_pk_bf16(sigmoidf_(v0[0]), sigmoidf_(v0[1])); w.y = cvt_pk_bf16(sigmoidf_(v0[2]), sigmoidf_(v0[3])); w.z = cvt_pk_bf16(sigmoidf_(v1[0]), sigmoidf_(v1[1])); w.w = cvt_pk_bf16(sigmoidf_(v1[2]), sigmoidf_(v1[3]));
                    *(u32x4*)(gp + rr * 2048 + bj * HALF) = w; v0 = (f32x4){0.f, 0.f, 0.f, 0.f}; v1 = (f32x4){0.f, 0.f, 0.f, 0.f}; } }
    }
    __device__ __forceinline__ void operator()(const f32x4 (&acc)[2][2][4][2], const Unit& u, int wr, int wc, int fr, int fq) const {
        int row0 = u.pm * BM + wr * 64 + fr; const int col0 = u.pn * BM + wc * 32 + 8 * fq;
        asm volatile("" : "+v"(row0));
        const bf16_t* gp = Gp + (size_t)row0 * 2048 + col0; bf16_t* op = O + (size_t)row0 * 2048 + col0;
#pragma unroll
        for (int ai = 0; ai < 2; ++ai)
#pragma unroll
            for (int m = 0; m < 4; ++m) { const int rr = ai * HALF + m * 16;
#pragma unroll
                for (int bj = 0; bj < 2; ++bj) { const u32x4 b = *(const u32x4*)(gp + rr * 2048 + bj * HALF); const f32x4 v0 = acc[ai][bj][m][0], v1 = acc[ai][bj][m][1];
                    u32x4 w; w.x = cvt_pk_bf16(v0[0] * bflo(b.x), v0[1] * bfhi(b.x)); w.y = cvt_pk_bf16(v0[2] * bflo(b.y), v0[3] * bfhi(b.y)); w.z = cvt_pk_bf16(v1[0] * bflo(b.z), v1[1] * bfhi(b.z)); w.w = cvt_pk_bf16(v1[2] * bflo(b.w), v1[3] * bfhi(b.w));
                    *(u32x4*)(op + rr * 2048 + bj * HALF) = w; } }
    }
};
struct EpiInProj {
    static constexpr bool PERM = false, AFTER_DRAIN = false;
    bf16_t* QKV; bf16_t* SG; const float* rope; float* km;
    __device__ __forceinline__ void operator()(const f32x4 (&acc)[2][2][4][2], const Unit& u, int wr, int wc, int fr, int fq) const {
        typedef unsigned u32x2 __attribute__((ext_vector_type(2)));
        const int pn = u.pn, row0 = u.pm * BM + wr * 64 + fr;
        if (pn < 24) {
            const int sec = pn >> 2; const bool rot = (sec != 2) && (sec != 5) && (wc == 0);
            const int b = (u.pm * BM) / SEQ;
            f32x4 ks[2][2] = {{(f32x4){0.f, 0.f, 0.f, 0.f}, (f32x4){0.f, 0.f, 0.f, 0.f}}, {(f32x4){0.f, 0.f, 0.f, 0.f}, (f32x4){0.f, 0.f, 0.f, 0.f}}};
#pragma unroll
            for (int ai = 0; ai < 2; ++ai)
#pragma unroll
                for (int m = 0; m < 4; ++m) { const int r = row0 + ai * HALF + m * 16, pos = r - b * SEQ;
                    f32x4 cs = (f32x4){1.f, 1.f, 1.f, 1.f}, sn = (f32x4){0.f, 0.f, 0.f, 0.f};
                    if (rot) { cs = *(const f32x4*)(rope + (size_t)pos * 32 + 4 * fq); sn = *(const f32x4*)(rope + (size_t)pos * 32 + 16 + 4 * fq); }
#pragma unroll
                    for (int bj = 0; bj < 2; ++bj) { const int h8 = (pn & 3) * 2 + bj; f32x4 v0 = acc[ai][bj][m][0], v1 = acc[ai][bj][m][1];
                        if (rot) { const f32x4 a = v0 * cs - v1 * sn, bb = v1 * cs + v0 * sn; v0 = a; v1 = bb; }
                        if (sec == 1) { ks[bj][0] += v0; ks[bj][1] += v1; }
                        bf16_t* dst = QKV + (size_t)sec * SEC_ELEMS + ((size_t)(b * NH8 + h8) * SEQ + pos) * 128 + wc * 32 + 4 * fq;
                        u32x2 w0, w1; w0.x = cvt_pk_bf16(v0[0], v0[1]); w0.y = cvt_pk_bf16(v0[2], v0[3]); w1.x = cvt_pk_bf16(v1[0], v1[1]); w1.y = cvt_pk_bf16(v1[2], v1[3]);
                        *(u32x2*)dst = w0; *(u32x2*)(dst + 16) = w1; } }
            if (sec == 1) {
                const int blk = u.pm - b * (SEQ / 256);
#pragma unroll
                for (int bj = 0; bj < 2; ++bj)
#pragma unroll
                    for (int n = 0; n < 2; ++n)
#pragma unroll
                        for (int e = 0; e < 4; ++e) { float v = ks[bj][n][e]; v += __shfl_xor(v, 1); v += __shfl_xor(v, 2); v += __shfl_xor(v, 4); v += __shfl_xor(v, 8);
                            if (fr == 0) atomicAdd(km + ((size_t)((b * NH8 + (pn & 3) * 2 + bj) * 64 + blk)) * 128 + wc * 32 + n * 16 + 4 * fq + e, v * (1.0f / 256.0f)); }
            }
        } else {
            const int col0 = (pn - 24) * BM + wc * 32 + 4 * fq;
#pragma unroll
            for (int ai = 0; ai < 2; ++ai)
#pragma unroll
                for (int m = 0; m < 4; ++m) { bf16_t* rowp = SG + (size_t)(row0 + ai * HALF + m * 16) * 4096 + col0;
#pragma unroll
                    for (int bj = 0; bj < 2; ++bj)
#pragma unroll
                        for (int n = 0; n < 2; ++n) { const f32x4 v = acc[ai][bj][m][n]; u32x2 w; w.x = cvt_pk_bf16(sigmoidf_(v[0]), sigmoidf_(v[1])); w.y = cvt_pk_bf16(sigmoidf_(v[2]), sigmoidf_(v[3]));
                            *(u32x2*)(rowp + bj * HALF + n * 16) = w; } }
        }
    }
};
}

#define XB_TMO      128
#define XB_XCNT(j)  (256  + 64 * (j))
#define XB_XSUB(j)  (1280 + 64 * (j))
#define XB_XGEN(j)  (2304 + 64 * (j))
#define XB_TOP      3328
#define XB_TOPGEN   3392
#define XCD_BAR_WORDS 3456
#define XB_SPIN_CAP (1u << 18)

__device__ __forceinline__ unsigned xb_ld(unsigned* p)              { return __hip_atomic_load(p, __ATOMIC_RELAXED, __HIP_MEMORY_SCOPE_AGENT); }
__device__ __forceinline__ unsigned xb_add(unsigned* p, unsigned v) { return __hip_atomic_fetch_add(p, v, __ATOMIC_RELAXED, __HIP_MEMORY_SCOPE_AGENT); }
__device__ __forceinline__ unsigned xb_xcc_id() { return (unsigned)__builtin_amdgcn_s_getreg((3 << 11) | 20) & 0xFu; }
#define XB_SPIN(cond, bar) do { unsigned _sp = 0; while (cond) { __builtin_amdgcn_s_sleep(1); \
    if ((++_sp & 255u) == 0u) { if (xb_ld(&(bar)[XB_TMO])) break; if (_sp > XB_SPIN_CAP) { atomicAdd(&(bar)[XB_TMO], 1u); break; } } } } while (0)

struct XcdBarrier {
    unsigned* bar; unsigned x;
    volatile LAS unsigned* st;
};

__device__ __forceinline__ XcdBarrier xcd_barrier_post(unsigned* bar, volatile LAS unsigned* st) {
    XcdBarrier b; b.bar = bar; b.x = xb_xcc_id(); b.st = st;
    if (threadIdx.x == 0) (void)xb_add(&bar[XB_XCNT(b.x)], 1u);
    return b;
}
__device__ __forceinline__ void xcd_barrier_complete(unsigned* bar, unsigned x, unsigned& nloc, unsigned& nx) {
    const unsigned G = gridDim.x * gridDim.y * gridDim.z;
    unsigned sum, cnt, mine, sp = 0u;
    for (;;) {
        sum = 0u; cnt = 0u; mine = 0u;
#pragma unroll
        for (unsigned j = 0; j < 16; ++j) { const unsigned c = xb_ld(&bar[XB_XCNT(j)]); sum += c; cnt += (c > 0u) ? 1u : 0u; mine = (j == x) ? c : mine; }
        if (sum == G) break;
        __builtin_amdgcn_s_sleep(1);
        if ((++sp & 255u) == 0u) { if (xb_ld(&bar[XB_TMO])) break; if (sp > XB_SPIN_CAP) { atomicAdd(&bar[XB_TMO], 1u); break; } }
    }
    nloc = mine > 0u ? mine : 1u; nx = cnt > 0u ? cnt : 1u;
}

__device__ __forceinline__ void xcd_barrier(const XcdBarrier& b) {
    asm volatile("s_waitcnt vmcnt(0)" ::: "memory");
    __syncthreads();
    if (threadIdx.x == 0) {
        unsigned* bar = b.bar;
        __builtin_amdgcn_s_waitcnt(0);
        unsigned nloc = b.st[0], nx = b.st[1];
        if (nloc == 0u) { xcd_barrier_complete(bar, b.x, nloc, nx); b.st[0] = nloc; b.st[1] = nx; }
        const unsigned old = xb_add(&bar[XB_XSUB(b.x)], 1u);
        const unsigned gen = old / nloc;
        if (old + 1u == (gen + 1u) * nloc) {
            __builtin_amdgcn_fence(__ATOMIC_RELEASE, "agent");
            asm volatile("s_waitcnt vmcnt(0)" ::: "memory");
            const unsigned og = xb_add(&bar[XB_TOP], 1u);
            const unsigned tg = og / nx;
            if (og + 1u == (tg + 1u) * nx) xb_add(&bar[XB_TOPGEN], 1u);
            else XB_SPIN(xb_ld(&bar[XB_TOPGEN]) == tg, bar);
            __builtin_amdgcn_fence(__ATOMIC_ACQUIRE, "agent");
            xb_add(&bar[XB_XGEN(b.x)], 1u);
            asm volatile("s_waitcnt vmcnt(0)" ::: "memory");
        } else {
            XB_SPIN(xb_ld(&bar[XB_XGEN(b.x)]) == gen, bar);
            __builtin_amdgcn_fence(__ATOMIC_ACQUIRE, "agent");
            asm volatile("s_waitcnt vmcnt(0)" ::: "memory");
        }
    }
    __syncthreads();
}

struct Args { const float* in[21]; float* out; unsigned char* ws; int ph_lo, ph_hi, coop, pad; };

__device__ __forceinline__ void p0_transpose_item(const float* W, int K, int N, bf16* WT, LAS float* scr, int item, int lane, int ldt = 0) {
    if (ldt == 0) ldt = K;
    const int nblk = N / 64, kb = item / nblk, nb = item % nblk, k0 = 64 * kb, n0 = 64 * nb;
    const int lr = lane >> 4, lc = (lane & 15) * 4;
    f32x4 v[16];
#pragma unroll
    for (int i = 0; i < 16; ++i) v[i] = ntload((const f32x4*)(W + (size_t)(k0 + 4 * i + lr) * N + n0 + lc));
#pragma unroll
    for (int i = 0; i < 16; ++i) { LAS float* d = scr + (4 * i + lr) * 65 + lc; d[0] = v[i].x; d[1] = v[i].y; d[2] = v[i].z; d[3] = v[i].w; }
    LDS_WAIT(); asm volatile("" ::: "memory");
    const int c = lane & 7;
#pragma unroll
    for (int j = 0; j < 8; ++j) { const int n = (lane >> 3) + 8 * j; const LAS float* sp = scr + (8 * c) * 65 + n;
        v4u o; o.x = pk2(sp[0 * 65], sp[1 * 65]); o.y = pk2(sp[2 * 65], sp[3 * 65]); o.z = pk2(sp[4 * 65], sp[5 * 65]); o.w = pk2(sp[6 * 65], sp[7 * 65]);
        *(GAS v4u*)(WT + (size_t)(n0 + n) * ldt + k0 + 8 * c) = o; }
    LDS_WAIT(); asm volatile("" ::: "memory");
}
__device__ __forceinline__ void rms_row_to_bf16(const float* xrow, const float* g, bf16* orow, int lane) {
    f32x4 v[8]; float s = 0.f;
#pragma unroll
    for (int j = 0; j < 4; ++j) { const float* p = xrow + j * 512 + lane * 8; v[2 * j] = ntload((const f32x4*)p); v[2 * j + 1] = ntload((const f32x4*)(p + 4)); }
#pragma unroll
    for (int j = 0; j < 8; ++j) s += (v[j].x * v[j].x + v[j].y * v[j].y) + (v[j].z * v[j].z + v[j].w * v[j].w);
    const float rstd = 1.0f / sqrtf(wave_sum(s) * (1.f / DM) + NORM_EPS);
#pragma unroll
    for (int j = 0; j < 4; ++j) { const float* gp = g + j * 512 + lane * 8; const f32x4 g0 = *(const f32x4*)gp, g1 = *(const f32x4*)(gp + 4); const f32x4 a = v[2 * j] * rstd * g0, b = v[2 * j + 1] * rstd * g1;
        v4u o; o.x = pk2(a.x, a.y); o.y = pk2(a.z, a.w); o.z = pk2(b.x, b.y); o.w = pk2(b.z, b.w); *(v4u*)(orow + j * 512 + lane * 8) = o; }
}
__device__ __forceinline__ void row_pass(const bf16* Y, const float* base, const float* gA, float* outh, const float* gB, bf16* xn, int gw, int NGW, int lane, int ldx = DM, const float* pin = nullptr) {
    for (int row0 = gw; row0 < T; row0 += 2 * NGW) {
        f32x4 h[2][8]; v4u yw[2][4];
#pragma unroll
        for (int k = 0; k < 2; ++k)
#pragma unroll
            for (int j = 0; j < 4; ++j) { const size_t off = (size_t)(row0 + k * NGW) * DM + j * 512 + lane * 8; yw[k][j] = ntload((const v4u*)(Y + off));
                h[k][2 * j] = ntload((const f32x4*)(base + off)); h[k][2 * j + 1] = ntload((const f32x4*)(base + off + 4)); }
#pragma unroll
        for (int k = 0; k < 2; ++k) { const int row = row0 + k * NGW;
            f32x4 y[8]; float s = 0.f;
#pragma unroll
            for (int j = 0; j < 4; ++j) { const v4u w = yw[k][j]; y[2 * j] = (f32x4){bflo(w.x), bfhi(w.x), bflo(w.y), bfhi(w.y)}; y[2 * j + 1] = (f32x4){bflo(w.z), bfhi(w.z), bflo(w.w), bfhi(w.w)}; }
#pragma unroll
            for (int j = 0; j < 8; ++j) s += (y[j].x * y[j].x + y[j].y * y[j].y) + (y[j].z * y[j].z + y[j].w * y[j].w);
            const float r1 = 1.0f / sqrtf(wave_sum(s) * (1.f / DM) + NORM_EPS); float s2 = 0.f;
#pragma unroll
            for (int j = 0; j < 4; ++j) { const int c = j * 512 + lane * 8; const f32x4 g0 = *(const f32x4*)(gA + c), g1 = *(const f32x4*)(gA + c + 4);
                h[k][2 * j] = h[k][2 * j] + y[2 * j] * r1 * g0; h[k][2 * j + 1] = h[k][2 * j + 1] + y[2 * j + 1] * r1 * g1;
                ntstore(h[k][2 * j], (f32x4*)(outh + (size_t)row * DM + c)); ntstore(h[k][2 * j + 1], (f32x4*)(outh + (size_t)row * DM + c + 4)); }
            if (xn) {
#pragma unroll
                for (int j = 0; j < 8; ++j) s2 += (h[k][j].x * h[k][j].x + h[k][j].y * h[k][j].y) + (h[k][j].z * h[k][j].z + h[k][j].w * h[k][j].w);
                const float r2 = 1.0f / sqrtf(wave_sum(s2) * (1.f / DM) + NORM_EPS);
#pragma unroll
                for (int j = 0; j < 4; ++j) { const int c = j * 512 + lane * 8; const f32x4 g0 = *(const f32x4*)(gB + c), g1 = *(const f32x4*)(gB + c + 4); const f32x4 a = h[k][2 * j] * r2 * g0, b = h[k][2 * j + 1] * r2 * g1;
                    v4u o; o.x = pk2(a.x, a.y); o.y = pk2(a.z, a.w); o.z = pk2(b.x, b.y); o.w = pk2(b.z, b.w); *(v4u*)(xn + (size_t)row * ldx + c) = o; }
                if (pin) { const f32x4 pv = *(const f32x4*)(pin + (size_t)row * PLE + lane * 4); v2u o; o.x = pk2(pv.x, pv.y); o.y = pk2(pv.z, pv.w); *(v2u*)(xn + (size_t)row * ldx + DM + lane * 4) = o; }
            }
        }
    }
}

typedef swa::BlockRef<swa::bf16, swa::bf16> ABlock;
__device__ __forceinline__ ABlock attn_ref(int head, int qb, unsigned char* ws, float* dout) {
    const swa::bf16* QKVs = (const swa::bf16*)(ws + WS_QKV); ABlock r;
    const int b = head >> 4, hd = (head >> 2) & 3, c = (head >> 1) & 1, j = head & 1; const int sh = b * NH8 + hd * 2 + c, vh = b * NH8 + hd * 2 + j;
    r.Q = QKVs + 3 * SEC_ELEMS + ((size_t)sh * SEQ + (size_t)qb * 256) * 128; r.K = QKVs + 4 * SEC_ELEMS + (size_t)sh * SEQ * 128; r.V = QKVs + 5 * SEC_ELEMS + (size_t)vh * SEQ * 128;
    r.O = (swa::bf16*)dout + ((size_t)b * SEQ + (size_t)qb * 256) * 4096 + hd * 512 + c * 256 + j * 128;
    r.ldo = 4096; r.rows = nullptr; r.dst = nullptr; r.stat = nullptr; r.P0 = qb * 256;
    return r;
}
constexpr int MOBA_PER = 320, MOBA_ITEMS = 16 * MOBA_PER;
__device__ __forceinline__ bool moba_valid(int L, const int* nblk) { const int bh = L / MOBA_PER, k = L - bh * MOBA_PER; return k >= 256 || k < nblk[bh]; }
__device__ __forceinline__ int moba_next(int L, int G, const int* nblk) { do { L += G; } while (L < MOBA_ITEMS && !moba_valid(L, nblk)); return L; }
__device__ __forceinline__ ABlock moba_ref(int L, unsigned char* ws, float* dout) {
    const swa::bf16* QKVs = (const swa::bf16*)(ws + WS_QKV); ABlock r;
    const int bh = L / MOBA_PER, k = L - bh * MOBA_PER; int j, lp, p0;
    if (k < 256) { const int2 t = ((const int2*)(ws + WS_TAB))[bh * 256 + k]; j = t.x; lp = t.y; p0 = 256; } else { j = k - 256; lp = 65536 + j * 256; p0 = 0; }
    r.Q = QKVs + (size_t)bh * SEQ * 128; r.K = QKVs + 1 * SEC_ELEMS + ((size_t)bh * SEQ + (size_t)j * 256) * 128; r.V = QKVs + 2 * SEC_ELEMS + ((size_t)bh * SEQ + (size_t)j * 256) * 128;
    r.O = (swa::bf16*)dout; r.ldo = 128; r.rows = (const int*)(ws + WS_ROWL) + (size_t)bh * LSTR + lp; r.dst = (const int*)(ws + WS_DSTL) + (size_t)bh * LSTR + lp; r.stat = (float*)(ws + WS_STATS); r.P0 = p0;
    return r;
}

__global__ void __launch_bounds__(NWAVES * 64, 2) mk_fwd(Args args) {
    extern __shared__ __attribute__((aligned(16))) unsigned char lds[];
    LAS unsigned char* L = (LAS unsigned char*)lds;
    const int tid = threadIdx.x, lane = tid & 63, wave = __builtin_amdgcn_readfirstlane(tid >> 6);
    const int G = gridDim.x, bx = blockIdx.x;
    const int vcu = (G % 8 == 0) ? (bx % 8) * (G / 8) + bx / 8 : bx;
    const int gw = vcu * NWAVES + wave, NGW = G * NWAVES;
    unsigned char* ws = args.ws;
#define x_in (args.in[0])
#define p_in (args.in[1])
#define Win_t ((bf16*)(ws + WS_WIN))
#define Wa_t ((bf16*)(ws + WS_WA))
#define Wb_t ((bf16*)(ws + WS_WB))
#define Wout_t ((bf16*)(ws + WS_WOUT))
#define Wup_t ((bf16*)(ws + WS_WUP))
#define Wdn_t ((bf16*)(ws + WS_WDN))
#define Wpg_t ((bf16*)(ws + WS_WPG))
#define Wpp_t ((bf16*)(ws + WS_WPP))
#define XN ((bf16*)(ws + WS_XN))
#define PB ((bf16*)(ws + WS_PB))
#define QKV ((bf16*)(ws + WS_QKV))
#define SG ((bf16*)(ws + WS_SG))
#define OAB ((bf16*)(ws + WS_XN))
#define MIX ((bf16*)(ws + WS_MIX))
#define HID ((bf16*)(ws + WS_HID))
#define G3 ((bf16*)(ws + WS_G3))
#define Y ((bf16*)(ws + WS_Y))
#define rope ((float*)(ws + WS_ROPE))
#define kmean ((float*)(ws + WS_KMEAN))
#define out (args.out)
    const int lo = args.ph_lo, hi = args.ph_hi;
#define IN(k) (lo <= (k) && (k) < hi)
#define SEAM(k) do { if (IN(k) && IN((k) + 1)) { if (args.coop) { if ((k) == 0) { asm volatile("s_waitcnt vmcnt(0) lgkmcnt(0)" ::: "memory"); cg::this_grid().sync(); } else { xcd_barrier(xbar); } } } } while (0)
    volatile LAS unsigned* bst = (volatile LAS unsigned*)(L + LDS_BYTES - 64);
    if (tid < 2) bst[tid] = 0u;
    __syncthreads();
    XcdBarrier xbar; xbar.bar = (unsigned*)(ws + WS_BAR); xbar.x = 0; xbar.st = bst;
    if (args.coop) xbar = xcd_barrier_post((unsigned*)(ws + WS_BAR), bst);

    if (IN(0)) {
        LAS float* scr = (LAS float*)(L + wave * 16896);
        constexpr int I_IN = (DM / 64) * (INW / 64), I_BR = (1024 / 64) * (DM / 64), I_OUT = (DM / 64) * (DM / 64), I_UP = (DM / 64) * (DFF / 64), I_DN = (DFF / 64) * (DM / 64), I_PP = (PLE / 64) * (DM / 64);
        constexpr int NITEMS = I_IN + 2 * I_BR + I_OUT + I_UP + I_DN + I_OUT + I_PP;
        for (int it = gw; it < NITEMS; it += NGW) {
            int r = it;
            if (r < I_IN) { p0_transpose_item(args.in[2], DM, INW, Win_t, scr, r, lane); continue; } r -= I_IN;
            if (r < I_BR) { p0_transpose_item(args.in[3], 1024, DM, Wa_t, scr, r, lane, 2048); continue; } r -= I_BR;
            if (r < I_BR) { p0_transpose_item(args.in[4], 1024, DM, Wa_t + 1024, scr, r, lane, 2048); continue; } r -= I_BR;
            if (r < I_OUT) { p0_transpose_item(args.in[5], DM, DM, Wout_t, scr, r, lane); continue; } r -= I_OUT;
            if (r < I_UP) { p0_transpose_item(args.in[13], DM, DFF, Wup_t, scr, r, lane); continue; } r -= I_UP;
            if (r < I_DN) { p0_transpose_item(args.in[14], DFF, DM, Wdn_t, scr, r, lane); continue; } r -= I_DN;
            if (r < I_OUT) { p0_transpose_item(args.in[18], DM, DM, Wpg_t, scr, r, lane, DM + PLE); continue; } r -= I_OUT;
            p0_transpose_item(args.in[17], PLE, DM, Wpg_t + DM, scr, r, lane, DM + PLE);
        }
        for (int m = gw; m < T; m += NGW) rms_row_to_bf16(x_in + (size_t)m * DM, args.in[11], XN + (size_t)m * DM, lane);
        if (bx == 0) { for (int i = tid; i < 16 * 64 + 16; i += 512) { if (i < 1024) ((int*)(ws + WS_CNT))[i] = 0; else ((int*)(ws + WS_NBLK))[i - 1024] = 0; } }
        for (int i = bx * 512 + tid; i < 16 * 64 * 128; i += G * 512) kmean[i] = 0.f;
        for (int i = bx * 512 + tid; i < SEQ * 16; i += G * 512) { const int pos = i >> 4, k = i & 15;
            double fr_ = 1.0; for (int j_ = 0; j_ < k; ++j_) fr_ *= 0.4403666026717805;
            const float angf = (float)pos * (float)fr_; const double a = (double)angf;
            const double TWO_PI = 6.283185307179586476925286766559; double q = __builtin_rint(a / TWO_PI); double r = a - q * TWO_PI;
            const double r2 = r * r; double sn = 1.0, cs = 1.0;
            sn = 1.0 - r2 / (22.0 * 23.0); sn = 1.0 - r2 / (20.0 * 21.0) * sn; sn = 1.0 - r2 / (18.0 * 19.0) * sn; sn = 1.0 - r2 / (16.0 * 17.0) * sn; sn = 1.0 - r2 / (14.0 * 15.0) * sn; sn = 1.0 - r2 / (12.0 * 13.0) * sn;
            sn = 1.0 - r2 / (10.0 * 11.0) * sn; sn = 1.0 - r2 / (8.0 * 9.0) * sn; sn = 1.0 - r2 / (6.0 * 7.0) * sn; sn = 1.0 - r2 / (4.0 * 5.0) * sn; sn = 1.0 - r2 / (2.0 * 3.0) * sn; sn = r * sn;
            cs = 1.0 - r2 / (21.0 * 22.0); cs = 1.0 - r2 / (19.0 * 20.0) * cs; cs = 1.0 - r2 / (17.0 * 18.0) * cs; cs = 1.0 - r2 / (15.0 * 16.0) * cs; cs = 1.0 - r2 / (13.0 * 14.0) * cs; cs = 1.0 - r2 / (11.0 * 12.0) * cs;
            cs = 1.0 - r2 / (9.0 * 10.0) * cs; cs = 1.0 - r2 / (7.0 * 8.0) * cs; cs = 1.0 - r2 / (5.0 * 6.0) * cs; cs = 1.0 - r2 / (3.0 * 4.0) * cs; cs = 1.0 - r2 / (1.0 * 2.0) * cs;
            rope[(size_t)pos * 32 + k] = (float)cs; rope[(size_t)pos * 32 + 16 + k] = (float)sn; }
    }
    SEAM(0);
    if (IN(1)) {
        pg8::Gemm g{XN, Win_t, T, INW, DM}; pg8::StaticOrder S; S.init(T, INW, G, bx);
        pg8::EpiInProj E{QKV, SG, (const float*)rope, kmean};
        pg8::gemm_phase<pg8::EpiInProj, pg8::StaticOrder, true, true>(L, g, S, E);
    }
    SEAM(1);
    if (IN(3)) {
        LAS float* km = (LAS float*)L;
        const bf16* QA = QKV;
        for (int u = vcu; u < 16 * 64; u += G) {
            const int bh = u & 15, qb = u >> 4;
            __syncthreads();
            for (int i = tid; i < qb * 128 / 4; i += 512) *(LAS f32x4*)(km + i * 4) = *(const f32x4*)(kmean + (size_t)bh * 64 * 128 + i * 4);
            __syncthreads();
            const int row = tid >> 1, half = tid & 1;
            const bf16* qp = QA + ((size_t)bh * SEQ + (size_t)qb * 256 + row) * 128 + half * 64;
            float q[64];
#pragma unroll
            for (int i = 0; i < 8; ++i) { const v4u w = *(const v4u*)(qp + i * 8);
                q[8 * i + 0] = bflo(w.x); q[8 * i + 1] = bfhi(w.x); q[8 * i + 2] = bflo(w.y); q[8 * i + 3] = bfhi(w.y); q[8 * i + 4] = bflo(w.z); q[8 * i + 5] = bfhi(w.z); q[8 * i + 6] = bflo(w.w); q[8 * i + 7] = bfhi(w.w); }
            float g0 = -__builtin_inff(), g1 = g0, g2 = g0; int i0 = -1, i1 = -1, i2 = -1;
            for (int n = 0; n < qb; ++n) {
                const LAS float* kp = km + n * 128 + half * 64; float s = 0.f;
#pragma unroll
                for (int i = 0; i < 16; ++i) { const f32x4 kv = *(const LAS f32x4*)(kp + 4 * i); s += q[4 * i] * kv.x + q[4 * i + 1] * kv.y + q[4 * i + 2] * kv.z + q[4 * i + 3] * kv.w; }
                s += __shfl_xor(s, 1);
                if (s > g0) { g2 = g1; i2 = i1; g1 = g0; i1 = i0; g0 = s; i0 = n; }
                else if (s > g1) { g2 = g1; i2 = i1; g1 = s; i1 = n; }
                else if (s > g2) { g2 = s; i2 = n; }
            }
            if (half == 0) {
                const int grow = qb * 256 + row; int s0 = -1, s1 = -1, s2 = -1; int* cnt = (int*)(ws + WS_CNT) + bh * 64; float2* stt = (float2*)(ws + WS_STATS);
                float2 none; none.x = -1e30f; none.y = 0.f;
                if (i0 >= 0) s0 = atomicAdd(cnt + i0, 1); else stt[(size_t)(bh * 4 + 0) * SEQ + grow] = none;
                if (i1 >= 0) s1 = atomicAdd(cnt + i1, 1); else stt[(size_t)(bh * 4 + 1) * SEQ + grow] = none;
                if (i2 >= 0) s2 = atomicAdd(cnt + i2, 1); else stt[(size_t)(bh * 4 + 2) * SEQ + grow] = none;
                int4 rec; rec.x = (i0 & 255) | ((i1 & 255) << 8) | ((i2 & 255) << 16); rec.y = s0; rec.z = s1; rec.w = s2;
                ((int4*)(ws + WS_SEL))[(size_t)bh * SEQ + grow] = rec; }
        }
        __syncthreads();
    }
    SEAM(3);
    if (IN(4)) {
        LAS int* cn = (LAS int*)L; LAS int* offs = cn + 64;
        int* ROWL = (int*)(ws + WS_ROWL); int* DSTL = (int*)(ws + WS_DSTL);
        for (int u = vcu; u < 16 * 64; u += G) {
            const int bh = u & 15, chunk = u >> 4;
            __syncthreads();
            if (tid < 64) cn[tid] = ((const int*)(ws + WS_CNT))[bh * 64 + tid];
            __syncthreads();
            if (tid == 0) { int a = 0; for (int j = 0; j < 64; ++j) { offs[j] = a; a += (cn[j] + 255) & ~255; } offs[64] = a; }
            __syncthreads();
            int* rl = ROWL + (size_t)bh * LSTR; int* dl = DSTL + (size_t)bh * LSTR;
            if (tid < 256) { const int row = chunk * 256 + tid; const int4 rec = ((const int4*)(ws + WS_SEL))[(size_t)bh * SEQ + row];
                const int j0 = rec.x & 255, j1 = (rec.x >> 8) & 255, j2 = (rec.x >> 16) & 255;
                if (j0 != 255) { const int gp = offs[j0] + rec.y; rl[gp] = row; dl[gp] = (bh * 4 + 0) * SEQ + row; }
                if (j1 != 255) { const int gp = offs[j1] + rec.z; rl[gp] = row; dl[gp] = (bh * 4 + 1) * SEQ + row; }
                if (j2 != 255) { const int gp = offs[j2] + rec.w; rl[gp] = row; dl[gp] = (bh * 4 + 2) * SEQ + row; }
                rl[65536 + row] = row; dl[65536 + row] = (bh * 4 + 3) * SEQ + row; }
            if (chunk == 0) {
                for (int idx = tid; idx < 64 * 256; idx += 512) { const int j = idx >> 8, c = cn[j], pos = c + (idx & 255);
                    if (pos < ((c + 255) & ~255)) { rl[offs[j] + pos] = 0; dl[offs[j] + pos] = -1; } }
                if (tid == 0) { int k = 0; int2* tab = (int2*)(ws + WS_TAB) + bh * 256;
                    for (int j = 0; j < 64; ++j) { const int nb = (cn[j] + 255) >> 8; for (int b_ = 0; b_ < nb; ++b_) { if (k < 256) { int2 t; t.x = j; t.y = offs[j] + 256 * b_; tab[k] = t; } ++k; } }
                    ((int*)(ws + WS_NBLK))[bh] = k < 256 ? k : 256; }
            }
        }
        __syncthreads();
    }
    SEAM(4);
    if (IN(5)) {
        const int* nblk = (const int*)(ws + WS_NBLK);
        static_assert(swa::MOBA_LDS_BYTES <= LDS_BYTES - 64, "MoBA short-block LDS");
        int Lc = vcu; if (!moba_valid(Lc, nblk)) Lc = moba_next(Lc, G, nblk);
        for (; Lc < MOBA_ITEMS; Lc = moba_next(Lc, G, nblk)) { const ABlock cur = moba_ref(Lc, ws, out); swa::moba_block(cur, (char*)lds); }
        __syncthreads();
    }
    SEAM(5);
    if (IN(6)) {
        const float2* stt = (const float2*)(ws + WS_STATS); const bf16* PART = (const bf16*)out; constexpr float C2 = 1.4426950408889634f * 0.08838834764831845f;
        for (int u0 = gw; u0 < 16 * SEQ; u0 += 4 * NGW) {
            float2 st[4][4]; unsigned pw[4][4];
#pragma unroll
            for (int k = 0; k < 4; ++k) { const int u = u0 + k * NGW, bh = u >> 14, row = u & (SEQ - 1);
#pragma unroll
                for (int s_ = 0; s_ < 4; ++s_) { const size_t di = (size_t)(bh * 4 + s_) * SEQ + row; st[k][s_] = stt[di]; pw[k][s_] = ntload((const unsigned*)(PART + di * 128 + lane * 2)); } }
#pragma unroll
            for (int k = 0; k < 4; ++k) { const int u = u0 + k * NGW, bh = u >> 14, row = u & (SEQ - 1);
                float M = -1e30f;
#pragma unroll
                for (int s_ = 0; s_ < 4; ++s_) if (st[k][s_].y > 0.f) M = fmaxf(M, st[k][s_].x);
                float a0 = 0.f, a1 = 0.f, den = 0.f;
#pragma unroll
                for (int s_ = 0; s_ < 4; ++s_) { const bool ok = st[k][s_].y > 0.f; const float w = ok ? st[k][s_].y * __builtin_amdgcn_exp2f((st[k][s_].x - M) * C2) : 0.f;
                    a0 += ok ? w * bflo(pw[k][s_]) : 0.f; a1 += ok ? w * bfhi(pw[k][s_]) : 0.f; den += w; }
                const float inv = 1.0f / den;
                *(unsigned*)(OAB + ((size_t)(bh >> 3) * SEQ + row) * 2048 + (bh & 7) * 128 + lane * 2) = pk2(a0 * inv, a1 * inv); } }
    }
    SEAM(6);
    if (IN(7)) {
        constexpr int NITEM = 32 * 32;
        int Lc = vcu;
        if (Lc < NITEM) {
            int head = Lc >> 5, xx = Lc & 31, pass = 0;
            ABlock cur = attn_ref(head, xx, ws, out);
            swa::Seam<swa::bf16> S;
            swa::causal_swa_prime<swa::bf16, swa::bf16>(cur, SEQ, (char*)lds, S);
            for (;;) {
                const bool more_pass = pass == 0, more_item = Lc + G < NITEM, last = !more_pass && !more_item;
                int headn = head, xn = xx, passn = pass + 1, Ln = Lc;
                if (!more_pass) { passn = 0; Ln = more_item ? Lc + G : Lc; headn = Ln >> 5; xn = Ln & 31; }
                const int qbn = passn ? 63 - xn : xn;
                ABlock nxt = cur;
                if (!last) nxt = attn_ref(headn, qbn, ws, out);
                swa::causal_swa_block<swa::bf16, swa::bf16>(cur, nxt, SEQ, SEQ, (char*)lds, S);
                if (last) break;
                cur = nxt; head = headn; xx = xn; pass = passn; Lc = Ln;
            }
        }
        __syncthreads();
    }
    SEAM(7);
    if (IN(8)) {
        float lam;
        { const float* q1 = args.in[6]; const float* k1 = args.in[7]; const float* q2 = args.in[8]; const float* k2 = args.in[9];
          const float s1 = wave_sum(q1[lane] * k1[lane] + q1[lane + 64] * k1[lane + 64]), s2 = wave_sum(q2[lane] * k2[lane] + q2[lane + 64] * k2[lane + 64]);
          lam = __expf(s1) - __expf(s2) + LAMBDA_INIT; }
        const bf16* AD = (const bf16*)out; const float* sg = args.in[10];
        const f32x4 gg = *(const f32x4*)(sg + lane * 4);
        for (int u0 = gw; u0 < T * 4; u0 += 4 * NGW) {
            v2u w0[4], w1[4];
#pragma unroll
            for (int k = 0; k < 4; ++k) { const int u = u0 + k * NGW, t = u >> 2, hd = u & 3; const bf16* a = AD + (size_t)t * 4096 + hd * 512 + lane * 4; w0[k] = ntload((const v2u*)a); w1[k] = ntload((const v2u*)(a + 256)); }
#pragma unroll
            for (int k = 0; k < 4; ++k) { const int u = u0 + k * NGW, t = u >> 2, hd = u & 3;
                f32x4 d; d.x = bflo(w0[k].x) - lam * bflo(w1[k].x); d.y = bfhi(w0[k].x) - lam * bfhi(w1[k].x); d.z = bflo(w0[k].y) - lam * bflo(w1[k].y); d.w = bfhi(w0[k].y) - lam * bfhi(w1[k].y);
                const float ss = wave_sum((d.x * d.x + d.y * d.y) + (d.z * d.z + d.w * d.w));
                const float r = (1.0f - LAMBDA_INIT) / sqrtf(ss * (1.f / 256.f) + NORM_EPS);
                v2u o; o.x = pk2(d.x * r * gg.x, d.y * r * gg.y); o.y = pk2(d.z * r * gg.z, d.w * r * gg.w);
                *(v2u*)(OAB + (size_t)t * 2048 + 1024 + hd * 256 + lane * 4) = o; } }
    }
    SEAM(8);
    if (IN(9)) { pg8::Gemm g{OAB, Wa_t, T, DM, 2048}; pg8::StaticOrder S; S.init(T, DM, G, bx); pg8::EpiGate2 E{MIX, SG};
        pg8::gemm_phase<pg8::EpiGate2, pg8::StaticOrder, true, true, true>(L, g, S, E); }
    SEAM(9);
    if (IN(11)) { pg8::Gemm g{MIX, Wout_t, T, DM, DM}; pg8::StaticOrder S; S.init(T, DM, G, bx); pg8::EpiT<0> E{Y, DM, nullptr, 0};
        pg8::gemm_phase<pg8::EpiT<0>, pg8::StaticOrder, true, true>(L, g, S, E); }
    SEAM(11);
    if (IN(12)) row_pass(Y, x_in, args.in[12], out, args.in[15], XN, gw, NGW, lane);
    SEAM(12);
    if (IN(13)) { pg8::Gemm g{XN, Wup_t, T, DFF, DM}; pg8::StaticOrder S; S.init(T, DFF, G, bx); pg8::EpiT<1> E{HID, DFF, nullptr, 0};
        pg8::gemm_phase<pg8::EpiT<1>, pg8::StaticOrder, true, true>(L, g, S, E); }
    SEAM(13);
    if (IN(14)) { pg8::Gemm g{HID, Wdn_t, T, DM, DFF}; pg8::StaticOrder S; S.init(T, DM, G, bx); pg8::EpiT<0> E{Y, DM, nullptr, 0};
        pg8::gemm_phase<pg8::EpiT<0>, pg8::StaticOrder, true, true>(L, g, S, E); }
    SEAM(14);
    if (IN(15)) row_pass(Y, out, args.in[16], out, args.in[19], (bf16*)(ws + WS_XN3), gw, NGW, lane, DM + PLE, p_in);
    SEAM(15);
    if (IN(16)) { pg8::Gemm g{(bf16*)(ws + WS_XN3), Wpg_t, T, DM, DM + PLE}; pg8::StaticOrder S; S.init(T, DM, G, bx); pg8::EpiPle E{Y, G3};
        pg8::gemm_phase<pg8::EpiPle, pg8::StaticOrder, true, true, true>(L, g, S, E); }
    SEAM(17);
    if (IN(18)) row_pass(Y, out, args.in[20], out, nullptr, nullptr, gw, NGW, lane);
#undef IN
#undef SEAM
#undef x_in
#undef p_in
#undef Win_t
#undef Wa_t
#undef Wb_t
#undef Wout_t
#undef Wup_t
#undef Wdn_t
#undef Wpg_t
#undef Wpp_t
#undef XN
#undef PB
#undef QKV
#undef SG
#undef OAB
#undef MIX
#undef HID
#undef G3
#undef Y
#undef rope
#undef kmean
#undef out
}

extern "C" void kernel_launch(void* const* d_in, const int* in_sizes, int n_in, void* d_out, int out_size, void* d_ws, size_t ws_size, hipStream_t stream) {
    static int grid = 0;
    if (grid == 0) {
        if (n_in != 21 || out_size != T * DM || ws_size < WS_TOP) { fprintf(stderr, "kernel_launch: unexpected shapes n_in %d out %d ws %zu\n", n_in, out_size, ws_size); grid = -1; return; }
        int dev = 0, cus = 0, per_cu = 0;
        (void)hipGetDevice(&dev); (void)hipDeviceGetAttribute(&cus, hipDeviceAttributeMultiprocessorCount, dev);
        if (hipFuncSetAttribute((const void*)mk_fwd, hipFuncAttributeMaxDynamicSharedMemorySize, LDS_BYTES) != hipSuccess) { fprintf(stderr, "kernel_launch: hipFuncSetAttribute failed\n"); grid = -1; return; }
        if (hipOccupancyMaxActiveBlocksPerMultiprocessor(&per_cu, (const void*)mk_fwd, NWAVES * 64, LDS_BYTES) != hipSuccess || per_cu < 1) { fprintf(stderr, "kernel_launch: occupancy query says %d\n", per_cu); per_cu = 1; }
        (void)hipGetLastError();
        grid = cus * 1;
        if (grid <= 0) grid = 256;
    }
    if (grid < 0) return;
    (void)hipMemsetAsync((unsigned char*)d_ws + WS_BAR, 0, WS_BAR_BYTES, stream);
    Args a{};
    for (int i = 0; i < 21; ++i) a.in[i] = (const float*)d_in[i];
    a.out = (float*)d_out; a.ws = (unsigned char*)d_ws;
#if MK_ONE_LAUNCH
    a.ph_lo = 0; a.ph_hi = NPHASE; a.coop = 1;
    void* kargs[] = {&a};
    hipError_t e = hipLaunchCooperativeKernel((const void*)mk_fwd, dim3(grid), dim3(NWAVES * 64), kargs, LDS_BYTES, stream);
    if (e != hipSuccess) fprintf(stderr, "cooperative launch failed: %s (grid %d)\n", hipGetErrorString(e), grid);
#else
    for (int ph = 0; ph < NPHASE; ++ph) { a.ph_lo = ph; a.ph_hi = ph + 1; a.coop = 0;
        hipLaunchKernelGGL(mk_fwd, dim3(grid), dim3(NWAVES * 64), LDS_BYTES, stream, a); }
#endif
}
```

```cpp
#include <hip/hip_runtime.h>
#include <hip/hip_bf16.h>
#include <cstdio>
#include <cstdint>
#include <cmath>
namespace pg8 {
#define PG8_LAS __attribute__((address_space(3)))
typedef unsigned short bf16_t;
typedef short bf16x8 __attribute__((ext_vector_type(8)));
typedef float f32x4 __attribute__((ext_vector_type(4)));
typedef unsigned u32x4 __attribute__((ext_vector_type(4)));
constexpr int BM = 256, BK = 64, HALF = 128, HTB = HALF * BK * 2  , STAGE_BYTES = 8 * HTB, NXCD = 8, WGM = 8;

__host__ __device__ __forceinline__ int lds_byte(int r, int c) { const int st = (r >> 4) * 2 + (c >> 5), rr = r & 15, cc = c & 31, ob = rr * 64 + cc * 2; return st * 1024 + (ob ^ (((ob >> 9) & 1) << 5)); }
__host__ __device__ __forceinline__ void stage_rc(int b, int& R, int& C) { const int st = b / 1024, sb = b % 1024, swz = sb ^ (((sb >> 9) & 1) << 5); R = (st >> 1) * 16 + swz / 64; C = (st & 1) * 32 + (swz % 64) / 2; }
__host__ __device__ __forceinline__ int perm32(int rho) { const int n = rho >> 4, i = rho & 15; return 8 * (i >> 2) + 4 * n + (i & 3); }

struct Unit { int pm, pn; };
struct Gemm { const bf16_t* A; const bf16_t* Bt; int M, N, K; };

struct StaticOrder {
    int nM, nN, nwg, G, c;
    __host__ __device__ void init(int M, int N, int G_, int c_) { nM = M / BM; nN = N / BM; nwg = nM * nN; G = G_; c = c_; }
    __host__ __device__ bool next(int i, Unit& u) const {
        const long L = (long)i * G + c; if (L >= nwg) return false;
        int wgid = (int)L; { const int q = nwg / NXCD, r = nwg % NXCD, xcd = wgid % NXCD, off = wgid / NXCD; wgid = (xcd < r ? xcd * (q + 1) : r * (q + 1) + (xcd - r) * q) + off; }
        const int nig = WGM * nN, gid = wgid / nig, fm = gid * WGM, gsz = (nM - fm) < WGM ? (nM - fm) : WGM;
        u.pm = fm + ((wgid % nig) % gsz); u.pn = (wgid % nig) / gsz; return true;
    }
    __device__ __forceinline__ void a_ready(const Unit&) const {}
    __device__ __forceinline__ void done(const Unit&) const {}
};

typedef float f32x2_c __attribute__((ext_vector_type(2))); typedef __bf16 bf16x2_c __attribute__((ext_vector_type(2)));
__device__ __forceinline__ unsigned cvt_pk_bf16(float lo, float hi) { f32x2_c v = {lo, hi}; bf16x2_c b = __builtin_convertvector(v, bf16x2_c); return __builtin_bit_cast(unsigned, b); }
typedef float f32x2 __attribute__((ext_vector_type(2)));
__device__ __forceinline__ f32x2 gelu_pk(f32x2 v) {
    const f32x2 av = __builtin_elementwise_abs(v), d = av * 0.2316418882f + 1.0f;
    f32x2 t; t.x = __builtin_amdgcn_rcpf(d.x); t.y = __builtin_amdgcn_rcpf(d.y);
    f32x2 q = t * 0.5307027145f + (-0.7265760135f); q = q * t + 0.7107068705f; q = q * t + (-0.142248368f); q = q * t + 0.127414796f; q = q * t;
    const f32x2 s = (v * v) * (-0.72134752044f);
    f32x2 e; e.x = __builtin_amdgcn_exp2f(s.x); e.y = __builtin_amdgcn_exp2f(s.y);
    const f32x2 m = v * (q * e), r = v - m;
    f32x2 o; o.x = v.x < 0.f ? m.x : r.x; o.y = v.y < 0.f ? m.y : r.y; return o;
}

template <int ACT  > struct EpiBf16 {
    static constexpr bool PERM = true, AFTER_DRAIN = false; static_assert(ACT == 0 || ACT == 1, "EpiBf16: ACT is 0 (none) or 1 (gelu_pk)");
    bf16_t* O; int ldc; const float* bias; int split_cols; size_t split_stride; float scale0;
    __device__ __forceinline__ void operator()(const f32x4 (&acc)[2][2][4][2], const Unit& u, int wr, int wc, int fr, int fq) const {
        const int row0 = u.pm * BM + wr * 64 + fr; int colt = u.pn * BM; bf16_t* base = O;
        float sc = 1.f; if (split_cols) { const int t = colt / split_cols; base += (size_t)t * split_stride; colt -= t * split_cols; if (t == 0) sc = scale0; }
        const int col0 = colt + wc * 32 + 8 * fq, bcol0 = u.pn * BM + wc * 32 + 8 * fq;
        f32x4 bv[2][2];
#pragma unroll
        for (int bj = 0; bj < 2; ++bj)
#pragma unroll
            for (int n = 0; n < 2; ++n) bv[bj][n] = bias ? *(const f32x4*)(bias + bcol0 + bj * HALF + 4 * n) : (f32x4){0.f, 0.f, 0.f, 0.f};
#pragma unroll
        for (int ai = 0; ai < 2; ++ai)
#pragma unroll
            for (int m = 0; m < 4; ++m) { bf16_t* rowp = base + (size_t)(row0 + ai * HALF + m * 16) * ldc + col0;
#pragma unroll
                for (int bj = 0; bj < 2; ++bj) { f32x4 v0 = acc[ai][bj][m][0] + bv[bj][0], v1 = acc[ai][bj][m][1] + bv[bj][1];
                    if (ACT == 1) { f32x2 a = gelu_pk((f32x2){v0[0], v0[1]}), b = gelu_pk((f32x2){v0[2], v0[3]}), c = gelu_pk((f32x2){v1[0], v1[1]}), d = gelu_pk((f32x2){v1[2], v1[3]});
                        v0 = (f32x4){a.x, a.y, b.x, b.y}; v1 = (f32x4){c.x, c.y, d.x, d.y}; }
                    v0 = v0 * sc; v1 = v1 * sc; u32x4 w; w.x = cvt_pk_bf16(v0[0], v0[1]); w.y = cvt_pk_bf16(v0[2], v0[3]); w.z = cvt_pk_bf16(v1[0], v1[1]); w.w = cvt_pk_bf16(v1[2], v1[3]);
                    *(u32x4*)(rowp + bj * HALF) = w; } }
    }
};

template <class Epi, class Sched, bool ALIGN_EPI = false, bool SP2 = false, bool MID = false>
__device__ __forceinline__ void gemm_phase(PG8_LAS unsigned char* lds, const Gemm g, const Sched& S, const Epi& E) {
    const int tid = threadIdx.x, wid = __builtin_amdgcn_readfirstlane(tid >> 6), lane = tid & 63, wr = wid >> 2, wc = wid & 3, fr = lane & 15, fq = lane >> 4;
    const int K = g.K, nt = K / BK;
    unsigned voffA[2], voffB[2];
#pragma unroll
    for (int i = 0; i < 2; ++i) { int R, C; stage_rc(tid * 16 + i * 8192, R, C); const int Rb = Epi::PERM ? ((R & ~31) + perm32(R & 31)) : R;
        voffA[i] = (unsigned)(R * K + C) * 2u; voffB[i] = (unsigned)(Rb * K + C) * 2u; }
    const size_t kstep = (size_t)(BK * 2);
    const size_t hstep = (size_t)HALF * K * 2;
    const size_t tstep = 2 * hstep;
    const unsigned ldsw = (unsigned)wid * 1024u;
    const int aoff = lds_byte(wr * 64 + fr, fq * 8), boff = lds_byte(wc * 32 + fr, fq * 8);
#define PG8_SA(b, h) (((b) * 2 + (h)) * HTB)
#define PG8_SB(b, h) ((4 + (b) * 2 + (h)) * HTB)
#define PG8_STAGE(bufoff, gbase, voff) do { _Pragma("unroll") for (int _i = 0; _i < 2; ++_i) \
        __builtin_amdgcn_global_load_lds((const unsigned*)((const char*)(gbase) + (voff)[_i]), (PG8_LAS unsigned*)(lds + (bufoff) + ldsw + _i * 8192), 16, 0, 0); } while (0)
#define PG8_LDA(dst, b, h) do { _Pragma("unroll") for (int m = 0; m < 4; ++m) _Pragma("unroll") for (int k = 0; k < 2; ++k) dst[m][k] = *(const PG8_LAS bf16x8*)(lds + PG8_SA(b, h) + aoff + m * 2048 + k * 1024); } while (0)
#define PG8_LDB(dst, b, h) do { _Pragma("unroll") for (int n = 0; n < 2; ++n) _Pragma("unroll") for (int k = 0; k < 2; ++k) dst[n][k] = *(const PG8_LAS bf16x8*)(lds + PG8_SB(b, h) + boff + n * 2048 + k * 1024); } while (0)
#define PG8_MMA(ai, bj, At, Bt) do { __builtin_amdgcn_s_setprio(1); _Pragma("unroll") for (int m = 0; m < 4; ++m) _Pragma("unroll") for (int n = 0; n < 2; ++n) _Pragma("unroll") for (int k = 0; k < 2; ++k) \
        acc[ai][bj][m][n] = __builtin_amdgcn_mfma_f32_16x16x32_bf16(Bt[n][k], At[m][k], acc[ai][bj][m][n], 0, 0, 0); __builtin_amdgcn_s_setprio(0); } while (0)
#define PG8_WAIT_V(n) asm volatile("s_waitcnt vmcnt(" #n ")" ::: "memory")
#define PG8_WAIT_L(n) asm volatile("s_waitcnt lgkmcnt(" #n ")" ::: "memory")
#define PG8_BAR __builtin_amdgcn_s_barrier()
#define PG8_SCHED __builtin_amdgcn_sched_barrier(0)
    Unit cur, nxt; int ui = 0;
    if (!S.next(0, cur)) return;
    f32x4 acc[2][2][4][2];
#pragma unroll
    for (int a = 0; a < 2; ++a)
#pragma unroll
        for (int b = 0; b < 2; ++b)
#pragma unroll
            for (int m = 0; m < 4; ++m)
#pragma unroll
                for (int n = 0; n < 2; ++n) acc[a][b][m][n] = (f32x4){0.f, 0.f, 0.f, 0.f};
    bf16x8 At[4][2], B0[2][2], B1[2][2];
    const char* cA = (const char*)g.A + (size_t)cur.pm * tstep; const char* cB = (const char*)g.Bt + (size_t)cur.pn * tstep;
    S.a_ready(cur);
    if constexpr (SP2) {
        PG8_STAGE(PG8_SB(0, 0), cB, voffB); PG8_STAGE(PG8_SB(0, 1), cB + hstep, voffB); PG8_STAGE(PG8_SA(0, 0), cA, voffA); PG8_STAGE(PG8_SA(0, 1), cA + hstep, voffA);
        if (wr == 1) PG8_BAR;
        PG8_WAIT_V(2); PG8_BAR;
        PG8_STAGE(PG8_SB(1, 0), cB + kstep, voffB); PG8_STAGE(PG8_SA(1, 0), cA + kstep, voffA); PG8_STAGE(PG8_SB(1, 1), cB + hstep + kstep, voffB);
        PG8_WAIT_V(6); PG8_BAR;
    } else {
        PG8_STAGE(PG8_SB(0, 0), cB, voffB); PG8_STAGE(PG8_SA(0, 0), cA, voffA); PG8_STAGE(PG8_SB(0, 1), cB + hstep, voffB); PG8_STAGE(PG8_SA(0, 1), cA + hstep, voffA);
        if (wr == 1) PG8_BAR;
        PG8_WAIT_V(4); PG8_BAR;
        PG8_STAGE(PG8_SB(1, 0), cB + kstep, voffB); PG8_STAGE(PG8_SA(1, 0), cA + kstep, voffA); PG8_STAGE(PG8_SB(1, 1), cB + hstep + kstep, voffB);
        PG8_WAIT_V(6); PG8_BAR;
    }
    for (;;) {
        const bool has_next = S.next(ui + 1, nxt);
        const char* nA = has_next ? (const char*)g.A + (size_t)nxt.pm * tstep : cA; const char* nB = has_next ? (const char*)g.Bt + (size_t)nxt.pn * tstep : cB;
        for (int t = 0; t < nt; t += 2) {
            const bool last = (t == nt - 2);
            if constexpr (MID) { if (t == Epi::MID_T) { PG8_SCHED; E.mid(acc, cur, wr, wc, fr, fq); PG8_SCHED; } }
            const char* a1 = cA + (size_t)(t + 1) * kstep;
            const char* a2 = last ? nA : cA + (size_t)(t + 2) * kstep; const char* b2 = last ? nB : cB + (size_t)(t + 2) * kstep;
            const char* a3 = a2 + kstep; const char* b3 = b2 + kstep;
            if (last && has_next) S.a_ready(nxt);
            if constexpr (SP2) {
            PG8_LDB(B0, 0, 0); PG8_LDB(B1, 0, 1); PG8_SCHED; PG8_LDA(At, 0, 0); PG8_STAGE(PG8_SA(1, 1), a1 + hstep, voffA);
            PG8_WAIT_V(8); PG8_WAIT_L(0); PG8_BAR; PG8_MMA(0, 0, At, B0); PG8_MMA(0, 1, At, B1); PG8_BAR; PG8_SCHED;
            PG8_LDA(At, 0, 1); PG8_STAGE(PG8_SB(0, 0), b2, voffB); PG8_STAGE(PG8_SB(0, 1), b2 + hstep, voffB); PG8_STAGE(PG8_SA(0, 0), a2, voffA);
            PG8_WAIT_V(8); PG8_WAIT_L(0); PG8_BAR; PG8_MMA(1, 0, At, B0); PG8_MMA(1, 1, At, B1); PG8_BAR; PG8_SCHED;
            PG8_LDB(B0, 1, 0); PG8_LDB(B1, 1, 1); PG8_SCHED; PG8_LDA(At, 1, 0); PG8_STAGE(PG8_SA(0, 1), a2 + hstep, voffA);
            PG8_WAIT_V(8); PG8_WAIT_L(0); PG8_BAR; PG8_MMA(0, 0, At, B0); PG8_MMA(0, 1, At, B1); PG8_BAR; PG8_SCHED;
            PG8_LDA(At, 1, 1); PG8_STAGE(PG8_SB(1, 0), b3, voffB); PG8_STAGE(PG8_SB(1, 1), b3 + hstep, voffB); PG8_STAGE(PG8_SA(1, 0), a3, voffA);
            PG8_WAIT_V(8); PG8_WAIT_L(0); PG8_BAR; PG8_MMA(1, 0, At, B0); PG8_MMA(1, 1, At, B1); PG8_BAR; PG8_SCHED;
            } else {
            PG8_LDB(B0, 0, 0); PG8_SCHED; PG8_LDA(At, 0, 0); PG8_STAGE(PG8_SA(1, 1), a1 + hstep, voffA);
            PG8_WAIT_L(8); PG8_BAR; PG8_WAIT_L(0); PG8_MMA(0, 0, At, B0); PG8_BAR; PG8_SCHED;
            PG8_LDB(B1, 0, 1); PG8_STAGE(PG8_SB(0, 0), b2, voffB);
            PG8_BAR; PG8_WAIT_L(0); PG8_MMA(0, 1, At, B1); PG8_BAR;
            PG8_LDA(At, 0, 1); PG8_STAGE(PG8_SA(0, 0), a2, voffA);
            PG8_BAR; PG8_WAIT_L(0); PG8_MMA(1, 0, At, B0); PG8_BAR; PG8_SCHED;
            PG8_STAGE(PG8_SB(0, 1), b2 + hstep, voffB);
            PG8_WAIT_V(6); PG8_BAR; PG8_MMA(1, 1, At, B1); PG8_BAR;
            PG8_LDB(B0, 1, 0); PG8_SCHED; PG8_LDA(At, 1, 0); PG8_STAGE(PG8_SA(0, 1), a2 + hstep, voffA);
            PG8_WAIT_L(8); PG8_BAR; PG8_WAIT_L(0); PG8_MMA(0, 0, At, B0); PG8_BAR; PG8_SCHED;
            PG8_LDB(B1, 1, 1); PG8_STAGE(PG8_SB(1, 0), b3, voffB);
            PG8_BAR; PG8_WAIT_L(0); PG8_MMA(0, 1, At, B1); PG8_BAR;
            PG8_LDA(At, 1, 1); PG8_STAGE(PG8_SA(1, 0), a3, voffA);
            PG8_BAR; PG8_WAIT_L(0); PG8_MMA(1, 0, At, B0); PG8_BAR; PG8_SCHED;
            PG8_STAGE(PG8_SB(1, 1), b3 + hstep, voffB);
            PG8_WAIT_V(6); PG8_BAR; PG8_MMA(1, 1, At, B1); PG8_BAR;
            }
        }
        if constexpr (ALIGN_EPI) { if (wr == 0) PG8_BAR; }
        if constexpr (!Epi::AFTER_DRAIN) { E(acc, cur, wr, wc, fr, fq); S.done(cur); }
        if (!has_next) break;
#pragma unroll
        for (int a = 0; a < 2; ++a)
#pragma unroll
            for (int b = 0; b < 2; ++b)
#pragma unroll
                for (int m = 0; m < 4; ++m)
#pragma unroll
                    for (int n = 0; n < 2; ++n) acc[a][b][m][n] = (f32x4){0.f, 0.f, 0.f, 0.f};
        cur = nxt; cA = nA; cB = nB; ++ui;
        if constexpr (ALIGN_EPI) { if (wr == 1) PG8_BAR; }
    }
    PG8_WAIT_V(0);
    if constexpr (!ALIGN_EPI) { if (wr == 0) PG8_BAR; }
    PG8_BAR;
    if constexpr (Epi::AFTER_DRAIN) { E.fused(acc, cur, wr, wc, fr, fq, lds, wid, lane); S.done(cur); }
#undef PG8_SA
#undef PG8_SB
#undef PG8_STAGE
#undef PG8_LDA
#undef PG8_LDB
#undef PG8_MMA
#undef PG8_WAIT_V
#undef PG8_WAIT_L
#undef PG8_BAR
#undef PG8_SCHED
}
}
namespace swa {
constexpr int D = 128;
constexpr float THR = 8.f;
constexpr bool WSKIP = false;
constexpr float SCALE = 0.08838834764831845f;
constexpr int NW = 8, QBLK = 32, KVBLK = 64, QB = NW * QBLK;
constexpr int SHM_V = KVBLK * D * 2, SHM_K = KVBLK * D * 2;
constexpr int MSLOT_OFF = 2 * SHM_V + 2 * SHM_K + NW * 64 * 4, QLDS_OFF = MSLOT_OFF + 4096;
constexpr int LDS_BYTES = QLDS_OFF + NW * 8192;

using bf16 = __hip_bfloat16;
typedef short bf16x8 __attribute__((ext_vector_type(8)));
typedef short s16x4 __attribute__((ext_vector_type(4)));
typedef float f32x16 __attribute__((ext_vector_type(16)));
typedef float f32x4 __attribute__((ext_vector_type(4)));
typedef unsigned u32x4 __attribute__((ext_vector_type(4)));
template <class A, class Bt> struct same_t { static constexpr bool v = false; };
template <class A> struct same_t<A, A> { static constexpr bool v = true; };

#define KSWZ(row, colB) ((row) * 256 + ((colB) ^ (((row) & 7) << 4)))
#define SBAR() __builtin_amdgcn_sched_barrier(0)
__device__ __forceinline__ int v_st(int k, int c) { const int kk = (k & ~0xC) | ((k & 4) << 1) | ((k & 8) >> 1); return ((kk >> 3) * 4 + (c >> 5)) * 512 + ((kk & 7) * 32 + (c & 31)) * 2; }
__device__ __forceinline__ int v_rd_base(int lane) { return ((lane & 3) << 3) | (((lane >> 2) & 3) << 6) | (((lane >> 4) & 1) << 5) | (((lane >> 5) & 1) << 8); }
constexpr int v_rd_off(int d0, int ks, int half) { return d0 * 512 + ks * 4096 + half * 2048; }
__device__ __forceinline__ int crow(int r, int hi) { return (r & 3) + 8 * (r >> 2) + 4 * hi; }
typedef float f32x2_c __attribute__((ext_vector_type(2))); typedef __bf16 bf16x2_c __attribute__((ext_vector_type(2)));
__device__ __forceinline__ unsigned cvtpk(float lo, float hi) { f32x2_c v = {lo, hi}; bf16x2_c b = __builtin_convertvector(v, bf16x2_c); return __builtin_bit_cast(unsigned, b); }
__device__ __forceinline__ bf16x8 pack8(f32x4 a, f32x4 b) {
    u32x4 w = {cvtpk(a[0], a[1]), cvtpk(a[2], a[3]), cvtpk(b[0], b[1]), cvtpk(b[2], b[3])};
    return *reinterpret_cast<bf16x8*>(&w);
}
template <class T> __device__ __forceinline__ bf16x8 load8(const T* p) {
    if constexpr (same_t<T, float>::v) { return pack8(*(const f32x4*)p, *(const f32x4*)(p + 4)); }
    else { return *reinterpret_cast<const bf16x8*>(p); }
}
__device__ __forceinline__ void mask_tile(f32x16& p0, f32x16& p1, int dq, unsigned W) {
    const float NEG = -__builtin_inff();
#pragma unroll
    for (int r = 0; r < 16; ++r) {
        const int c = (r & 3) + 8 * (r >> 2);
        if ((unsigned)(dq - c) >= W) p0[r] = NEG;
        if ((unsigned)(dq - c - 32) >= W) p1[r] = NEG;
    }
}
__device__ __forceinline__ void partialSM(f32x16& p0, f32x16& p1, float& m_reg, float& mn, float& alpha) {
    float pmax = p0[0]; for (int r = 1; r < 16; ++r) pmax = fmaxf(pmax, p0[r]); for (int r = 0; r < 16; ++r) pmax = fmaxf(pmax, p1[r]);
    { auto rr = __builtin_amdgcn_permlane32_swap(__float_as_uint(pmax), __float_as_uint(pmax), false, false);
      pmax = fmaxf(__uint_as_float(rr[0]), __uint_as_float(rr[1])); }
    constexpr float C2 = 1.4426950408889634f * SCALE;
    if (__builtin_expect(__all((pmax - m_reg) * SCALE <= THR), 1)) { mn = m_reg; alpha = 1.f; }
    else { mn = fmaxf(m_reg, pmax); alpha = __builtin_amdgcn_exp2f((m_reg - mn) * C2); m_reg = mn; }
    const float mnL = -mn * C2;
    for (int r = 0; r < 16; ++r) p0[r] = fmaf(p0[r], C2, mnL); for (int r = 0; r < 16; ++r) p1[r] = fmaf(p1[r], C2, mnL);
    for (int r = 0; r < 16; ++r) p0[r] = __builtin_amdgcn_exp2f(p0[r]);
}
__device__ __forceinline__ void finishSM(f32x16& p0, f32x16& p1, float alpha, float& l_reg, bf16x8& pa0, bf16x8& pa1, bf16x8& pa2, bf16x8& pa3) {
    for (int r = 0; r < 16; ++r) p1[r] = __builtin_amdgcn_exp2f(p1[r]);
    float ps = 0; for (int r = 0; r < 16; ++r) ps += p0[r]; for (int r = 0; r < 16; ++r) ps += p1[r];
    { auto rr = __builtin_amdgcn_permlane32_swap(__float_as_uint(ps), __float_as_uint(ps), false, false);
      ps = __uint_as_float(rr[0]) + __uint_as_float(rr[1]); }
    l_reg = l_reg * alpha + ps;
#define PK4(P, B_, OUT) do { unsigned a0 = cvtpk(P[B_+0], P[B_+1]), a1 = cvtpk(P[B_+2], P[B_+3]);                          \
        unsigned b0 = cvtpk(P[B_+4], P[B_+5]), b1 = cvtpk(P[B_+6], P[B_+7]);                                             \
        auto r0 = __builtin_amdgcn_permlane32_swap(a0, b0, false, false); auto r1 = __builtin_amdgcn_permlane32_swap(a1, b1, false, false); \
        u32x4 w = {r0[0], r1[0], r0[1], r1[1]}; OUT = *reinterpret_cast<bf16x8*>(&w); } while (0)
    PK4(p0, 0, pa0); PK4(p0, 8, pa1); PK4(p1, 0, pa2); PK4(p1, 8, pa3);
#undef PK4
}
template <int KB, bool SK>
__device__ __forceinline__ void qkt(f32x16& p0, f32x16& p1, const char* K_lds, int r32, int hi, const bf16x8* qr, bool act) {
    if (SK && !act) { const float NEG = -__builtin_inff();
#pragma unroll
        for (int r = 0; r < 16; ++r) { p0[r] = NEG; p1[r] = NEG; } return; }
    p0 = f32x16{}; p1 = f32x16{};
    const char* kb[4];
#pragma unroll
    for (int dd = 0; dd < 4; ++dd) kb[dd] = K_lds + KB * SHM_K + KSWZ(r32, (dd * 16 + hi * 8) * 2);
#pragma unroll
    for (int d0 = 0; d0 < 8; ++d0) { const char* a = kb[d0 & 3] + (d0 >> 2) * 128;
        bf16x8 b0 = *reinterpret_cast<const bf16x8*>(a);
        bf16x8 b1 = *reinterpret_cast<const bf16x8*>(a + 32 * 256);
        const bf16x8 qf = qr[d0];
        p0 = __builtin_amdgcn_mfma_f32_32x32x16_bf16(b0, qf, p0, 0, 0, 0);
        p1 = __builtin_amdgcn_mfma_f32_32x32x16_bf16(b1, qf, p1, 0, 0, 0); }
}
template <int VB, bool SK>
__device__ __forceinline__ void pv_tile(f32x16* o, int vb0, bf16x8 pa0, bf16x8 pa1, bf16x8 pa2, bf16x8 pa3, bool act) {
    if (SK && !act) return;
#define TRRD(dst, off) asm volatile("ds_read_b64_tr_b16 %0, %1 offset:%2" : "=&v"(dst) : "v"(vb0), "i"(off) : "memory")
#define PV_D0(d0) do { s16x4 l0, l1, l2, l3, h0, h1, h2, h3; constexpr int b_ = VB * SHM_V + v_rd_off(d0, 0, 0);     \
        TRRD(l0, b_); TRRD(h0, b_ + 2048); TRRD(l1, b_ + 4096); TRRD(h1, b_ + 6144); TRRD(l2, b_ + 8192); TRRD(h2, b_ + 10240); TRRD(l3, b_ + 12288); TRRD(h3, b_ + 14336); \
        asm volatile("s_waitcnt lgkmcnt(0)" ::: "memory"); SBAR();                 \
        o[d0] = __builtin_amdgcn_mfma_f32_32x32x16_bf16(pa0, (bf16x8){l0[0], l0[1], l0[2], l0[3], h0[0], h0[1], h0[2], h0[3]}, o[d0], 0, 0, 0);   \
        o[d0] = __builtin_amdgcn_mfma_f32_32x32x16_bf16(pa1, (bf16x8){l1[0], l1[1], l1[2], l1[3], h1[0], h1[1], h1[2], h1[3]}, o[d0], 0, 0, 0);   \
        o[d0] = __builtin_amdgcn_mfma_f32_32x32x16_bf16(pa2, (bf16x8){l2[0], l2[1], l2[2], l2[3], h2[0], h2[1], h2[2], h2[3]}, o[d0], 0, 0, 0);   \
        o[d0] = __builtin_amdgcn_mfma_f32_32x32x16_bf16(pa3, (bf16x8){l3[0], l3[1], l3[2], l3[3], h3[0], h3[1], h3[2], h3[3]}, o[d0], 0, 0, 0); } while (0)
    PV_D0(0); PV_D0(1); PV_D0(2); PV_D0(3);
#undef PV_D0
#undef TRRD
}

template <class TIn, class TOut> struct BlockRef { const TIn* Q; const TIn* K; const TIn* V; TOut* O; int P0; int ldo; const int* rows; const int* dst; float* stat; };
template <class TIn> struct Seam {
    bf16x8 qr[8];
    bf16x8 st_v0, st_v1, st_k0, st_k1; f32x4 sf0, sf1, sf2, sf3;
    f32x4 tq[16];
};
__device__ __forceinline__ int swa_jlo(int P0, int W) { const int lowk = P0 - W + 1; return lowk > 0 ? lowk / KVBLK : 0; }
#define ROW(p, k0, rr) ((p) + (unsigned)(((k0) + (rr)) * D + sc))
#define VMW() asm volatile("s_waitcnt vmcnt(0)" ::: "memory")
#define VMWN(n) asm volatile("s_waitcnt vmcnt(%0)" :: "i"(n) : "memory")
#define SLOAD_H(Kp, Vp, k0) do { S.st_v0 = load8<TIn>(ROW(Vp, k0, sr)); S.st_v1 = load8<TIn>(ROW(Vp, k0, 32 + sr));              \
                         S.st_k0 = load8<TIn>(ROW(Kp, k0, sr)); S.st_k1 = load8<TIn>(ROW(Kp, k0, 32 + sr)); } while (0)
#define SWRITE_HK(bf) do { *(bf16x8*)(K_lds + (bf) * SHM_K + kws) = S.st_k0; *(bf16x8*)(K_lds + (bf) * SHM_K + kws + 32 * 256) = S.st_k1; } while (0)
#define SWRITE_HV(bf) do { *(bf16x8*)(V_lds + (bf) * SHM_V + vst0) = S.st_v0; *(bf16x8*)(V_lds + (bf) * SHM_V + vst1) = S.st_v1; } while (0)
#define SWRITE_H(bf) do { SWRITE_HV(bf); SWRITE_HK(bf); } while (0)
#define SLOAD_F(p, k0) do { S.sf0 = *(const f32x4*)ROW(p, k0, sr); S.sf1 = *(const f32x4*)(ROW(p, k0, sr) + 4);                \
                            S.sf2 = *(const f32x4*)ROW(p, k0, 32 + sr); S.sf3 = *(const f32x4*)(ROW(p, k0, 32 + sr) + 4); } while (0)
#define SWRITE_KF(bf) do { *(bf16x8*)(K_lds + (bf) * SHM_K + kws) = pack8(S.sf0, S.sf1); *(bf16x8*)(K_lds + (bf) * SHM_K + kws + 32 * 256) = pack8(S.sf2, S.sf3); } while (0)
#define SWRITE_VF(bf) do { *(bf16x8*)(V_lds + (bf) * SHM_V + vst0) = pack8(S.sf0, S.sf1); *(bf16x8*)(V_lds + (bf) * SHM_V + vst1) = pack8(S.sf2, S.sf3); } while (0)
template <class TIn, class TOut>
__device__ __forceinline__ void causal_swa_prime(const BlockRef<TIn, TOut>& cur, int W, char* lds, Seam<TIn>& S) {
    constexpr bool F32 = same_t<TIn, float>::v;
    const int tid = threadIdx.x, wid = __builtin_amdgcn_readfirstlane(tid >> 6), lane = tid & 63, r32 = lane & 31, hi = lane >> 5;
    const int sr = tid >> 4, sc = (tid & 15) * 8, kws = KSWZ(sr, sc * 2); char* K_lds = lds + 2 * SHM_V;
    const int kb0 = swa_jlo(cur.P0, W) * KVBLK;
    for (int d0 = 0; d0 < 8; ++d0) S.qr[d0] = load8<TIn>(cur.Q + (size_t)(wid * QBLK + r32) * D + d0 * 16 + hi * 8);
    if constexpr (F32) { SLOAD_F((const float*)cur.K, kb0); VMW(); SWRITE_KF(0); SBAR(); SLOAD_F((const float*)cur.V, kb0); }
    else { SLOAD_H(cur.K, cur.V, kb0); VMW(); SWRITE_HK(0); }
    __syncthreads();
}
template <class TIn, class TOut>
__device__ __forceinline__ void causal_swa_block(const BlockRef<TIn, TOut>& cur, const BlockRef<TIn, TOut>& nxt, int skv, int W, char* lds, Seam<TIn>& S) {
    constexpr bool F32 = same_t<TIn, float>::v;
    const int tid = threadIdx.x, wid = __builtin_amdgcn_readfirstlane(tid >> 6), lane = tid & 63, r32 = lane & 31, hi = lane >> 5;
    const int j_lo = swa_jlo(cur.P0, W);
    int j_hi = (cur.P0 + QB - 1) / KVBLK + 1; if (j_hi > skv / KVBLK) j_hi = skv / KVBLK;
    const int NT = j_hi - j_lo;
    const int kbn = swa_jlo(nxt.P0, W) * KVBLK;
    const int qlo = cur.P0 + wid * QBLK, qm = qlo + r32 - 4 * hi;
    char* V_lds = lds; char* K_lds = lds + 2 * SHM_V;
    float* ws = (float*)(lds + 2 * SHM_V + 2 * SHM_K) + wid * 64; float* li_l = ws, * al_l = ws + 32;
    float m_reg = -1e30f, l_reg = 0; f32x16 o[4] = {};
    const int sr = tid >> 4, sc = (tid & 15) * 8, vst0 = v_st(sr, sc), vst1 = v_st(32 + sr, sc), kws = KSWZ(sr, sc * 2);
    const int vb0 = (int)(uintptr_t)V_lds + v_rd_base(lane);
    const TIn* Kh = cur.K; const TIn* Vh = cur.V;
#define RESC(a) do { if (__any((a) < 1.f)) { if (hi == 0) al_l[r32] = (a); asm volatile("s_waitcnt lgkmcnt(0)" ::: "memory");              \
                     for (int d_ = 0; d_ < 4; ++d_) for (int r = 0; r < 16; ++r) o[d_][r] *= al_l[crow(r, hi)]; } } while (0)
#define KBASE(t) ((j_lo + (t)) * KVBLK)
#define ACT(t) (KBASE(t) <= qlo + QBLK - 1 && KBASE(t) + KVBLK - 1 >= qlo - W + 1)
#define MASKT(P0_, P1_, t) do { const int kb_ = KBASE(t); if ((!SK || ACT(t)) && (kb_ + KVBLK - 1 > qlo || kb_ <= qlo + QBLK - 1 - W)) mask_tile(P0_, P1_, qm - kb_, (unsigned)W); } while (0)
    constexpr int NQL = F32 ? 16 : 8;
    constexpr bool SK = WSKIP && !F32;
#define SEAM_K0() do { VMWN(NQL); if constexpr (F32) { SWRITE_KF(0); SBAR(); SLOAD_F((const float*)nxt.V, kbn); } else { SWRITE_HK(0); } SBAR(); } while (0)
    f32x16 pA0, pA1, pB0, pB1; float mnA, mnB, alA, alB; bf16x8 pa0, pa1, pa2, pa3;
    if constexpr (F32) { VMW(); SWRITE_VF(0); SBAR(); } else { SWRITE_HV(0); SBAR(); }
    if (NT > 1) { if constexpr (F32) SLOAD_F((const float*)Kh, KBASE(1)); else SLOAD_H(Kh, Vh, KBASE(1)); }
    SBAR(); qkt<0, SK>(pA0, pA1, K_lds, r32, hi, S.qr, ACT(0));
    if constexpr (F32) { if (NT > 1) { VMW(); SWRITE_KF(1); SBAR(); SLOAD_F((const float*)Vh, KBASE(1)); } }
    MASKT(pA0, pA1, 0); partialSM(pA0, pA1, m_reg, mnA, alA);
    if (NT > 1) { VMW(); if constexpr (F32) { SWRITE_VF(1); SBAR(); if (NT > 2) SLOAD_F((const float*)Kh, KBASE(2)); } else SWRITE_H(1); }
    __syncthreads();
#define HALF_STEP(PX0, PX1, mnX, alX, PY0, PY1, alY, t, KB, VB, SB) do {                                                      \
        SBAR(); qkt<KB, SK>(PX0, PX1, K_lds, r32, hi, S.qr, ACT(t));                                             \
        finishSM(PY0, PY1, alY, l_reg, pa0, pa1, pa2, pa3); SBAR();                                                           \
        if ((t) + 1 < NT) { if constexpr (F32) { VMW(); SWRITE_KF(SB); SBAR(); SLOAD_F((const float*)Vh, KBASE((t) + 1)); }  \
                            else { SLOAD_H(Kh, Vh, KBASE((t) + 1)); } SBAR(); }                                               \
        pv_tile<VB, SK>(o, vb0, pa0, pa1, pa2, pa3, ACT((t) - 1)); MASKT(PX0, PX1, (t)); partialSM(PX0, PX1, m_reg, mnX, alX);                                        \
        __syncthreads();                                                                                                      \
        if ((t) + 1 < NT) { VMW(); if constexpr (F32) { SWRITE_VF(SB); SBAR(); if ((t) + 2 < NT) SLOAD_F((const float*)Kh, KBASE((t) + 2)); } \
                            else { SWRITE_H(SB); } }                                                                          \
        RESC(alX); __syncthreads(); } while (0)
    for (int t = 1; t + 1 < NT; t += 2) {
        HALF_STEP(pB0, pB1, mnB, alB, pA0, pA1, alA, t, 1, 0, 0);
        HALF_STEP(pA0, pA1, mnA, alA, pB0, pB1, alB, t + 1, 0, 1, 1);
    }
    const bool even = (NT & 1) == 0;
    if (even) { SBAR(); qkt<1, SK>(pB0, pB1, K_lds, r32, hi, S.qr, ACT(NT - 1)); SBAR(); }
#define QROW(e) (nxt.Q + (size_t)(wid * QBLK + r32) * D + ((e) >> 1) * 16 + hi * 8 + ((e) & 1) * 4)
    if constexpr (F32) { SLOAD_F((const float*)nxt.K, kbn); SBAR();
#pragma unroll
        for (int e = 0; e < 8; ++e) S.tq[e] = *(const f32x4*)QROW(e); }
    else { const size_t qrown_ = (size_t)(wid * QBLK + r32);
        SLOAD_H(nxt.K, nxt.V, kbn); SBAR();
#pragma unroll
        for (int d0 = 0; d0 < 8; ++d0) S.qr[d0] = load8<TIn>(nxt.Q + qrown_ * D + d0 * 16 + hi * 8); }
    SBAR();
    finishSM(pA0, pA1, alA, l_reg, pa0, pa1, pa2, pa3); SBAR();
    if constexpr (F32) {
#pragma unroll
        for (int e = 8; e < 16; ++e) S.tq[e] = *(const f32x4*)QROW(e); SBAR(); }
#undef QROW
    pv_tile<0, SK>(o, vb0, pa0, pa1, pa2, pa3, ACT(even ? NT - 2 : NT - 1));
    if (even) { MASKT(pB0, pB1, NT - 1); partialSM(pB0, pB1, m_reg, mnB, alB); __syncthreads(); RESC(alB);
        finishSM(pB0, pB1, alB, l_reg, pa0, pa1, pa2, pa3); SBAR(); pv_tile<1, SK>(o, vb0, pa0, pa1, pa2, pa3, ACT(NT - 1)); }
    SBAR(); SEAM_K0();
    if (hi == 0) li_l[r32] = l_reg; asm volatile("s_waitcnt lgkmcnt(0)" ::: "memory");
    float rli[16];
#pragma unroll
    for (int r = 0; r < 16; ++r) rli[r] = __builtin_amdgcn_rcpf(li_l[crow(r, hi)]);
    {
    int ld_ = cur.ldo; asm volatile("" : "+s"(ld_));
    TOut* Ow = cur.O + (size_t)(wid * QBLK) * ld_;
#pragma unroll
    for (int r = 0; r < 16; ++r) { const unsigned ro = (unsigned)crow(r, hi) * (unsigned)ld_ + (unsigned)r32;
#pragma unroll
        for (int d0 = 0; d0 < 4; ++d0) { const float v = o[d0][r] * rli[r];
            if constexpr (same_t<TOut, float>::v) { Ow[ro + d0 * 32] = v; }
            else { const float vn = __shfl_xor(v, 1);
                   if ((r32 & 1) == 0) *(unsigned*)(Ow + ro + d0 * 32) = cvtpk(v, vn); } } }
    }
    if constexpr (F32) {
#pragma unroll
        for (int d0 = 0; d0 < 8; ++d0) S.qr[d0] = pack8(S.tq[2 * d0], S.tq[2 * d0 + 1]); }
    __syncthreads();
#undef RESC
#undef KBASE
#undef ACT
#undef MASKT
#undef SEAM_K0
#undef HALF_STEP
}
#undef ROW
#undef VMW
#undef VMWN
#undef SLOAD_H
#undef SWRITE_HK
#undef SWRITE_HV
#undef SWRITE_H
#undef SLOAD_F
#undef SWRITE_KF
#undef SWRITE_VF


template <int KB>
__device__ __forceinline__ void qkt_r(f32x16& p0, f32x16& p1, const char* K_lds, int r32, int hi, const bf16x8* qr) {
    p0 = f32x16{}; p1 = f32x16{};
    const char* kb[4];
#pragma unroll
    for (int dd = 0; dd < 4; ++dd) kb[dd] = K_lds + KB * SHM_K + KSWZ(r32, (dd * 16 + hi * 8) * 2);
#pragma unroll
    for (int d0 = 0; d0 < 8; ++d0) { const char* a = kb[d0 & 3] + (d0 >> 2) * 128;
        bf16x8 b0 = *reinterpret_cast<const bf16x8*>(a);
        bf16x8 b1 = *reinterpret_cast<const bf16x8*>(a + 32 * 256);
        p0 = __builtin_amdgcn_mfma_f32_32x32x16_bf16(b0, qr[d0], p0, 0, 0, 0);
        p1 = __builtin_amdgcn_mfma_f32_32x32x16_bf16(b1, qr[d0], p1, 0, 0, 0); }
}
constexpr int MOBA_LDS_BYTES = 4 * SHM_V + 4 * SHM_K + NW * 64 * 4;
struct MobaStage { bf16x8 qr[8]; bf16x8 k0[2], k1[2], v0[2], v1[2]; };
#define MOBA_LOAD_Q(B) do { const unsigned qoff_ = (unsigned)(B).rows[wid * QBLK + r32] * D + hi * 8;                                  \
        _Pragma("unroll") for (int d0 = 0; d0 < 8; ++d0) ST.qr[d0] = load8<bf16>((B).Q + qoff_ + d0 * 16); } while (0)
#define MOBA_LOAD_KV(B, T0) do { _Pragma("unroll") for (int t = 0; t < 2; ++t) { const unsigned eo_ = (unsigned)(((T0) + t) * KVBLK + sr) * D + sc; \
        ST.k0[t] = load8<bf16>((B).K + eo_); ST.k1[t] = load8<bf16>((B).K + eo_ + 32 * D); ST.v0[t] = load8<bf16>((B).V + eo_); ST.v1[t] = load8<bf16>((B).V + eo_ + 32 * D); } } while (0)
#define MOBA_WRITE_KV(T0) do { _Pragma("unroll") for (int t = 0; t < 2; ++t) { *(bf16x8*)(K_lds + ((T0) + t) * SHM_K + kws) = ST.k0[t]; *(bf16x8*)(K_lds + ((T0) + t) * SHM_K + kws + 32 * 256) = ST.k1[t]; \
        *(bf16x8*)(V_lds + ((T0) + t) * SHM_V + vst0) = ST.v0[t]; *(bf16x8*)(V_lds + ((T0) + t) * SHM_V + vst1) = ST.v1[t]; } } while (0)
__device__ __forceinline__ void moba_block(const BlockRef<bf16, bf16>& cur, const BlockRef<bf16, bf16>& nxt, bool has_next, char* lds, MobaStage& ST) {
    const int tid = threadIdx.x, wid = __builtin_amdgcn_readfirstlane(tid >> 6), lane = tid & 63, r32 = lane & 31, hi = lane >> 5;
    char* V_lds = lds; char* K_lds = lds + 4 * SHM_V;
    float* wsc = (float*)(lds + 4 * SHM_V + 4 * SHM_K) + wid * 64; float* li_l = wsc, * al_l = wsc + 32;
    const int sr = tid >> 4, sc = (tid & 15) * 8, vst0 = v_st(sr, sc), vst1 = v_st(32 + sr, sc), kws = KSWZ(sr, sc * 2);
    const int vb0 = (int)(uintptr_t)V_lds + v_rd_base(lane);
    __syncthreads();
    MOBA_WRITE_KV(0);
    __syncthreads();
    MOBA_LOAD_KV(cur, 2);
    SBAR();
    float m_reg = -1e30f, l_reg = 0; f32x16 o[4] = {};
    const bool causal = cur.P0 == 0; const int qlo = wid * QBLK, qm = qlo + r32 - 4 * hi;
    f32x16 p0, p1; float mn, al; bf16x8 pa0, pa1, pa2, pa3;
#define RESCM(a) do { if (__any((a) < 1.f)) { if (hi == 0) al_l[r32] = (a); asm volatile("s_waitcnt lgkmcnt(0)" ::: "memory");              \
                      for (int d_ = 0; d_ < 4; ++d_) for (int r = 0; r < 16; ++r) o[d_][r] *= al_l[crow(r, hi)]; } } while (0)
#define SKIPT(t) (causal && (t) * KVBLK > qlo + QBLK - 1)
#define MTA(t) do { if (!SKIPT(t)) { SBAR(); qkt_r<t>(p0, p1, K_lds, r32, hi, ST.qr); if (causal && (t) * KVBLK + KVBLK - 1 > qlo) mask_tile(p0, p1, qm - (t) * KVBLK, 1u << 30); } } while (0)
#define MTB(t) do { if (!SKIPT(t)) { partialSM(p0, p1, m_reg, mn, al); RESCM(al); finishSM(p0, p1, al, l_reg, pa0, pa1, pa2, pa3); SBAR(); pv_tile<t, false>(o, vb0, pa0, pa1, pa2, pa3, true); } } while (0)
    MTA(0); MTB(0); MTA(1); MTB(1);
    SBAR();
    MOBA_WRITE_KV(2);
    __syncthreads();
    if (has_next) MOBA_LOAD_KV(nxt, 0);
    SBAR();
    MTA(2); MTB(2); MTA(3);
    SBAR();
    if (has_next) MOBA_LOAD_Q(nxt);
    SBAR();
    MTB(3);
#undef MTA
#undef MTB
#undef SKIPT
#undef RESCM
    if (hi == 0) li_l[r32] = l_reg; asm volatile("s_waitcnt lgkmcnt(0)" ::: "memory");
    float rli[16];
#pragma unroll
    for (int r = 0; r < 16; ++r) rli[r] = __builtin_amdgcn_rcpf(li_l[crow(r, hi)]);
    { const int dme_ = cur.dst[wid * QBLK + r32]; if (hi == 0 && dme_ >= 0) { float2 st_; st_.x = m_reg; st_.y = l_reg; *(float2*)(cur.stat + 2 * (size_t)dme_) = st_; } }
#pragma unroll
    for (int r = 0; r < 16; ++r) { const int di_ = cur.dst[wid * QBLK + crow(r, hi)];
#pragma unroll
        for (int d0 = 0; d0 < 4; ++d0) { const float v = o[d0][r] * rli[r]; const float vn = __shfl_xor(v, 1);
            if ((r32 & 1) == 0 && di_ >= 0) *(unsigned*)(cur.O + (size_t)di_ * 128 + d0 * 32 + r32) = cvtpk(v, vn); } }
}
__device__ __forceinline__ void moba_prime(const BlockRef<bf16, bf16>& cur, MobaStage& ST) {
    const int tid = threadIdx.x, wid = __builtin_amdgcn_readfirstlane(tid >> 6), lane = tid & 63, r32 = lane & 31, hi = lane >> 5;
    const int sr = tid >> 4, sc = (tid & 15) * 8;
    MOBA_LOAD_Q(cur); MOBA_LOAD_KV(cur, 0);
}
#undef MOBA_LOAD_Q
#undef MOBA_LOAD_KV
#undef MOBA_WRITE_KV
}
#include <hip/hip_cooperative_groups.h>
namespace cg = cooperative_groups;

constexpr int NWAVES = 8;
#ifndef MK_ONE_LAUNCH
#define MK_ONE_LAUNCH 1
#endif
constexpr int BATCH = 2, SEQ = 16384, T = BATCH * SEQ, DM = 2048, INW = 10240, DFF = 8192, PLE = 256;
constexpr int NH8 = 8;
constexpr float NORM_EPS = 1e-6f;
constexpr float LAMBDA_INIT = 0.2f;
constexpr int NPHASE = 19;

constexpr size_t MiB = 1u << 20;
constexpr size_t WS_ROPE = 1 * MiB;
constexpr size_t WS_KMEAN = 3 * MiB;
constexpr size_t WS_CNT = 0, WS_NBLK = 8192, WS_TAB = 65536;
constexpr size_t WS_BAR = 131072, WS_BAR_BYTES = 16384;
constexpr size_t WS_SEL = 4 * MiB;
constexpr int LSTR = 65536 + SEQ;
constexpr size_t WS_ROWL = 986 * MiB, WS_DSTL = 992 * MiB;
constexpr size_t WS_STATS = 1000 * MiB;
constexpr size_t WS_TOP = 1008 * MiB;
constexpr size_t WS_WIN = 8 * MiB, WS_WA = 48 * MiB, WS_WB = 52 * MiB, WS_WOUT = 56 * MiB, WS_WUP = 64 * MiB, WS_WDN = 96 * MiB, WS_WPG = 128 * MiB, WS_WPP = 136 * MiB;
constexpr size_t WS_PB = 138 * MiB;
constexpr size_t WS_XN = 154 * MiB;
constexpr size_t WS_OB = 154 * MiB;
constexpr size_t WS_QKV = 282 * MiB;
constexpr size_t SEC_ELEMS = (size_t)T * 1024;
constexpr size_t WS_SG = 666 * MiB;
constexpr size_t WS_OA = 922 * MiB;
constexpr size_t WS_MIX = 282 * MiB;
constexpr size_t WS_HID = 282 * MiB;
constexpr size_t WS_G3 = 282 * MiB;
constexpr size_t WS_XN3 = 410 * MiB;
constexpr size_t WS_Y = 794 * MiB;
constexpr size_t WS_END = 986 * MiB;
static_assert(WS_HID + (size_t)T * DFF * 2 <= WS_Y && WS_Y + (size_t)T * DM * 2 <= WS_OA && WS_OA + (size_t)T * 1024 * 2 == WS_END, "ws map");

constexpr int RING_BYTES = 131072, LDS_BYTES = 147456;

#define GAS __attribute__((address_space(1)))
#define LAS __attribute__((address_space(3)))
typedef unsigned short bf16;
typedef unsigned v4u __attribute__((ext_vector_type(4)));
typedef unsigned v2u __attribute__((ext_vector_type(2)));
typedef float f32x4 __attribute__((ext_vector_type(4)));
#define LDS_WAIT() asm volatile("s_waitcnt lgkmcnt(0)" ::: "memory")
__device__ __forceinline__ unsigned f2bf(float f) { unsigned u = __builtin_bit_cast(unsigned, f); return (u + 0x7fffu + ((u >> 16) & 1u)) >> 16; }
__device__ __forceinline__ unsigned pk2(float lo, float hi) { return f2bf(lo) | (f2bf(hi) << 16); }
__device__ __forceinline__ float bflo(unsigned w) { return __uint_as_float(w << 16); }
__device__ __forceinline__ float bfhi(unsigned w) { return __uint_as_float(w & 0xffff0000u); }
__device__ __forceinline__ float wave_sum(float v) {
#pragma unroll
    for (int o = 1; o < 64; o <<= 1) v += __shfl_xor(v, o);
    return v;
}
template <class Tv> __device__ __forceinline__ Tv ntload(const Tv* p) { return __builtin_nontemporal_load(p); }
template <class Tv> __device__ __forceinline__ void ntstore(Tv v, Tv* p) { __builtin_nontemporal_store(v, p); }
__device__ __forceinline__ float sigmoidf_(float x) { return __builtin_amdgcn_rcpf(1.0f + __expf(-x)); }

namespace pg8 {
template <int MODE> struct EpiT {
    static constexpr bool PERM = true, AFTER_DRAIN = false;
    bf16_t* O; int ldo; const bf16_t* G; int ldg;
    __device__ __forceinline__ void operator()(const f32x4 (&acc)[2][2][4][2], const Unit& u, int wr, int wc, int fr, int fq) const {
        const int row0 = u.pm * BM + wr * 64 + fr, col0 = u.pn * BM + wc * 32 + 8 * fq;
#pragma unroll
        for (int ai = 0; ai < 2; ++ai)
#pragma unroll
            for (int m = 0; m < 4; ++m) { const size_t r = (size_t)(row0 + ai * HALF + m * 16);
#pragma unroll
                for (int bj = 0; bj < 2; ++bj) { f32x4 v0 = acc[ai][bj][m][0], v1 = acc[ai][bj][m][1]; const int c = col0 + bj * HALF;
                    if (MODE == 1) {
#pragma unroll
                        for (int e = 0; e < 4; ++e) { float a = fmaxf(v0[e], 0.f), b = fmaxf(v1[e], 0.f); v0[e] = a * a; v1[e] = b * b; } }
                    if (MODE == 2) {
#pragma unroll
                        for (int e = 0; e < 4; ++e) { v0[e] = sigmoidf_(v0[e]); v1[e] = sigmoidf_(v1[e]); } }
                    if (MODE == 3 || MODE == 4) { const u32x4 g = *(const u32x4*)(G + r * ldg + c);
                        v0[0] *= bflo(g.x); v0[1] *= bfhi(g.x); v0[2] *= bflo(g.y); v0[3] *= bfhi(g.y); v1[0] *= bflo(g.z); v1[1] *= bfhi(g.z); v1[2] *= bflo(g.w); v1[3] *= bfhi(g.w); }
                    if (MODE == 4) { const u32x4 g = *(const u32x4*)(O + r * ldo + c);
                        v0[0] += bflo(g.x); v0[1] += bfhi(g.x); v0[2] += bflo(g.y); v0[3] += bfhi(g.y); v1[0] += bflo(g.z); v1[1] += bfhi(g.z); v1[2] += bflo(g.w); v1[3] += bfhi(g.w); }
                    u32x4 w; w.x = cvt_pk_bf16(v0[0], v0[1]); w.y = cvt_pk_bf16(v0[2], v0[3]); w.z = cvt_pk_bf16(v1[0], v1[1]); w.w = cvt_pk_bf16(v1[2], v1[3]);
                    *(u32x4*)(O + r * ldo + c) = w; } }
    }
};
struct EpiGate2 {
    static constexpr bool PERM = true, AFTER_DRAIN = false; static constexpr int MID_T = 16;
    bf16_t* O; const bf16_t* SGp;
    __device__ __forceinline__ void mid(f32x4 (&acc)[2][2][4][2], const Unit& u, int wr, int wc, int fr, int fq) const {
        int row0 = u.pm * BM + wr * 64 + fr; const int col0 = u.pn * BM + wc * 32 + 8 * fq;
        asm volatile("" : "+v"(row0));
        const bf16_t* gp = SGp + (size_t)row0 * 4096 + col0;
#pragma unroll
        for (int ai = 0; ai < 2; ++ai)
#pragma unroll
            for (int m = 0; m < 4; ++m) { const int ro = (ai * HALF + m * 16) * 4096;
#pragma unroll
                for (int bj = 0; bj < 2; ++bj) { const u32x4 a = *(const u32x4*)(gp + ro + bj * HALF), b = *(const u32x4*)(gp + ro + bj * HALF + 2048);
                    f32x4& v0 = acc[ai][bj][m][0]; f32x4& v1 = acc[ai][bj][m][1];
                    v0[0] *= bflo(a.x) * __builtin_amdgcn_rcpf(bflo(b.x)); v0[1] *= bfhi(a.x) * __builtin_amdgcn_rcpf(bfhi(b.x)); v0[2] *= bflo(a.y) * __builtin_amdgcn_rcpf(bflo(b.y)); v0[3] *= bfhi(a.y) * __builtin_amdgcn_rcpf(bfhi(b.y));
                    v1[0] *= bflo(a.z) * __builtin_amdgcn_rcpf(bflo(b.z)); v1[1] *= bfhi(a.z) * __builtin_amdgcn_rcpf(bfhi(b.z)); v1[2] *= bflo(a.w) * __builtin_amdgcn_rcpf(bflo(b.w)); v1[3] *= bfhi(a.w) * __builtin_amdgcn_rcpf(bfhi(b.w)); }
                if (m == 3) asm volatile("" ::: "memory"); }
    }
    __device__ __forceinline__ void operator()(const f32x4 (&acc)[2][2][4][2], const Unit& u, int wr, int wc, int fr, int fq) const {
        int row0 = u.pm * BM + wr * 64 + fr; const int col0 = u.pn * BM + wc * 32 + 8 * fq;
        asm volatile("" : "+v"(row0));
        const bf16_t* gp = SGp + (size_t)row0 * 4096 + 2048 + col0; bf16_t* op = O + (size_t)row0 * 2048 + col0;
#pragma unroll
        for (int ai = 0; ai < 2; ++ai)
#pragma unroll
            for (int m = 0; m < 4; ++m) { const int rr = ai * HALF + m * 16;
#pragma unroll
                for (int bj = 0; bj < 2; ++bj) { const u32x4 b = *(const u32x4*)(gp + rr * 4096 + bj * HALF); const f32x4 v0 = acc[ai][bj][m][0], v1 = acc[ai][bj][m][1];
                    u32x4 w; w.x = cvt_pk_bf16(v0[0] * bflo(b.x), v0[1] * bfhi(b.x)); w.y = cvt_pk_bf16(v0[2] * bflo(b.y), v0[3] * bfhi(b.y)); w.z = cvt_pk_bf16(v1[0] * bflo(b.z), v1[1] * bfhi(b.z)); w.w = cvt_pk_bf16(v1[2] * bflo(b.w), v1[3] * bfhi(b.w));
                    *(u32x4*)(op + rr * 2048 + bj * HALF) = w; } }
    }
};
struct EpiPle {
    static constexpr bool PERM = true, AFTER_DRAIN = false; static constexpr int MID_T = 32;
    bf16_t* O; bf16_t* Gp;
    __device__ __forceinline__ void mid(f32x4 (&acc)[2][2][4][2], const Unit& u, int wr, int wc, int fr, int fq) const {
        int row0 = u.pm * BM + wr * 64 + fr; const int col0 = u.pn * BM + wc * 32 + 8 * fq;
        asm volatile("" : "+v"(row0));
        bf16_t* gp = Gp + (size_t)row0 * 2048 + col0;
#pragma unroll
        for (int ai = 0; ai < 2; ++ai)
#pragma unroll
            for (int m = 0; m < 4; ++m) { const int rr = ai * HALF + m * 16;
#pragma unroll
                for (int bj = 0; bj < 2; ++bj) { f32x4& v0 = acc[ai][bj][m][0]; f32x4& v1 = acc[ai][bj][m][1];
                    u32x4 w; w.x = cvt_pk_bf16(sigmoidf_(v0[0]), sigmoidf_(v0[1])); w.y = cvt_pk_bf16(sigmoidf_(v0[2]), sigmoidf_(v0[3])); w.z = cvt_pk_bf16(sigmoidf_(v1[0]), sigmoidf_(v1[1])); w.w = cvt_pk_bf16(sigmoidf_(v1[2]), sigmoidf_(v1[3]));
                    *(u32x4*)(gp + rr * 2048 + bj * HALF) = w; v0 = (f32x4){0.f, 0.f, 0.f, 0.f}; v1 = (f32x4){0.f, 0.f, 0.f, 0.f}; } }
    }
    __device__ __forceinline__ void operator()(const f32x4 (&acc)[2][2][4][2], const Unit& u, int wr, int wc, int fr, int fq) const {
        int row0 = u.pm * BM + wr * 64 + fr; const int col0 = u.pn * BM + wc * 32 + 8 * fq;
        asm volatile("" : "+v"(row0));
        const bf16_t* gp = Gp + (size_t)row0 * 2048 + col0; bf16_t* op = O + (size_t)row0 * 2048 + col0;
#pragma unroll
        for (int ai = 0; ai < 2; ++ai)
#pragma unroll
            for (int m = 0; m < 4; ++m) { const int rr = ai * HALF + m * 16;
#pragma unroll
                for (int bj = 0; bj < 2; ++bj) { const u32x4 b = *(const u32x4*)(gp + rr * 2048 + bj * HALF); const f32x4 v0 = acc[ai][bj][m][0], v1 = acc[ai][bj][m][1];
                    u32x4 w; w.x = cvt_pk_bf16(v0[0] * bflo(b.x), v0[1] * bfhi(b.x)); w.y = cvt_pk_bf16(v0[2] * bflo(b.y), v0[3] * bfhi(b.y)); w.z = cvt_pk_bf16(v1[0] * bflo(b.z), v1[1] * bfhi(b.z)); w.w = cvt_pk_bf16(v1[2] * bflo(b.w), v1[3] * bfhi(b.w));
                    *(u32x4*)(op + rr * 2048 + bj * HALF) = w; } }
    }
};
struct EpiInProj {
    static constexpr bool PERM = false, AFTER_DRAIN = false;
    bf16_t* QKV; bf16_t* SG; const float* rope; float* km;
    __device__ __forceinline__ void operator()(const f32x4 (&acc)[2][2][4][2], const Unit& u, int wr, int wc, int fr, int fq) const {
        typedef unsigned u32x2 __attribute__((ext_vector_type(2)));
        const int pn = u.pn, row0 = u.pm * BM + wr * 64 + fr;
        if (pn < 24) {
            const int sec = pn >> 2; const bool rot = (sec != 2) && (sec != 5) && (wc == 0);
            const int b = (u.pm * BM) / SEQ;
            f32x4 ks[2][2] = {{(f32x4){0.f, 0.f, 0.f, 0.f}, (f32x4){0.f, 0.f, 0.f, 0.f}}, {(f32x4){0.f, 0.f, 0.f, 0.f}, (f32x4){0.f, 0.f, 0.f, 0.f}}};
#pragma unroll
            for (int ai = 0; ai < 2; ++ai)
#pragma unroll
                for (int m = 0; m < 4; ++m) { const int r = row0 + ai * HALF + m * 16, pos = r - b * SEQ;
                    f32x4 cs = (f32x4){1.f, 1.f, 1.f, 1.f}, sn = (f32x4){0.f, 0.f, 0.f, 0.f};
                    if (rot) { cs = *(const f32x4*)(rope + (size_t)pos * 32 + 4 * fq); sn = *(const f32x4*)(rope + (size_t)pos * 32 + 16 + 4 * fq); }
#pragma unroll
                    for (int bj = 0; bj < 2; ++bj) { const int h8 = (pn & 3) * 2 + bj; f32x4 v0 = acc[ai][bj][m][0], v1 = acc[ai][bj][m][1];
                        if (rot) { const f32x4 a = v0 * cs - v1 * sn, bb = v1 * cs + v0 * sn; v0 = a; v1 = bb; }
                        if (sec == 1) { ks[bj][0] += v0; ks[bj][1] += v1; }
                        bf16_t* dst = QKV + (size_t)sec * SEC_ELEMS + ((size_t)(b * NH8 + h8) * SEQ + pos) * 128 + wc * 32 + 4 * fq;
                        u32x2 w0, w1; w0.x = cvt_pk_bf16(v0[0], v0[1]); w0.y = cvt_pk_bf16(v0[2], v0[3]); w1.x = cvt_pk_bf16(v1[0], v1[1]); w1.y = cvt_pk_bf16(v1[2], v1[3]);
                        *(u32x2*)dst = w0; *(u32x2*)(dst + 16) = w1; } }
            if (sec == 1) {
                const int blk = u.pm - b * (SEQ / 256);
#pragma unroll
                for (int bj = 0; bj < 2; ++bj)
#pragma unroll
                    for (int n = 0; n < 2; ++n)
#pragma unroll
                        for (int e = 0; e < 4; ++e) { float v = ks[bj][n][e]; v += __shfl_xor(v, 1); v += __shfl_xor(v, 2); v += __shfl_xor(v, 4); v += __shfl_xor(v, 8);
                            if (fr == 0) atomicAdd(km + ((size_t)((b * NH8 + (pn & 3) * 2 + bj) * 64 + blk)) * 128 + wc * 32 + n * 16 + 4 * fq + e, v * (1.0f / 256.0f)); }
            }
        } else {
            const int col0 = (pn - 24) * BM + wc * 32 + 4 * fq;
#pragma unroll
            for (int ai = 0; ai < 2; ++ai)
#pragma unroll
                for (int m = 0; m < 4; ++m) { bf16_t* rowp = SG + (size_t)(row0 + ai * HALF + m * 16) * 4096 + col0;
#pragma unroll
                    for (int bj = 0; bj < 2; ++bj)
#pragma unroll
                        for (int n = 0; n < 2; ++n) { const f32x4 v = acc[ai][bj][m][n]; u32x2 w; w.x = cvt_pk_bf16(sigmoidf_(v[0]), sigmoidf_(v[1])); w.y = cvt_pk_bf16(sigmoidf_(v[2]), sigmoidf_(v[3]));
                            *(u32x2*)(rowp + bj * HALF + n * 16) = w; } }
        }
    }
};
}

#define XB_TMO      128
#define XB_XCNT(j)  (256  + 64 * (j))
#define XB_XSUB(j)  (1280 + 64 * (j))
#define XB_XGEN(j)  (2304 + 64 * (j))
#define XB_TOP      3328
#define XB_TOPGEN   3392
#define XCD_BAR_WORDS 3456
#define XB_SPIN_CAP (1u << 18)

__device__ __forceinline__ unsigned xb_ld(unsigned* p)              { return __hip_atomic_load(p, __ATOMIC_RELAXED, __HIP_MEMORY_SCOPE_AGENT); }
__device__ __forceinline__ unsigned xb_add(unsigned* p, unsigned v) { return __hip_atomic_fetch_add(p, v, __ATOMIC_RELAXED, __HIP_MEMORY_SCOPE_AGENT); }
__device__ __forceinline__ unsigned xb_xcc_id() { return (unsigned)__builtin_amdgcn_s_getreg((3 << 11) | 20) & 0xFu; }
#define XB_SPIN(cond, bar) do { unsigned _sp = 0; while (cond) { __builtin_amdgcn_s_sleep(1); \
    if ((++_sp & 255u) == 0u) { if (xb_ld(&(bar)[XB_TMO])) break; if (_sp > XB_SPIN_CAP) { atomicAdd(&(bar)[XB_TMO], 1u); break; } } } } while (0)

struct XcdBarrier {
    unsigned* bar; unsigned x;
    volatile LAS unsigned* st;
};

__device__ __forceinline__ XcdBarrier xcd_barrier_post(unsigned* bar, volatile LAS unsigned* st) {
    XcdBarrier b; b.bar = bar; b.x = xb_xcc_id(); b.st = st;
    if (threadIdx.x == 0) (void)xb_add(&bar[XB_XCNT(b.x)], 1u);
    return b;
}
__device__ __forceinline__ void xcd_barrier_complete(unsigned* bar, unsigned x, unsigned& nloc, unsigned& nx) {
    const unsigned G = gridDim.x * gridDim.y * gridDim.z;
    unsigned sum, cnt, mine, sp = 0u;
    for (;;) {
        sum = 0u; cnt = 0u; mine = 0u;
#pragma unroll
        for (unsigned j = 0; j < 16; ++j) { const unsigned c = xb_ld(&bar[XB_XCNT(j)]); sum += c; cnt += (c > 0u) ? 1u : 0u; mine = (j == x) ? c : mine; }
        if (sum == G) break;
        __builtin_amdgcn_s_sleep(1);
        if ((++sp & 255u) == 0u) { if (xb_ld(&bar[XB_TMO])) break; if (sp > XB_SPIN_CAP) { atomicAdd(&bar[XB_TMO], 1u); break; } }
    }
    nloc = mine > 0u ? mine : 1u; nx = cnt > 0u ? cnt : 1u;
}

__device__ __forceinline__ void xcd_barrier(const XcdBarrier& b) {
    asm volatile("s_waitcnt vmcnt(0)" ::: "memory");
    __syncthreads();
    if (threadIdx.x == 0) {
        unsigned* bar = b.bar;
        __builtin_amdgcn_s_waitcnt(0);
        unsigned nloc = b.st[0], nx = b.st[1];
        if (nloc == 0u) { xcd_barrier_complete(bar, b.x, nloc, nx); b.st[0] = nloc; b.st[1] = nx; }
        const unsigned old = xb_add(&bar[XB_XSUB(b.x)], 1u);
        const unsigned gen = old / nloc;
        if (old + 1u == (gen + 1u) * nloc) {
            __builtin_amdgcn_fence(__ATOMIC_RELEASE, "agent");
            asm volatile("s_waitcnt vmcnt(0)" ::: "memory");
            const unsigned og = xb_add(&bar[XB_TOP], 1u);
            const unsigned tg = og / nx;
            if (og + 1u == (tg + 1u) * nx) xb_add(&bar[XB_TOPGEN], 1u);
            else XB_SPIN(xb_ld(&bar[XB_TOPGEN]) == tg, bar);
            __builtin_amdgcn_fence(__ATOMIC_ACQUIRE, "agent");
            xb_add(&bar[XB_XGEN(b.x)], 1u);
            asm volatile("s_waitcnt vmcnt(0)" ::: "memory");
        } else {
            XB_SPIN(xb_ld(&bar[XB_XGEN(b.x)]) == gen, bar);
            __builtin_amdgcn_fence(__ATOMIC_ACQUIRE, "agent");
            asm volatile("s_waitcnt vmcnt(0)" ::: "memory");
        }
    }
    __syncthreads();
}

struct Args { const float* in[21]; float* out; unsigned char* ws; int ph_lo, ph_hi, coop, pad; };

__device__ __forceinline__ void p0_transpose_item(const float* W, int K, int N, bf16* WT, LAS float* scr, int item, int lane, int ldt = 0) {
    if (ldt == 0) ldt = K;
    const int nblk = N / 64, kb = item / nblk, nb = item % nblk, k0 = 64 * kb, n0 = 64 * nb;
    const int lr = lane >> 4, lc = (lane & 15) * 4;
    f32x4 v[16];
#pragma unroll
    for (int i = 0; i < 16; ++i) v[i] = ntload((const f32x4*)(W + (size_t)(k0 + 4 * i + lr) * N + n0 + lc));
#pragma unroll
    for (int i = 0; i < 16; ++i) { LAS float* d = scr + (4 * i + lr) * 65 + lc; d[0] = v[i].x; d[1] = v[i].y; d[2] = v[i].z; d[3] = v[i].w; }
    LDS_WAIT(); asm volatile("" ::: "memory");
    const int c = lane & 7;
#pragma unroll
    for (int j = 0; j < 8; ++j) { const int n = (lane >> 3) + 8 * j; const LAS float* sp = scr + (8 * c) * 65 + n;
        v4u o; o.x = pk2(sp[0 * 65], sp[1 * 65]); o.y = pk2(sp[2 * 65], sp[3 * 65]); o.z = pk2(sp[4 * 65], sp[5 * 65]); o.w = pk2(sp[6 * 65], sp[7 * 65]);
        *(GAS v4u*)(WT + (size_t)(n0 + n) * ldt + k0 + 8 * c) = o; }
    LDS_WAIT(); asm volatile("" ::: "memory");
}
__device__ __forceinline__ void rms_row_to_bf16(const float* xrow, const float* g, bf16* orow, int lane) {
    f32x4 v[8]; float s = 0.f;
#pragma unroll
    for (int j = 0; j < 4; ++j) { const float* p = xrow + j * 512 + lane * 8; v[2 * j] = ntload((const f32x4*)p); v[2 * j + 1] = ntload((const f32x4*)(p + 4)); }
#pragma unroll
    for (int j = 0; j < 8; ++j) s += (v[j].x * v[j].x + v[j].y * v[j].y) + (v[j].z * v[j].z + v[j].w * v[j].w);
    const float rstd = 1.0f / sqrtf(wave_sum(s) * (1.f / DM) + NORM_EPS);
#pragma unroll
    for (int j = 0; j < 4; ++j) { const float* gp = g + j * 512 + lane * 8; const f32x4 g0 = *(const f32x4*)gp, g1 = *(const f32x4*)(gp + 4); const f32x4 a = v[2 * j] * rstd * g0, b = v[2 * j + 1] * rstd * g1;
        v4u o; o.x = pk2(a.x, a.y); o.y = pk2(a.z, a.w); o.z = pk2(b.x, b.y); o.w = pk2(b.z, b.w); *(v4u*)(orow + j * 512 + lane * 8) = o; }
}
__device__ __forceinline__ void row_pass(const bf16* Y, const float* base, const float* gA, float* outh, const float* gB, bf16* xn, int gw, int NGW, int lane, int ldx = DM, const float* pin = nullptr) {
    for (int row0 = gw; row0 < T; row0 += 2 * NGW) {
        f32x4 h[2][8]; v4u yw[2][4];
#pragma unroll
        for (int k = 0; k < 2; ++k)
#pragma unroll
            for (int j = 0; j < 4; ++j) { const size_t off = (size_t)(row0 + k * NGW) * DM + j * 512 + lane * 8; yw[k][j] = ntload((const v4u*)(Y + off));
                h[k][2 * j] = ntload((const f32x4*)(base + off)); h[k][2 * j + 1] = ntload((const f32x4*)(base + off + 4)); }
#pragma unroll
        for (int k = 0; k < 2; ++k) { const int row = row0 + k * NGW;
            f32x4 y[8]; float s = 0.f;
#pragma unroll
            for (int j = 0; j < 4; ++j) { const v4u w = yw[k][j]; y[2 * j] = (f32x4){bflo(w.x), bfhi(w.x), bflo(w.y), bfhi(w.y)}; y[2 * j + 1] = (f32x4){bflo(w.z), bfhi(w.z), bflo(w.w), bfhi(w.w)}; }
#pragma unroll
            for (int j = 0; j < 8; ++j) s += (y[j].x * y[j].x + y[j].y * y[j].y) + (y[j].z * y[j].z + y[j].w * y[j].w);
            const float r1 = 1.0f / sqrtf(wave_sum(s) * (1.f / DM) + NORM_EPS); float s2 = 0.f;
#pragma unroll
            for (int j = 0; j < 4; ++j) { const int c = j * 512 + lane * 8; const f32x4 g0 = *(const f32x4*)(gA + c), g1 = *(const f32x4*)(gA + c + 4);
                h[k][2 * j] = h[k][2 * j] + y[2 * j] * r1 * g0; h[k][2 * j + 1] = h[k][2 * j + 1] + y[2 * j + 1] * r1 * g1;
                ntstore(h[k][2 * j], (f32x4*)(outh + (size_t)row * DM + c)); ntstore(h[k][2 * j + 1], (f32x4*)(outh + (size_t)row * DM + c + 4)); }
            if (xn) {
#pragma unroll
                for (int j = 0; j < 8; ++j) s2 += (h[k][j].x * h[k][j].x + h[k][j].y * h[k][j].y) + (h[k][j].z * h[k][j].z + h[k][j].w * h[k][j].w);
                const float r2 = 1.0f / sqrtf(wave_sum(s2) * (1.f / DM) + NORM_EPS);
#pragma unroll
                for (int j = 0; j < 4; ++j) { const int c = j * 512 + lane * 8; const f32x4 g0 = *(const f32x4*)(gB + c), g1 = *(const f32x4*)(gB + c + 4); const f32x4 a = h[k][2 * j] * r2 * g0, b = h[k][2 * j + 1] * r2 * g1;
                    v4u o; o.x = pk2(a.x, a.y); o.y = pk2(a.z, a.w); o.z = pk2(b.x, b.y); o.w = pk2(b.z, b.w); *(v4u*)(xn + (size_t)row * ldx + c) = o; }
                if (pin) { const f32x4 pv = *(const f32x4*)(pin + (size_t)row * PLE + lane * 4); v2u o; o.x = pk2(pv.x, pv.y); o.y = pk2(pv.z, pv.w); *(v2u*)(xn + (size_t)row * ldx + DM + lane * 4) = o; }
            }
        }
    }
}

typedef swa::BlockRef<swa::bf16, swa::bf16> ABlock;
__device__ __forceinline__ ABlock attn_ref(int head, int qb, unsigned char* ws, float* dout) {
    const swa::bf16* QKVs = (const swa::bf16*)(ws + WS_QKV); ABlock r;
    const int b = head >> 4, hd = (head >> 2) & 3, c = (head >> 1) & 1, j = head & 1; const int sh = b * NH8 + hd * 2 + c, vh = b * NH8 + hd * 2 + j;
    r.Q = QKVs + 3 * SEC_ELEMS + ((size_t)sh * SEQ + (size_t)qb * 256) * 128; r.K = QKVs + 4 * SEC_ELEMS + (size_t)sh * SEQ * 128; r.V = QKVs + 5 * SEC_ELEMS + (size_t)vh * SEQ * 128;
    r.O = (swa::bf16*)dout + ((size_t)b * SEQ + (size_t)qb * 256) * 4096 + hd * 512 + c * 256 + j * 128;
    r.ldo = 4096; r.rows = nullptr; r.dst = nullptr; r.stat = nullptr; r.P0 = qb * 256;
    return r;
}
constexpr int MOBA_PER = 320, MOBA_ITEMS = 16 * MOBA_PER;
__device__ __forceinline__ bool moba_valid(int L, const int* nblk) { const int bh = L / MOBA_PER, k = L - bh * MOBA_PER; return k >= 256 || k < nblk[bh]; }
__device__ __forceinline__ int moba_next(int L, int G, const int* nblk) { do { L += G; } while (L < MOBA_ITEMS && !moba_valid(L, nblk)); return L; }
__device__ __forceinline__ ABlock moba_ref(int L, unsigned char* ws, float* dout) {
    const swa::bf16* QKVs = (const swa::bf16*)(ws + WS_QKV); ABlock r;
    const int bh = L / MOBA_PER, k = L - bh * MOBA_PER; int j, lp, p0;
    if (k < 256) { const int2 t = ((const int2*)(ws + WS_TAB))[bh * 256 + k]; j = t.x; lp = t.y; p0 = 256; } else { j = k - 256; lp = 65536 + j * 256; p0 = 0; }
    r.Q = QKVs + (size_t)bh * SEQ * 128; r.K = QKVs + 1 * SEC_ELEMS + ((size_t)bh * SEQ + (size_t)j * 256) * 128; r.V = QKVs + 2 * SEC_ELEMS + ((size_t)bh * SEQ + (size_t)j * 256) * 128;
    r.O = (swa::bf16*)dout; r.ldo = 128; r.rows = (const int*)(ws + WS_ROWL) + (size_t)bh * LSTR + lp; r.dst = (const int*)(ws + WS_DSTL) + (size_t)bh * LSTR + lp; r.stat = (float*)(ws + WS_STATS); r.P0 = p0;
    return r;
}

__global__ void __launch_bounds__(NWAVES * 64, 2) mk_fwd(Args args) {
    extern __shared__ __attribute__((aligned(16))) unsigned char lds[];
    LAS unsigned char* L = (LAS unsigned char*)lds;
    const int tid = threadIdx.x, lane = tid & 63, wave = __builtin_amdgcn_readfirstlane(tid >> 6);
    const int G = gridDim.x, bx = blockIdx.x;
    const int vcu = (G % 8 == 0) ? (bx % 8) * (G / 8) + bx / 8 : bx;
    const int gw = vcu * NWAVES + wave, NGW = G * NWAVES;
    unsigned char* ws = args.ws;
#define x_in (args.in[0])
#define p_in (args.in[1])
#define Win_t ((bf16*)(ws + WS_WIN))
#define Wa_t ((bf16*)(ws + WS_WA))
#define Wb_t ((bf16*)(ws + WS_WB))
#define Wout_t ((bf16*)(ws + WS_WOUT))
#define Wup_t ((bf16*)(ws + WS_WUP))
#define Wdn_t ((bf16*)(ws + WS_WDN))
#define Wpg_t ((bf16*)(ws + WS_WPG))
#define Wpp_t ((bf16*)(ws + WS_WPP))
#define XN ((bf16*)(ws + WS_XN))
#define PB ((bf16*)(ws + WS_PB))
#define QKV ((bf16*)(ws + WS_QKV))
#define SG ((bf16*)(ws + WS_SG))
#define OAB ((bf16*)(ws + WS_XN))
#define MIX ((bf16*)(ws + WS_MIX))
#define HID ((bf16*)(ws + WS_HID))
#define G3 ((bf16*)(ws + WS_G3))
#define Y ((bf16*)(ws + WS_Y))
#define rope ((float*)(ws + WS_ROPE))
#define kmean ((float*)(ws + WS_KMEAN))
#define out (args.out)
    const int lo = args.ph_lo, hi = args.ph_hi;
#define IN(k) (lo <= (k) && (k) < hi)
#define SEAM(k) do { if (IN(k) && IN((k) + 1)) { if (args.coop) { if ((k) == 0) { asm volatile("s_waitcnt vmcnt(0) lgkmcnt(0)" ::: "memory"); cg::this_grid().sync(); } else { xcd_barrier(xbar); } } } } while (0)
    volatile LAS unsigned* bst = (volatile LAS unsigned*)(L + LDS_BYTES - 64);
    if (tid < 2) bst[tid] = 0u;
    __syncthreads();
    XcdBarrier xbar; xbar.bar = (unsigned*)(ws + WS_BAR); xbar.x = 0; xbar.st = bst;
    if (args.coop) xbar = xcd_barrier_post((unsigned*)(ws + WS_BAR), bst);

    if (IN(0)) {
        LAS float* scr = (LAS float*)(L + wave * 16896);
        constexpr int I_IN = (DM / 64) * (INW / 64), I_BR = (1024 / 64) * (DM / 64), I_OUT = (DM / 64) * (DM / 64), I_UP = (DM / 64) * (DFF / 64), I_DN = (DFF / 64) * (DM / 64), I_PP = (PLE / 64) * (DM / 64);
        constexpr int NITEMS = I_IN + 2 * I_BR + I_OUT + I_UP + I_DN + I_OUT + I_PP;
        for (int it = gw; it < NITEMS; it += NGW) {
            int r = it;
            if (r < I_IN) { p0_transpose_item(args.in[2], DM, INW, Win_t, scr, r, lane); continue; } r -= I_IN;
            if (r < I_BR) { p0_transpose_item(args.in[3], 1024, DM, Wa_t, scr, r, lane, 2048); continue; } r -= I_BR;
            if (r < I_BR) { p0_transpose_item(args.in[4], 1024, DM, Wa_t + 1024, scr, r, lane, 2048); continue; } r -= I_BR;
            if (r < I_OUT) { p0_transpose_item(args.in[5], DM, DM, Wout_t, scr, r, lane); continue; } r -= I_OUT;
            if (r < I_UP) { p0_transpose_item(args.in[13], DM, DFF, Wup_t, scr, r, lane); continue; } r -= I_UP;
            if (r < I_DN) { p0_transpose_item(args.in[14], DFF, DM, Wdn_t, scr, r, lane); continue; } r -= I_DN;
            if (r < I_OUT) { p0_transpose_item(args.in[18], DM, DM, Wpg_t, scr, r, lane, DM + PLE); continue; } r -= I_OUT;
            p0_transpose_item(args.in[17], PLE, DM, Wpg_t + DM, scr, r, lane, DM + PLE);
        }
        for (int m = gw; m < T; m += NGW) rms_row_to_bf16(x_in + (size_t)m * DM, args.in[11], XN + (size_t)m * DM, lane);
        if (bx == 0) { for (int i = tid; i < 16 * 64 + 16; i += 512) { if (i < 1024) ((int*)(ws + WS_CNT))[i] = 0; else ((int*)(ws + WS_NBLK))[i - 1024] = 0; } }
        for (int i = bx * 512 + tid; i < 16 * 64 * 128; i += G * 512) kmean[i] = 0.f;
        for (int i = bx * 512 + tid; i < SEQ * 16; i += G * 512) { const int pos = i >> 4, k = i & 15;
            double fr_ = 1.0; for (int j_ = 0; j_ < k; ++j_) fr_ *= 0.4403666026717805;
            const float angf = (float)pos * (float)fr_; const double a = (double)angf;
            const double TWO_PI = 6.283185307179586476925286766559; double q = __builtin_rint(a / TWO_PI); double r = a - q * TWO_PI;
            const double r2 = r * r; double sn = 1.0, cs = 1.0;
            sn = 1.0 - r2 / (22.0 * 23.0); sn = 1.0 - r2 / (20.0 * 21.0) * sn; sn = 1.0 - r2 / (18.0 * 19.0) * sn; sn = 1.0 - r2 / (16.0 * 17.0) * sn; sn = 1.0 - r2 / (14.0 * 15.0) * sn; sn = 1.0 - r2 / (12.0 * 13.0) * sn;
            sn = 1.0 - r2 / (10.0 * 11.0) * sn; sn = 1.0 - r2 / (8.0 * 9.0) * sn; sn = 1.0 - r2 / (6.0 * 7.0) * sn; sn = 1.0 - r2 / (4.0 * 5.0) * sn; sn = 1.0 - r2 / (2.0 * 3.0) * sn; sn = r * sn;
            cs = 1.0 - r2 / (21.0 * 22.0); cs = 1.0 - r2 / (19.0 * 20.0) * cs; cs = 1.0 - r2 / (17.0 * 18.0) * cs; cs = 1.0 - r2 / (15.0 * 16.0) * cs; cs = 1.0 - r2 / (13.0 * 14.0) * cs; cs = 1.0 - r2 / (11.0 * 12.0) * cs;
            cs = 1.0 - r2 / (9.0 * 10.0) * cs; cs = 1.0 - r2 / (7.0 * 8.0) * cs; cs = 1.0 - r2 / (5.0 * 6.0) * cs; cs = 1.0 - r2 / (3.0 * 4.0) * cs; cs = 1.0 - r2 / (1.0 * 2.0) * cs;
            rope[(size_t)pos * 32 + k] = (float)cs; rope[(size_t)pos * 32 + 16 + k] = (float)sn; }
    }
    SEAM(0);
    if (IN(1)) {
        pg8::Gemm g{XN, Win_t, T, INW, DM}; pg8::StaticOrder S; S.init(T, INW, G, bx);
        pg8::EpiInProj E{QKV, SG, (const float*)rope, kmean};
        pg8::gemm_phase<pg8::EpiInProj, pg8::StaticOrder, true, true>(L, g, S, E);
    }
    SEAM(1);
    if (IN(3)) {
        LAS float* km = (LAS float*)L;
        const bf16* QA = QKV;
        for (int u = vcu; u < 16 * 64; u += G) {
            const int bh = u & 15, qb = u >> 4;
            __syncthreads();
            for (int i = tid; i < qb * 128 / 4; i += 512) *(LAS f32x4*)(km + i * 4) = *(const f32x4*)(kmean + (size_t)bh * 64 * 128 + i * 4);
            __syncthreads();
            const int row = tid >> 1, half = tid & 1;
            const bf16* qp = QA + ((size_t)bh * SEQ + (size_t)qb * 256 + row) * 128 + half * 64;
            float q[64];
#pragma unroll
            for (int i = 0; i < 8; ++i) { const v4u w = *(const v4u*)(qp + i * 8);
                q[8 * i + 0] = bflo(w.x); q[8 * i + 1] = bfhi(w.x); q[8 * i + 2] = bflo(w.y); q[8 * i + 3] = bfhi(w.y); q[8 * i + 4] = bflo(w.z); q[8 * i + 5] = bfhi(w.z); q[8 * i + 6] = bflo(w.w); q[8 * i + 7] = bfhi(w.w); }
            float g0 = -__builtin_inff(), g1 = g0, g2 = g0; int i0 = -1, i1 = -1, i2 = -1;
            for (int n = 0; n < qb; ++n) {
                const LAS float* kp = km + n * 128 + half * 64; float s = 0.f;
#pragma unroll
                for (int i = 0; i < 16; ++i) { const f32x4 kv = *(const LAS f32x4*)(kp + 4 * i); s += q[4 * i] * kv.x + q[4 * i + 1] * kv.y + q[4 * i + 2] * kv.z + q[4 * i + 3] * kv.w; }
                s += __shfl_xor(s, 1);
                if (s > g0) { g2 = g1; i2 = i1; g1 = g0; i1 = i0; g0 = s; i0 = n; }
                else if (s > g1) { g2 = g1; i2 = i1; g1 = s; i1 = n; }
                else if (s > g2) { g2 = s; i2 = n; }
            }
            if (half == 0) {
                const int grow = qb * 256 + row; int s0 = -1, s1 = -1, s2 = -1; int* cnt = (int*)(ws + WS_CNT) + bh * 64; float2* stt = (float2*)(ws + WS_STATS);
                float2 none; none.x = -1e30f; none.y = 0.f;
                if (i0 >= 0) s0 = atomicAdd(cnt + i0, 1); else stt[(size_t)(bh * 4 + 0) * SEQ + grow] = none;
                if (i1 >= 0) s1 = atomicAdd(cnt + i1, 1); else stt[(size_t)(bh * 4 + 1) * SEQ + grow] = none;
                if (i2 >= 0) s2 = atomicAdd(cnt + i2, 1); else stt[(size_t)(bh * 4 + 2) * SEQ + grow] = none;
                int4 rec; rec.x = (i0 & 255) | ((i1 & 255) << 8) | ((i2 & 255) << 16); rec.y = s0; rec.z = s1; rec.w = s2;
                ((int4*)(ws + WS_SEL))[(size_t)bh * SEQ + grow] = rec; }
        }
        __syncthreads();
    }
    SEAM(3);
    if (IN(4)) {
        LAS int* cn = (LAS int*)L; LAS int* offs = cn + 64;
        int* ROWL = (int*)(ws + WS_ROWL); int* DSTL = (int*)(ws + WS_DSTL);
        for (int u = vcu; u < 16 * 64; u += G) {
            const int bh = u & 15, chunk = u >> 4;
            __syncthreads();
            if (tid < 64) cn[tid] = ((const int*)(ws + WS_CNT))[bh * 64 + tid];
            __syncthreads();
            if (tid == 0) { int a = 0; for (int j = 0; j < 64; ++j) { offs[j] = a; a += (cn[j] + 255) & ~255; } offs[64] = a; }
            __syncthreads();
            int* rl = ROWL + (size_t)bh * LSTR; int* dl = DSTL + (size_t)bh * LSTR;
            if (tid < 256) { const int row = chunk * 256 + tid; const int4 rec = ((const int4*)(ws + WS_SEL))[(size_t)bh * SEQ + row];
                const int j0 = rec.x & 255, j1 = (rec.x >> 8) & 255, j2 = (rec.x >> 16) & 255;
                if (j0 != 255) { const int gp = offs[j0] + rec.y; rl[gp] = row; dl[gp] = (bh * 4 + 0) * SEQ + row; }
                if (j1 != 255) { const int gp = offs[j1] + rec.z; rl[gp] = row; dl[gp] = (bh * 4 + 1) * SEQ + row; }
                if (j2 != 255) { const int gp = offs[j2] + rec.w; rl[gp] = row; dl[gp] = (bh * 4 + 2) * SEQ + row; }
                rl[65536 + row] = row; dl[65536 + row] = (bh * 4 + 3) * SEQ + row; }
            if (chunk == 0) {
                for (int idx = tid; idx < 64 * 256; idx += 512) { const int j = idx >> 8, c = cn[j], pos = c + (idx & 255);
                    if (pos < ((c + 255) & ~255)) { rl[offs[j] + pos] = 0; dl[offs[j] + pos] = -1; } }
                if (tid == 0) { int k = 0; int2* tab = (int2*)(ws + WS_TAB) + bh * 256;
                    for (int j = 0; j < 64; ++j) { const int nb = (cn[j] + 255) >> 8; for (int b_ = 0; b_ < nb; ++b_) { if (k < 256) { int2 t; t.x = j; t.y = offs[j] + 256 * b_; tab[k] = t; } ++k; } }
                    ((int*)(ws + WS_NBLK))[bh] = k < 256 ? k : 256; }
            }
        }
        __syncthreads();
    }
    SEAM(4);
    if (IN(5)) {
        const int* nblk = (const int*)(ws + WS_NBLK);
        static_assert(swa::MOBA_LDS_BYTES <= LDS_BYTES - 64, "MoBA short-block LDS");
        int Lc = vcu; if (!moba_valid(Lc, nblk)) Lc = moba_next(Lc, G, nblk);
        if (Lc < MOBA_ITEMS) {
            ABlock cur = moba_ref(Lc, ws, out); swa::MobaStage ST; swa::moba_prime(cur, ST);
            for (;;) { const int Ln = moba_next(Lc, G, nblk); const bool has_next = Ln < MOBA_ITEMS;
                ABlock nxt = cur; if (has_next) nxt = moba_ref(Ln, ws, out);
                swa::moba_block(cur, nxt, has_next, (char*)lds, ST);
                if (!has_next) break;
                cur = nxt; Lc = Ln; }
        }
        __syncthreads();
    }
    SEAM(5);
    if (IN(6)) {
        const float2* stt = (const float2*)(ws + WS_STATS); const bf16* PART = (const bf16*)out; constexpr float C2 = 1.4426950408889634f * 0.08838834764831845f;
        for (int u0 = gw; u0 < 16 * SEQ; u0 += 4 * NGW) {
            float2 st[4][4]; unsigned pw[4][4];
#pragma unroll
            for (int k = 0; k < 4; ++k) { const int u = u0 + k * NGW, bh = u >> 14, row = u & (SEQ - 1);
#pragma unroll
                for (int s_ = 0; s_ < 4; ++s_) { const size_t di = (size_t)(bh * 4 + s_) * SEQ + row; st[k][s_] = stt[di]; pw[k][s_] = ntload((const unsigned*)(PART + di * 128 + lane * 2)); } }
#pragma unroll
            for (int k = 0; k < 4; ++k) { const int u = u0 + k * NGW, bh = u >> 14, row = u & (SEQ - 1);
                float M = -1e30f;
#pragma unroll
                for (int s_ = 0; s_ < 4; ++s_) if (st[k][s_].y > 0.f) M = fmaxf(M, st[k][s_].x);
                float a0 = 0.f, a1 = 0.f, den = 0.f;
#pragma unroll
                for (int s_ = 0; s_ < 4; ++s_) { const bool ok = st[k][s_].y > 0.f; const float w = ok ? st[k][s_].y * __builtin_amdgcn_exp2f((st[k][s_].x - M) * C2) : 0.f;
                    a0 += ok ? w * bflo(pw[k][s_]) : 0.f; a1 += ok ? w * bfhi(pw[k][s_]) : 0.f; den += w; }
                const float inv = 1.0f / den;
                *(unsigned*)(OAB + ((size_t)(bh >> 3) * SEQ + row) * 2048 + (bh & 7) * 128 + lane * 2) = pk2(a0 * inv, a1 * inv); } }
    }
    SEAM(6);
    if (IN(7)) {
        constexpr int NITEM = 32 * 32;
        int Lc = vcu;
        if (Lc < NITEM) {
            int head = Lc >> 5, xx = Lc & 31, pass = 0;
            ABlock cur = attn_ref(head, xx, ws, out);
            swa::Seam<swa::bf16> S;
            swa::causal_swa_prime<swa::bf16, swa::bf16>(cur, SEQ, (char*)lds, S);
            for (;;) {
                const bool more_pass = pass == 0, more_item = Lc + G < NITEM, last = !more_pass && !more_item;
                int headn = head, xn = xx, passn = pass + 1, Ln = Lc;
                if (!more_pass) { passn = 0; Ln = more_item ? Lc + G : Lc; headn = Ln >> 5; xn = Ln & 31; }
                const int qbn = passn ? 63 - xn : xn;
                ABlock nxt = cur;
                if (!last) nxt = attn_ref(headn, qbn, ws, out);
                swa::causal_swa_block<swa::bf16, swa::bf16>(cur, nxt, SEQ, SEQ, (char*)lds, S);
                if (last) break;
                cur = nxt; head = headn; xx = xn; pass = passn; Lc = Ln;
            }
        }
        __syncthreads();
    }
    SEAM(7);
    if (IN(8)) {
        float lam;
        { const float* q1 = args.in[6]; const float* k1 = args.in[7]; const float* q2 = args.in[8]; const float* k2 = args.in[9];
          const float s1 = wave_sum(q1[lane] * k1[lane] + q1[lane + 64] * k1[lane + 64]), s2 = wave_sum(q2[lane] * k2[lane] + q2[lane + 64] * k2[lane + 64]);
          lam = __expf(s1) - __expf(s2) + LAMBDA_INIT; }
        const bf16* AD = (const bf16*)out; const float* sg = args.in[10];
        const f32x4 gg = *(const f32x4*)(sg + lane * 4);
        for (int u0 = gw; u0 < T * 4; u0 += 4 * NGW) {
            v2u w0[4], w1[4];
#pragma unroll
            for (int k = 0; k < 4; ++k) { const int u = u0 + k * NGW, t = u >> 2, hd = u & 3; const bf16* a = AD + (size_t)t * 4096 + hd * 512 + lane * 4; w0[k] = ntload((const v2u*)a); w1[k] = ntload((const v2u*)(a + 256)); }
#pragma unroll
            for (int k = 0; k < 4; ++k) { const int u = u0 + k * NGW, t = u >> 2, hd = u & 3;
                f32x4 d; d.x = bflo(w0[k].x) - lam * bflo(w1[k].x); d.y = bfhi(w0[k].x) - lam * bfhi(w1[k].x); d.z = bflo(w0[k].y) - lam * bflo(w1[k].y); d.w = bfhi(w0[k].y) - lam * bfhi(w1[k].y);
                const float ss = wave_sum((d.x * d.x + d.y * d.y) + (d.z * d.z + d.w * d.w));
                const float r = (1.0f - LAMBDA_INIT) / sqrtf(ss * (1.f / 256.f) + NORM_EPS);
                v2u o; o.x = pk2(d.x * r * gg.x, d.y * r * gg.y); o.y = pk2(d.z * r * gg.z, d.w * r * gg.w);
                *(v2u*)(OAB + (size_t)t * 2048 + 1024 + hd * 256 + lane * 4) = o; } }
    }
    SEAM(8);
    if (IN(9)) { pg8::Gemm g{OAB, Wa_t, T, DM, 2048}; pg8::StaticOrder S; S.init(T, DM, G, bx); pg8::EpiGate2 E{MIX, SG};
        pg8::gemm_phase<pg8::EpiGate2, pg8::StaticOrder, true, true, true>(L, g, S, E); }
    SEAM(9);
    if (IN(11)) { pg8::Gemm g{MIX, Wout_t, T, DM, DM}; pg8::StaticOrder S; S.init(T, DM, G, bx); pg8::EpiT<0> E{Y, DM, nullptr, 0};
        pg8::gemm_phase<pg8::EpiT<0>, pg8::StaticOrder, true, true>(L, g, S, E); }
    SEAM(11);
    if (IN(12)) row_pass(Y, x_in, args.in[12], out, args.in[15], XN, gw, NGW, lane);
    SEAM(12);
    if (IN(13)) { pg8::Gemm g{XN, Wup_t, T, DFF, DM}; pg8::StaticOrder S; S.init(T, DFF, G, bx); pg8::EpiT<1> E{HID, DFF, nullptr, 0};
        pg8::gemm_phase<pg8::EpiT<1>, pg8::StaticOrder, true, true>(L, g, S, E); }
    SEAM(13);
    if (IN(14)) { pg8::Gemm g{HID, Wdn_t, T, DM, DFF}; pg8::StaticOrder S; S.init(T, DM, G, bx); pg8::EpiT<0> E{Y, DM, nullptr, 0};
        pg8::gemm_phase<pg8::EpiT<0>, pg8::StaticOrder, true, true>(L, g, S, E); }
    SEAM(14);
    if (IN(15)) row_pass(Y, out, args.in[16], out, args.in[19], (bf16*)(ws + WS_XN3), gw, NGW, lane, DM + PLE, p_in);
    SEAM(15);
    if (IN(16)) { pg8::Gemm g{(bf16*)(ws + WS_XN3), Wpg_t, T, DM, DM + PLE}; pg8::StaticOrder S; S.init(T, DM, G, bx); pg8::EpiPle E{Y, G3};
        pg8::gemm_phase<pg8::EpiPle, pg8::StaticOrder, true, true, true>(L, g, S, E); }
    SEAM(17);
    if (IN(18)) row_pass(Y, out, args.in[20], out, nullptr, nullptr, gw, NGW, lane);
#undef IN
#undef SEAM
#undef x_in
#undef p_in
#undef Win_t
#undef Wa_t
#undef Wb_t
#undef Wout_t
#undef Wup_t
#undef Wdn_t
#undef Wpg_t
#undef Wpp_t
#undef XN
#undef PB
#undef QKV
#undef SG
#undef OAB
#undef MIX
#undef HID
#undef G3
#undef Y
#undef rope
#undef kmean
#undef out
}

extern "C" void kernel_launch(void* const* d_in, const int* in_sizes, int n_in, void* d_out, int out_size, void* d_ws, size_t ws_size, hipStream_t stream) {
    static int grid = 0;
    if (grid == 0) {
        if (n_in != 21 || out_size != T * DM || ws_size < WS_TOP) { fprintf(stderr, "kernel_launch: unexpected shapes n_in %d out %d ws %zu\n", n_in, out_size, ws_size); grid = -1; return; }
        int dev = 0, cus = 0, per_cu = 0;
        (void)hipGetDevice(&dev); (void)hipDeviceGetAttribute(&cus, hipDeviceAttributeMultiprocessorCount, dev);
        if (hipFuncSetAttribute((const void*)mk_fwd, hipFuncAttributeMaxDynamicSharedMemorySize, LDS_BYTES) != hipSuccess) { fprintf(stderr, "kernel_launch: hipFuncSetAttribute failed\n"); grid = -1; return; }
        if (hipOccupancyMaxActiveBlocksPerMultiprocessor(&per_cu, (const void*)mk_fwd, NWAVES * 64, LDS_BYTES) != hipSuccess || per_cu < 1) { fprintf(stderr, "kernel_launch: occupancy query says %d\n", per_cu); per_cu = 1; }
        (void)hipGetLastError();
        grid = cus * 1;
        if (grid <= 0) grid = 256;
    }
    if (grid < 0) return;
    (void)hipMemsetAsync((unsigned char*)d_ws + WS_BAR, 0, WS_BAR_BYTES, stream);
    Args a{};
    for (int i = 0; i < 21; ++i) a.in[i] = (const float*)d_in[i];
    a.out = (float*)d_out; a.ws = (unsigned char*)d_ws;
#if MK_ONE_LAUNCH
    a.ph_lo = 0; a.ph_hi = NPHASE; a.coop = 1;
    void* kargs[] = {&a};
    hipError_t e = hipLaunchCooperativeKernel((const void*)mk_fwd, dim3(grid), dim3(NWAVES * 64), kargs, LDS_BYTES, stream);
    if (e != hipSuccess) fprintf(stderr, "cooperative launch failed: %s (grid %d)\n", hipGetErrorString(e), grid);
#else
    for (int ph = 0; ph < NPHASE; ++ph) { a.ph_lo = ph; a.ph_hi = ph + 1; a.coop = 0;
        hipLaunchKernelGGL(mk_fwd, dim3(grid), dim3(NWAVES * 64), LDS_BYTES, stream, a); }
#endif
}
```

```cpp
#include <hip/hip_runtime.h>
#include <hip/hip_bf16.h>
#include <cstdio>
#include <cstdint>
#include <cmath>
namespace pg8 {
#define PG8_LAS __attribute__((address_space(3)))
typedef unsigned short bf16_t;
typedef short bf16x8 __attribute__((ext_vector_type(8)));
typedef float f32x4 __attribute__((ext_vector_type(4)));
typedef unsigned u32x4 __attribute__((ext_vector_type(4)));
constexpr int BM = 256, BK = 64, HALF = 128, HTB = HALF * BK * 2  , STAGE_BYTES = 8 * HTB, NXCD = 8, WGM = 8;

__host__ __device__ __forceinline__ int lds_byte(int r, int c) { const int st = (r >> 4) * 2 + (c >> 5), rr = r & 15, cc = c & 31, ob = rr * 64 + cc * 2; return st * 1024 + (ob ^ (((ob >> 9) & 1) << 5)); }
__host__ __device__ __forceinline__ void stage_rc(int b, int& R, int& C) { const int st = b / 1024, sb = b % 1024, swz = sb ^ (((sb >> 9) & 1) << 5); R = (st >> 1) * 16 + swz / 64; C = (st & 1) * 32 + (swz % 64) / 2; }
__host__ __device__ __forceinline__ int perm32(int rho) { const int n = rho >> 4, i = rho & 15; return 8 * (i >> 2) + 4 * n + (i & 3); }

struct Unit { int pm, pn; };
struct Gemm { const bf16_t* A; const bf16_t* Bt; int M, N, K; };

struct StaticOrder {
    int nM, nN, nwg, G, c;
    __host__ __device__ void init(int M, int N, int G_, int c_) { nM = M / BM; nN = N / BM; nwg = nM * nN; G = G_; c = c_; }
    __host__ __device__ bool next(int i, Unit& u) const {
        const long L = (long)i * G + c; if (L >= nwg) return false;
        int wgid = (int)L; { const int q = nwg / NXCD, r = nwg % NXCD, xcd = wgid % NXCD, off = wgid / NXCD; wgid = (xcd < r ? xcd * (q + 1) : r * (q + 1) + (xcd - r) * q) + off; }
        const int nig = WGM * nN, gid = wgid / nig, fm = gid * WGM, gsz = (nM - fm) < WGM ? (nM - fm) : WGM;
        u.pm = fm + ((wgid % nig) % gsz); u.pn = (wgid % nig) / gsz; return true;
    }
    __device__ __forceinline__ void a_ready(const Unit&) const {}
    __device__ __forceinline__ void done(const Unit&) const {}
};

typedef float f32x2_c __attribute__((ext_vector_type(2))); typedef __bf16 bf16x2_c __attribute__((ext_vector_type(2)));
__device__ __forceinline__ unsigned cvt_pk_bf16(float lo, float hi) { f32x2_c v = {lo, hi}; bf16x2_c b = __builtin_convertvector(v, bf16x2_c); return __builtin_bit_cast(unsigned, b); }
typedef float f32x2 __attribute__((ext_vector_type(2)));
__device__ __forceinline__ f32x2 gelu_pk(f32x2 v) {
    const f32x2 av = __builtin_elementwise_abs(v), d = av * 0.2316418882f + 1.0f;
    f32x2 t; t.x = __builtin_amdgcn_rcpf(d.x); t.y = __builtin_amdgcn_rcpf(d.y);
    f32x2 q = t * 0.5307027145f + (-0.7265760135f); q = q * t + 0.7107068705f; q = q * t + (-0.142248368f); q = q * t + 0.127414796f; q = q * t;
    const f32x2 s = (v * v) * (-0.72134752044f);
    f32x2 e; e.x = __builtin_amdgcn_exp2f(s.x); e.y = __builtin_amdgcn_exp2f(s.y);
    const f32x2 m = v * (q * e), r = v - m;
    f32x2 o; o.x = v.x < 0.f ? m.x : r.x; o.y = v.y < 0.f ? m.y : r.y; return o;
}

template <int ACT  > struct EpiBf16 {
    static constexpr bool PERM = true, AFTER_DRAIN = false; static_assert(ACT == 0 || ACT == 1, "EpiBf16: ACT is 0 (none) or 1 (gelu_pk)");
    bf16_t* O; int ldc; const float* bias; int split_cols; size_t split_stride; float scale0;
    __device__ __forceinline__ void operator()(const f32x4 (&acc)[2][2][4][2], const Unit& u, int wr, int wc, int fr, int fq) const {
        const int row0 = u.pm * BM + wr * 64 + fr; int colt = u.pn * BM; bf16_t* base = O;
        float sc = 1.f; if (split_cols) { const int t = colt / split_cols; base += (size_t)t * split_stride; colt -= t * split_cols; if (t == 0) sc = scale0; }
        const int col0 = colt + wc * 32 + 8 * fq, bcol0 = u.pn * BM + wc * 32 + 8 * fq;
        f32x4 bv[2][2];
#pragma unroll
        for (int bj = 0; bj < 2; ++bj)
#pragma unroll
            for (int n = 0; n < 2; ++n) bv[bj][n] = bias ? *(const f32x4*)(bias + bcol0 + bj * HALF + 4 * n) : (f32x4){0.f, 0.f, 0.f, 0.f};
#pragma unroll
        for (int ai = 0; ai < 2; ++ai)
#pragma unroll
            for (int m = 0; m < 4; ++m) { bf16_t* rowp = base + (size_t)(row0 + ai * HALF + m * 16) * ldc + col0;
#pragma unroll
                for (int bj = 0; bj < 2; ++bj) { f32x4 v0 = acc[ai][bj][m][0] + bv[bj][0], v1 = acc[ai][bj][m][1] + bv[bj][1];
                    if (ACT == 1) { f32x2 a = gelu_pk((f32x2){v0[0], v0[1]}), b = gelu_pk((f32x2){v0[2], v0[3]}), c = gelu_pk((f32x2){v1[0], v1[1]}), d = gelu_pk((f32x2){v1[2], v1[3]});
                        v0 = (f32x4){a.x, a.y, b.x, b.y}; v1 = (f32x4){c.x, c.y, d.x, d.y}; }
                    v0 = v0 * sc; v1 = v1 * sc; u32x4 w; w.x = cvt_pk_bf16(v0[0], v0[1]); w.y = cvt_pk_bf16(v0[2], v0[3]); w.z = cvt_pk_bf16(v1[0], v1[1]); w.w = cvt_pk_bf16(v1[2], v1[3]);
                    *(u32x4*)(rowp + bj * HALF) = w; } }
    }
};

template <class Epi, class Sched, bool ALIGN_EPI = false, bool SP2 = false, bool MID = false>
__device__ __forceinline__ void gemm_phase(PG8_LAS unsigned char* lds, const Gemm g, const Sched& S, const Epi& E) {
    const int tid = threadIdx.x, wid = __builtin_amdgcn_readfirstlane(tid >> 6), lane = tid & 63, wr = wid >> 2, wc = wid & 3, fr = lane & 15, fq = lane >> 4;
    const int K = g.K, nt = K / BK;
    unsigned voffA[2], voffB[2];
#pragma unroll
    for (int i = 0; i < 2; ++i) { int R, C; stage_rc(tid * 16 + i * 8192, R, C); const int Rb = Epi::PERM ? ((R & ~31) + perm32(R & 31)) : R;
        voffA[i] = (unsigned)(R * K + C) * 2u; voffB[i] = (unsigned)(Rb * K + C) * 2u; }
    const size_t kstep = (size_t)(BK * 2);
    const size_t hstep = (size_t)HALF * K * 2;
    const size_t tstep = 2 * hstep;
    const unsigned ldsw = (unsigned)wid * 1024u;
    const int aoff = lds_byte(wr * 64 + fr, fq * 8), boff = lds_byte(wc * 32 + fr, fq * 8);
#define PG8_SA(b, h) (((b) * 2 + (h)) * HTB)
#define PG8_SB(b, h) ((4 + (b) * 2 + (h)) * HTB)
#define PG8_STAGE(bufoff, gbase, voff) do { _Pragma("unroll") for (int _i = 0; _i < 2; ++_i) \
        __builtin_amdgcn_global_load_lds((const unsigned*)((const char*)(gbase) + (voff)[_i]), (PG8_LAS unsigned*)(lds + (bufoff) + ldsw + _i * 8192), 16, 0, 0); } while (0)
#define PG8_LDA(dst, b, h) do { _Pragma("unroll") for (int m = 0; m < 4; ++m) _Pragma("unroll") for (int k = 0; k < 2; ++k) dst[m][k] = *(const PG8_LAS bf16x8*)(lds + PG8_SA(b, h) + aoff + m * 2048 + k * 1024); } while (0)
#define PG8_LDB(dst, b, h) do { _Pragma("unroll") for (int n = 0; n < 2; ++n) _Pragma("unroll") for (int k = 0; k < 2; ++k) dst[n][k] = *(const PG8_LAS bf16x8*)(lds + PG8_SB(b, h) + boff + n * 2048 + k * 1024); } while (0)
#define PG8_MMA(ai, bj, At, Bt) do { __builtin_amdgcn_s_setprio(1); _Pragma("unroll") for (int m = 0; m < 4; ++m) _Pragma("unroll") for (int n = 0; n < 2; ++n) _Pragma("unroll") for (int k = 0; k < 2; ++k) \
        acc[ai][bj][m][n] = __builtin_amdgcn_mfma_f32_16x16x32_bf16(Bt[n][k], At[m][k], acc[ai][bj][m][n], 0, 0, 0); __builtin_amdgcn_s_setprio(0); } while (0)
#define PG8_WAIT_V(n) asm volatile("s_waitcnt vmcnt(" #n ")" ::: "memory")
#define PG8_WAIT_L(n) asm volatile("s_waitcnt lgkmcnt(" #n ")" ::: "memory")
#define PG8_BAR __builtin_amdgcn_s_barrier()
#define PG8_SCHED __builtin_amdgcn_sched_barrier(0)
    Unit cur, nxt; int ui = 0;
    if (!S.next(0, cur)) return;
    f32x4 acc[2][2][4][2];
#pragma unroll
    for (int a = 0; a < 2; ++a)
#pragma unroll
        for (int b = 0; b < 2; ++b)
#pragma unroll
            for (int m = 0; m < 4; ++m)
#pragma unroll
                for (int n = 0; n < 2; ++n) acc[a][b][m][n] = (f32x4){0.f, 0.f, 0.f, 0.f};
    bf16x8 At[4][2], B0[2][2], B1[2][2];
    const char* cA = (const char*)g.A + (size_t)cur.pm * tstep; const char* cB = (const char*)g.Bt + (size_t)cur.pn * tstep;
    S.a_ready(cur);
    if constexpr (SP2) {
        PG8_STAGE(PG8_SB(0, 0), cB, voffB); PG8_STAGE(PG8_SB(0, 1), cB + hstep, voffB); PG8_STAGE(PG8_SA(0, 0), cA, voffA); PG8_STAGE(PG8_SA(0, 1), cA + hstep, voffA);
        if (wr == 1) PG8_BAR;
        PG8_WAIT_V(2); PG8_BAR;
        PG8_STAGE(PG8_SB(1, 0), cB + kstep, voffB); PG8_STAGE(PG8_SA(1, 0), cA + kstep, voffA); PG8_STAGE(PG8_SB(1, 1), cB + hstep + kstep, voffB);
        PG8_WAIT_V(6); PG8_BAR;
    } else {
        PG8_STAGE(PG8_SB(0, 0), cB, voffB); PG8_STAGE(PG8_SA(0, 0), cA, voffA); PG8_STAGE(PG8_SB(0, 1), cB + hstep, voffB); PG8_STAGE(PG8_SA(0, 1), cA + hstep, voffA);
        if (wr == 1) PG8_BAR;
        PG8_WAIT_V(4); PG8_BAR;
        PG8_STAGE(PG8_SB(1, 0), cB + kstep, voffB); PG8_STAGE(PG8_SA(1, 0), cA + kstep, voffA); PG8_STAGE(PG8_SB(1, 1), cB + hstep + kstep, voffB);
        PG8_WAIT_V(6); PG8_BAR;
    }
    for (;;) {
        const bool has_next = S.next(ui + 1, nxt);
        const char* nA = has_next ? (const char*)g.A + (size_t)nxt.pm * tstep : cA; const char* nB = has_next ? (const char*)g.Bt + (size_t)nxt.pn * tstep : cB;
        for (int t = 0; t < nt; t += 2) {
            const bool last = (t == nt - 2);
            if constexpr (MID) { if (t == Epi::MID_T) { PG8_SCHED; E.mid(acc, cur, wr, wc, fr, fq); PG8_SCHED; } }
            const char* a1 = cA + (size_t)(t + 1) * kstep;
            const char* a2 = last ? nA : cA + (size_t)(t + 2) * kstep; const char* b2 = last ? nB : cB + (size_t)(t + 2) * kstep;
            const char* a3 = a2 + kstep; const char* b3 = b2 + kstep;
            if (last && has_next) S.a_ready(nxt);
            if constexpr (SP2) {
            PG8_LDB(B0, 0, 0); PG8_LDB(B1, 0, 1); PG8_SCHED; PG8_LDA(At, 0, 0); PG8_STAGE(PG8_SA(1, 1), a1 + hstep, voffA);
            PG8_WAIT_V(8); PG8_WAIT_L(0); PG8_BAR; PG8_MMA(0, 0, At, B0); PG8_MMA(0, 1, At, B1); PG8_BAR; PG8_SCHED;
            PG8_LDA(At, 0, 1); PG8_STAGE(PG8_SB(0, 0), b2, voffB); PG8_STAGE(PG8_SB(0, 1), b2 + hstep, voffB); PG8_STAGE(PG8_SA(0, 0), a2, voffA);
            PG8_WAIT_V(8); PG8_WAIT_L(0); PG8_BAR; PG8_MMA(1, 0, At, B0); PG8_MMA(1, 1, At, B1); PG8_BAR; PG8_SCHED;
            PG8_LDB(B0, 1, 0); PG8_LDB(B1, 1, 1); PG8_SCHED; PG8_LDA(At, 1, 0); PG8_STAGE(PG8_SA(0, 1), a2 + hstep, voffA);
            PG8_WAIT_V(8); PG8_WAIT_L(0); PG8_BAR; PG8_MMA(0, 0, At, B0); PG8_MMA(0, 1, At, B1); PG8_BAR; PG8_SCHED;
            PG8_LDA(At, 1, 1); PG8_STAGE(PG8_SB(1, 0), b3, voffB); PG8_STAGE(PG8_SB(1, 1), b3 + hstep, voffB); PG8_STAGE(PG8_SA(1, 0), a3, voffA);
            PG8_WAIT_V(8); PG8_WAIT_L(0); PG8_BAR; PG8_MMA(1, 0, At, B0); PG8_MMA(1, 1, At, B1); PG8_BAR; PG8_SCHED;
            } else {
            PG8_LDB(B0, 0, 0); PG8_SCHED; PG8_LDA(At, 0, 0); PG8_STAGE(PG8_SA(1, 1), a1 + hstep, voffA);
            PG8_WAIT_L(8); PG8_BAR; PG8_WAIT_L(0); PG8_MMA(0, 0, At, B0); PG8_BAR; PG8_SCHED;
            PG8_LDB(B1, 0, 1); PG8_STAGE(PG8_SB(0, 0), b2, voffB);
            PG8_BAR; PG8_WAIT_L(0); PG8_MMA(0, 1, At, B1); PG8_BAR;
            PG8_LDA(At, 0, 1); PG8_STAGE(PG8_SA(0, 0), a2, voffA);
            PG8_BAR; PG8_WAIT_L(0); PG8_MMA(1, 0, At, B0); PG8_BAR; PG8_SCHED;
            PG8_STAGE(PG8_SB(0, 1), b2 + hstep, voffB);
            PG8_WAIT_V(6); PG8_BAR; PG8_MMA(1, 1, At, B1); PG8_BAR;
            PG8_LDB(B0, 1, 0); PG8_SCHED; PG8_LDA(At, 1, 0); PG8_STAGE(PG8_SA(0, 1), a2 + hstep, voffA);
            PG8_WAIT_L(8); PG8_BAR; PG8_WAIT_L(0); PG8_MMA(0, 0, At, B0); PG8_BAR; PG8_SCHED;
            PG8_LDB(B1, 1, 1); PG8_STAGE(PG8_SB(1, 0), b3, voffB);
            PG8_BAR; PG8_WAIT_L(0); PG8_MMA(0, 1, At, B1); PG8_BAR;
            PG8_LDA(At, 1, 1); PG8_STAGE(PG8_SA(1, 0), a3, voffA);
            PG8_BAR; PG8_WAIT_L(0); PG8_MMA(1, 0, At, B0); PG8_BAR; PG8_SCHED;
            PG8_STAGE(PG8_SB(1, 1), b3 + hstep, voffB);
            PG8_WAIT_V(6); PG8_BAR; PG8_MMA(1, 1, At, B1); PG8_BAR;
            }
        }
        if constexpr (ALIGN_EPI) { if (wr == 0) PG8_BAR; }
        if constexpr (!Epi::AFTER_DRAIN) { E(acc, cur, wr, wc, fr, fq); S.done(cur); }
        if (!has_next) break;
#pragma unroll
        for (int a = 0; a < 2; ++a)
#pragma unroll
            for (int b = 0; b < 2; ++b)
#pragma unroll
                for (int m = 0; m < 4; ++m)
#pragma unroll
                    for (int n = 0; n < 2; ++n) acc[a][b][m][n] = (f32x4){0.f, 0.f, 0.f, 0.f};
        cur = nxt; cA = nA; cB = nB; ++ui;
        if constexpr (ALIGN_EPI) { if (wr == 1) PG8_BAR; }
    }
    PG8_WAIT_V(0);
    if constexpr (!ALIGN_EPI) { if (wr == 0) PG8_BAR; }
    PG8_BAR;
    if constexpr (Epi::AFTER_DRAIN) { E.fused(acc, cur, wr, wc, fr, fq, lds, wid, lane); S.done(cur); }
#undef PG8_SA
#undef PG8_SB
#undef PG8_STAGE
#undef PG8_LDA
#undef PG8_LDB
#undef PG8_MMA
#undef PG8_WAIT_V
#undef PG8_WAIT_L
#undef PG8_BAR
#undef PG8_SCHED
}
}
namespace swa {
constexpr int D = 128;
constexpr float THR = 8.f;
constexpr bool WSKIP = false;
constexpr float SCALE = 0.08838834764831845f;
constexpr int NW = 8, QBLK = 32, KVBLK = 64, QB = NW * QBLK;
constexpr int SHM_V = KVBLK * D * 2, SHM_K = KVBLK * D * 2;
constexpr int MSLOT_OFF = 2 * SHM_V + 2 * SHM_K + NW * 64 * 4, QLDS_OFF = MSLOT_OFF + 4096;
constexpr int LDS_BYTES = QLDS_OFF + NW * 8192;

using bf16 = __hip_bfloat16;
typedef short bf16x8 __attribute__((ext_vector_type(8)));
typedef short s16x4 __attribute__((ext_vector_type(4)));
typedef float f32x16 __attribute__((ext_vector_type(16)));
typedef float f32x4 __attribute__((ext_vector_type(4)));
typedef unsigned u32x4 __attribute__((ext_vector_type(4)));
template <class A, class Bt> struct same_t { static constexpr bool v = false; };
template <class A> struct same_t<A, A> { static constexpr bool v = true; };

#define KSWZ(row, colB) ((row) * 256 + ((colB) ^ (((row) & 7) << 4)))
#define SBAR() __builtin_amdgcn_sched_barrier(0)
__device__ __forceinline__ int v_st(int k, int c) { const int kk = (k & ~0xC) | ((k & 4) << 1) | ((k & 8) >> 1); return ((kk >> 3) * 4 + (c >> 5)) * 512 + ((kk & 7) * 32 + (c & 31)) * 2; }
__device__ __forceinline__ int v_rd_base(int lane) { return ((lane & 3) << 3) | (((lane >> 2) & 3) << 6) | (((lane >> 4) & 1) << 5) | (((lane >> 5) & 1) << 8); }
constexpr int v_rd_off(int d0, int ks, int half) { return d0 * 512 + ks * 4096 + half * 2048; }
__device__ __forceinline__ int crow(int r, int hi) { return (r & 3) + 8 * (r >> 2) + 4 * hi; }
typedef float f32x2_c __attribute__((ext_vector_type(2))); typedef __bf16 bf16x2_c __attribute__((ext_vector_type(2)));
__device__ __forceinline__ unsigned cvtpk(float lo, float hi) { f32x2_c v = {lo, hi}; bf16x2_c b = __builtin_convertvector(v, bf16x2_c); return __builtin_bit_cast(unsigned, b); }
__device__ __forceinline__ bf16x8 pack8(f32x4 a, f32x4 b) {
    u32x4 w = {cvtpk(a[0], a[1]), cvtpk(a[2], a[3]), cvtpk(b[0], b[1]), cvtpk(b[2], b[3])};
    return *reinterpret_cast<bf16x8*>(&w);
}
template <class T> __device__ __forceinline__ bf16x8 load8(const T* p) {
    if constexpr (same_t<T, float>::v) { return pack8(*(const f32x4*)p, *(const f32x4*)(p + 4)); }
    else { return *reinterpret_cast<const bf16x8*>(p); }
}
__device__ __forceinline__ void mask_tile(f32x16& p0, f32x16& p1, int dq, unsigned W) {
    const float NEG = -__builtin_inff();
#pragma unroll
    for (int r = 0; r < 16; ++r) {
        const int c = (r & 3) + 8 * (r >> 2);
        if ((unsigned)(dq - c) >= W) p0[r] = NEG;
        if ((unsigned)(dq - c - 32) >= W) p1[r] = NEG;
    }
}
__device__ __forceinline__ void partialSM(f32x16& p0, f32x16& p1, float& m_reg, float& mn, float& alpha) {
    float pmax = p0[0]; for (int r = 1; r < 16; ++r) pmax = fmaxf(pmax, p0[r]); for (int r = 0; r < 16; ++r) pmax = fmaxf(pmax, p1[r]);
    { auto rr = __builtin_amdgcn_permlane32_swap(__float_as_uint(pmax), __float_as_uint(pmax), false, false);
      pmax = fmaxf(__uint_as_float(rr[0]), __uint_as_float(rr[1])); }
    constexpr float C2 = 1.4426950408889634f * SCALE;
    if (__builtin_expect(__all((pmax - m_reg) * SCALE <= THR), 1)) { mn = m_reg; alpha = 1.f; }
    else { mn = fmaxf(m_reg, pmax); alpha = __builtin_amdgcn_exp2f((m_reg - mn) * C2); m_reg = mn; }
    const float mnL = -mn * C2;
    for (int r = 0; r < 16; ++r) p0[r] = fmaf(p0[r], C2, mnL); for (int r = 0; r < 16; ++r) p1[r] = fmaf(p1[r], C2, mnL);
    for (int r = 0; r < 16; ++r) p0[r] = __builtin_amdgcn_exp2f(p0[r]);
}
__device__ __forceinline__ void finishSM(f32x16& p0, f32x16& p1, float alpha, float& l_reg, bf16x8& pa0, bf16x8& pa1, bf16x8& pa2, bf16x8& pa3) {
    for (int r = 0; r < 16; ++r) p1[r] = __builtin_amdgcn_exp2f(p1[r]);
    float ps = 0; for (int r = 0; r < 16; ++r) ps += p0[r]; for (int r = 0; r < 16; ++r) ps += p1[r];
    { auto rr = __builtin_amdgcn_permlane32_swap(__float_as_uint(ps), __float_as_uint(ps), false, false);
      ps = __uint_as_float(rr[0]) + __uint_as_float(rr[1]); }
    l_reg = l_reg * alpha + ps;
#define PK4(P, B_, OUT) do { unsigned a0 = cvtpk(P[B_+0], P[B_+1]), a1 = cvtpk(P[B_+2], P[B_+3]);                          \
        unsigned b0 = cvtpk(P[B_+4], P[B_+5]), b1 = cvtpk(P[B_+6], P[B_+7]);                                             \
        auto r0 = __builtin_amdgcn_permlane32_swap(a0, b0, false, false); auto r1 = __builtin_amdgcn_permlane32_swap(a1, b1, false, false); \
        u32x4 w = {r0[0], r1[0], r0[1], r1[1]}; OUT = *reinterpret_cast<bf16x8*>(&w); } while (0)
    PK4(p0, 0, pa0); PK4(p0, 8, pa1); PK4(p1, 0, pa2); PK4(p1, 8, pa3);
#undef PK4
}
template <int KB, bool SK>
__device__ __forceinline__ void qkt(f32x16& p0, f32x16& p1, const char* K_lds, int r32, int hi, const bf16x8* qr, bool act) {
    if (SK && !act) { const float NEG = -__builtin_inff();
#pragma unroll
        for (int r = 0; r < 16; ++r) { p0[r] = NEG; p1[r] = NEG; } return; }
    p0 = f32x16{}; p1 = f32x16{};
    const char* kb[4];
#pragma unroll
    for (int dd = 0; dd < 4; ++dd) kb[dd] = K_lds + KB * SHM_K + KSWZ(r32, (dd * 16 + hi * 8) * 2);
#pragma unroll
    for (int d0 = 0; d0 < 8; ++d0) { const char* a = kb[d0 & 3] + (d0 >> 2) * 128;
        bf16x8 b0 = *reinterpret_cast<const bf16x8*>(a);
        bf16x8 b1 = *reinterpret_cast<const bf16x8*>(a + 32 * 256);
        const bf16x8 qf = qr[d0];
        p0 = __builtin_amdgcn_mfma_f32_32x32x16_bf16(b0, qf, p0, 0, 0, 0);
        p1 = __builtin_amdgcn_mfma_f32_32x32x16_bf16(b1, qf, p1, 0, 0, 0); }
}
template <int VB, bool SK>
__device__ __forceinline__ void pv_tile(f32x16* o, int vb0, bf16x8 pa0, bf16x8 pa1, bf16x8 pa2, bf16x8 pa3, bool act) {
    if (SK && !act) return;
#define TRRD(dst, off) asm volatile("ds_read_b64_tr_b16 %0, %1 offset:%2" : "=&v"(dst) : "v"(vb0), "i"(off) : "memory")
#define PV_D0(d0) do { s16x4 l0, l1, l2, l3, h0, h1, h2, h3; constexpr int b_ = VB * SHM_V + v_rd_off(d0, 0, 0);     \
        TRRD(l0, b_); TRRD(h0, b_ + 2048); TRRD(l1, b_ + 4096); TRRD(h1, b_ + 6144); TRRD(l2, b_ + 8192); TRRD(h2, b_ + 10240); TRRD(l3, b_ + 12288); TRRD(h3, b_ + 14336); \
        asm volatile("s_waitcnt lgkmcnt(0)" ::: "memory"); SBAR();                 \
        o[d0] = __builtin_amdgcn_mfma_f32_32x32x16_bf16(pa0, (bf16x8){l0[0], l0[1], l0[2], l0[3], h0[0], h0[1], h0[2], h0[3]}, o[d0], 0, 0, 0);   \
        o[d0] = __builtin_amdgcn_mfma_f32_32x32x16_bf16(pa1, (bf16x8){l1[0], l1[1], l1[2], l1[3], h1[0], h1[1], h1[2], h1[3]}, o[d0], 0, 0, 0);   \
        o[d0] = __builtin_amdgcn_mfma_f32_32x32x16_bf16(pa2, (bf16x8){l2[0], l2[1], l2[2], l2[3], h2[0], h2[1], h2[2], h2[3]}, o[d0], 0, 0, 0);   \
        o[d0] = __builtin_amdgcn_mfma_f32_32x32x16_bf16(pa3, (bf16x8){l3[0], l3[1], l3[2], l3[3], h3[0], h3[1], h3[2], h3[3]}, o[d0], 0, 0, 0); } while (0)
    PV_D0(0); PV_D0(1); PV_D0(2); PV_D0(3);
#undef PV_D0
#undef TRRD
}

template <class TIn, class TOut> struct BlockRef { const TIn* Q; const TIn* K; const TIn* V; TOut* O; int P0; int ldo; const int* rows; const int* dst; float* stat; };
template <class TIn> struct Seam {
    bf16x8 qr[8];
    bf16x8 st_v0, st_v1, st_k0, st_k1; f32x4 sf0, sf1, sf2, sf3;
    f32x4 tq[16];
};
__device__ __forceinline__ int swa_jlo(int P0, int W) { const int lowk = P0 - W + 1; return lowk > 0 ? lowk / KVBLK : 0; }
#define ROW(p, k0, rr) ((p) + (unsigned)(((k0) + (rr)) * D + sc))
#define VMW() asm volatile("s_waitcnt vmcnt(0)" ::: "memory")
#define VMWN(n) asm volatile("s_waitcnt vmcnt(%0)" :: "i"(n) : "memory")
#define SLOAD_H(Kp, Vp, k0) do { S.st_v0 = load8<TIn>(ROW(Vp, k0, sr)); S.st_v1 = load8<TIn>(ROW(Vp, k0, 32 + sr));              \
                         S.st_k0 = load8<TIn>(ROW(Kp, k0, sr)); S.st_k1 = load8<TIn>(ROW(Kp, k0, 32 + sr)); } while (0)
#define SWRITE_HK(bf) do { *(bf16x8*)(K_lds + (bf) * SHM_K + kws) = S.st_k0; *(bf16x8*)(K_lds + (bf) * SHM_K + kws + 32 * 256) = S.st_k1; } while (0)
#define SWRITE_HV(bf) do { *(bf16x8*)(V_lds + (bf) * SHM_V + vst0) = S.st_v0; *(bf16x8*)(V_lds + (bf) * SHM_V + vst1) = S.st_v1; } while (0)
#define SWRITE_H(bf) do { SWRITE_HV(bf); SWRITE_HK(bf); } while (0)
#define SLOAD_F(p, k0) do { S.sf0 = *(const f32x4*)ROW(p, k0, sr); S.sf1 = *(const f32x4*)(ROW(p, k0, sr) + 4);                \
                            S.sf2 = *(const f32x4*)ROW(p, k0, 32 + sr); S.sf3 = *(const f32x4*)(ROW(p, k0, 32 + sr) + 4); } while (0)
#define SWRITE_KF(bf) do { *(bf16x8*)(K_lds + (bf) * SHM_K + kws) = pack8(S.sf0, S.sf1); *(bf16x8*)(K_lds + (bf) * SHM_K + kws + 32 * 256) = pack8(S.sf2, S.sf3); } while (0)
#define SWRITE_VF(bf) do { *(bf16x8*)(V_lds + (bf) * SHM_V + vst0) = pack8(S.sf0, S.sf1); *(bf16x8*)(V_lds + (bf) * SHM_V + vst1) = pack8(S.sf2, S.sf3); } while (0)
template <class TIn, class TOut>
__device__ __forceinline__ void causal_swa_prime(const BlockRef<TIn, TOut>& cur, int W, char* lds, Seam<TIn>& S) {
    constexpr bool F32 = same_t<TIn, float>::v;
    const int tid = threadIdx.x, wid = __builtin_amdgcn_readfirstlane(tid >> 6), lane = tid & 63, r32 = lane & 31, hi = lane >> 5;
    const int sr = tid >> 4, sc = (tid & 15) * 8, kws = KSWZ(sr, sc * 2); char* K_lds = lds + 2 * SHM_V;
    const int kb0 = swa_jlo(cur.P0, W) * KVBLK;
    for (int d0 = 0; d0 < 8; ++d0) S.qr[d0] = load8<TIn>(cur.Q + (size_t)(wid * QBLK + r32) * D + d0 * 16 + hi * 8);
    if constexpr (F32) { SLOAD_F((const float*)cur.K, kb0); VMW(); SWRITE_KF(0); SBAR(); SLOAD_F((const float*)cur.V, kb0); }
    else { SLOAD_H(cur.K, cur.V, kb0); VMW(); SWRITE_HK(0); }
    __syncthreads();
}
template <class TIn, class TOut>
__device__ __forceinline__ void causal_swa_block(const BlockRef<TIn, TOut>& cur, const BlockRef<TIn, TOut>& nxt, int skv, int W, char* lds, Seam<TIn>& S) {
    constexpr bool F32 = same_t<TIn, float>::v;
    const int tid = threadIdx.x, wid = __builtin_amdgcn_readfirstlane(tid >> 6), lane = tid & 63, r32 = lane & 31, hi = lane >> 5;
    const int j_lo = swa_jlo(cur.P0, W);
    int j_hi = (cur.P0 + QB - 1) / KVBLK + 1; if (j_hi > skv / KVBLK) j_hi = skv / KVBLK;
    const int NT = j_hi - j_lo;
    const int kbn = swa_jlo(nxt.P0, W) * KVBLK;
    const int qlo = cur.P0 + wid * QBLK, qm = qlo + r32 - 4 * hi;
    char* V_lds = lds; char* K_lds = lds + 2 * SHM_V;
    float* ws = (float*)(lds + 2 * SHM_V + 2 * SHM_K) + wid * 64; float* li_l = ws, * al_l = ws + 32;
    float m_reg = -1e30f, l_reg = 0; f32x16 o[4] = {};
    const int sr = tid >> 4, sc = (tid & 15) * 8, vst0 = v_st(sr, sc), vst1 = v_st(32 + sr, sc), kws = KSWZ(sr, sc * 2);
    const int vb0 = (int)(uintptr_t)V_lds + v_rd_base(lane);
    const TIn* Kh = cur.K; const TIn* Vh = cur.V;
#define RESC(a) do { if (__any((a) < 1.f)) { if (hi == 0) al_l[r32] = (a); asm volatile("s_waitcnt lgkmcnt(0)" ::: "memory");              \
                     for (int d_ = 0; d_ < 4; ++d_) for (int r = 0; r < 16; ++r) o[d_][r] *= al_l[crow(r, hi)]; } } while (0)
#define KBASE(t) ((j_lo + (t)) * KVBLK)
#define ACT(t) (KBASE(t) <= qlo + QBLK - 1 && KBASE(t) + KVBLK - 1 >= qlo - W + 1)
#define MASKT(P0_, P1_, t) do { const int kb_ = KBASE(t); if ((!SK || ACT(t)) && (kb_ + KVBLK - 1 > qlo || kb_ <= qlo + QBLK - 1 - W)) mask_tile(P0_, P1_, qm - kb_, (unsigned)W); } while (0)
    constexpr int NQL = F32 ? 16 : 8;
    constexpr bool SK = WSKIP && !F32;
#define SEAM_K0() do { VMWN(NQL); if constexpr (F32) { SWRITE_KF(0); SBAR(); SLOAD_F((const float*)nxt.V, kbn); } else { SWRITE_HK(0); } SBAR(); } while (0)
    f32x16 pA0, pA1, pB0, pB1; float mnA, mnB, alA, alB; bf16x8 pa0, pa1, pa2, pa3;
    if constexpr (F32) { VMW(); SWRITE_VF(0); SBAR(); } else { SWRITE_HV(0); SBAR(); }
    if (NT > 1) { if constexpr (F32) SLOAD_F((const float*)Kh, KBASE(1)); else SLOAD_H(Kh, Vh, KBASE(1)); }
    SBAR(); qkt<0, SK>(pA0, pA1, K_lds, r32, hi, S.qr, ACT(0));
    if constexpr (F32) { if (NT > 1) { VMW(); SWRITE_KF(1); SBAR(); SLOAD_F((const float*)Vh, KBASE(1)); } }
    MASKT(pA0, pA1, 0); partialSM(pA0, pA1, m_reg, mnA, alA);
    if (NT > 1) { VMW(); if constexpr (F32) { SWRITE_VF(1); SBAR(); if (NT > 2) SLOAD_F((const float*)Kh, KBASE(2)); } else SWRITE_H(1); }
    __syncthreads();
#define HALF_STEP(PX0, PX1, mnX, alX, PY0, PY1, alY, t, KB, VB, SB) do {                                                      \
        SBAR(); qkt<KB, SK>(PX0, PX1, K_lds, r32, hi, S.qr, ACT(t));                                             \
        finishSM(PY0, PY1, alY, l_reg, pa0, pa1, pa2, pa3); SBAR();                                                           \
        if ((t) + 1 < NT) { if constexpr (F32) { VMW(); SWRITE_KF(SB); SBAR(); SLOAD_F((const float*)Vh, KBASE((t) + 1)); }  \
                            else { SLOAD_H(Kh, Vh, KBASE((t) + 1)); } SBAR(); }                                               \
        pv_tile<VB, SK>(o, vb0, pa0, pa1, pa2, pa3, ACT((t) - 1)); MASKT(PX0, PX1, (t)); partialSM(PX0, PX1, m_reg, mnX, alX);                                        \
        __syncthreads();                                                                                                      \
        if ((t) + 1 < NT) { VMW(); if constexpr (F32) { SWRITE_VF(SB); SBAR(); if ((t) + 2 < NT) SLOAD_F((const float*)Kh, KBASE((t) + 2)); } \
                            else { SWRITE_H(SB); } }                                                                          \
        RESC(alX); __syncthreads(); } while (0)
    for (int t = 1; t + 1 < NT; t += 2) {
        HALF_STEP(pB0, pB1, mnB, alB, pA0, pA1, alA, t, 1, 0, 0);
        HALF_STEP(pA0, pA1, mnA, alA, pB0, pB1, alB, t + 1, 0, 1, 1);
    }
    const bool even = (NT & 1) == 0;
    if (even) { SBAR(); qkt<1, SK>(pB0, pB1, K_lds, r32, hi, S.qr, ACT(NT - 1)); SBAR(); }
#define QROW(e) (nxt.Q + (size_t)(wid * QBLK + r32) * D + ((e) >> 1) * 16 + hi * 8 + ((e) & 1) * 4)
    if constexpr (F32) { SLOAD_F((const float*)nxt.K, kbn); SBAR();
#pragma unroll
        for (int e = 0; e < 8; ++e) S.tq[e] = *(const f32x4*)QROW(e); }
    else { const size_t qrown_ = (size_t)(wid * QBLK + r32);
        SLOAD_H(nxt.K, nxt.V, kbn); SBAR();
#pragma unroll
        for (int d0 = 0; d0 < 8; ++d0) S.qr[d0] = load8<TIn>(nxt.Q + qrown_ * D + d0 * 16 + hi * 8); }
    SBAR();
    finishSM(pA0, pA1, alA, l_reg, pa0, pa1, pa2, pa3); SBAR();
    if constexpr (F32) {
#pragma unroll
        for (int e = 8; e < 16; ++e) S.tq[e] = *(const f32x4*)QROW(e); SBAR(); }
#undef QROW
    pv_tile<0, SK>(o, vb0, pa0, pa1, pa2, pa3, ACT(even ? NT - 2 : NT - 1));
    if (even) { MASKT(pB0, pB1, NT - 1); partialSM(pB0, pB1, m_reg, mnB, alB); __syncthreads(); RESC(alB);
        finishSM(pB0, pB1, alB, l_reg, pa0, pa1, pa2, pa3); SBAR(); pv_tile<1, SK>(o, vb0, pa0, pa1, pa2, pa3, ACT(NT - 1)); }
    SBAR(); SEAM_K0();
    if (hi == 0) li_l[r32] = l_reg; asm volatile("s_waitcnt lgkmcnt(0)" ::: "memory");
    float rli[16];
#pragma unroll
    for (int r = 0; r < 16; ++r) rli[r] = __builtin_amdgcn_rcpf(li_l[crow(r, hi)]);
    {
    int ld_ = cur.ldo; asm volatile("" : "+s"(ld_));
    TOut* Ow = cur.O + (size_t)(wid * QBLK) * ld_;
#pragma unroll
    for (int r = 0; r < 16; ++r) { const unsigned ro = (unsigned)crow(r, hi) * (unsigned)ld_ + (unsigned)r32;
#pragma unroll
        for (int d0 = 0; d0 < 4; ++d0) { const float v = o[d0][r] * rli[r];
            if constexpr (same_t<TOut, float>::v) { Ow[ro + d0 * 32] = v; }
            else { const float vn = __shfl_xor(v, 1);
                   if ((r32 & 1) == 0) *(unsigned*)(Ow + ro + d0 * 32) = cvtpk(v, vn); } } }
    }
    if constexpr (F32) {
#pragma unroll
        for (int d0 = 0; d0 < 8; ++d0) S.qr[d0] = pack8(S.tq[2 * d0], S.tq[2 * d0 + 1]); }
    __syncthreads();
#undef RESC
#undef KBASE
#undef ACT
#undef MASKT
#undef SEAM_K0
#undef HALF_STEP
}
#undef ROW
#undef VMW
#undef VMWN
#undef SLOAD_H
#undef SWRITE_HK
#undef SWRITE_HV
#undef SWRITE_H
#undef SLOAD_F
#undef SWRITE_KF
#undef SWRITE_VF


template <int KB>
__device__ __forceinline__ void qkt_r(f32x16& p0, f32x16& p1, const char* K_lds, int r32, int hi, const bf16x8* qr) {
    p0 = f32x16{}; p1 = f32x16{};
    const char* kb[4];
#pragma unroll
    for (int dd = 0; dd < 4; ++dd) kb[dd] = K_lds + KB * SHM_K + KSWZ(r32, (dd * 16 + hi * 8) * 2);
#pragma unroll
    for (int d0 = 0; d0 < 8; ++d0) { const char* a = kb[d0 & 3] + (d0 >> 2) * 128;
        bf16x8 b0 = *reinterpret_cast<const bf16x8*>(a);
        bf16x8 b1 = *reinterpret_cast<const bf16x8*>(a + 32 * 256);
        p0 = __builtin_amdgcn_mfma_f32_32x32x16_bf16(b0, qr[d0], p0, 0, 0, 0);
        p1 = __builtin_amdgcn_mfma_f32_32x32x16_bf16(b1, qr[d0], p1, 0, 0, 0); }
}
constexpr int MOBA_LDS_BYTES = 4 * SHM_V + 4 * SHM_K + NW * 64 * 4;
struct MobaStage { bf16x8 qr[8]; bf16x8 k0[2], k1[2], v0[2], v1[2]; };
#define MOBA_LOAD_Q(B) do { const unsigned qoff_ = (unsigned)(B).rows[wid * QBLK + r32] * D + hi * 8;                                  \
        _Pragma("unroll") for (int d0 = 0; d0 < 8; ++d0) ST.qr[d0] = load8<bf16>((B).Q + qoff_ + d0 * 16); } while (0)
#define MOBA_LOAD_KV(B, T0) do { _Pragma("unroll") for (int t = 0; t < 2; ++t) { const unsigned eo_ = (unsigned)(((T0) + t) * KVBLK + sr) * D + sc; \
        ST.k0[t] = load8<bf16>((B).K + eo_); ST.k1[t] = load8<bf16>((B).K + eo_ + 32 * D); ST.v0[t] = load8<bf16>((B).V + eo_); ST.v1[t] = load8<bf16>((B).V + eo_ + 32 * D); } } while (0)
#define MOBA_WRITE_KV(T0) do { _Pragma("unroll") for (int t = 0; t < 2; ++t) { *(bf16x8*)(K_lds + ((T0) + t) * SHM_K + kws) = ST.k0[t]; *(bf16x8*)(K_lds + ((T0) + t) * SHM_K + kws + 32 * 256) = ST.k1[t]; \
        *(bf16x8*)(V_lds + ((T0) + t) * SHM_V + vst0) = ST.v0[t]; *(bf16x8*)(V_lds + ((T0) + t) * SHM_V + vst1) = ST.v1[t]; } } while (0)
__device__ __forceinline__ void moba_block(const BlockRef<bf16, bf16>& cur, const BlockRef<bf16, bf16>& nxt, bool has_next, char* lds, MobaStage& ST) {
    const int tid = threadIdx.x, wid = __builtin_amdgcn_readfirstlane(tid >> 6), lane = tid & 63, r32 = lane & 31, hi = lane >> 5;
    char* V_lds = lds; char* K_lds = lds + 4 * SHM_V;
    float* wsc = (float*)(lds + 4 * SHM_V + 4 * SHM_K) + wid * 64; float* li_l = wsc, * al_l = wsc + 32;
    const int sr = tid >> 4, sc = (tid & 15) * 8, vst0 = v_st(sr, sc), vst1 = v_st(32 + sr, sc), kws = KSWZ(sr, sc * 2);
    const int vb0 = (int)(uintptr_t)V_lds + v_rd_base(lane);
    __syncthreads();
    MOBA_WRITE_KV(0);
    __syncthreads();
    MOBA_LOAD_KV(cur, 2);
    SBAR();
    float m_reg = -1e30f, l_reg = 0; f32x16 o[4] = {};
    const bool causal = cur.P0 == 0; const int qlo = wid * QBLK, qm = qlo + r32 - 4 * hi;
    f32x16 p0, p1; float mn, al; bf16x8 pa0, pa1, pa2, pa3;
#define RESCM(a) do { if (__any((a) < 1.f)) { if (hi == 0) al_l[r32] = (a); asm volatile("s_waitcnt lgkmcnt(0)" ::: "memory");              \
                      for (int d_ = 0; d_ < 4; ++d_) for (int r = 0; r < 16; ++r) o[d_][r] *= al_l[crow(r, hi)]; } } while (0)
#define SKIPT(t) (causal && (t) * KVBLK > qlo + QBLK - 1)
#define MTA(t) do { if (!SKIPT(t)) { SBAR(); qkt_r<t>(p0, p1, K_lds, r32, hi, ST.qr); if (causal && (t) * KVBLK + KVBLK - 1 > qlo) mask_tile(p0, p1, qm - (t) * KVBLK, 1u << 30); } } while (0)
#define MTB(t) do { if (!SKIPT(t)) { partialSM(p0, p1, m_reg, mn, al); RESCM(al); finishSM(p0, p1, al, l_reg, pa0, pa1, pa2, pa3); SBAR(); pv_tile<t, false>(o, vb0, pa0, pa1, pa2, pa3, true); } } while (0)
    MTA(0); MTB(0); MTA(1); MTB(1);
    SBAR();
    MOBA_WRITE_KV(2);
    __syncthreads();
    if (has_next) MOBA_LOAD_KV(nxt, 0);
    SBAR();
    MTA(2); MTB(2); MTA(3);
    SBAR();
    if (has_next) MOBA_LOAD_Q(nxt);
    SBAR();
    MTB(3);
#undef MTA
#undef MTB
#undef SKIPT
#undef RESCM
    if (hi == 0) li_l[r32] = l_reg; asm volatile("s_waitcnt lgkmcnt(0)" ::: "memory");
    float rli[16];
#pragma unroll
    for (int r = 0; r < 16; ++r) rli[r] = __builtin_amdgcn_rcpf(li_l[crow(r, hi)]);
    { const int dme_ = cur.dst[wid * QBLK + r32]; if (hi == 0 && dme_ >= 0) { float2 st_; st_.x = m_reg; st_.y = l_reg; *(float2*)(cur.stat + 2 * (size_t)dme_) = st_; } }
#pragma unroll
    for (int r = 0; r < 16; ++r) { const int di_ = cur.dst[wid * QBLK + crow(r, hi)];
#pragma unroll
        for (int d0 = 0; d0 < 4; ++d0) { const float v = o[d0][r] * rli[r]; const float vn = __shfl_xor(v, 1);
            if ((r32 & 1) == 0 && di_ >= 0) *(unsigned*)(cur.O + (size_t)di_ * 128 + d0 * 32 + r32) = cvtpk(v, vn); } }
}
__device__ __forceinline__ void moba_prime(const BlockRef<bf16, bf16>& cur, MobaStage& ST) {
    const int tid = threadIdx.x, wid = __builtin_amdgcn_readfirstlane(tid >> 6), lane = tid & 63, r32 = lane & 31, hi = lane >> 5;
    const int sr = tid >> 4, sc = (tid & 15) * 8;
    MOBA_LOAD_Q(cur); MOBA_LOAD_KV(cur, 0);
}
#undef MOBA_LOAD_Q
#undef MOBA_LOAD_KV
#undef MOBA_WRITE_KV
}
#include <hip/hip_cooperative_groups.h>
namespace cg = cooperative_groups;

constexpr int NWAVES = 8;
#ifndef MK_ONE_LAUNCH
#define MK_ONE_LAUNCH 1
#endif
constexpr int BATCH = 2, SEQ = 16384, T = BATCH * SEQ, DM = 2048, INW = 10240, DFF = 8192, PLE = 256;
constexpr int NH8 = 8;
constexpr float NORM_EPS = 1e-6f;
constexpr float LAMBDA_INIT = 0.2f;
constexpr int NPHASE = 19;

constexpr size_t MiB = 1u << 20;
constexpr size_t WS_ROPE = 1 * MiB;
constexpr size_t WS_KMEAN = 3 * MiB;
constexpr size_t WS_CNT = 0, WS_NBLK = 8192, WS_TAB = 65536;
constexpr size_t WS_BAR = 131072, WS_BAR_BYTES = 16384;
constexpr size_t WS_SEL = 4 * MiB;
constexpr int LSTR = 65536 + SEQ;
constexpr size_t WS_ROWL = 986 * MiB, WS_DSTL = 992 * MiB;
constexpr size_t WS_STATS = 1000 * MiB;
constexpr size_t WS_TOP = 1008 * MiB;
constexpr size_t WS_WIN = 8 * MiB, WS_WA = 48 * MiB, WS_WB = 52 * MiB, WS_WOUT = 56 * MiB, WS_WUP = 64 * MiB, WS_WDN = 96 * MiB, WS_WPG = 128 * MiB, WS_WPP = 136 * MiB;
constexpr size_t WS_PB = 138 * MiB;
constexpr size_t WS_XN = 154 * MiB;
constexpr size_t WS_OB = 154 * MiB;
constexpr size_t WS_QKV = 282 * MiB;
constexpr size_t SEC_ELEMS = (size_t)T * 1024;
constexpr size_t WS_SG = 666 * MiB;
constexpr size_t WS_OA = 922 * MiB;
constexpr size_t WS_MIX = 282 * MiB;
constexpr size_t WS_HID = 282 * MiB;
constexpr size_t WS_G3 = 282 * MiB;
constexpr size_t WS_XN3 = 410 * MiB;
constexpr size_t WS_Y = 794 * MiB;
constexpr size_t WS_END = 986 * MiB;
static_assert(WS_HID + (size_t)T * DFF * 2 <= WS_Y && WS_Y + (size_t)T * DM * 2 <= WS_OA && WS_OA + (size_t)T * 1024 * 2 == WS_END, "ws map");

constexpr int RING_BYTES = 131072, LDS_BYTES = 147456;

#define GAS __attribute__((address_space(1)))
#define LAS __attribute__((address_space(3)))
typedef unsigned short bf16;
typedef unsigned v4u __attribute__((ext_vector_type(4)));
typedef unsigned v2u __attribute__((ext_vector_type(2)));
typedef float f32x4 __attribute__((ext_vector_type(4)));
#define LDS_WAIT() asm volatile("s_waitcnt lgkmcnt(0)" ::: "memory")
__device__ __forceinline__ unsigned f2bf(float f) { unsigned u = __builtin_bit_cast(unsigned, f); return (u + 0x7fffu + ((u >> 16) & 1u)) >> 16; }
__device__ __forceinline__ unsigned pk2(float lo, float hi) { return f2bf(lo) | (f2bf(hi) << 16); }
__device__ __forceinline__ float bflo(unsigned w) { return __uint_as_float(w << 16); }
__device__ __forceinline__ float bfhi(unsigned w) { return __uint_as_float(w & 0xffff0000u); }
__device__ __forceinline__ float wave_sum(float v) {
#pragma unroll
    for (int o = 1; o < 64; o <<= 1) v += __shfl_xor(v, o);
    return v;
}
template <class Tv> __device__ __forceinline__ Tv ntload(const Tv* p) { return __builtin_nontemporal_load(p); }
template <class Tv> __device__ __forceinline__ void ntstore(Tv v, Tv* p) { __builtin_nontemporal_store(v, p); }
__device__ __forceinline__ float sigmoidf_(float x) { return __builtin_amdgcn_rcpf(1.0f + __expf(-x)); }

namespace pg8 {
template <int MODE> struct EpiT {
    static constexpr bool PERM = true, AFTER_DRAIN = false;
    bf16_t* O; int ldo; const bf16_t* G; int ldg;
    __device__ __forceinline__ void operator()(const f32x4 (&acc)[2][2][4][2], const Unit& u, int wr, int wc, int fr, int fq) const {
        const int row0 = u.pm * BM + wr * 64 + fr, col0 = u.pn * BM + wc * 32 + 8 * fq;
#pragma unroll
        for (int ai = 0; ai < 2; ++ai)
#pragma unroll
            for (int m = 0; m < 4; ++m) { const size_t r = (size_t)(row0 + ai * HALF + m * 16);
#pragma unroll
                for (int bj = 0; bj < 2; ++bj) { f32x4 v0 = acc[ai][bj][m][0], v1 = acc[ai][bj][m][1]; const int c = col0 + bj * HALF;
                    if (MODE == 1) {
#pragma unroll
                        for (int e = 0; e < 4; ++e) { float a = fmaxf(v0[e], 0.f), b = fmaxf(v1[e], 0.f); v0[e] = a * a; v1[e] = b * b; } }
                    if (MODE == 2) {
#pragma unroll
                        for (int e = 0; e < 4; ++e) { v0[e] = sigmoidf_(v0[e]); v1[e] = sigmoidf_(v1[e]); } }
                    if (MODE == 3 || MODE == 4) { const u32x4 g = *(const u32x4*)(G + r * ldg + c);
                        v0[0] *= bflo(g.x); v0[1] *= bfhi(g.x); v0[2] *= bflo(g.y); v0[3] *= bfhi(g.y); v1[0] *= bflo(g.z); v1[1] *= bfhi(g.z); v1[2] *= bflo(g.w); v1[3] *= bfhi(g.w); }
                    if (MODE == 4) { const u32x4 g = *(const u32x4*)(O + r * ldo + c);
                        v0[0] += bflo(g.x); v0[1] += bfhi(g.x); v0[2] += bflo(g.y); v0[3] += bfhi(g.y); v1[0] += bflo(g.z); v1[1] += bfhi(g.z); v1[2] += bflo(g.w); v1[3] += bfhi(g.w); }
                    u32x4 w; w.x = cvt_pk_bf16(v0[0], v0[1]); w.y = cvt_pk_bf16(v0[2], v0[3]); w.z = cvt_pk_bf16(v1[0], v1[1]); w.w = cvt_pk_bf16(v1[2], v1[3]);
                    *(u32x4*)(O + r * ldo + c) = w; } }
    }
};
struct EpiGate2 {
    static constexpr bool PERM = true, AFTER_DRAIN = false; static constexpr int MID_T = 16;
    bf16_t* O; const bf16_t* SGp;
    __device__ __forceinline__ void mid(f32x4 (&acc)[2][2][4][2], const Unit& u, int wr, int wc, int fr, int fq) const {
        int row0 = u.pm * BM + wr * 64 + fr; const int col0 = u.pn * BM + wc * 32 + 8 * fq;
        asm volatile("" : "+v"(row0));
        const bf16_t* gp = SGp + (size_t)row0 * 4096 + col0;
#pragma unroll
        for (int ai = 0; ai < 2; ++ai)
#pragma unroll
            for (int m = 0; m < 4; ++m) { const int ro = (ai * HALF + m * 16) * 4096;
#pragma unroll
                for (int bj = 0; bj < 2; ++bj) { const u32x4 a = *(const u32x4*)(gp + ro + bj * HALF), b = *(const u32x4*)(gp + ro + bj * HALF + 2048);
                    f32x4& v0 = acc[ai][bj][m][0]; f32x4& v1 = acc[ai][bj][m][1];
                    v0[0] *= bflo(a.x) * __builtin_amdgcn_rcpf(bflo(b.x)); v0[1] *= bfhi(a.x) * __builtin_amdgcn_rcpf(bfhi(b.x)); v0[2] *= bflo(a.y) * __builtin_amdgcn_rcpf(bflo(b.y)); v0[3] *= bfhi(a.y) * __builtin_amdgcn_rcpf(bfhi(b.y));
                    v1[0] *= bflo(a.z) * __builtin_amdgcn_rcpf(bflo(b.z)); v1[1] *= bfhi(a.z) * __builtin_amdgcn_rcpf(bfhi(b.z)); v1[2] *= bflo(a.w) * __builtin_amdgcn_rcpf(bflo(b.w)); v1[3] *= bfhi(a.w) * __builtin_amdgcn_rcpf(bfhi(b.w)); }
                if (m == 3) asm volatile("" ::: "memory"); }
    }
    __device__ __forceinline__ void operator()(const f32x4 (&acc)[2][2][4][2], const Unit& u, int wr, int wc, int fr, int fq) const {
        int row0 = u.pm * BM + wr * 64 + fr; const int col0 = u.pn * BM + wc * 32 + 8 * fq;
        asm volatile("" : "+v"(row0));
        const bf16_t* gp = SGp + (size_t)row0 * 4096 + 2048 + col0; bf16_t* op = O + (size_t)row0 * 2048 + col0;
#pragma unroll
        for (int ai = 0; ai < 2; ++ai)
#pragma unroll
            for (int m = 0; m < 4; ++m) { const int rr = ai * HALF + m * 16;
#pragma unroll
                for (int bj = 0; bj < 2; ++bj) { const u32x4 b = *(const u32x4*)(gp + rr * 4096 + bj * HALF); const f32x4 v0 = acc[ai][bj][m][0], v1 = acc[ai][bj][m][1];
                    u32x4 w; w.x = cvt_pk_bf16(v0[0] * bflo(b.x), v0[1] * bfhi(b.x)); w.y = cvt_pk_bf16(v0[2] * bflo(b.y), v0[3] * bfhi(b.y)); w.z = cvt_pk_bf16(v1[0] * bflo(b.z), v1[1] * bfhi(b.z)); w.w = cvt_pk_bf16(v1[2] * bflo(b.w), v1[3] * bfhi(b.w));
                    *(u32x4*)(op + rr * 2048 + bj * HALF) = w; } }
    }
};
struct EpiPle {
    static constexpr bool PERM = true, AFTER_DRAIN = false; static constexpr int MID_T = 32;
    bf16_t* O; bf16_t* Gp;
    __device__ __forceinline__ void mid(f32x4 (&acc)[2][2][4][2], const Unit& u, int wr, int wc, int fr, int fq) const {
        int row0 = u.pm * BM + wr * 64 + fr; const int col0 = u.pn * BM + wc * 32 + 8 * fq;
        asm volatile("" : "+v"(row0));
        bf16_t* gp = Gp + (size_t)row0 * 2048 + col0;
#pragma unroll
        for (int ai = 0; ai < 2; ++ai)
#pragma unroll
            for (int m = 0; m < 4; ++m) { const int rr = ai * HALF + m * 16;
#pragma unroll
                for (int bj = 0; bj < 2; ++bj) { f32x4& v0 = acc[ai][bj][m][0]; f32x4& v1 = acc[ai][bj][m][1];
                    u32x4 w; w.x = cvt_pk_bf16(sigmoidf_(v0[0]), sigmoidf_(v0[1])); w.y = cvt_pk_bf16(sigmoidf_(v0[2]), sigmoidf_(v0[3])); w.z = cvt_pk_bf16(sigmoidf_(v1[0]), sigmoidf_(v1[1])); w.w = cvt_pk_bf16(sigmoidf_(v1[2]), sigmoidf_(v1[3]));
                    *(u32x4*)(gp + rr * 2048 + bj * HALF) = w; v0 = (f32x4){0.f, 0.f, 0.f, 0.f}; v1 = (f32x4){0.f, 0.f, 0.f, 0.f}; } }
    }
    __device__ __forceinline__ void operator()(const f32x4 (&acc)[2][2][4][2], const Unit& u, int wr, int wc, int fr, int fq) const {
        int row0 = u.pm * BM + wr * 64 + fr; const int col0 = u.pn * BM + wc * 32 + 8 * fq;
        asm volatile("" : "+v"(row0));
        const bf16_t* gp = Gp + (size_t)row0 * 2048 + col0; bf16_t* op = O + (size_t)row0 * 2048 + col0;
#pragma unroll
        for (int ai = 0; ai < 2; ++ai)
#pragma unroll
            for (int m = 0; m < 4; ++m) { const int rr = ai * HALF + m * 16;
#pragma unroll
                for (int bj = 0; bj < 2; ++bj) { const u32x4 b = *(const u32x4*)(gp + rr * 2048 + bj * HALF); const f32x4 v0 = acc[ai][bj][m][0], v1 = acc[ai][bj][m][1];
                    u32x4 w; w.x = cvt_pk_bf16(v0[0] * bflo(b.x), v0[1] * bfhi(b.x)); w.y = cvt_pk_bf16(v0[2] * bflo(b.y), v0[3] * bfhi(b.y)); w.z = cvt_pk_bf16(v1[0] * bflo(b.z), v1[1] * bfhi(b.z)); w.w = cvt_pk_bf16(v1[2] * bflo(b.w), v1[3] * bfhi(b.w));
                    *(u32x4*)(op + rr * 2048 + bj * HALF) = w; } }
    }
};
struct EpiInProj {
    static constexpr bool PERM = false, AFTER_DRAIN = false;
    bf16_t* QKV; bf16_t* SG; const float* rope; float* km;
    __device__ __forceinline__ void operator()(const f32x4 (&acc)[2][2][4][2], const Unit& u, int wr, int wc, int fr, int fq) const {
        typedef unsigned u32x2 __attribute__((ext_vector_type(2)));
        const int pn = u.pn, row0 = u.pm * BM + wr * 64 + fr;
        if (pn < 24) {
            const int sec = pn >> 2; const bool rot = (sec != 2) && (sec != 5) && (wc == 0);
            const int b = (u.pm * BM) / SEQ;
            f32x4 ks[2][2] = {{(f32x4){0.f, 0.f, 0.f, 0.f}, (f32x4){0.f, 0.f, 0.f, 0.f}}, {(f32x4){0.f, 0.f, 0.f, 0.f}, (f32x4){0.f, 0.f, 0.f, 0.f}}};
#pragma unroll
            for (int ai = 0; ai < 2; ++ai)
#pragma unroll
                for (int m = 0; m < 4; ++m) { const int r = row0 + ai * HALF + m * 16, pos = r - b * SEQ;
                    f32x4 cs = (f32x4){1.f, 1.f, 1.f, 1.f}, sn = (f32x4){0.f, 0.f, 0.f, 0.f};
                    if (rot) { cs = *(const f32x4*)(rope + (size_t)pos * 32 + 4 * fq); sn = *(const f32x4*)(rope + (size_t)pos * 32 + 16 + 4 * fq); }
#pragma unroll
                    for (int bj = 0; bj < 2; ++bj) { const int h8 = (pn & 3) * 2 + bj; f32x4 v0 = acc[ai][bj][m][0], v1 = acc[ai][bj][m][1];
                        if (rot) { const f32x4 a = v0 * cs - v1 * sn, bb = v1 * cs + v0 * sn; v0 = a; v1 = bb; }
                        if (sec == 1) { ks[bj][0] += v0; ks[bj][1] += v1; }
                        bf16_t* dst = QKV + (size_t)sec * SEC_ELEMS + ((size_t)(b * NH8 + h8) * SEQ + pos) * 128 + wc * 32 + 4 * fq;
                        u32x2 w0, w1; w0.x = cvt_pk_bf16(v0[0], v0[1]); w0.y = cvt_pk_bf16(v0[2], v0[3]); w1.x = cvt_pk_bf16(v1[0], v1[1]); w1.y = cvt_pk_bf16(v1[2], v1[3]);
                        *(u32x2*)dst = w0; *(u32x2*)(dst + 16) = w1; } }
            if (sec == 1) {
                const int blk = u.pm - b * (SEQ / 256);
#pragma unroll
                for (int bj = 0; bj < 2; ++bj)
#pragma unroll
                    for (int n = 0; n < 2; ++n)
#pragma unroll
                        for (int e = 0; e < 4; ++e) { float v = ks[bj][n][e]; v += __shfl_xor(v, 1); v += __shfl_xor(v, 2); v += __shfl_xor(v, 4); v += __shfl_xor(v, 8);
                            if (fr == 0) atomicAdd(km + ((size_t)((b * NH8 + (pn & 3) * 2 + bj) * 64 + blk)) * 128 + wc * 32 + n * 16 + 4 * fq + e, v * (1.0f / 256.0f)); }
            }
        } else {
            const int col0 = (pn - 24) * BM + wc * 32 + 4 * fq;
#pragma unroll
            for (int ai = 0; ai < 2; ++ai)
#pragma unroll
                for (int m = 0; m < 4; ++m) { bf16_t* rowp = SG + (size_t)(row0 + ai * HALF + m * 16) * 4096 + col0;
#pragma unroll
                    for (int bj = 0; bj < 2; ++bj)
#pragma unroll
                        for (int n = 0; n < 2; ++n) { const f32x4 v = acc[ai][bj][m][n]; u32x2 w; w.x = cvt_pk_bf16(sigmoidf_(v[0]), sigmoidf_(v[1])); w.y = cvt_pk_bf16(sigmoidf_(v[2]), sigmoidf_(v[3]));
                            *(u32x2*)(rowp + bj * HALF + n * 16) = w; } }
        }
    }
};
}

#define XB_TMO      128
#define XB_XCNT(j)  (256  + 64 * (j))
#define XB_XSUB(j)  (1280 + 64 * (j))
#define XB_XGEN(j)  (2304 + 64 * (j))
#define XB_TOP      3328
#define XB_TOPGEN   3392
#define XCD_BAR_WORDS 3456
#define XB_SPIN_CAP (1u << 18)

__device__ __forceinline__ unsigned xb_ld(unsigned* p)              { return __hip_atomic_load(p, __ATOMIC_RELAXED, __HIP_MEMORY_SCOPE_AGENT); }
__device__ __forceinline__ unsigned xb_add(unsigned* p, unsigned v) { return __hip_atomic_fetch_add(p, v, __ATOMIC_RELAXED, __HIP_MEMORY_SCOPE_AGENT); }
__device__ __forceinline__ unsigned xb_xcc_id() { return (unsigned)__builtin_amdgcn_s_getreg((3 << 11) | 20) & 0xFu; }
#define XB_SPIN(cond, bar) do { unsigned _sp = 0; while (cond) { __builtin_amdgcn_s_sleep(1); \
    if ((++_sp & 255u) == 0u) { if (xb_ld(&(bar)[XB_TMO])) break; if (_sp > XB_SPIN_CAP) { atomicAdd(&(bar)[XB_TMO], 1u); break; } } } } while (0)

struct XcdBarrier {
    unsigned* bar; unsigned x;
    volatile LAS unsigned* st;
};

__device__ __forceinline__ XcdBarrier xcd_barrier_post(unsigned* bar, volatile LAS unsigned* st) {
    XcdBarrier b; b.bar = bar; b.x = xb_xcc_id(); b.st = st;
    if (threadIdx.x == 0) (void)xb_add(&bar[XB_XCNT(b.x)], 1u);
    return b;
}
__device__ __forceinline__ void xcd_barrier_complete(unsigned* bar, unsigned x, unsigned& nloc, unsigned& nx) {
    const unsigned G = gridDim.x * gridDim.y * gridDim.z;
    unsigned sum, cnt, mine, sp = 0u;
    for (;;) {
        sum = 0u; cnt = 0u; mine = 0u;
#pragma unroll
        for (unsigned j = 0; j < 16; ++j) { const unsigned c = xb_ld(&bar[XB_XCNT(j)]); sum += c; cnt += (c > 0u) ? 1u : 0u; mine = (j == x) ? c : mine; }
        if (sum == G) break;
        __builtin_amdgcn_s_sleep(1);
        if ((++sp & 255u) == 0u) { if (xb_ld(&bar[XB_TMO])) break; if (sp > XB_SPIN_CAP) { atomicAdd(&bar[XB_TMO], 1u); break; } }
    }
    nloc = mine > 0u ? mine : 1u; nx = cnt > 0u ? cnt : 1u;
}

__device__ __forceinline__ void xcd_barrier(const XcdBarrier& b) {
    asm volatile("s_waitcnt vmcnt(0)" ::: "memory");
    __syncthreads();
    if (threadIdx.x == 0) {
        unsigned* bar = b.bar;
        __builtin_amdgcn_s_waitcnt(0);
        unsigned nloc = b.st[0], nx = b.st[1];
        if (nloc == 0u) { xcd_barrier_complete(bar, b.x, nloc, nx); b.st[0] = nloc; b.st[1] = nx; }
        const unsigned old = xb_add(&bar[XB_XSUB(b.x)], 1u);
        const unsigned gen = old / nloc;
        if (old + 1u == (gen + 1u) * nloc) {
            __builtin_amdgcn_fence(__ATOMIC_RELEASE, "agent");
            asm volatile("s_waitcnt vmcnt(0)" ::: "memory");
            const unsigned og = xb_add(&bar[XB_TOP], 1u);
            const unsigned tg = og / nx;
            if (og + 1u == (tg + 1u) * nx) xb_add(&bar[XB_TOPGEN], 1u);
            else XB_SPIN(xb_ld(&bar[XB_TOPGEN]) == tg, bar);
            __builtin_amdgcn_fence(__ATOMIC_ACQUIRE, "agent");
            xb_add(&bar[XB_XGEN(b.x)], 1u);
            asm volatile("s_waitcnt vmcnt(0)" ::: "memory");
        } else {
            XB_SPIN(xb_ld(&bar[XB_XGEN(b.x)]) == gen, bar);
            __builtin_amdgcn_fence(__ATOMIC_ACQUIRE, "agent");
            asm volatile("s_waitcnt vmcnt(0)" ::: "memory");
        }
    }
    __syncthreads();
}

struct Args { const float* in[21]; float* out; unsigned char* ws; int ph_lo, ph_hi, coop, pad; };

__device__ __forceinline__ void p0_transpose_item(const float* W, int K, int N, bf16* WT, LAS float* scr, int item, int lane, int ldt = 0) {
    if (ldt == 0) ldt = K;
    const int nblk = N / 64, kb = item / nblk, nb = item % nblk, k0 = 64 * kb, n0 = 64 * nb;
    const int lr = lane >> 4, lc = (lane & 15) * 4;
    f32x4 v[16];
#pragma unroll
    for (int i = 0; i < 16; ++i) v[i] = ntload((const f32x4*)(W + (size_t)(k0 + 4 * i + lr) * N + n0 + lc));
#pragma unroll
    for (int i = 0; i < 16; ++i) { LAS float* d = scr + (4 * i + lr) * 65 + lc; d[0] = v[i].x; d[1] = v[i].y; d[2] = v[i].z; d[3] = v[i].w; }
    LDS_WAIT(); asm volatile("" ::: "memory");
    const int c = lane & 7;
#pragma unroll
    for (int j = 0; j < 8; ++j) { const int n = (lane >> 3) + 8 * j; const LAS float* sp = scr + (8 * c) * 65 + n;
        v4u o; o.x = pk2(sp[0 * 65], sp[1 * 65]); o.y = pk2(sp[2 * 65], sp[3 * 65]); o.z = pk2(sp[4 * 65], sp[5 * 65]); o.w = pk2(sp[6 * 65], sp[7 * 65]);
        *(GAS v4u*)(WT + (size_t)(n0 + n) * ldt + k0 + 8 * c) = o; }
    LDS_WAIT(); asm volatile("" ::: "memory");
}
__device__ __forceinline__ void rms_row_to_bf16(const float* xrow, const float* g, bf16* orow, int lane) {
    f32x4 v[8]; float s = 0.f;
#pragma unroll
    for (int j = 0; j < 4; ++j) { const float* p = xrow + j * 512 + lane * 8; v[2 * j] = ntload((const f32x4*)p); v[2 * j + 1] = ntload((const f32x4*)(p + 4)); }
#pragma unroll
    for (int j = 0; j < 8; ++j) s += (v[j].x * v[j].x + v[j].y * v[j].y) + (v[j].z * v[j].z + v[j].w * v[j].w);
    const float rstd = 1.0f / sqrtf(wave_sum(s) * (1.f / DM) + NORM_EPS);
#pragma unroll
    for (int j = 0; j < 4; ++j) { const float* gp = g + j * 512 + lane * 8; const f32x4 g0 = *(const f32x4*)gp, g1 = *(const f32x4*)(gp + 4); const f32x4 a = v[2 * j] * rstd * g0, b = v[2 * j + 1] * rstd * g1;
        v4u o; o.x = pk2(a.x, a.y); o.y = pk2(a.z, a.w); o.z = pk2(b.x, b.y); o.w = pk2(b.z, b.w); *(v4u*)(orow + j * 512 + lane * 8) = o; }
}
__device__ __forceinline__ void row_pass(const bf16* Y, const float* base, const float* gA, float* outh, const float* gB, bf16* xn, int gw, int NGW, int lane, int ldx = DM, const float* pin = nullptr) {
    for (int row0 = gw; row0 < T; row0 += 2 * NGW) {
        f32x4 h[2][8]; v4u yw[2][4];
#pragma unroll
        for (int k = 0; k < 2; ++k)
#pragma unroll
            for (int j = 0; j < 4; ++j) { const size_t off = (size_t)(row0 + k * NGW) * DM + j * 512 + lane * 8; yw[k][j] = ntload((const v4u*)(Y + off));
                h[k][2 * j] = ntload((const f32x4*)(base + off)); h[k][2 * j + 1] = ntload((const f32x4*)(base + off + 4)); }
#pragma unroll
        for (int k = 0; k < 2; ++k) { const int row = row0 + k * NGW;
            f32x4 y[8]; float s = 0.f;
#pragma unroll
            for (int j = 0; j < 4; ++j) { const v4u w = yw[k][j]; y[2 * j] = (f32x4){bflo(w.x), bfhi(w.x), bflo(w.y), bfhi(w.y)}; y[2 * j + 1] = (f32x4){bflo(w.z), bfhi(w.z), bflo(w.w), bfhi(w.w)}; }
#pragma unroll
            for (int j = 0; j < 8; ++j) s += (y[j].x * y[j].x + y[j].y * y[j].y) + (y[j].z * y[j].z + y[j].w * y[j].w);
            const float r1 = 1.0f / sqrtf(wave_sum(s) * (1.f / DM) + NORM_EPS); float s2 = 0.f;
#pragma unroll
            for (int j = 0; j < 4; ++j) { const int c = j * 512 + lane * 8; const f32x4 g0 = *(const f32x4*)(gA + c), g1 = *(const f32x4*)(gA + c + 4);
                h[k][2 * j] = h[k][2 * j] + y[2 * j] * r1 * g0; h[k][2 * j + 1] = h[k][2 * j + 1] + y[2 * j + 1] * r1 * g1;
                ntstore(h[k][2 * j], (f32x4*)(outh + (size_t)row * DM + c)); ntstore(h[k][2 * j + 1], (f32x4*)(outh + (size_t)row * DM + c + 4)); }
            if (xn) {
#pragma unroll
                for (int j = 0; j < 8; ++j) s2 += (h[k][j].x * h[k][j].x + h[k][j].y * h[k][j].y) + (h[k][j].z * h[k][j].z + h[k][j].w * h[k][j].w);
                const float r2 = 1.0f / sqrtf(wave_sum(s2) * (1.f / DM) + NORM_EPS);
#pragma unroll
                for (int j = 0; j < 4; ++j) { const int c = j * 512 + lane * 8; const f32x4 g0 = *(const f32x4*)(gB + c), g1 = *(const f32x4*)(gB + c + 4); const f32x4 a = h[k][2 * j] * r2 * g0, b = h[k][2 * j + 1] * r2 * g1;
                    v4u o; o.x = pk2(a.x, a.y); o.y = pk2(a.z, a.w); o.z = pk2(b.x, b.y); o.w = pk2(b.z, b.w); *(v4u*)(xn + (size_t)row * ldx + c) = o; }
                if (pin) { const f32x4 pv = *(const f32x4*)(pin + (size_t)row * PLE + lane * 4); v2u o; o.x = pk2(pv.x, pv.y); o.y = pk2(pv.z, pv.w); *(v2u*)(xn + (size_t)row * ldx + DM + lane * 4) = o; }
            }
        }
    }
}

typedef swa::BlockRef<swa::bf16, swa::bf16> ABlock;
__device__ __forceinline__ ABlock attn_ref(int head, int qb, unsigned char* ws, float* dout) {
    const swa::bf16* QKVs = (const swa::bf16*)(ws + WS_QKV); ABlock r;
    const int b = head >> 4, hd = (head >> 2) & 3, c = (head >> 1) & 1, j = head & 1; const int sh = b * NH8 + hd * 2 + c, vh = b * NH8 + hd * 2 + j;
    r.Q = QKVs + 3 * SEC_ELEMS + ((size_t)sh * SEQ + (size_t)qb * 256) * 128; r.K = QKVs + 4 * SEC_ELEMS + (size_t)sh * SEQ * 128; r.V = QKVs + 5 * SEC_ELEMS + (size_t)vh * SEQ * 128;
    r.O = (swa::bf16*)dout + ((size_t)b * SEQ + (size_t)qb * 256) * 4096 + hd * 512 + c * 256 + j * 128;
    r.ldo = 4096; r.rows = nullptr; r.dst = nullptr; r.stat = nullptr; r.P0 = qb * 256;
    return r;
}
constexpr int MOBA_PER = 320, MOBA_ITEMS = 16 * MOBA_PER;
__device__ __forceinline__ bool moba_valid(int L, const int* nblk) { const int bh = L / MOBA_PER, k = L - bh * MOBA_PER; return k >= 256 || k < nblk[bh]; }
__device__ __forceinline__ int moba_next(int L, int G, const int* nblk) { do { L += G; } while (L < MOBA_ITEMS && !moba_valid(L, nblk)); return L; }
__device__ __forceinline__ ABlock moba_ref(int L, unsigned char* ws, float* dout) {
    const swa::bf16* QKVs = (const swa::bf16*)(ws + WS_QKV); ABlock r;
    const int bh = L / MOBA_PER, k = L - bh * MOBA_PER; int j, lp, p0;
    if (k < 256) { const int2 t = ((const int2*)(ws + WS_TAB))[bh * 256 + k]; j = t.x; lp = t.y; p0 = 256; } else { j = k - 256; lp = 65536 + j * 256; p0 = 0; }
    r.Q = QKVs + (size_t)bh * SEQ * 128; r.K = QKVs + 1 * SEC_ELEMS + ((size_t)bh * SEQ + (size_t)j * 256) * 128; r.V = QKVs + 2 * SEC_ELEMS + ((size_t)bh * SEQ + (size_t)j * 256) * 128;
    r.O = (swa::bf16*)dout; r.ldo = 128; r.rows = (const int*)(ws + WS_ROWL) + (size_t)bh * LSTR + lp; r.dst = (const int*)(ws + WS_DSTL) + (size_t)bh * LSTR + lp; r.stat = (float*)(ws + WS_STATS); r.P0 = p0;
    return r;
}

__global__ void __launch_bounds__(NWAVES * 64, 2) mk_fwd(Args args) {
    extern __shared__ __attribute__((aligned(16))) unsigned char lds[];
    LAS unsigned char* L = (LAS unsigned char*)lds;
    const int tid = threadIdx.x, lane = tid & 63, wave = __builtin_amdgcn_readfirstlane(tid >> 6);
    const int G = gridDim.x, bx = blockIdx.x;
    const int vcu = (G % 8 == 0) ? (bx % 8) * (G / 8) + bx / 8 : bx;
    const int gw = vcu * NWAVES + wave, NGW = G * NWAVES;
    unsigned char* ws = args.ws;
#define x_in (args.in[0])
#define p_in (args.in[1])
#define Win_t ((bf16*)(ws + WS_WIN))
#define Wa_t ((bf16*)(ws + WS_WA))
#define Wb_t ((bf16*)(ws + WS_WB))
#define Wout_t ((bf16*)(ws + WS_WOUT))
#define Wup_t ((bf16*)(ws + WS_WUP))
#define Wdn_t ((bf16*)(ws + WS_WDN))
#define Wpg_t ((bf16*)(ws + WS_WPG))
#define Wpp_t ((bf16*)(ws + WS_WPP))
#define XN ((bf16*)(ws + WS_XN))
#define PB ((bf16*)(ws + WS_PB))
#define QKV ((bf16*)(ws + WS_QKV))
#define SG ((bf16*)(ws + WS_SG))
#define OAB ((bf16*)(ws + WS_XN))
#define MIX ((bf16*)(ws + WS_MIX))
#define HID ((bf16*)(ws + WS_HID))
#define G3 ((bf16*)(ws + WS_G3))
#define Y ((bf16*)(ws + WS_Y))
#define rope ((float*)(ws + WS_ROPE))
#define kmean ((float*)(ws + WS_KMEAN))
#define out (args.out)
    const int lo = args.ph_lo, hi = args.ph_hi;
#define IN(k) (lo <= (k) && (k) < hi)
#define SEAM(k) do { if (IN(k) && IN((k) + 1)) { if (args.coop) { if ((k) == 0) { asm volatile("s_waitcnt vmcnt(0) lgkmcnt(0)" ::: "memory"); cg::this_grid().sync(); } else { xcd_barrier(xbar); } } } } while (0)
    volatile LAS unsigned* bst = (volatile LAS unsigned*)(L + LDS_BYTES - 64);
    if (tid < 2) bst[tid] = 0u;
    __syncthreads();
    XcdBarrier xbar; xbar.bar = (unsigned*)(ws + WS_BAR); xbar.x = 0; xbar.st = bst;
    if (args.coop) xbar = xcd_barrier_post((unsigned*)(ws + WS_BAR), bst);

    if (IN(0)) {
        LAS float* scr = (LAS float*)(L + wave * 16896);
        constexpr int I_IN = (DM / 64) * (INW / 64), I_BR = (1024 / 64) * (DM / 64), I_OUT = (DM / 64) * (DM / 64), I_UP = (DM / 64) * (DFF / 64), I_DN = (DFF / 64) * (DM / 64), I_PP = (PLE / 64) * (DM / 64);
        constexpr int NITEMS = I_IN + 2 * I_BR + I_OUT + I_UP + I_DN + I_OUT + I_PP;
        for (int it = gw; it < NITEMS; it += NGW) {
            int r = it;
            if (r < I_IN) { p0_transpose_item(args.in[2], DM, INW, Win_t, scr, r, lane); continue; } r -= I_IN;
            if (r < I_BR) { p0_transpose_item(args.in[3], 1024, DM, Wa_t, scr, r, lane, 2048); continue; } r -= I_BR;
            if (r < I_BR) { p0_transpose_item(args.in[4], 1024, DM, Wa_t + 1024, scr, r, lane, 2048); continue; } r -= I_BR;
            if (r < I_OUT) { p0_transpose_item(args.in[5], DM, DM, Wout_t, scr, r, lane); continue; } r -= I_OUT;
            if (r < I_UP) { p0_transpose_item(args.in[13], DM, DFF, Wup_t, scr, r, lane); continue; } r -= I_UP;
            if (r < I_DN) { p0_transpose_item(args.in[14], DFF, DM, Wdn_t, scr, r, lane); continue; } r -= I_DN;
            if (r < I_OUT) { p0_transpose_item(args.in[18], DM, DM, Wpg_t, scr, r, lane, DM + PLE); continue; } r -= I_OUT;
            p0_transpose_item(args.in[17], PLE, DM, Wpg_t + DM, scr, r, lane, DM + PLE);
        }
        for (int m = gw; m < T; m += NGW) rms_row_to_bf16(x_in + (size_t)m * DM, args.in[11], XN + (size_t)m * DM, lane);
        if (bx == 0) { for (int i = tid; i < 16 * 64 + 16; i += 512) { if (i < 1024) ((int*)(ws + WS_CNT))[i] = 0; else ((int*)(ws + WS_NBLK))[i - 1024] = 0; } }
        for (int i = bx * 512 + tid; i < 16 * 64 * 128; i += G * 512) kmean[i] = 0.f;
        for (int i = bx * 512 + tid; i < SEQ * 16; i += G * 512) { const int pos = i >> 4, k = i & 15;
            double fr_ = 1.0; for (int j_ = 0; j_ < k; ++j_) fr_ *= 0.4403666026717805;
            const float angf = (float)pos * (float)fr_; const double a = (double)angf;
            const double TWO_PI = 6.283185307179586476925286766559; double q = __builtin_rint(a / TWO_PI); double r = a - q * TWO_PI;
            const double r2 = r * r; double sn = 1.0, cs = 1.0;
            sn = 1.0 - r2 / (22.0 * 23.0); sn = 1.0 - r2 / (20.0 * 21.0) * sn; sn = 1.0 - r2 / (18.0 * 19.0) * sn; sn = 1.0 - r2 / (16.0 * 17.0) * sn; sn = 1.0 - r2 / (14.0 * 15.0) * sn; sn = 1.0 - r2 / (12.0 * 13.0) * sn;
            sn = 1.0 - r2 / (10.0 * 11.0) * sn; sn = 1.0 - r2 / (8.0 * 9.0) * sn; sn = 1.0 - r2 / (6.0 * 7.0) * sn; sn = 1.0 - r2 / (4.0 * 5.0) * sn; sn = 1.0 - r2 / (2.0 * 3.0) * sn; sn = r * sn;
            cs = 1.0 - r2 / (21.0 * 22.0); cs = 1.0 - r2 / (19.0 * 20.0) * cs; cs = 1.0 - r2 / (17.0 * 18.0) * cs; cs = 1.0 - r2 / (15.0 * 16.0) * cs; cs = 1.0 - r2 / (13.0 * 14.0) * cs; cs = 1.0 - r2 / (11.0 * 12.0) * cs;
            cs = 1.0 - r2 / (9.0 * 10.0) * cs; cs = 1.0 - r2 / (7.0 * 8.0) * cs; cs = 1.0 - r2 / (5.0 * 6.0) * cs; cs = 1.0 - r2 / (3.0 * 4.0) * cs; cs = 1.0 - r2 / (1.0 * 2.0) * cs;
            rope[(size_t)pos * 32 + k] = (float)cs; rope[(size_t)pos * 32 + 16 + k] = (float)sn; }
    }
    SEAM(0);
    if (IN(1)) {
        pg8::Gemm g{XN, Win_t, T, INW, DM}; pg8::StaticOrder S; S.init(T, INW, G, bx);
        pg8::EpiInProj E{QKV, SG, (const float*)rope, kmean};
        pg8::gemm_phase<pg8::EpiInProj, pg8::StaticOrder, true, true>(L, g, S, E);
    }
    SEAM(1);
    if (IN(3)) {
        char* Kl = (char*)lds;
        const int lane_ = tid & 63, r32 = lane_ & 31, hi = lane_ >> 5;
        const int sr = tid >> 4, sc = (tid & 15) * 8, kws = KSWZ(sr, sc * 2);
        int bh_loaded = -1;
        for (int u = vcu; u < 16 * 64; u += G) {
            const int bh = u & 15, qb = u >> 4;
            if (bh != bh_loaded) {
                __syncthreads();
#pragma unroll
                for (int h2 = 0; h2 < 2; ++h2) { const float* kp = kmean + ((size_t)bh * 64 + sr + 32 * h2) * 128 + sc; const f32x4 a = *(const f32x4*)kp, b = *(const f32x4*)(kp + 4);
                    const float v[8] = {a.x, a.y, a.z, a.w, b.x, b.y, b.z, b.w}; unsigned hb[8], lb[8];
#pragma unroll
                    for (int e = 0; e < 8; ++e) { hb[e] = f2bf(v[e]); lb[e] = f2bf(v[e] - __uint_as_float(hb[e] << 16)); }
                    v4u wh, wl; wh.x = hb[0] | (hb[1] << 16); wh.y = hb[2] | (hb[3] << 16); wh.z = hb[4] | (hb[5] << 16); wh.w = hb[6] | (hb[7] << 16);
                    wl.x = lb[0] | (lb[1] << 16); wl.y = lb[2] | (lb[3] << 16); wl.z = lb[4] | (lb[5] << 16); wl.w = lb[6] | (lb[7] << 16);
                    *(v4u*)(Kl + kws + h2 * 32 * 256) = wh; *(v4u*)(Kl + swa::SHM_K + kws + h2 * 32 * 256) = wl; }
                __syncthreads();
                bh_loaded = bh;
            }
            const int row = wave * 32 + r32;
            swa::bf16x8 qr[8];
            { const swa::bf16* qp = (const swa::bf16*)QKV + ((size_t)bh * SEQ + (size_t)qb * 256 + row) * 128 + hi * 8;
#pragma unroll
              for (int d0 = 0; d0 < 8; ++d0) qr[d0] = swa::load8<swa::bf16>(qp + d0 * 16); }
            swa::f32x16 ph0, ph1, pl0, pl1;
            swa::qkt_r<0>(ph0, ph1, Kl, r32, hi, qr); swa::qkt_r<1>(pl0, pl1, Kl, r32, hi, qr);
            float g0 = -__builtin_inff(), g1 = g0, g2 = g0; int i0 = -1, i1 = -1, i2 = -1;
#define INS3(gv, iv) do { const float g_ = (gv); const int i_ = (iv); if (g_ > g0) { g2 = g1; i2 = i1; g1 = g0; i1 = i0; g0 = g_; i0 = i_; } else if (g_ > g1) { g2 = g1; i2 = i1; g1 = g_; i1 = i_; } else if (g_ > g2) { g2 = g_; i2 = i_; } } while (0)
#pragma unroll
            for (int r = 0; r < 16; ++r) { const int n = swa::crow(r, hi); if (n < qb) INS3(ph0[r] + pl0[r], n); }
#pragma unroll
            for (int r = 0; r < 16; ++r) { const int n = 32 + swa::crow(r, hi); if (n < qb) INS3(ph1[r] + pl1[r], n); }
            { const float pg0 = __shfl_xor(g0, 32), pg1 = __shfl_xor(g1, 32), pg2 = __shfl_xor(g2, 32); const int pi0 = __shfl_xor(i0, 32), pi1 = __shfl_xor(i1, 32), pi2 = __shfl_xor(i2, 32);
              INS3(pg0, pi0); INS3(pg1, pi1); INS3(pg2, pi2); }
#undef INS3
            if (hi == 0) {
                const int grow = qb * 256 + row; int s0 = -1, s1 = -1, s2 = -1; int* cnt = (int*)(ws + WS_CNT) + bh * 64; float2* stt = (float2*)(ws + WS_STATS);
                float2 none; none.x = -1e30f; none.y = 0.f;
                if (i0 >= 0) s0 = atomicAdd(cnt + i0, 1); else stt[(size_t)(bh * 4 + 0) * SEQ + grow] = none;
                if (i1 >= 0) s1 = atomicAdd(cnt + i1, 1); else stt[(size_t)(bh * 4 + 1) * SEQ + grow] = none;
                if (i2 >= 0) s2 = atomicAdd(cnt + i2, 1); else stt[(size_t)(bh * 4 + 2) * SEQ + grow] = none;
                int4 rec; rec.x = (i0 & 255) | ((i1 & 255) << 8) | ((i2 & 255) << 16); rec.y = s0; rec.z = s1; rec.w = s2;
                ((int4*)(ws + WS_SEL))[(size_t)bh * SEQ + grow] = rec; }
        }
        __syncthreads();
    }
    SEAM(3);
    if (IN(4)) {
        LAS int* cn = (LAS int*)L; LAS int* offs = cn + 64;
        int* ROWL = (int*)(ws + WS_ROWL); int* DSTL = (int*)(ws + WS_DSTL);
        for (int u = vcu; u < 16 * 64; u += G) {
            const int bh = u & 15, chunk = u >> 4;
            __syncthreads();
            if (tid < 64) cn[tid] = ((const int*)(ws + WS_CNT))[bh * 64 + tid];
            __syncthreads();
            if (tid == 0) { int a = 0; for (int j = 0; j < 64; ++j) { offs[j] = a; a += (cn[j] + 255) & ~255; } offs[64] = a; }
            __syncthreads();
            int* rl = ROWL + (size_t)bh * LSTR; int* dl = DSTL + (size_t)bh * LSTR;
            if (tid < 256) { const int row = chunk * 256 + tid; const int4 rec = ((const int4*)(ws + WS_SEL))[(size_t)bh * SEQ + row];
                const int j0 = rec.x & 255, j1 = (rec.x >> 8) & 255, j2 = (rec.x >> 16) & 255;
                if (j0 != 255) { const int gp = offs[j0] + rec.y; rl[gp] = row; dl[gp] = (bh * 4 + 0) * SEQ + row; }
                if (j1 != 255) { const int gp = offs[j1] + rec.z; rl[gp] = row; dl[gp] = (bh * 4 + 1) * SEQ + row; }
                if (j2 != 255) { const int gp = offs[j2] + rec.w; rl[gp] = row; dl[gp] = (bh * 4 + 2) * SEQ + row; }
                rl[65536 + row] = row; dl[65536 + row] = (bh * 4 + 3) * SEQ + row; }
            if (chunk == 0) {
                for (int idx = tid; idx < 64 * 256; idx += 512) { const int j = idx >> 8, c = cn[j], pos = c + (idx & 255);
                    if (pos < ((c + 255) & ~255)) { rl[offs[j] + pos] = 0; dl[offs[j] + pos] = -1; } }
                if (tid == 0) { int k = 0; int2* tab = (int2*)(ws + WS_TAB) + bh * 256;
                    for (int j = 0; j < 64; ++j) { const int nb = (cn[j] + 255) >> 8; for (int b_ = 0; b_ < nb; ++b_) { if (k < 256) { int2 t; t.x = j; t.y = offs[j] + 256 * b_; tab[k] = t; } ++k; } }
                    ((int*)(ws + WS_NBLK))[bh] = k < 256 ? k : 256; }
            }
        }
        __syncthreads();
    }
    SEAM(4);
    if (IN(5)) {
        const int* nblk = (const int*)(ws + WS_NBLK);
        static_assert(swa::MOBA_LDS_BYTES <= LDS_BYTES - 64, "MoBA short-block LDS");
        int Lc = vcu; if (!moba_valid(Lc, nblk)) Lc = moba_next(Lc, G, nblk);
        if (Lc < MOBA_ITEMS) {
            ABlock cur = moba_ref(Lc, ws, out); swa::MobaStage ST; swa::moba_prime(cur, ST);
            for (;;) { const int Ln = moba_next(Lc, G, nblk); const bool has_next = Ln < MOBA_ITEMS;
                ABlock nxt = cur; if (has_next) nxt = moba_ref(Ln, ws, out);
                swa::moba_block(cur, nxt, has_next, (char*)lds, ST);
                if (!has_next) break;
                cur = nxt; Lc = Ln; }
        }
        __syncthreads();
    }
    SEAM(5);
    if (IN(6)) {
        const float2* stt = (const float2*)(ws + WS_STATS); const bf16* PART = (const bf16*)out; constexpr float C2 = 1.4426950408889634f * 0.08838834764831845f;
        for (int u0 = gw; u0 < 16 * SEQ; u0 += 4 * NGW) {
            float2 st[4][4]; unsigned pw[4][4];
#pragma unroll
            for (int k = 0; k < 4; ++k) { const int u = u0 + k * NGW, bh = u >> 14, row = u & (SEQ - 1);
#pragma unroll
                for (int s_ = 0; s_ < 4; ++s_) { const size_t di = (size_t)(bh * 4 + s_) * SEQ + row; st[k][s_] = stt[di]; pw[k][s_] = ntload((const unsigned*)(PART + di * 128 + lane * 2)); } }
#pragma unroll
            for (int k = 0; k < 4; ++k) { const int u = u0 + k * NGW, bh = u >> 14, row = u & (SEQ - 1);
                float M = -1e30f;
#pragma unroll
                for (int s_ = 0; s_ < 4; ++s_) if (st[k][s_].y > 0.f) M = fmaxf(M, st[k][s_].x);
                float a0 = 0.f, a1 = 0.f, den = 0.f;
#pragma unroll
                for (int s_ = 0; s_ < 4; ++s_) { const bool ok = st[k][s_].y > 0.f; const float w = ok ? st[k][s_].y * __builtin_amdgcn_exp2f((st[k][s_].x - M) * C2) : 0.f;
                    a0 += ok ? w * bflo(pw[k][s_]) : 0.f; a1 += ok ? w * bfhi(pw[k][s_]) : 0.f; den += w; }
                const float inv = 1.0f / den;
                *(unsigned*)(OAB + ((size_t)(bh >> 3) * SEQ + row) * 2048 + (bh & 7) * 128 + lane * 2) = pk2(a0 * inv, a1 * inv); } }
    }
    SEAM(6);
    if (IN(7)) {
        constexpr int NITEM = 32 * 32;
        int Lc = vcu;
        if (Lc < NITEM) {
            int head = Lc >> 5, xx = Lc & 31, pass = 0;
            ABlock cur = attn_ref(head, xx, ws, out);
            swa::Seam<swa::bf16> S;
            swa::causal_swa_prime<swa::bf16, swa::bf16>(cur, SEQ, (char*)lds, S);
            for (;;) {
                const bool more_pass = pass == 0, more_item = Lc + G < NITEM, last = !more_pass && !more_item;
                int headn = head, xn = xx, passn = pass + 1, Ln = Lc;
                if (!more_pass) { passn = 0; Ln = more_item ? Lc + G : Lc; headn = Ln >> 5; xn = Ln & 31; }
                const int qbn = passn ? 63 - xn : xn;
                ABlock nxt = cur;
                if (!last) nxt = attn_ref(headn, qbn, ws, out);
                swa::causal_swa_block<swa::bf16, swa::bf16>(cur, nxt, SEQ, SEQ, (char*)lds, S);
                if (last) break;
                cur = nxt; head = headn; xx = xn; pass = passn; Lc = Ln;
            }
        }
        __syncthreads();
    }
    SEAM(7);
    if (IN(8)) {
        float lam;
        { const float* q1 = args.in[6]; const float* k1 = args.in[7]; const float* q2 = args.in[8]; const float* k2 = args.in[9];
          const float s1 = wave_sum(q1[lane] * k1[lane] + q1[lane + 64] * k1[lane + 64]), s2 = wave_sum(q2[lane] * k2[lane] + q2[lane + 64] * k2[lane + 64]);
          lam = __expf(s1) - __expf(s2) + LAMBDA_INIT; }
        const bf16* AD = (const bf16*)out; const float* sg = args.in[10];
        const f32x4 gg = *(const f32x4*)(sg + lane * 4);
        for (int u0 = gw; u0 < T * 4; u0 += 4 * NGW) {
            v2u w0[4], w1[4];
#pragma unroll
            for (int k = 0; k < 4; ++k) { const int u = u0 + k * NGW, t = u >> 2, hd = u & 3; const bf16* a = AD + (size_t)t * 4096 + hd * 512 + lane * 4; w0[k] = ntload((const v2u*)a); w1[k] = ntload((const v2u*)(a + 256)); }
#pragma unroll
            for (int k = 0; k < 4; ++k) { const int u = u0 + k * NGW, t = u >> 2, hd = u & 3;
                f32x4 d; d.x = bflo(w0[k].x) - lam * bflo(w1[k].x); d.y = bfhi(w0[k].x) - lam * bfhi(w1[k].x); d.z = bflo(w0[k].y) - lam * bflo(w1[k].y); d.w = bfhi(w0[k].y) - lam * bfhi(w1[k].y);
                const float ss = wave_sum((d.x * d.x + d.y * d.y) + (d.z * d.z + d.w * d.w));
                const float r = (1.0f - LAMBDA_INIT) / sqrtf(ss * (1.f / 256.f) + NORM_EPS);
                v2u o; o.x = pk2(d.x * r * gg.x, d.y * r * gg.y); o.y = pk2(d.z * r * gg.z, d.w * r * gg.w);
                *(v2u*)(OAB + (size_t)t * 2048 + 1024 + hd * 256 + lane * 4) = o; } }
    }
    SEAM(8);
    if (IN(9)) { pg8::Gemm g{OAB, Wa_t, T, DM, 2048}; pg8::StaticOrder S; S.init(T, DM, G, bx); pg8::EpiGate2 E{MIX, SG};
        pg8::gemm_phase<pg8::EpiGate2, pg8::StaticOrder, true, true, true>(L, g, S, E); }
    SEAM(9);
    if (IN(11)) { pg8::Gemm g{MIX, Wout_t, T, DM, DM}; pg8::StaticOrder S; S.init(T, DM, G, bx); pg8::EpiT<0> E{Y, DM, nullptr, 0};
        pg8::gemm_phase<pg8::EpiT<0>, pg8::StaticOrder, true, true>(L, g, S, E); }
    SEAM(11);
    if (IN(12)) row_pass(Y, x_in, args.in[12], out, args.in[15], XN, gw, NGW, lane);
    SEAM(12);
    if (IN(13)) { pg8::Gemm g{XN, Wup_t, T, DFF, DM}; pg8::StaticOrder S; S.init(T, DFF, G, bx); pg8::EpiT<1> E{HID, DFF, nullptr, 0};
        pg8::gemm_phase<pg8::EpiT<1>, pg8::StaticOrder, true, true>(L, g, S, E); }
    SEAM(13);
    if (IN(14)) { pg8::Gemm g{HID, Wdn_t, T, DM, DFF}; pg8::StaticOrder S; S.init(T, DM, G, bx); pg8::EpiT<0> E{Y, DM, nullptr, 0};
        pg8::gemm_phase<pg8::EpiT<0>, pg8::StaticOrder, true, true>(L, g, S, E); }
    SEAM(14);
    if (IN(15)) row_pass(Y, out, args.in[16], out, args.in[19], (bf16*)(ws + WS_XN3), gw, NGW, lane, DM + PLE, p_in);
    SEAM(15);
    if (IN(16)) { pg8::Gemm g{(bf16*)(ws + WS_XN3), Wpg_t, T, DM, DM + PLE}; pg8::StaticOrder S; S.init(T, DM, G, bx); pg8::EpiPle E{Y, G3};
        pg8::gemm_phase<pg8::EpiPle, pg8::StaticOrder, true, true, true>(L, g, S, E); }
    SEAM(17);
    if (IN(18)) row_pass(Y, out, args.in[20], out, nullptr, nullptr, gw, NGW, lane);
#undef IN
#undef SEAM
#undef x_in
#undef p_in
#undef Win_t
#undef Wa_t
#undef Wb_t
#undef Wout_t
#undef Wup_t
#undef Wdn_t
#undef Wpg_t
#undef Wpp_t
#undef XN
#undef PB
#undef QKV
#undef SG
#undef OAB
#undef MIX
#undef HID
#undef G3
#undef Y
#undef rope
#undef kmean
#undef out
}

extern "C" void kernel_launch(void* const* d_in, const int* in_sizes, int n_in, void* d_out, int out_size, void* d_ws, size_t ws_size, hipStream_t stream) {
    static int grid = 0;
    if (grid == 0) {
        if (n_in != 21 || out_size != T * DM || ws_size < WS_TOP) { fprintf(stderr, "kernel_launch: unexpected shapes n_in %d out %d ws %zu\n", n_in, out_size, ws_size); grid = -1; return; }
        int dev = 0, cus = 0, per_cu = 0;
        (void)hipGetDevice(&dev); (void)hipDeviceGetAttribute(&cus, hipDeviceAttributeMultiprocessorCount, dev);
        if (hipFuncSetAttribute((const void*)mk_fwd, hipFuncAttributeMaxDynamicSharedMemorySize, LDS_BYTES) != hipSuccess) { fprintf(stderr, "kernel_launch: hipFuncSetAttribute failed\n"); grid = -1; return; }
        if (hipOccupancyMaxActiveBlocksPerMultiprocessor(&per_cu, (const void*)mk_fwd, NWAVES * 64, LDS_BYTES) != hipSuccess || per_cu < 1) { fprintf(stderr, "kernel_launch: occupancy query says %d\n", per_cu); per_cu = 1; }
        (void)hipGetLastError();
        grid = cus * 1;
        if (grid <= 0) grid = 256;
    }
    if (grid < 0) return;
    (void)hipMemsetAsync((unsigned char*)d_ws + WS_BAR, 0, WS_BAR_BYTES, stream);
    Args a{};
    for (int i = 0; i < 21; ++i) a.in[i] = (const float*)d_in[i];
    a.out = (float*)d_out; a.ws = (unsigned char*)d_ws;
#if MK_ONE_LAUNCH
    a.ph_lo = 0; a.ph_hi = NPHASE; a.coop = 1;
    void* kargs[] = {&a};
    hipError_t e = hipLaunchCooperativeKernel((const void*)mk_fwd, dim3(grid), dim3(NWAVES * 64), kargs, LDS_BYTES, stream);
    if (e != hipSuccess) fprintf(stderr, "cooperative launch failed: %s (grid %d)\n", hipGetErrorString(e), grid);
#else
    for (int ph = 0; ph < NPHASE; ++ph) { a.ph_lo = ph; a.ph_hi = ph + 1; a.coop = 0;
        hipLaunchKernelGGL(mk_fwd, dim3(grid), dim3(NWAVES * 64), LDS_BYTES, stream, a); }
#endif
}
```

```cpp
#include <hip/hip_runtime.h>
#include <hip/hip_bf16.h>
#include <cstdio>
#include <cstdint>
#include <cmath>
namespace pg8 {
#define PG8_LAS __attribute__((address_space(3)))
typedef unsigned short bf16_t;
typedef short bf16x8 __attribute__((ext_vector_type(8)));
typedef float f32x4 __attribute__((ext_vector_type(4)));
typedef unsigned u32x4 __attribute__((ext_vector_type(4)));
constexpr int BM = 256, BK = 64, HALF = 128, HTB = HALF * BK * 2  , STAGE_BYTES = 8 * HTB, NXCD = 8, WGM = 8;

__host__ __device__ __forceinline__ int lds_byte(int r, int c) { const int st = (r >> 4) * 2 + (c >> 5), rr = r & 15, cc = c & 31, ob = rr * 64 + cc * 2; return st * 1024 + (ob ^ (((ob >> 9) & 1) << 5)); }
__host__ __device__ __forceinline__ void stage_rc(int b, int& R, int& C) { const int st = b / 1024, sb = b % 1024, swz = sb ^ (((sb >> 9) & 1) << 5); R = (st >> 1) * 16 + swz / 64; C = (st & 1) * 32 + (swz % 64) / 2; }
__host__ __device__ __forceinline__ int perm32(int rho) { const int n = rho >> 4, i = rho & 15; return 8 * (i >> 2) + 4 * n + (i & 3); }

struct Unit { int pm, pn; };
struct Gemm { const bf16_t* A; const bf16_t* Bt; int M, N, K; };

struct StaticOrder {
    int nM, nN, nwg, G, c;
    __host__ __device__ void init(int M, int N, int G_, int c_) { nM = M / BM; nN = N / BM; nwg = nM * nN; G = G_; c = c_; }
    __host__ __device__ bool next(int i, Unit& u) const {
        const long L = (long)i * G + c; if (L >= nwg) return false;
        int wgid = (int)L; { const int q = nwg / NXCD, r = nwg % NXCD, xcd = wgid % NXCD, off = wgid / NXCD; wgid = (xcd < r ? xcd * (q + 1) : r * (q + 1) + (xcd - r) * q) + off; }
        const int nig = WGM * nN, gid = wgid / nig, fm = gid * WGM, gsz = (nM - fm) < WGM ? (nM - fm) : WGM;
        u.pm = fm + ((wgid % nig) % gsz); u.pn = (wgid % nig) / gsz; return true;
    }
    __device__ __forceinline__ void a_ready(const Unit&) const {}
    __device__ __forceinline__ void done(const Unit&) const {}
};

typedef float f32x2_c __attribute__((ext_vector_type(2))); typedef __bf16 bf16x2_c __attribute__((ext_vector_type(2)));
__device__ __forceinline__ unsigned cvt_pk_bf16(float lo, float hi) { f32x2_c v = {lo, hi}; bf16x2_c b = __builtin_convertvector(v, bf16x2_c); return __builtin_bit_cast(unsigned, b); }
typedef float f32x2 __attribute__((ext_vector_type(2)));
__device__ __forceinline__ f32x2 gelu_pk(f32x2 v) {
    const f32x2 av = __builtin_elementwise_abs(v), d = av * 0.2316418882f + 1.0f;
    f32x2 t; t.x = __builtin_amdgcn_rcpf(d.x); t.y = __builtin_amdgcn_rcpf(d.y);
    f32x2 q = t * 0.5307027145f + (-0.7265760135f); q = q * t + 0.7107068705f; q = q * t + (-0.142248368f); q = q * t + 0.127414796f; q = q * t;
    const f32x2 s = (v * v) * (-0.72134752044f);
    f32x2 e; e.x = __builtin_amdgcn_exp2f(s.x); e.y = __builtin_amdgcn_exp2f(s.y);
    const f32x2 m = v * (q * e), r = v - m;
    f32x2 o; o.x = v.x < 0.f ? m.x : r.x; o.y = v.y < 0.f ? m.y : r.y; return o;
}

template <int ACT  > struct EpiBf16 {
    static constexpr bool PERM = true, AFTER_DRAIN = false; static_assert(ACT == 0 || ACT == 1, "EpiBf16: ACT is 0 (none) or 1 (gelu_pk)");
    bf16_t* O; int ldc; const float* bias; int split_cols; size_t split_stride; float scale0;
    __device__ __forceinline__ void operator()(const f32x4 (&acc)[2][2][4][2], const Unit& u, int wr, int wc, int fr, int fq) const {
        const int row0 = u.pm * BM + wr * 64 + fr; int colt = u.pn * BM; bf16_t* base = O;
        float sc = 1.f; if (split_cols) { const int t = colt / split_cols; base += (size_t)t * split_stride; colt -= t * split_cols; if (t == 0) sc = scale0; }
        const int col0 = colt + wc * 32 + 8 * fq, bcol0 = u.pn * BM + wc * 32 + 8 * fq;
        f32x4 bv[2][2];
#pragma unroll
        for (int bj = 0; bj < 2; ++bj)
#pragma unroll
            for (int n = 0; n < 2; ++n) bv[bj][n] = bias ? *(const f32x4*)(bias + bcol0 + bj * HALF + 4 * n) : (f32x4){0.f, 0.f, 0.f, 0.f};
#pragma unroll
        for (int ai = 0; ai < 2; ++ai)
#pragma unroll
            for (int m = 0; m < 4; ++m) { bf16_t* rowp = base + (size_t)(row0 + ai * HALF + m * 16) * ldc + col0;
#pragma unroll
                for (int bj = 0; bj < 2; ++bj) { f32x4 v0 = acc[ai][bj][m][0] + bv[bj][0], v1 = acc[ai][bj][m][1] + bv[bj][1];
                    if (ACT == 1) { f32x2 a = gelu_pk((f32x2){v0[0], v0[1]}), b = gelu_pk((f32x2){v0[2], v0[3]}), c = gelu_pk((f32x2){v1[0], v1[1]}), d = gelu_pk((f32x2){v1[2], v1[3]});
                        v0 = (f32x4){a.x, a.y, b.x, b.y}; v1 = (f32x4){c.x, c.y, d.x, d.y}; }
                    v0 = v0 * sc; v1 = v1 * sc; u32x4 w; w.x = cvt_pk_bf16(v0[0], v0[1]); w.y = cvt_pk_bf16(v0[2], v0[3]); w.z = cvt_pk_bf16(v1[0], v1[1]); w.w = cvt_pk_bf16(v1[2], v1[3]);
                    *(u32x4*)(rowp + bj * HALF) = w; } }
    }
};

template <class Epi, class Sched, bool ALIGN_EPI = false, bool SP2 = false, bool MID = false>
__device__ __forceinline__ void gemm_phase(PG8_LAS unsigned char* lds, const Gemm g, const Sched& S, const Epi& E) {
    const int tid = threadIdx.x, wid = __builtin_amdgcn_readfirstlane(tid >> 6), lane = tid & 63, wr = wid >> 2, wc = wid & 3, fr = lane & 15, fq = lane >> 4;
    const int K = g.K, nt = K / BK;
    unsigned voffA[2], voffB[2];
#pragma unroll
    for (int i = 0; i < 2; ++i) { int R, C; stage_rc(tid * 16 + i * 8192, R, C); const int Rb = Epi::PERM ? ((R & ~31) + perm32(R & 31)) : R;
        voffA[i] = (unsigned)(R * K + C) * 2u; voffB[i] = (unsigned)(Rb * K + C) * 2u; }
    const size_t kstep = (size_t)(BK * 2);
    const size_t hstep = (size_t)HALF * K * 2;
    const size_t tstep = 2 * hstep;
    const unsigned ldsw = (unsigned)wid * 1024u;
    const int aoff = lds_byte(wr * 64 + fr, fq * 8), boff = lds_byte(wc * 32 + fr, fq * 8);
#define PG8_SA(b, h) (((b) * 2 + (h)) * HTB)
#define PG8_SB(b, h) ((4 + (b) * 2 + (h)) * HTB)
#define PG8_STAGE(bufoff, gbase, voff) do { _Pragma("unroll") for (int _i = 0; _i < 2; ++_i) \
        __builtin_amdgcn_global_load_lds((const unsigned*)((const char*)(gbase) + (voff)[_i]), (PG8_LAS unsigned*)(lds + (bufoff) + ldsw + _i * 8192), 16, 0, 0); } while (0)
#define PG8_LDA(dst, b, h) do { _Pragma("unroll") for (int m = 0; m < 4; ++m) _Pragma("unroll") for (int k = 0; k < 2; ++k) dst[m][k] = *(const PG8_LAS bf16x8*)(lds + PG8_SA(b, h) + aoff + m * 2048 + k * 1024); } while (0)
#define PG8_LDB(dst, b, h) do { _Pragma("unroll") for (int n = 0; n < 2; ++n) _Pragma("unroll") for (int k = 0; k < 2; ++k) dst[n][k] = *(const PG8_LAS bf16x8*)(lds + PG8_SB(b, h) + boff + n * 2048 + k * 1024); } while (0)
#define PG8_MMA(ai, bj, At, Bt) do { __builtin_amdgcn_s_setprio(1); _Pragma("unroll") for (int m = 0; m < 4; ++m) _Pragma("unroll") for (int n = 0; n < 2; ++n) _Pragma("unroll") for (int k = 0; k < 2; ++k) \
        acc[ai][bj][m][n] = __builtin_amdgcn_mfma_f32_16x16x32_bf16(Bt[n][k], At[m][k], acc[ai][bj][m][n], 0, 0, 0); __builtin_amdgcn_s_setprio(0); } while (0)
#define PG8_WAIT_V(n) asm volatile("s_waitcnt vmcnt(" #n ")" ::: "memory")
#define PG8_WAIT_L(n) asm volatile("s_waitcnt lgkmcnt(" #n ")" ::: "memory")
#define PG8_BAR __builtin_amdgcn_s_barrier()
#define PG8_SCHED __builtin_amdgcn_sched_barrier(0)
    Unit cur, nxt; int ui = 0;
    if (!S.next(0, cur)) return;
    f32x4 acc[2][2][4][2];
#pragma unroll
    for (int a = 0; a < 2; ++a)
#pragma unroll
        for (int b = 0; b < 2; ++b)
#pragma unroll
            for (int m = 0; m < 4; ++m)
#pragma unroll
                for (int n = 0; n < 2; ++n) acc[a][b][m][n] = (f32x4){0.f, 0.f, 0.f, 0.f};
    bf16x8 At[4][2], B0[2][2], B1[2][2];
    const char* cA = (const char*)g.A + (size_t)cur.pm * tstep; const char* cB = (const char*)g.Bt + (size_t)cur.pn * tstep;
    S.a_ready(cur);
    if constexpr (SP2) {
        PG8_STAGE(PG8_SB(0, 0), cB, voffB); PG8_STAGE(PG8_SB(0, 1), cB + hstep, voffB); PG8_STAGE(PG8_SA(0, 0), cA, voffA); PG8_STAGE(PG8_SA(0, 1), cA + hstep, voffA);
        if (wr == 1) PG8_BAR;
        PG8_WAIT_V(2); PG8_BAR;
        PG8_STAGE(PG8_SB(1, 0), cB + kstep, voffB); PG8_STAGE(PG8_SA(1, 0), cA + kstep, voffA); PG8_STAGE(PG8_SB(1, 1), cB + hstep + kstep, voffB);
        PG8_WAIT_V(6); PG8_BAR;
    } else {
        PG8_STAGE(PG8_SB(0, 0), cB, voffB); PG8_STAGE(PG8_SA(0, 0), cA, voffA); PG8_STAGE(PG8_SB(0, 1), cB + hstep, voffB); PG8_STAGE(PG8_SA(0, 1), cA + hstep, voffA);
        if (wr == 1) PG8_BAR;
        PG8_WAIT_V(4); PG8_BAR;
        PG8_STAGE(PG8_SB(1, 0), cB + kstep, voffB); PG8_STAGE(PG8_SA(1, 0), cA + kstep, voffA); PG8_STAGE(PG8_SB(1, 1), cB + hstep + kstep, voffB);
        PG8_WAIT_V(6); PG8_BAR;
    }
    for (;;) {
        const bool has_next = S.next(ui + 1, nxt);
        const char* nA = has_next ? (const char*)g.A + (size_t)nxt.pm * tstep : cA; const char* nB = has_next ? (const char*)g.Bt + (size_t)nxt.pn * tstep : cB;
        for (int t = 0; t < nt; t += 2) {
            const bool last = (t == nt - 2);
            if constexpr (MID) { if (t == Epi::MID_T) { PG8_SCHED; E.mid(acc, cur, wr, wc, fr, fq); PG8_SCHED; } }
            const char* a1 = cA + (size_t)(t + 1) * kstep;
            const char* a2 = last ? nA : cA + (size_t)(t + 2) * kstep; const char* b2 = last ? nB : cB + (size_t)(t + 2) * kstep;
            const char* a3 = a2 + kstep; const char* b3 = b2 + kstep;
            if (last && has_next) S.a_ready(nxt);
            if constexpr (SP2) {
            PG8_LDB(B0, 0, 0); PG8_LDB(B1, 0, 1); PG8_SCHED; PG8_LDA(At, 0, 0); PG8_STAGE(PG8_SA(1, 1), a1 + hstep, voffA);
            PG8_WAIT_V(8); PG8_WAIT_L(0); PG8_BAR; PG8_MMA(0, 0, At, B0); PG8_MMA(0, 1, At, B1); PG8_BAR; PG8_SCHED;
            PG8_LDA(At, 0, 1); PG8_STAGE(PG8_SB(0, 0), b2, voffB); PG8_STAGE(PG8_SB(0, 1), b2 + hstep, voffB); PG8_STAGE(PG8_SA(0, 0), a2, voffA);
            PG8_WAIT_V(8); PG8_WAIT_L(0); PG8_BAR; PG8_MMA(1, 0, At, B0); PG8_MMA(1, 1, At, B1); PG8_BAR; PG8_SCHED;
            PG8_LDB(B0, 1, 0); PG8_LDB(B1, 1, 1); PG8_SCHED; PG8_LDA(At, 1, 0); PG8_STAGE(PG8_SA(0, 1), a2 + hstep, voffA);
            PG8_WAIT_V(8); PG8_WAIT_L(0); PG8_BAR; PG8_MMA(0, 0, At, B0); PG8_MMA(0, 1, At, B1); PG8_BAR; PG8_SCHED;
            PG8_LDA(At, 1, 1); PG8_STAGE(PG8_SB(1, 0), b3, voffB); PG8_STAGE(PG8_SB(1, 1), b3 + hstep, voffB); PG8_STAGE(PG8_SA(1, 0), a3, voffA);
            PG8_WAIT_V(8); PG8_WAIT_L(0); PG8_BAR; PG8_MMA(1, 0, At, B0); PG8_MMA(1, 1, At, B1); PG8_BAR; PG8_SCHED;
            } else {
            PG8_LDB(B0, 0, 0); PG8_SCHED; PG8_LDA(At, 0, 0); PG8_STAGE(PG8_SA(1, 1), a1 + hstep, voffA);
            PG8_WAIT_L(8); PG8_BAR; PG8_WAIT_L(0); PG8_MMA(0, 0, At, B0); PG8_BAR; PG8_SCHED;
            PG8_LDB(B1, 0, 1); PG8_STAGE(PG8_SB(0, 0), b2, voffB);
            PG8_BAR; PG8_WAIT_L(0); PG8_MMA(0, 1, At, B1); PG8_BAR;
            PG8_LDA(At, 0, 1); PG8_STAGE(PG8_SA(0, 0), a2, voffA);
            PG8_BAR; PG8_WAIT_L(0); PG8_MMA(1, 0, At, B0); PG8_BAR; PG8_SCHED;
            PG8_STAGE(PG8_SB(0, 1), b2 + hstep, voffB);
            PG8_WAIT_V(6); PG8_BAR; PG8_MMA(1, 1, At, B1); PG8_BAR;
            PG8_LDB(B0, 1, 0); PG8_SCHED; PG8_LDA(At, 1, 0); PG8_STAGE(PG8_SA(0, 1), a2 + hstep, voffA);
            PG8_WAIT_L(8); PG8_BAR; PG8_WAIT_L(0); PG8_MMA(0, 0, At, B0); PG8_BAR; PG8_SCHED;
            PG8_LDB(B1, 1, 1); PG8_STAGE(PG8_SB(1, 0), b3, voffB);
            PG8_BAR; PG8_WAIT_L(0); PG8_MMA(0, 1, At, B1); PG8_BAR;
            PG8_LDA(At, 1, 1); PG8_STAGE(PG8_SA(1, 0), a3, voffA);
            PG8_BAR; PG8_WAIT_L(0); PG8_MMA(1, 0, At, B0); PG8_BAR; PG8_SCHED;
            PG8_STAGE(PG8_SB(1, 1), b3 + hstep, voffB);
            PG8_WAIT_V(6); PG8_BAR; PG8_MMA(1, 1, At, B1); PG8_BAR;
            }
        }
        if constexpr (ALIGN_EPI) { if (wr == 0) PG8_BAR; }
        if constexpr (!Epi::AFTER_DRAIN) { E(acc, cur, wr, wc, fr, fq); S.done(cur); }
        if (!has_next) break;
#pragma unroll
        for (int a = 0; a < 2; ++a)
#pragma unroll
            for (int b = 0; b < 2; ++b)
#pragma unroll
                for (int m = 0; m < 4; ++m)
#pragma unroll
                    for (int n = 0; n < 2; ++n) acc[a][b][m][n] = (f32x4){0.f, 0.f, 0.f, 0.f};
        cur = nxt; cA = nA; cB = nB; ++ui;
        if constexpr (ALIGN_EPI) { if (wr == 1) PG8_BAR; }
    }
    PG8_WAIT_V(0);
    if constexpr (!ALIGN_EPI) { if (wr == 0) PG8_BAR; }
    PG8_BAR;
    if constexpr (Epi::AFTER_DRAIN) { E.fused(acc, cur, wr, wc, fr, fq, lds, wid, lane); S.done(cur); }
#undef PG8_SA
#undef PG8_SB
#undef PG8_STAGE
#undef PG8_LDA
#undef PG8_LDB
#undef PG8_MMA
#undef PG8_WAIT_V
#undef PG8_WAIT_L
#undef PG8_BAR
#undef PG8_SCHED
}
}
namespace swa {
constexpr int D = 128;
constexpr float THR = 8.f;
constexpr bool WSKIP = false;
constexpr float SCALE = 0.08838834764831845f;
constexpr int NW = 8, QBLK = 32, KVBLK = 64, QB = NW * QBLK;
constexpr int SHM_V = KVBLK * D * 2, SHM_K = KVBLK * D * 2;
constexpr int MSLOT_OFF = 2 * SHM_V + 2 * SHM_K + NW * 64 * 4, QLDS_OFF = MSLOT_OFF + 4096;
constexpr int LDS_BYTES = QLDS_OFF + NW * 8192;

using bf16 = __hip_bfloat16;
typedef short bf16x8 __attribute__((ext_vector_type(8)));
typedef short s16x4 __attribute__((ext_vector_type(4)));
typedef float f32x16 __attribute__((ext_vector_type(16)));
typedef float f32x4 __attribute__((ext_vector_type(4)));
typedef unsigned u32x4 __attribute__((ext_vector_type(4)));
template <class A, class Bt> struct same_t { static constexpr bool v = false; };
template <class A> struct same_t<A, A> { static constexpr bool v = true; };

#define KSWZ(row, colB) ((row) * 256 + ((colB) ^ (((row) & 7) << 4)))
#define SBAR() __builtin_amdgcn_sched_barrier(0)
__device__ __forceinline__ int v_st(int k, int c) { const int kk = (k & ~0xC) | ((k & 4) << 1) | ((k & 8) >> 1); return ((kk >> 3) * 4 + (c >> 5)) * 512 + ((kk & 7) * 32 + (c & 31)) * 2; }
__device__ __forceinline__ int v_rd_base(int lane) { return ((lane & 3) << 3) | (((lane >> 2) & 3) << 6) | (((lane >> 4) & 1) << 5) | (((lane >> 5) & 1) << 8); }
constexpr int v_rd_off(int d0, int ks, int half) { return d0 * 512 + ks * 4096 + half * 2048; }
__device__ __forceinline__ int crow(int r, int hi) { return (r & 3) + 8 * (r >> 2) + 4 * hi; }
typedef float f32x2_c __attribute__((ext_vector_type(2))); typedef __bf16 bf16x2_c __attribute__((ext_vector_type(2)));
__device__ __forceinline__ unsigned cvtpk(float lo, float hi) { f32x2_c v = {lo, hi}; bf16x2_c b = __builtin_convertvector(v, bf16x2_c); return __builtin_bit_cast(unsigned, b); }
__device__ __forceinline__ bf16x8 pack8(f32x4 a, f32x4 b) {
    u32x4 w = {cvtpk(a[0], a[1]), cvtpk(a[2], a[3]), cvtpk(b[0], b[1]), cvtpk(b[2], b[3])};
    return *reinterpret_cast<bf16x8*>(&w);
}
template <class T> __device__ __forceinline__ bf16x8 load8(const T* p) {
    if constexpr (same_t<T, float>::v) { return pack8(*(const f32x4*)p, *(const f32x4*)(p + 4)); }
    else { return *reinterpret_cast<const bf16x8*>(p); }
}
__device__ __forceinline__ void mask_tile(f32x16& p0, f32x16& p1, int dq, unsigned W) {
    const float NEG = -__builtin_inff();
#pragma unroll
    for (int r = 0; r < 16; ++r) {
        const int c = (r & 3) + 8 * (r >> 2);
        if ((unsigned)(dq - c) >= W) p0[r] = NEG;
        if ((unsigned)(dq - c - 32) >= W) p1[r] = NEG;
    }
}
__device__ __forceinline__ void partialSM(f32x16& p0, f32x16& p1, float& m_reg, float& mn, float& alpha) {
    float pmax = p0[0]; for (int r = 1; r < 16; ++r) pmax = fmaxf(pmax, p0[r]); for (int r = 0; r < 16; ++r) pmax = fmaxf(pmax, p1[r]);
    { auto rr = __builtin_amdgcn_permlane32_swap(__float_as_uint(pmax), __float_as_uint(pmax), false, false);
      pmax = fmaxf(__uint_as_float(rr[0]), __uint_as_float(rr[1])); }
    constexpr float C2 = 1.4426950408889634f * SCALE;
    if (__builtin_expect(__all((pmax - m_reg) * SCALE <= THR), 1)) { mn = m_reg; alpha = 1.f; }
    else { mn = fmaxf(m_reg, pmax); alpha = __builtin_amdgcn_exp2f((m_reg - mn) * C2); m_reg = mn; }
    const float mnL = -mn * C2;
    for (int r = 0; r < 16; ++r) p0[r] = fmaf(p0[r], C2, mnL); for (int r = 0; r < 16; ++r) p1[r] = fmaf(p1[r], C2, mnL);
    for (int r = 0; r < 16; ++r) p0[r] = __builtin_amdgcn_exp2f(p0[r]);
}
__device__ __forceinline__ void finishSM(f32x16& p0, f32x16& p1, float alpha, float& l_reg, bf16x8& pa0, bf16x8& pa1, bf16x8& pa2, bf16x8& pa3) {
    for (int r = 0; r < 16; ++r) p1[r] = __builtin_amdgcn_exp2f(p1[r]);
    float ps = 0; for (int r = 0; r < 16; ++r) ps += p0[r]; for (int r = 0; r < 16; ++r) ps += p1[r];
    { auto rr = __builtin_amdgcn_permlane32_swap(__float_as_uint(ps), __float_as_uint(ps), false, false);
      ps = __uint_as_float(rr[0]) + __uint_as_float(rr[1]); }
    l_reg = l_reg * alpha + ps;
#define PK4(P, B_, OUT) do { unsigned a0 = cvtpk(P[B_+0], P[B_+1]), a1 = cvtpk(P[B_+2], P[B_+3]);                          \
        unsigned b0 = cvtpk(P[B_+4], P[B_+5]), b1 = cvtpk(P[B_+6], P[B_+7]);                                             \
        auto r0 = __builtin_amdgcn_permlane32_swap(a0, b0, false, false); auto r1 = __builtin_amdgcn_permlane32_swap(a1, b1, false, false); \
        u32x4 w = {r0[0], r1[0], r0[1], r1[1]}; OUT = *reinterpret_cast<bf16x8*>(&w); } while (0)
    PK4(p0, 0, pa0); PK4(p0, 8, pa1); PK4(p1, 0, pa2); PK4(p1, 8, pa3);
#undef PK4
}
template <int KB, bool SK>
__device__ __forceinline__ void qkt(f32x16& p0, f32x16& p1, const char* K_lds, int r32, int hi, const bf16x8* qr, bool act) {
    if (SK && !act) { const float NEG = -__builtin_inff();
#pragma unroll
        for (int r = 0; r < 16; ++r) { p0[r] = NEG; p1[r] = NEG; } return; }
    p0 = f32x16{}; p1 = f32x16{};
    const char* kb[4];
#pragma unroll
    for (int dd = 0; dd < 4; ++dd) kb[dd] = K_lds + KB * SHM_K + KSWZ(r32, (dd * 16 + hi * 8) * 2);
#pragma unroll
    for (int d0 = 0; d0 < 8; ++d0) { const char* a = kb[d0 & 3] + (d0 >> 2) * 128;
        bf16x8 b0 = *reinterpret_cast<const bf16x8*>(a);
        bf16x8 b1 = *reinterpret_cast<const bf16x8*>(a + 32 * 256);
        const bf16x8 qf = qr[d0];
        p0 = __builtin_amdgcn_mfma_f32_32x32x16_bf16(b0, qf, p0, 0, 0, 0);
        p1 = __builtin_amdgcn_mfma_f32_32x32x16_bf16(b1, qf, p1, 0, 0, 0); }
}
template <int VB, bool SK>
__device__ __forceinline__ void pv_tile(f32x16* o, int vb0, bf16x8 pa0, bf16x8 pa1, bf16x8 pa2, bf16x8 pa3, bool act) {
    if (SK && !act) return;
#define TRRD(dst, off) asm volatile("ds_read_b64_tr_b16 %0, %1 offset:%2" : "=&v"(dst) : "v"(vb0), "i"(off) : "memory")
#define PV_D0(d0) do { s16x4 l0, l1, l2, l3, h0, h1, h2, h3; constexpr int b_ = VB * SHM_V + v_rd_off(d0, 0, 0);     \
        TRRD(l0, b_); TRRD(h0, b_ + 2048); TRRD(l1, b_ + 4096); TRRD(h1, b_ + 6144); TRRD(l2, b_ + 8192); TRRD(h2, b_ + 10240); TRRD(l3, b_ + 12288); TRRD(h3, b_ + 14336); \
        asm volatile("s_waitcnt lgkmcnt(0)" ::: "memory"); SBAR();                 \
        o[d0] = __builtin_amdgcn_mfma_f32_32x32x16_bf16(pa0, (bf16x8){l0[0], l0[1], l0[2], l0[3], h0[0], h0[1], h0[2], h0[3]}, o[d0], 0, 0, 0);   \
        o[d0] = __builtin_amdgcn_mfma_f32_32x32x16_bf16(pa1, (bf16x8){l1[0], l1[1], l1[2], l1[3], h1[0], h1[1], h1[2], h1[3]}, o[d0], 0, 0, 0);   \
        o[d0] = __builtin_amdgcn_mfma_f32_32x32x16_bf16(pa2, (bf16x8){l2[0], l2[1], l2[2], l2[3], h2[0], h2[1], h2[2], h2[3]}, o[d0], 0, 0, 0);   \
        o[d0] = __builtin_amdgcn_mfma_f32_32x32x16_bf16(pa3, (bf16x8){l3[0], l3[1], l3[2], l3[3], h3[0], h3[1], h3[2], h3[3]}, o[d0], 0, 0, 0); } while (0)
    PV_D0(0); PV_D0(1); PV_D0(2); PV_D0(3);
#undef PV_D0
#undef TRRD
}

template <class TIn, class TOut> struct BlockRef { const TIn* Q; const TIn* K; const TIn* V; TOut* O; int P0; int ldo; const int* rows; const int* dst; float* stat; };
template <class TIn> struct Seam {
    bf16x8 qr[8];
    bf16x8 st_v0, st_v1, st_k0, st_k1; f32x4 sf0, sf1, sf2, sf3;
    f32x4 tq[16];
};
__device__ __forceinline__ int swa_jlo(int P0, int W) { const int lowk = P0 - W + 1; return lowk > 0 ? lowk / KVBLK : 0; }
#define ROW(p, k0, rr) ((p) + (unsigned)(((k0) + (rr)) * D + sc))
#define VMW() asm volatile("s_waitcnt vmcnt(0)" ::: "memory")
#define VMWN(n) asm volatile("s_waitcnt vmcnt(%0)" :: "i"(n) : "memory")
#define SLOAD_H(Kp, Vp, k0) do { S.st_v0 = load8<TIn>(ROW(Vp, k0, sr)); S.st_v1 = load8<TIn>(ROW(Vp, k0, 32 + sr));              \
                         S.st_k0 = load8<TIn>(ROW(Kp, k0, sr)); S.st_k1 = load8<TIn>(ROW(Kp, k0, 32 + sr)); } while (0)
#define SWRITE_HK(bf) do { *(bf16x8*)(K_lds + (bf) * SHM_K + kws) = S.st_k0; *(bf16x8*)(K_lds + (bf) * SHM_K + kws + 32 * 256) = S.st_k1; } while (0)
#define SWRITE_HV(bf) do { *(bf16x8*)(V_lds + (bf) * SHM_V + vst0) = S.st_v0; *(bf16x8*)(V_lds + (bf) * SHM_V + vst1) = S.st_v1; } while (0)
#define SWRITE_H(bf) do { SWRITE_HV(bf); SWRITE_HK(bf); } while (0)
#define SLOAD_F(p, k0) do { S.sf0 = *(const f32x4*)ROW(p, k0, sr); S.sf1 = *(const f32x4*)(ROW(p, k0, sr) + 4);                \
                            S.sf2 = *(const f32x4*)ROW(p, k0, 32 + sr); S.sf3 = *(const f32x4*)(ROW(p, k0, 32 + sr) + 4); } while (0)
#define SWRITE_KF(bf) do { *(bf16x8*)(K_lds + (bf) * SHM_K + kws) = pack8(S.sf0, S.sf1); *(bf16x8*)(K_lds + (bf) * SHM_K + kws + 32 * 256) = pack8(S.sf2, S.sf3); } while (0)
#define SWRITE_VF(bf) do { *(bf16x8*)(V_lds + (bf) * SHM_V + vst0) = pack8(S.sf0, S.sf1); *(bf16x8*)(V_lds + (bf) * SHM_V + vst1) = pack8(S.sf2, S.sf3); } while (0)
template <class TIn, class TOut>
__device__ __forceinline__ void causal_swa_prime(const BlockRef<TIn, TOut>& cur, int W, char* lds, Seam<TIn>& S) {
    constexpr bool F32 = same_t<TIn, float>::v;
    const int tid = threadIdx.x, wid = __builtin_amdgcn_readfirstlane(tid >> 6), lane = tid & 63, r32 = lane & 31, hi = lane >> 5;
    const int sr = tid >> 4, sc = (tid & 15) * 8, kws = KSWZ(sr, sc * 2); char* K_lds = lds + 2 * SHM_V;
    const int kb0 = swa_jlo(cur.P0, W) * KVBLK;
    for (int d0 = 0; d0 < 8; ++d0) S.qr[d0] = load8<TIn>(cur.Q + (size_t)(wid * QBLK + r32) * D + d0 * 16 + hi * 8);
    if constexpr (F32) { SLOAD_F((const float*)cur.K, kb0); VMW(); SWRITE_KF(0); SBAR(); SLOAD_F((const float*)cur.V, kb0); }
    else { SLOAD_H(cur.K, cur.V, kb0); VMW(); SWRITE_HK(0); }
    __syncthreads();
}
template <class TIn, class TOut>
__device__ __forceinline__ void causal_swa_block(const BlockRef<TIn, TOut>& cur, const BlockRef<TIn, TOut>& nxt, int skv, int W, char* lds, Seam<TIn>& S) {
    constexpr bool F32 = same_t<TIn, float>::v;
    const int tid = threadIdx.x, wid = __builtin_amdgcn_readfirstlane(tid >> 6), lane = tid & 63, r32 = lane & 31, hi = lane >> 5;
    const int j_lo = swa_jlo(cur.P0, W);
    int j_hi = (cur.P0 + QB - 1) / KVBLK + 1; if (j_hi > skv / KVBLK) j_hi = skv / KVBLK;
    const int NT = j_hi - j_lo;
    const int kbn = swa_jlo(nxt.P0, W) * KVBLK;
    const int qlo = cur.P0 + wid * QBLK, qm = qlo + r32 - 4 * hi;
    char* V_lds = lds; char* K_lds = lds + 2 * SHM_V;
    float* ws = (float*)(lds + 2 * SHM_V + 2 * SHM_K) + wid * 64; float* li_l = ws, * al_l = ws + 32;
    float m_reg = -1e30f, l_reg = 0; f32x16 o[4] = {};
    const int sr = tid >> 4, sc = (tid & 15) * 8, vst0 = v_st(sr, sc), vst1 = v_st(32 + sr, sc), kws = KSWZ(sr, sc * 2);
    const int vb0 = (int)(uintptr_t)V_lds + v_rd_base(lane);
    const TIn* Kh = cur.K; const TIn* Vh = cur.V;
#define RESC(a) do { if (__any((a) < 1.f)) { if (hi == 0) al_l[r32] = (a); asm volatile("s_waitcnt lgkmcnt(0)" ::: "memory");              \
                     for (int d_ = 0; d_ < 4; ++d_) for (int r = 0; r < 16; ++r) o[d_][r] *= al_l[crow(r, hi)]; } } while (0)
#define KBASE(t) ((j_lo + (t)) * KVBLK)
#define ACT(t) (KBASE(t) <= qlo + QBLK - 1 && KBASE(t) + KVBLK - 1 >= qlo - W + 1)
#define MASKT(P0_, P1_, t) do { const int kb_ = KBASE(t); if ((!SK || ACT(t)) && (kb_ + KVBLK - 1 > qlo || kb_ <= qlo + QBLK - 1 - W)) mask_tile(P0_, P1_, qm - kb_, (unsigned)W); } while (0)
    constexpr int NQL = F32 ? 16 : 8;
    constexpr bool SK = WSKIP && !F32;
#define SEAM_K0() do { VMWN(NQL); if constexpr (F32) { SWRITE_KF(0); SBAR(); SLOAD_F((const float*)nxt.V, kbn); } else { SWRITE_HK(0); } SBAR(); } while (0)
    f32x16 pA0, pA1, pB0, pB1; float mnA, mnB, alA, alB; bf16x8 pa0, pa1, pa2, pa3;
    if constexpr (F32) { VMW(); SWRITE_VF(0); SBAR(); } else { SWRITE_HV(0); SBAR(); }
    if (NT > 1) { if constexpr (F32) SLOAD_F((const float*)Kh, KBASE(1)); else SLOAD_H(Kh, Vh, KBASE(1)); }
    SBAR(); qkt<0, SK>(pA0, pA1, K_lds, r32, hi, S.qr, ACT(0));
    if constexpr (F32) { if (NT > 1) { VMW(); SWRITE_KF(1); SBAR(); SLOAD_F((const float*)Vh, KBASE(1)); } }
    MASKT(pA0, pA1, 0); partialSM(pA0, pA1, m_reg, mnA, alA);
    if (NT > 1) { VMW(); if constexpr (F32) { SWRITE_VF(1); SBAR(); if (NT > 2) SLOAD_F((const float*)Kh, KBASE(2)); } else SWRITE_H(1); }
    __syncthreads();
#define HALF_STEP(PX0, PX1, mnX, alX, PY0, PY1, alY, t, KB, VB, SB) do {                                                      \
        SBAR(); qkt<KB, SK>(PX0, PX1, K_lds, r32, hi, S.qr, ACT(t));                                             \
        finishSM(PY0, PY1, alY, l_reg, pa0, pa1, pa2, pa3); SBAR();                                                           \
        if ((t) + 1 < NT) { if constexpr (F32) { VMW(); SWRITE_KF(SB); SBAR(); SLOAD_F((const float*)Vh, KBASE((t) + 1)); }  \
                            else { SLOAD_H(Kh, Vh, KBASE((t) + 1)); } SBAR(); }                                               \
        pv_tile<VB, SK>(o, vb0, pa0, pa1, pa2, pa3, ACT((t) - 1)); MASKT(PX0, PX1, (t)); partialSM(PX0, PX1, m_reg, mnX, alX);                                        \
        __syncthreads();                                                                                                      \
        if ((t) + 1 < NT) { VMW(); if constexpr (F32) { SWRITE_VF(SB); SBAR(); if ((t) + 2 < NT) SLOAD_F((const float*)Kh, KBASE((t) + 2)); } \
                            else { SWRITE_H(SB); } }                                                                          \
        RESC(alX); __syncthreads(); } while (0)
    for (int t = 1; t + 1 < NT; t += 2) {
        HALF_STEP(pB0, pB1, mnB, alB, pA0, pA1, alA, t, 1, 0, 0);
        HALF_STEP(pA0, pA1, mnA, alA, pB0, pB1, alB, t + 1, 0, 1, 1);
    }
    const bool even = (NT & 1) == 0;
    if (even) { SBAR(); qkt<1, SK>(pB0, pB1, K_lds, r32, hi, S.qr, ACT(NT - 1)); SBAR(); }
#define QROW(e) (nxt.Q + (size_t)(wid * QBLK + r32) * D + ((e) >> 1) * 16 + hi * 8 + ((e) & 1) * 4)
    if constexpr (F32) { SLOAD_F((const float*)nxt.K, kbn); SBAR();
#pragma unroll
        for (int e = 0; e < 8; ++e) S.tq[e] = *(const f32x4*)QROW(e); }
    else { const size_t qrown_ = (size_t)(wid * QBLK + r32);
        SLOAD_H(nxt.K, nxt.V, kbn); SBAR();
#pragma unroll
        for (int d0 = 0; d0 < 8; ++d0) S.qr[d0] = load8<TIn>(nxt.Q + qrown_ * D + d0 * 16 + hi * 8); }
    SBAR();
    finishSM(pA0, pA1, alA, l_reg, pa0, pa1, pa2, pa3); SBAR();
    if constexpr (F32) {
#pragma unroll
        for (int e = 8; e < 16; ++e) S.tq[e] = *(const f32x4*)QROW(e); SBAR(); }
#undef QROW
    pv_tile<0, SK>(o, vb0, pa0, pa1, pa2, pa3, ACT(even ? NT - 2 : NT - 1));
    if (even) { MASKT(pB0, pB1, NT - 1); partialSM(pB0, pB1, m_reg, mnB, alB); __syncthreads(); RESC(alB);
        finishSM(pB0, pB1, alB, l_reg, pa0, pa1, pa2, pa3); SBAR(); pv_tile<1, SK>(o, vb0, pa0, pa1, pa2, pa3, ACT(NT - 1)); }
    SBAR(); SEAM_K0();
    if (hi == 0) li_l[r32] = l_reg; asm volatile("s_waitcnt lgkmcnt(0)" ::: "memory");
    float rli[16];
#pragma unroll
    for (int r = 0; r < 16; ++r) rli[r] = __builtin_amdgcn_rcpf(li_l[crow(r, hi)]);
    {
    int ld_ = cur.ldo; asm volatile("" : "+s"(ld_));
    TOut* Ow = cur.O + (size_t)(wid * QBLK) * ld_;
#pragma unroll
    for (int r = 0; r < 16; ++r) { const unsigned ro = (unsigned)crow(r, hi) * (unsigned)ld_ + (unsigned)r32;
#pragma unroll
        for (int d0 = 0; d0 < 4; ++d0) { const float v = o[d0][r] * rli[r];
            if constexpr (same_t<TOut, float>::v) { Ow[ro + d0 * 32] = v; }
            else { const float vn = __shfl_xor(v, 1);
                   if ((r32 & 1) == 0) *(unsigned*)(Ow + ro + d0 * 32) = cvtpk(v, vn); } } }
    }
    if constexpr (F32) {
#pragma unroll
        for (int d0 = 0; d0 < 8; ++d0) S.qr[d0] = pack8(S.tq[2 * d0], S.tq[2 * d0 + 1]); }
    __syncthreads();
#undef RESC
#undef KBASE
#undef ACT
#undef MASKT
#undef SEAM_K0
#undef HALF_STEP
}
#undef ROW
#undef VMW
#undef VMWN
#undef SLOAD_H
#undef SWRITE_HK
#undef SWRITE_HV
#undef SWRITE_H
#undef SLOAD_F
#undef SWRITE_KF
#undef SWRITE_VF


template <int KB>
__device__ __forceinline__ void qkt_r(f32x16& p0, f32x16& p1, const char* K_lds, int r32, int hi, const bf16x8* qr) {
    p0 = f32x16{}; p1 = f32x16{};
    const char* kb[4];
#pragma unroll
    for (int dd = 0; dd < 4; ++dd) kb[dd] = K_lds + KB * SHM_K + KSWZ(r32, (dd * 16 + hi * 8) * 2);
#pragma unroll
    for (int d0 = 0; d0 < 8; ++d0) { const char* a = kb[d0 & 3] + (d0 >> 2) * 128;
        bf16x8 b0 = *reinterpret_cast<const bf16x8*>(a);
        bf16x8 b1 = *reinterpret_cast<const bf16x8*>(a + 32 * 256);
        p0 = __builtin_amdgcn_mfma_f32_32x32x16_bf16(b0, qr[d0], p0, 0, 0, 0);
        p1 = __builtin_amdgcn_mfma_f32_32x32x16_bf16(b1, qr[d0], p1, 0, 0, 0); }
}
constexpr int MOBA_LDS_BYTES = 4 * SHM_V + 4 * SHM_K + NW * 64 * 4;
struct MobaStage { bf16x8 qr[8]; bf16x8 k0[2], k1[2], v0[2], v1[2]; };
#define MOBA_LOAD_Q(B) do { const unsigned qoff_ = (unsigned)(B).rows[wid * QBLK + r32] * D + hi * 8;                                  \
        _Pragma("unroll") for (int d0 = 0; d0 < 8; ++d0) ST.qr[d0] = load8<bf16>((B).Q + qoff_ + d0 * 16); } while (0)
#define MOBA_LOAD_KV(B, T0) do { _Pragma("unroll") for (int t = 0; t < 2; ++t) { const unsigned eo_ = (unsigned)(((T0) + t) * KVBLK + sr) * D + sc; \
        ST.k0[t] = load8<bf16>((B).K + eo_); ST.k1[t] = load8<bf16>((B).K + eo_ + 32 * D); ST.v0[t] = load8<bf16>((B).V + eo_); ST.v1[t] = load8<bf16>((B).V + eo_ + 32 * D); } } while (0)
#define MOBA_WRITE_KV(T0) do { _Pragma("unroll") for (int t = 0; t < 2; ++t) { *(bf16x8*)(K_lds + ((T0) + t) * SHM_K + kws) = ST.k0[t]; *(bf16x8*)(K_lds + ((T0) + t) * SHM_K + kws + 32 * 256) = ST.k1[t]; \
        *(bf16x8*)(V_lds + ((T0) + t) * SHM_V + vst0) = ST.v0[t]; *(bf16x8*)(V_lds + ((T0) + t) * SHM_V + vst1) = ST.v1[t]; } } while (0)
__device__ __forceinline__ void moba_block(const BlockRef<bf16, bf16>& cur, const BlockRef<bf16, bf16>& nxt, bool has_next, char* lds, MobaStage& ST) {
    const int tid = threadIdx.x, wid = __builtin_amdgcn_readfirstlane(tid >> 6), lane = tid & 63, r32 = lane & 31, hi = lane >> 5;
    char* V_lds = lds; char* K_lds = lds + 4 * SHM_V;
    float* wsc = (float*)(lds + 4 * SHM_V + 4 * SHM_K) + wid * 64; float* li_l = wsc, * al_l = wsc + 32;
    const int sr = tid >> 4, sc = (tid & 15) * 8, vst0 = v_st(sr, sc), vst1 = v_st(32 + sr, sc), kws = KSWZ(sr, sc * 2);
    const int vb0 = (int)(uintptr_t)V_lds + v_rd_base(lane);
    __syncthreads();
    MOBA_WRITE_KV(0);
    __syncthreads();
    MOBA_LOAD_KV(cur, 2);
    SBAR();
    float m_reg = -1e30f, l_reg = 0; f32x16 o[4] = {};
    const bool causal = cur.P0 == 0; const int qlo = wid * QBLK, qm = qlo + r32 - 4 * hi;
    f32x16 p0, p1; float mn, al; bf16x8 pa0, pa1, pa2, pa3;
#define RESCM(a) do { if (__any((a) < 1.f)) { if (hi == 0) al_l[r32] = (a); asm volatile("s_waitcnt lgkmcnt(0)" ::: "memory");              \
                      for (int d_ = 0; d_ < 4; ++d_) for (int r = 0; r < 16; ++r) o[d_][r] *= al_l[crow(r, hi)]; } } while (0)
#define SKIPT(t) (causal && (t) * KVBLK > qlo + QBLK - 1)
#define MTA(t) do { if (!SKIPT(t)) { SBAR(); qkt_r<t>(p0, p1, K_lds, r32, hi, ST.qr); if (causal && (t) * KVBLK + KVBLK - 1 > qlo) mask_tile(p0, p1, qm - (t) * KVBLK, 1u << 30); } } while (0)
#define MTB(t) do { if (!SKIPT(t)) { partialSM(p0, p1, m_reg, mn, al); RESCM(al); finishSM(p0, p1, al, l_reg, pa0, pa1, pa2, pa3); SBAR(); pv_tile<t, false>(o, vb0, pa0, pa1, pa2, pa3, true); } } while (0)
    MTA(0); MTB(0); MTA(1); MTB(1);
    SBAR();
    MOBA_WRITE_KV(2);
    __syncthreads();
    if (has_next) MOBA_LOAD_KV(nxt, 0);
    SBAR();
    MTA(2); MTB(2); MTA(3);
    SBAR();
    if (has_next) MOBA_LOAD_Q(nxt);
    SBAR();
    MTB(3);
#undef MTA
#undef MTB
#undef SKIPT
#undef RESCM
    if (hi == 0) li_l[r32] = l_reg; asm volatile("s_waitcnt lgkmcnt(0)" ::: "memory");
    float rli[16];
#pragma unroll
    for (int r = 0; r < 16; ++r) rli[r] = __builtin_amdgcn_rcpf(li_l[crow(r, hi)]);
    { const int dme_ = cur.dst[wid * QBLK + r32]; if (hi == 0 && dme_ >= 0) { float2 st_; st_.x = m_reg; st_.y = l_reg; *(float2*)(cur.stat + 2 * (size_t)dme_) = st_; } }
#pragma unroll
    for (int r = 0; r < 16; ++r) { const int di_ = cur.dst[wid * QBLK + crow(r, hi)];
#pragma unroll
        for (int d0 = 0; d0 < 4; ++d0) { const float v = o[d0][r] * rli[r]; const float vn = __shfl_xor(v, 1);
            if ((r32 & 1) == 0 && di_ >= 0) *(unsigned*)(cur.O + (size_t)di_ * 128 + d0 * 32 + r32) = cvtpk(v, vn); } }
}
__device__ __forceinline__ void moba_prime(const BlockRef<bf16, bf16>& cur, MobaStage& ST) {
    const int tid = threadIdx.x, wid = __builtin_amdgcn_readfirstlane(tid >> 6), lane = tid & 63, r32 = lane & 31, hi = lane >> 5;
    const int sr = tid >> 4, sc = (tid & 15) * 8;
    MOBA_LOAD_Q(cur); MOBA_LOAD_KV(cur, 0);
}
#undef MOBA_LOAD_Q
#undef MOBA_LOAD_KV
#undef MOBA_WRITE_KV
}
#include <hip/hip_cooperative_groups.h>
namespace cg = cooperative_groups;

constexpr int NWAVES = 8;
#ifndef MK_ONE_LAUNCH
#define MK_ONE_LAUNCH 1
#endif
constexpr int BATCH = 2, SEQ = 16384, T = BATCH * SEQ, DM = 2048, INW = 10240, DFF = 8192, PLE = 256;
constexpr int NH8 = 8;
constexpr float NORM_EPS = 1e-6f;
constexpr float LAMBDA_INIT = 0.2f;
constexpr int NPHASE = 19;

constexpr size_t MiB = 1u << 20;
constexpr size_t WS_ROPE = 1 * MiB;
constexpr size_t WS_KMEAN = 3 * MiB;
constexpr size_t WS_CNT = 0, WS_NBLK = 8192, WS_TAB = 65536;
constexpr size_t WS_BAR = 131072, WS_BAR_BYTES = 16384;
constexpr size_t WS_SEL = 4 * MiB;
constexpr int LSTR = 65536 + SEQ;
constexpr size_t WS_ROWL = 986 * MiB, WS_DSTL = 992 * MiB;
constexpr size_t WS_STATS = 1000 * MiB;
constexpr size_t WS_TOP = 1008 * MiB;
constexpr size_t WS_WIN = 8 * MiB, WS_WA = 48 * MiB, WS_WB = 52 * MiB, WS_WOUT = 56 * MiB, WS_WUP = 64 * MiB, WS_WDN = 96 * MiB, WS_WPG = 128 * MiB, WS_WPP = 136 * MiB;
constexpr size_t WS_PB = 138 * MiB;
constexpr size_t WS_XN = 154 * MiB;
constexpr size_t WS_OB = 154 * MiB;
constexpr size_t WS_QKV = 282 * MiB;
constexpr size_t SEC_ELEMS = (size_t)T * 1024;
constexpr size_t WS_SG = 666 * MiB;
constexpr size_t WS_OA = 922 * MiB;
constexpr size_t WS_MIX = 282 * MiB;
constexpr size_t WS_HID = 282 * MiB;
constexpr size_t WS_G3 = 282 * MiB;
constexpr size_t WS_H2 = 554 * MiB;
constexpr size_t WS_XN3 = 410 * MiB;
constexpr size_t WS_Y = 794 * MiB;
constexpr size_t WS_END = 986 * MiB;
static_assert(WS_HID + (size_t)T * DFF * 2 <= WS_Y && WS_Y + (size_t)T * DM * 2 <= WS_OA && WS_OA + (size_t)T * 1024 * 2 == WS_END, "ws map");

constexpr int RING_BYTES = 131072, LDS_BYTES = 147456;

#define GAS __attribute__((address_space(1)))
#define LAS __attribute__((address_space(3)))
typedef unsigned short bf16;
typedef unsigned v4u __attribute__((ext_vector_type(4)));
typedef unsigned v2u __attribute__((ext_vector_type(2)));
typedef float f32x4 __attribute__((ext_vector_type(4)));
#define LDS_WAIT() asm volatile("s_waitcnt lgkmcnt(0)" ::: "memory")
__device__ __forceinline__ unsigned f2bf(float f) { unsigned u = __builtin_bit_cast(unsigned, f); return (u + 0x7fffu + ((u >> 16) & 1u)) >> 16; }
__device__ __forceinline__ unsigned pk2(float lo, float hi) { return f2bf(lo) | (f2bf(hi) << 16); }
__device__ __forceinline__ float bflo(unsigned w) { return __uint_as_float(w << 16); }
__device__ __forceinline__ float bfhi(unsigned w) { return __uint_as_float(w & 0xffff0000u); }
__device__ __forceinline__ float wave_sum(float v) {
#pragma unroll
    for (int o = 1; o < 64; o <<= 1) v += __shfl_xor(v, o);
    return v;
}
template <class Tv> __device__ __forceinline__ Tv ntload(const Tv* p) { return __builtin_nontemporal_load(p); }
template <class Tv> __device__ __forceinline__ void ntstore(Tv v, Tv* p) { __builtin_nontemporal_store(v, p); }
__device__ __forceinline__ float sigmoidf_(float x) { return __builtin_amdgcn_rcpf(1.0f + __expf(-x)); }

namespace pg8 {
template <int MODE> struct EpiT {
    static constexpr bool PERM = true, AFTER_DRAIN = false;
    bf16_t* O; int ldo; const bf16_t* G; int ldg;
    __device__ __forceinline__ void operator()(const f32x4 (&acc)[2][2][4][2], const Unit& u, int wr, int wc, int fr, int fq) const {
        const int row0 = u.pm * BM + wr * 64 + fr, col0 = u.pn * BM + wc * 32 + 8 * fq;
#pragma unroll
        for (int ai = 0; ai < 2; ++ai)
#pragma unroll
            for (int m = 0; m < 4; ++m) { const size_t r = (size_t)(row0 + ai * HALF + m * 16);
#pragma unroll
                for (int bj = 0; bj < 2; ++bj) { f32x4 v0 = acc[ai][bj][m][0], v1 = acc[ai][bj][m][1]; const int c = col0 + bj * HALF;
                    if (MODE == 1) {
#pragma unroll
                        for (int e = 0; e < 4; ++e) { float a = fmaxf(v0[e], 0.f), b = fmaxf(v1[e], 0.f); v0[e] = a * a; v1[e] = b * b; } }
                    if (MODE == 2) {
#pragma unroll
                        for (int e = 0; e < 4; ++e) { v0[e] = sigmoidf_(v0[e]); v1[e] = sigmoidf_(v1[e]); } }
                    if (MODE == 3 || MODE == 4) { const u32x4 g = *(const u32x4*)(G + r * ldg + c);
                        v0[0] *= bflo(g.x); v0[1] *= bfhi(g.x); v0[2] *= bflo(g.y); v0[3] *= bfhi(g.y); v1[0] *= bflo(g.z); v1[1] *= bfhi(g.z); v1[2] *= bflo(g.w); v1[3] *= bfhi(g.w); }
                    if (MODE == 4) { const u32x4 g = *(const u32x4*)(O + r * ldo + c);
                        v0[0] += bflo(g.x); v0[1] += bfhi(g.x); v0[2] += bflo(g.y); v0[3] += bfhi(g.y); v1[0] += bflo(g.z); v1[1] += bfhi(g.z); v1[2] += bflo(g.w); v1[3] += bfhi(g.w); }
                    u32x4 w; w.x = cvt_pk_bf16(v0[0], v0[1]); w.y = cvt_pk_bf16(v0[2], v0[3]); w.z = cvt_pk_bf16(v1[0], v1[1]); w.w = cvt_pk_bf16(v1[2], v1[3]);
                    *(u32x4*)(O + r * ldo + c) = w; } }
    }
};
struct EpiGate2 {
    static constexpr bool PERM = true, AFTER_DRAIN = false; static constexpr int MID_T = 16;
    bf16_t* O; const bf16_t* SGp;
    __device__ __forceinline__ void mid(f32x4 (&acc)[2][2][4][2], const Unit& u, int wr, int wc, int fr, int fq) const {
        int row0 = u.pm * BM + wr * 64 + fr; const int col0 = u.pn * BM + wc * 32 + 8 * fq;
        asm volatile("" : "+v"(row0));
        const bf16_t* gp = SGp + (size_t)row0 * 4096 + col0;
#pragma unroll
        for (int ai = 0; ai < 2; ++ai)
#pragma unroll
            for (int m = 0; m < 4; ++m) { const int ro = (ai * HALF + m * 16) * 4096;
#pragma unroll
                for (int bj = 0; bj < 2; ++bj) { const u32x4 a = *(const u32x4*)(gp + ro + bj * HALF), b = *(const u32x4*)(gp + ro + bj * HALF + 2048);
                    f32x4& v0 = acc[ai][bj][m][0]; f32x4& v1 = acc[ai][bj][m][1];
                    v0[0] *= bflo(a.x) * __builtin_amdgcn_rcpf(bflo(b.x)); v0[1] *= bfhi(a.x) * __builtin_amdgcn_rcpf(bfhi(b.x)); v0[2] *= bflo(a.y) * __builtin_amdgcn_rcpf(bflo(b.y)); v0[3] *= bfhi(a.y) * __builtin_amdgcn_rcpf(bfhi(b.y));
                    v1[0] *= bflo(a.z) * __builtin_amdgcn_rcpf(bflo(b.z)); v1[1] *= bfhi(a.z) * __builtin_amdgcn_rcpf(bfhi(b.z)); v1[2] *= bflo(a.w) * __builtin_amdgcn_rcpf(bflo(b.w)); v1[3] *= bfhi(a.w) * __builtin_amdgcn_rcpf(bfhi(b.w)); }
                if (m == 3) asm volatile("" ::: "memory"); }
    }
    __device__ __forceinline__ void operator()(const f32x4 (&acc)[2][2][4][2], const Unit& u, int wr, int wc, int fr, int fq) const {
        int row0 = u.pm * BM + wr * 64 + fr; const int col0 = u.pn * BM + wc * 32 + 8 * fq;
        asm volatile("" : "+v"(row0));
        const bf16_t* gp = SGp + (size_t)row0 * 4096 + 2048 + col0; bf16_t* op = O + (size_t)row0 * 2048 + col0;
#pragma unroll
        for (int ai = 0; ai < 2; ++ai)
#pragma unroll
            for (int m = 0; m < 4; ++m) { const int rr = ai * HALF + m * 16;
#pragma unroll
                for (int bj = 0; bj < 2; ++bj) { const u32x4 b = *(const u32x4*)(gp + rr * 4096 + bj * HALF); const f32x4 v0 = acc[ai][bj][m][0], v1 = acc[ai][bj][m][1];
                    u32x4 w; w.x = cvt_pk_bf16(v0[0] * bflo(b.x), v0[1] * bfhi(b.x)); w.y = cvt_pk_bf16(v0[2] * bflo(b.y), v0[3] * bfhi(b.y)); w.z = cvt_pk_bf16(v1[0] * bflo(b.z), v1[1] * bfhi(b.z)); w.w = cvt_pk_bf16(v1[2] * bflo(b.w), v1[3] * bfhi(b.w));
                    *(u32x4*)(op + rr * 2048 + bj * HALF) = w; } }
    }
};
struct EpiPle {
    static constexpr bool PERM = true, AFTER_DRAIN = false; static constexpr int MID_T = 32;
    bf16_t* O; bf16_t* Gp;
    __device__ __forceinline__ void mid(f32x4 (&acc)[2][2][4][2], const Unit& u, int wr, int wc, int fr, int fq) const {
        int row0 = u.pm * BM + wr * 64 + fr; const int col0 = u.pn * BM + wc * 32 + 8 * fq;
        asm volatile("" : "+v"(row0));
        bf16_t* gp = Gp + (size_t)row0 * 2048 + col0;
#pragma unroll
        for (int ai = 0; ai < 2; ++ai)
#pragma unroll
            for (int m = 0; m < 4; ++m) { const int rr = ai * HALF + m * 16;
#pragma unroll
                for (int bj = 0; bj < 2; ++bj) { f32x4& v0 = acc[ai][bj][m][0]; f32x4& v1 = acc[ai][bj][m][1];
                    u32x4 w; w.x = cvt_pk_bf16(sigmoidf_(v0[0]), sigmoidf_(v0[1])); w.y = cvt_pk_bf16(sigmoidf_(v0[2]), sigmoidf_(v0[3])); w.z = cvt_pk_bf16(sigmoidf_(v1[0]), sigmoidf_(v1[1])); w.w = cvt_pk_bf16(sigmoidf_(v1[2]), sigmoidf_(v1[3]));
                    *(u32x4*)(gp + rr * 2048 + bj * HALF) = w; v0 = (f32x4){0.f, 0.f, 0.f, 0.f}; v1 = (f32x4){0.f, 0.f, 0.f, 0.f}; } }
    }
    __device__ __forceinline__ void operator()(const f32x4 (&acc)[2][2][4][2], const Unit& u, int wr, int wc, int fr, int fq) const {
        int row0 = u.pm * BM + wr * 64 + fr; const int col0 = u.pn * BM + wc * 32 + 8 * fq;
        asm volatile("" : "+v"(row0));
        const bf16_t* gp = Gp + (size_t)row0 * 2048 + col0; bf16_t* op = O + (size_t)row0 * 2048 + col0;
#pragma unroll
        for (int ai = 0; ai < 2; ++ai)
#pragma unroll
            for (int m = 0; m < 4; ++m) { const int rr = ai * HALF + m * 16;
#pragma unroll
                for (int bj = 0; bj < 2; ++bj) { const u32x4 b = *(const u32x4*)(gp + rr * 2048 + bj * HALF); const f32x4 v0 = acc[ai][bj][m][0], v1 = acc[ai][bj][m][1];
                    u32x4 w; w.x = cvt_pk_bf16(v0[0] * bflo(b.x), v0[1] * bfhi(b.x)); w.y = cvt_pk_bf16(v0[2] * bflo(b.y), v0[3] * bfhi(b.y)); w.z = cvt_pk_bf16(v1[0] * bflo(b.z), v1[1] * bfhi(b.z)); w.w = cvt_pk_bf16(v1[2] * bflo(b.w), v1[3] * bfhi(b.w));
                    *(u32x4*)(op + rr * 2048 + bj * HALF) = w; } }
    }
};
struct EpiInProj {
    static constexpr bool PERM = false, AFTER_DRAIN = false;
    bf16_t* QKV; bf16_t* SG; const float* rope; float* km;
    __device__ __forceinline__ void operator()(const f32x4 (&acc)[2][2][4][2], const Unit& u, int wr, int wc, int fr, int fq) const {
        typedef unsigned u32x2 __attribute__((ext_vector_type(2)));
        const int pn = u.pn, row0 = u.pm * BM + wr * 64 + fr;
        if (pn < 24) {
            const int sec = pn >> 2; const bool rot = (sec != 2) && (sec != 5) && (wc == 0);
            const int b = (u.pm * BM) / SEQ;
            f32x4 ks[2][2] = {{(f32x4){0.f, 0.f, 0.f, 0.f}, (f32x4){0.f, 0.f, 0.f, 0.f}}, {(f32x4){0.f, 0.f, 0.f, 0.f}, (f32x4){0.f, 0.f, 0.f, 0.f}}};
#pragma unroll
            for (int ai = 0; ai < 2; ++ai)
#pragma unroll
                for (int m = 0; m < 4; ++m) { const int r = row0 + ai * HALF + m * 16, pos = r - b * SEQ;
                    f32x4 cs = (f32x4){1.f, 1.f, 1.f, 1.f}, sn = (f32x4){0.f, 0.f, 0.f, 0.f};
                    if (rot) { cs = *(const f32x4*)(rope + (size_t)pos * 32 + 4 * fq); sn = *(const f32x4*)(rope + (size_t)pos * 32 + 16 + 4 * fq); }
#pragma unroll
                    for (int bj = 0; bj < 2; ++bj) { const int h8 = (pn & 3) * 2 + bj; f32x4 v0 = acc[ai][bj][m][0], v1 = acc[ai][bj][m][1];
                        if (rot) { const f32x4 a = v0 * cs - v1 * sn, bb = v1 * cs + v0 * sn; v0 = a; v1 = bb; }
                        if (sec == 1) { ks[bj][0] += v0; ks[bj][1] += v1; }
                        bf16_t* dst = QKV + (size_t)sec * SEC_ELEMS + ((size_t)(b * NH8 + h8) * SEQ + pos) * 128 + wc * 32 + 4 * fq;
                        u32x2 w0, w1; w0.x = cvt_pk_bf16(v0[0], v0[1]); w0.y = cvt_pk_bf16(v0[2], v0[3]); w1.x = cvt_pk_bf16(v1[0], v1[1]); w1.y = cvt_pk_bf16(v1[2], v1[3]);
                        *(u32x2*)dst = w0; *(u32x2*)(dst + 16) = w1; } }
            if (sec == 1) {
                const int blk = u.pm - b * (SEQ / 256);
#pragma unroll
                for (int bj = 0; bj < 2; ++bj)
#pragma unroll
                    for (int n = 0; n < 2; ++n)
#pragma unroll
                        for (int e = 0; e < 4; ++e) { float v = ks[bj][n][e]; v += __shfl_xor(v, 1); v += __shfl_xor(v, 2); v += __shfl_xor(v, 4); v += __shfl_xor(v, 8);
                            if (fr == 0) atomicAdd(km + ((size_t)((b * NH8 + (pn & 3) * 2 + bj) * 64 + blk)) * 128 + wc * 32 + n * 16 + 4 * fq + e, v * (1.0f / 256.0f)); }
            }
        } else {
            const int col0 = (pn - 24) * BM + wc * 32 + 4 * fq;
#pragma unroll
            for (int ai = 0; ai < 2; ++ai)
#pragma unroll
                for (int m = 0; m < 4; ++m) { bf16_t* rowp = SG + (size_t)(row0 + ai * HALF + m * 16) * 4096 + col0;
#pragma unroll
                    for (int bj = 0; bj < 2; ++bj)
#pragma unroll
                        for (int n = 0; n < 2; ++n) { const f32x4 v = acc[ai][bj][m][n]; u32x2 w; w.x = cvt_pk_bf16(sigmoidf_(v[0]), sigmoidf_(v[1])); w.y = cvt_pk_bf16(sigmoidf_(v[2]), sigmoidf_(v[3]));
                            *(u32x2*)(rowp + bj * HALF + n * 16) = w; } }
        }
    }
};
}

#define XB_TMO      128
#define XB_XCNT(j)  (256  + 64 * (j))
#define XB_XSUB(j)  (1280 + 64 * (j))
#define XB_XGEN(j)  (2304 + 64 * (j))
#define XB_TOP      3328
#define XB_TOPGEN   3392
#define XCD_BAR_WORDS 3456
#define XB_SPIN_CAP (1u << 18)

__device__ __forceinline__ unsigned xb_ld(unsigned* p)              { return __hip_atomic_load(p, __ATOMIC_RELAXED, __HIP_MEMORY_SCOPE_AGENT); }
__device__ __forceinline__ unsigned xb_add(unsigned* p, unsigned v) { return __hip_atomic_fetch_add(p, v, __ATOMIC_RELAXED, __HIP_MEMORY_SCOPE_AGENT); }
__device__ __forceinline__ unsigned xb_xcc_id() { return (unsigned)__builtin_amdgcn_s_getreg((3 << 11) | 20) & 0xFu; }
#define XB_SPIN(cond, bar) do { unsigned _sp = 0; while (cond) { __builtin_amdgcn_s_sleep(1); \
    if ((++_sp & 255u) == 0u) { if (xb_ld(&(bar)[XB_TMO])) break; if (_sp > XB_SPIN_CAP) { atomicAdd(&(bar)[XB_TMO], 1u); break; } } } } while (0)

struct XcdBarrier {
    unsigned* bar; unsigned x;
    volatile LAS unsigned* st;
};

__device__ __forceinline__ XcdBarrier xcd_barrier_post(unsigned* bar, volatile LAS unsigned* st) {
    XcdBarrier b; b.bar = bar; b.x = xb_xcc_id(); b.st = st;
    if (threadIdx.x == 0) (void)xb_add(&bar[XB_XCNT(b.x)], 1u);
    return b;
}
__device__ __forceinline__ void xcd_barrier_complete(unsigned* bar, unsigned x, unsigned& nloc, unsigned& nx) {
    const unsigned G = gridDim.x * gridDim.y * gridDim.z;
    unsigned sum, cnt, mine, sp = 0u;
    for (;;) {
        sum = 0u; cnt = 0u; mine = 0u;
#pragma unroll
        for (unsigned j = 0; j < 16; ++j) { const unsigned c = xb_ld(&bar[XB_XCNT(j)]); sum += c; cnt += (c > 0u) ? 1u : 0u; mine = (j == x) ? c : mine; }
        if (sum == G) break;
        __builtin_amdgcn_s_sleep(1);
        if ((++sp & 255u) == 0u) { if (xb_ld(&bar[XB_TMO])) break; if (sp > XB_SPIN_CAP) { atomicAdd(&bar[XB_TMO], 1u); break; } }
    }
    nloc = mine > 0u ? mine : 1u; nx = cnt > 0u ? cnt : 1u;
}

__device__ __forceinline__ void xcd_barrier(const XcdBarrier& b) {
    asm volatile("s_waitcnt vmcnt(0)" ::: "memory");
    __syncthreads();
    if (threadIdx.x == 0) {
        unsigned* bar = b.bar;
        __builtin_amdgcn_s_waitcnt(0);
        unsigned nloc = b.st[0], nx = b.st[1];
        if (nloc == 0u) { xcd_barrier_complete(bar, b.x, nloc, nx); b.st[0] = nloc; b.st[1] = nx; }
        const unsigned old = xb_add(&bar[XB_XSUB(b.x)], 1u);
        const unsigned gen = old / nloc;
        if (old + 1u == (gen + 1u) * nloc) {
            __builtin_amdgcn_fence(__ATOMIC_RELEASE, "agent");
            asm volatile("s_waitcnt vmcnt(0)" ::: "memory");
            const unsigned og = xb_add(&bar[XB_TOP], 1u);
            const unsigned tg = og / nx;
            if (og + 1u == (tg + 1u) * nx) xb_add(&bar[XB_TOPGEN], 1u);
            else XB_SPIN(xb_ld(&bar[XB_TOPGEN]) == tg, bar);
            __builtin_amdgcn_fence(__ATOMIC_ACQUIRE, "agent");
            xb_add(&bar[XB_XGEN(b.x)], 1u);
            asm volatile("s_waitcnt vmcnt(0)" ::: "memory");
        } else {
            XB_SPIN(xb_ld(&bar[XB_XGEN(b.x)]) == gen, bar);
            __builtin_amdgcn_fence(__ATOMIC_ACQUIRE, "agent");
            asm volatile("s_waitcnt vmcnt(0)" ::: "memory");
        }
    }
    __syncthreads();
}

struct Args { const float* in[21]; float* out; unsigned char* ws; int ph_lo, ph_hi, coop, pad; };

__device__ __forceinline__ void p0_transpose_item(const float* W, int K, int N, bf16* WT, LAS float* scr, int item, int lane, int ldt = 0) {
    if (ldt == 0) ldt = K;
    const int nblk = N / 64, kb = item / nblk, nb = item % nblk, k0 = 64 * kb, n0 = 64 * nb;
    const int lr = lane >> 4, lc = (lane & 15) * 4;
    f32x4 v[16];
#pragma unroll
    for (int i = 0; i < 16; ++i) v[i] = ntload((const f32x4*)(W + (size_t)(k0 + 4 * i + lr) * N + n0 + lc));
#pragma unroll
    for (int i = 0; i < 16; ++i) { LAS float* d = scr + (4 * i + lr) * 65 + lc; d[0] = v[i].x; d[1] = v[i].y; d[2] = v[i].z; d[3] = v[i].w; }
    LDS_WAIT(); asm volatile("" ::: "memory");
    const int c = lane & 7;
#pragma unroll
    for (int j = 0; j < 8; ++j) { const int n = (lane >> 3) + 8 * j; const LAS float* sp = scr + (8 * c) * 65 + n;
        v4u o; o.x = pk2(sp[0 * 65], sp[1 * 65]); o.y = pk2(sp[2 * 65], sp[3 * 65]); o.z = pk2(sp[4 * 65], sp[5 * 65]); o.w = pk2(sp[6 * 65], sp[7 * 65]);
        *(GAS v4u*)(WT + (size_t)(n0 + n) * ldt + k0 + 8 * c) = o; }
    LDS_WAIT(); asm volatile("" ::: "memory");
}
__device__ __forceinline__ void rms_row_to_bf16(const float* xrow, const float* g, bf16* orow, int lane) {
    f32x4 v[8]; float s = 0.f;
#pragma unroll
    for (int j = 0; j < 4; ++j) { const float* p = xrow + j * 512 + lane * 8; v[2 * j] = ntload((const f32x4*)p); v[2 * j + 1] = ntload((const f32x4*)(p + 4)); }
#pragma unroll
    for (int j = 0; j < 8; ++j) s += (v[j].x * v[j].x + v[j].y * v[j].y) + (v[j].z * v[j].z + v[j].w * v[j].w);
    const float rstd = 1.0f / sqrtf(wave_sum(s) * (1.f / DM) + NORM_EPS);
#pragma unroll
    for (int j = 0; j < 4; ++j) { const float* gp = g + j * 512 + lane * 8; const f32x4 g0 = *(const f32x4*)gp, g1 = *(const f32x4*)(gp + 4); const f32x4 a = v[2 * j] * rstd * g0, b = v[2 * j + 1] * rstd * g1;
        v4u o; o.x = pk2(a.x, a.y); o.y = pk2(a.z, a.w); o.z = pk2(b.x, b.y); o.w = pk2(b.z, b.w); *(v4u*)(orow + j * 512 + lane * 8) = o; }
}
template <bool BASE_BF, bool OUT_BF>
__device__ __forceinline__ void row_pass(const bf16* Y, const void* basev, const float* gA, void* outv, const float* gB, bf16* xn, int gw, int NGW, int lane, int ldx = DM, const float* pin = nullptr) {
    const float* base = (const float*)basev; const bf16* baseb = (const bf16*)basev; float* outh = (float*)outv; bf16* outb = (bf16*)outv;
    for (int row0 = gw; row0 < T; row0 += 2 * NGW) {
        f32x4 h[2][8]; v4u yw[2][4];
#pragma unroll
        for (int k = 0; k < 2; ++k)
#pragma unroll
            for (int j = 0; j < 4; ++j) { const size_t off = (size_t)(row0 + k * NGW) * DM + j * 512 + lane * 8; yw[k][j] = ntload((const v4u*)(Y + off));
                if constexpr (BASE_BF) { const v4u bw = ntload((const v4u*)(baseb + off)); h[k][2 * j] = (f32x4){bflo(bw.x), bfhi(bw.x), bflo(bw.y), bfhi(bw.y)}; h[k][2 * j + 1] = (f32x4){bflo(bw.z), bfhi(bw.z), bflo(bw.w), bfhi(bw.w)}; }
                else { h[k][2 * j] = ntload((const f32x4*)(base + off)); h[k][2 * j + 1] = ntload((const f32x4*)(base + off + 4)); } }
#pragma unroll
        for (int k = 0; k < 2; ++k) { const int row = row0 + k * NGW;
            f32x4 y[8]; float s = 0.f;
#pragma unroll
            for (int j = 0; j < 4; ++j) { const v4u w = yw[k][j]; y[2 * j] = (f32x4){bflo(w.x), bfhi(w.x), bflo(w.y), bfhi(w.y)}; y[2 * j + 1] = (f32x4){bflo(w.z), bfhi(w.z), bflo(w.w), bfhi(w.w)}; }
#pragma unroll
            for (int j = 0; j < 8; ++j) s += (y[j].x * y[j].x + y[j].y * y[j].y) + (y[j].z * y[j].z + y[j].w * y[j].w);
            const float r1 = 1.0f / sqrtf(wave_sum(s) * (1.f / DM) + NORM_EPS); float s2 = 0.f;
#pragma unroll
            for (int j = 0; j < 4; ++j) { const int c = j * 512 + lane * 8; const f32x4 g0 = *(const f32x4*)(gA + c), g1 = *(const f32x4*)(gA + c + 4);
                h[k][2 * j] = h[k][2 * j] + y[2 * j] * r1 * g0; h[k][2 * j + 1] = h[k][2 * j + 1] + y[2 * j + 1] * r1 * g1;
                if constexpr (OUT_BF) { const f32x4 a = h[k][2 * j], b = h[k][2 * j + 1]; v4u o; o.x = pk2(a.x, a.y); o.y = pk2(a.z, a.w); o.z = pk2(b.x, b.y); o.w = pk2(b.z, b.w); ntstore(o, (v4u*)(outb + (size_t)row * DM + c)); }
                else { ntstore(h[k][2 * j], (f32x4*)(outh + (size_t)row * DM + c)); ntstore(h[k][2 * j + 1], (f32x4*)(outh + (size_t)row * DM + c + 4)); } }
            if (xn) {
#pragma unroll
                for (int j = 0; j < 8; ++j) s2 += (h[k][j].x * h[k][j].x + h[k][j].y * h[k][j].y) + (h[k][j].z * h[k][j].z + h[k][j].w * h[k][j].w);
                const float r2 = 1.0f / sqrtf(wave_sum(s2) * (1.f / DM) + NORM_EPS);
#pragma unroll
                for (int j = 0; j < 4; ++j) { const int c = j * 512 + lane * 8; const f32x4 g0 = *(const f32x4*)(gB + c), g1 = *(const f32x4*)(gB + c + 4); const f32x4 a = h[k][2 * j] * r2 * g0, b = h[k][2 * j + 1] * r2 * g1;
                    v4u o; o.x = pk2(a.x, a.y); o.y = pk2(a.z, a.w); o.z = pk2(b.x, b.y); o.w = pk2(b.z, b.w); *(v4u*)(xn + (size_t)row * ldx + c) = o; }
                if (pin) { const f32x4 pv = *(const f32x4*)(pin + (size_t)row * PLE + lane * 4); v2u o; o.x = pk2(pv.x, pv.y); o.y = pk2(pv.z, pv.w); *(v2u*)(xn + (size_t)row * ldx + DM + lane * 4) = o; }
            }
        }
    }
}

typedef swa::BlockRef<swa::bf16, swa::bf16> ABlock;
__device__ __forceinline__ ABlock attn_ref(int head, int qb, unsigned char* ws, float* dout) {
    const swa::bf16* QKVs = (const swa::bf16*)(ws + WS_QKV); ABlock r;
    const int b = head >> 4, hd = (head >> 2) & 3, c = (head >> 1) & 1, j = head & 1; const int sh = b * NH8 + hd * 2 + c, vh = b * NH8 + hd * 2 + j;
    r.Q = QKVs + 3 * SEC_ELEMS + ((size_t)sh * SEQ + (size_t)qb * 256) * 128; r.K = QKVs + 4 * SEC_ELEMS + (size_t)sh * SEQ * 128; r.V = QKVs + 5 * SEC_ELEMS + (size_t)vh * SEQ * 128;
    r.O = (swa::bf16*)dout + ((size_t)b * SEQ + (size_t)qb * 256) * 4096 + hd * 512 + c * 256 + j * 128;
    r.ldo = 4096; r.rows = nullptr; r.dst = nullptr; r.stat = nullptr; r.P0 = qb * 256;
    return r;
}
constexpr int MOBA_PER = 320, MOBA_ITEMS = 16 * MOBA_PER;
__device__ __forceinline__ bool moba_valid(int L, const int* nblk) { const int bh = L / MOBA_PER, k = L - bh * MOBA_PER; return k >= 256 || k < nblk[bh]; }
__device__ __forceinline__ int moba_next(int L, int G, const int* nblk) { do { L += G; } while (L < MOBA_ITEMS && !moba_valid(L, nblk)); return L; }
__device__ __forceinline__ ABlock moba_ref(int L, unsigned char* ws, float* dout) {
    const swa::bf16* QKVs = (const swa::bf16*)(ws + WS_QKV); ABlock r;
    const int bh = L / MOBA_PER, k = L - bh * MOBA_PER; int j, lp, p0;
    if (k < 256) { const int2 t = ((const int2*)(ws + WS_TAB))[bh * 256 + k]; j = t.x; lp = t.y; p0 = 256; } else { j = k - 256; lp = 65536 + j * 256; p0 = 0; }
    r.Q = QKVs + (size_t)bh * SEQ * 128; r.K = QKVs + 1 * SEC_ELEMS + ((size_t)bh * SEQ + (size_t)j * 256) * 128; r.V = QKVs + 2 * SEC_ELEMS + ((size_t)bh * SEQ + (size_t)j * 256) * 128;
    r.O = (swa::bf16*)dout; r.ldo = 128; r.rows = (const int*)(ws + WS_ROWL) + (size_t)bh * LSTR + lp; r.dst = (const int*)(ws + WS_DSTL) + (size_t)bh * LSTR + lp; r.stat = (float*)(ws + WS_STATS); r.P0 = p0;
    return r;
}

__global__ void __launch_bounds__(NWAVES * 64, 2) mk_fwd(Args args) {
    extern __shared__ __attribute__((aligned(16))) unsigned char lds[];
    LAS unsigned char* L = (LAS unsigned char*)lds;
    const int tid = threadIdx.x, lane = tid & 63, wave = __builtin_amdgcn_readfirstlane(tid >> 6);
    const int G = gridDim.x, bx = blockIdx.x;
    const int vcu = (G % 8 == 0) ? (bx % 8) * (G / 8) + bx / 8 : bx;
    const int gw = vcu * NWAVES + wave, NGW = G * NWAVES;
    unsigned char* ws = args.ws;
#define x_in (args.in[0])
#define p_in (args.in[1])
#define Win_t ((bf16*)(ws + WS_WIN))
#define Wa_t ((bf16*)(ws + WS_WA))
#define Wb_t ((bf16*)(ws + WS_WB))
#define Wout_t ((bf16*)(ws + WS_WOUT))
#define Wup_t ((bf16*)(ws + WS_WUP))
#define Wdn_t ((bf16*)(ws + WS_WDN))
#define Wpg_t ((bf16*)(ws + WS_WPG))
#define Wpp_t ((bf16*)(ws + WS_WPP))
#define XN ((bf16*)(ws + WS_XN))
#define PB ((bf16*)(ws + WS_PB))
#define QKV ((bf16*)(ws + WS_QKV))
#define SG ((bf16*)(ws + WS_SG))
#define OAB ((bf16*)(ws + WS_XN))
#define MIX ((bf16*)(ws + WS_MIX))
#define HID ((bf16*)(ws + WS_HID))
#define G3 ((bf16*)(ws + WS_G3))
#define Y ((bf16*)(ws + WS_Y))
#define rope ((float*)(ws + WS_ROPE))
#define kmean ((float*)(ws + WS_KMEAN))
#define out (args.out)
    const int lo = args.ph_lo, hi = args.ph_hi;
#define IN(k) (lo <= (k) && (k) < hi)
#define SEAM(k) do { if (IN(k) && IN((k) + 1)) { if (args.coop) { if ((k) == 0) { asm volatile("s_waitcnt vmcnt(0) lgkmcnt(0)" ::: "memory"); cg::this_grid().sync(); } else { xcd_barrier(xbar); } } } } while (0)
    volatile LAS unsigned* bst = (volatile LAS unsigned*)(L + LDS_BYTES - 64);
    if (tid < 2) bst[tid] = 0u;
    __syncthreads();
    XcdBarrier xbar; xbar.bar = (unsigned*)(ws + WS_BAR); xbar.x = 0; xbar.st = bst;
    if (args.coop) xbar = xcd_barrier_post((unsigned*)(ws + WS_BAR), bst);

    if (IN(0)) {
        LAS float* scr = (LAS float*)(L + wave * 16896);
        constexpr int I_IN = (DM / 64) * (INW / 64), I_BR = (1024 / 64) * (DM / 64), I_OUT = (DM / 64) * (DM / 64), I_UP = (DM / 64) * (DFF / 64), I_DN = (DFF / 64) * (DM / 64), I_PP = (PLE / 64) * (DM / 64);
        constexpr int NITEMS = I_IN + 2 * I_BR + I_OUT + I_UP + I_DN + I_OUT + I_PP;
        for (int it = gw; it < NITEMS; it += NGW) {
            int r = it;
            if (r < I_IN) { p0_transpose_item(args.in[2], DM, INW, Win_t, scr, r, lane); continue; } r -= I_IN;
            if (r < I_BR) { p0_transpose_item(args.in[3], 1024, DM, Wa_t, scr, r, lane, 2048); continue; } r -= I_BR;
            if (r < I_BR) { p0_transpose_item(args.in[4], 1024, DM, Wa_t + 1024, scr, r, lane, 2048); continue; } r -= I_BR;
            if (r < I_OUT) { p0_transpose_item(args.in[5], DM, DM, Wout_t, scr, r, lane); continue; } r -= I_OUT;
            if (r < I_UP) { p0_transpose_item(args.in[13], DM, DFF, Wup_t, scr, r, lane); continue; } r -= I_UP;
            if (r < I_DN) { p0_transpose_item(args.in[14], DFF, DM, Wdn_t, scr, r, lane); continue; } r -= I_DN;
            if (r < I_OUT) { p0_transpose_item(args.in[18], DM, DM, Wpg_t, scr, r, lane, DM + PLE); continue; } r -= I_OUT;
            p0_transpose_item(args.in[17], PLE, DM, Wpg_t + DM, scr, r, lane, DM + PLE);
        }
        for (int m = gw; m < T; m += NGW) rms_row_to_bf16(x_in + (size_t)m * DM, args.in[11], XN + (size_t)m * DM, lane);
        if (bx == 0) { for (int i = tid; i < 16 * 64 + 16; i += 512) { if (i < 1024) ((int*)(ws + WS_CNT))[i] = 0; else ((int*)(ws + WS_NBLK))[i - 1024] = 0; } }
        for (int i = bx * 512 + tid; i < 16 * 64 * 128; i += G * 512) kmean[i] = 0.f;
        for (int i = bx * 512 + tid; i < SEQ * 16; i += G * 512) { const int pos = i >> 4, k = i & 15;
            double fr_ = 1.0; for (int j_ = 0; j_ < k; ++j_) fr_ *= 0.4403666026717805;
            const float angf = (float)pos * (float)fr_; const double a = (double)angf;
            const double TWO_PI = 6.283185307179586476925286766559; double q = __builtin_rint(a / TWO_PI); double r = a - q * TWO_PI;
            const double r2 = r * r; double sn = 1.0, cs = 1.0;
            sn = 1.0 - r2 / (22.0 * 23.0); sn = 1.0 - r2 / (20.0 * 21.0) * sn; sn = 1.0 - r2 / (18.0 * 19.0) * sn; sn = 1.0 - r2 / (16.0 * 17.0) * sn; sn = 1.0 - r2 / (14.0 * 15.0) * sn; sn = 1.0 - r2 / (12.0 * 13.0) * sn;
            sn = 1.0 - r2 / (10.0 * 11.0) * sn; sn = 1.0 - r2 / (8.0 * 9.0) * sn; sn = 1.0 - r2 / (6.0 * 7.0) * sn; sn = 1.0 - r2 / (4.0 * 5.0) * sn; sn = 1.0 - r2 / (2.0 * 3.0) * sn; sn = r * sn;
            cs = 1.0 - r2 / (21.0 * 22.0); cs = 1.0 - r2 / (19.0 * 20.0) * cs; cs = 1.0 - r2 / (17.0 * 18.0) * cs; cs = 1.0 - r2 / (15.0 * 16.0) * cs; cs = 1.0 - r2 / (13.0 * 14.0) * cs; cs = 1.0 - r2 / (11.0 * 12.0) * cs;
            cs = 1.0 - r2 / (9.0 * 10.0) * cs; cs = 1.0 - r2 / (7.0 * 8.0) * cs; cs = 1.0 - r2 / (5.0 * 6.0) * cs; cs = 1.0 - r2 / (3.0 * 4.0) * cs; cs = 1.0 - r2 / (1.0 * 2.0) * cs;
            rope[(size_t)pos * 32 + k] = (float)cs; rope[(size_t)pos * 32 + 16 + k] = (float)sn; }
    }
    SEAM(0);
    if (IN(1)) {
        pg8::Gemm g{XN, Win_t, T, INW, DM}; pg8::StaticOrder S; S.init(T, INW, G, bx);
        pg8::EpiInProj E{QKV, SG, (const float*)rope, kmean};
        pg8::gemm_phase<pg8::EpiInProj, pg8::StaticOrder, true, true>(L, g, S, E);
    }
    SEAM(1);
    if (IN(3)) {
        char* Kl = (char*)lds;
        const int lane_ = tid & 63, r32 = lane_ & 31, hi = lane_ >> 5;
        const int sr = tid >> 4, sc = (tid & 15) * 8, kws = KSWZ(sr, sc * 2);
        int bh_loaded = -1;
        for (int u = vcu; u < 16 * 64; u += G) {
            const int bh = u & 15, qb = u >> 4;
            if (bh != bh_loaded) {
                __syncthreads();
#pragma unroll
                for (int h2 = 0; h2 < 2; ++h2) { const float* kp = kmean + ((size_t)bh * 64 + sr + 32 * h2) * 128 + sc; const f32x4 a = *(const f32x4*)kp, b = *(const f32x4*)(kp + 4);
                    const float v[8] = {a.x, a.y, a.z, a.w, b.x, b.y, b.z, b.w}; unsigned hb[8], lb[8];
#pragma unroll
                    for (int e = 0; e < 8; ++e) { hb[e] = f2bf(v[e]); lb[e] = f2bf(v[e] - __uint_as_float(hb[e] << 16)); }
                    v4u wh, wl; wh.x = hb[0] | (hb[1] << 16); wh.y = hb[2] | (hb[3] << 16); wh.z = hb[4] | (hb[5] << 16); wh.w = hb[6] | (hb[7] << 16);
                    wl.x = lb[0] | (lb[1] << 16); wl.y = lb[2] | (lb[3] << 16); wl.z = lb[4] | (lb[5] << 16); wl.w = lb[6] | (lb[7] << 16);
                    *(v4u*)(Kl + kws + h2 * 32 * 256) = wh; *(v4u*)(Kl + swa::SHM_K + kws + h2 * 32 * 256) = wl; }
                __syncthreads();
                bh_loaded = bh;
            }
            const int row = wave * 32 + r32;
            swa::bf16x8 qr[8];
            { const swa::bf16* qp = (const swa::bf16*)QKV + ((size_t)bh * SEQ + (size_t)qb * 256 + row) * 128 + hi * 8;
#pragma unroll
              for (int d0 = 0; d0 < 8; ++d0) qr[d0] = swa::load8<swa::bf16>(qp + d0 * 16); }
            swa::f32x16 ph0, ph1, pl0, pl1;
            swa::qkt_r<0>(ph0, ph1, Kl, r32, hi, qr); swa::qkt_r<1>(pl0, pl1, Kl, r32, hi, qr);
            float g0 = -__builtin_inff(), g1 = g0, g2 = g0; int i0 = -1, i1 = -1, i2 = -1;
#define INS3(gv, iv) do { const float g_ = (gv); const int i_ = (iv); if (g_ > g0) { g2 = g1; i2 = i1; g1 = g0; i1 = i0; g0 = g_; i0 = i_; } else if (g_ > g1) { g2 = g1; i2 = i1; g1 = g_; i1 = i_; } else if (g_ > g2) { g2 = g_; i2 = i_; } } while (0)
#pragma unroll
            for (int r = 0; r < 16; ++r) { const int n = swa::crow(r, hi); if (n < qb) INS3(ph0[r] + pl0[r], n); }
#pragma unroll
            for (int r = 0; r < 16; ++r) { const int n = 32 + swa::crow(r, hi); if (n < qb) INS3(ph1[r] + pl1[r], n); }
            { const float pg0 = __shfl_xor(g0, 32), pg1 = __shfl_xor(g1, 32), pg2 = __shfl_xor(g2, 32); const int pi0 = __shfl_xor(i0, 32), pi1 = __shfl_xor(i1, 32), pi2 = __shfl_xor(i2, 32);
              INS3(pg0, pi0); INS3(pg1, pi1); INS3(pg2, pi2); }
#undef INS3
            if (hi == 0) {
                const int grow = qb * 256 + row; int s0 = -1, s1 = -1, s2 = -1; int* cnt = (int*)(ws + WS_CNT) + bh * 64; float2* stt = (float2*)(ws + WS_STATS);
                float2 none; none.x = -1e30f; none.y = 0.f;
                if (i0 >= 0) s0 = atomicAdd(cnt + i0, 1); else stt[(size_t)(bh * 4 + 0) * SEQ + grow] = none;
                if (i1 >= 0) s1 = atomicAdd(cnt + i1, 1); else stt[(size_t)(bh * 4 + 1) * SEQ + grow] = none;
                if (i2 >= 0) s2 = atomicAdd(cnt + i2, 1); else stt[(size_t)(bh * 4 + 2) * SEQ + grow] = none;
                int4 rec; rec.x = (i0 & 255) | ((i1 & 255) << 8) | ((i2 & 255) << 16); rec.y = s0; rec.z = s1; rec.w = s2;
                ((int4*)(ws + WS_SEL))[(size_t)bh * SEQ + grow] = rec; }
        }
        __syncthreads();
    }
    SEAM(3);
    if (IN(4)) {
        LAS int* cn = (LAS int*)L; LAS int* offs = cn + 64;
        int* ROWL = (int*)(ws + WS_ROWL); int* DSTL = (int*)(ws + WS_DSTL);
        for (int u = vcu; u < 16 * 64; u += G) {
            const int bh = u & 15, chunk = u >> 4;
            __syncthreads();
            if (tid < 64) cn[tid] = ((const int*)(ws + WS_CNT))[bh * 64 + tid];
            __syncthreads();
            if (tid == 0) { int a = 0; for (int j = 0; j < 64; ++j) { offs[j] = a; a += (cn[j] + 255) & ~255; } offs[64] = a; }
            __syncthreads();
            int* rl = ROWL + (size_t)bh * LSTR; int* dl = DSTL + (size_t)bh * LSTR;
            if (tid < 256) { const int row = chunk * 256 + tid; const int4 rec = ((const int4*)(ws + WS_SEL))[(size_t)bh * SEQ + row];
                const int j0 = rec.x & 255, j1 = (rec.x >> 8) & 255, j2 = (rec.x >> 16) & 255;
                if (j0 != 255) { const int gp = offs[j0] + rec.y; rl[gp] = row; dl[gp] = (bh * 4 + 0) * SEQ + row; }
                if (j1 != 255) { const int gp = offs[j1] + rec.z; rl[gp] = row; dl[gp] = (bh * 4 + 1) * SEQ + row; }
                if (j2 != 255) { const int gp = offs[j2] + rec.w; rl[gp] = row; dl[gp] = (bh * 4 + 2) * SEQ + row; }
                rl[65536 + row] = row; dl[65536 + row] = (bh * 4 + 3) * SEQ + row; }
            if (chunk == 0) {
                for (int idx = tid; idx < 64 * 256; idx += 512) { const int j = idx >> 8, c = cn[j], pos = c + (idx & 255);
                    if (pos < ((c + 255) & ~255)) { rl[offs[j] + pos] = 0; dl[offs[j] + pos] = -1; } }
                if (tid == 0) { int k = 0; int2* tab = (int2*)(ws + WS_TAB) + bh * 256;
                    for (int j = 0; j < 64; ++j) { const int nb = (cn[j] + 255) >> 8; for (int b_ = 0; b_ < nb; ++b_) { if (k < 256) { int2 t; t.x = j; t.y = offs[j] + 256 * b_; tab[k] = t; } ++k; } }
                    ((int*)(ws + WS_NBLK))[bh] = k < 256 ? k : 256; }
            }
        }
        __syncthreads();
    }
    SEAM(4);
    if (IN(5)) {
        const int* nblk = (const int*)(ws + WS_NBLK);
        static_assert(swa::MOBA_LDS_BYTES <= LDS_BYTES - 64, "MoBA short-block LDS");
        int Lc = vcu; if (!moba_valid(Lc, nblk)) Lc = moba_next(Lc, G, nblk);
        if (Lc < MOBA_ITEMS) {
            ABlock cur = moba_ref(Lc, ws, out); swa::MobaStage ST; swa::moba_prime(cur, ST);
            for (;;) { const int Ln = moba_next(Lc, G, nblk); const bool has_next = Ln < MOBA_ITEMS;
                ABlock nxt = cur; if (has_next) nxt = moba_ref(Ln, ws, out);
                swa::moba_block(cur, nxt, has_next, (char*)lds, ST);
                if (!has_next) break;
                cur = nxt; Lc = Ln; }
        }
        __syncthreads();
    }
    SEAM(5);
    if (IN(6)) {
        const float2* stt = (const float2*)(ws + WS_STATS); const bf16* PART = (const bf16*)out; constexpr float C2 = 1.4426950408889634f * 0.08838834764831845f;
        for (int u0 = gw; u0 < 16 * SEQ; u0 += 4 * NGW) {
            float2 st[4][4]; unsigned pw[4][4];
#pragma unroll
            for (int k = 0; k < 4; ++k) { const int u = u0 + k * NGW, bh = u >> 14, row = u & (SEQ - 1);
#pragma unroll
                for (int s_ = 0; s_ < 4; ++s_) { const size_t di = (size_t)(bh * 4 + s_) * SEQ + row; st[k][s_] = stt[di]; pw[k][s_] = ntload((const unsigned*)(PART + di * 128 + lane * 2)); } }
#pragma unroll
            for (int k = 0; k < 4; ++k) { const int u = u0 + k * NGW, bh = u >> 14, row = u & (SEQ - 1);
                float M = -1e30f;
#pragma unroll
                for (int s_ = 0; s_ < 4; ++s_) if (st[k][s_].y > 0.f) M = fmaxf(M, st[k][s_].x);
                float a0 = 0.f, a1 = 0.f, den = 0.f;
#pragma unroll
                for (int s_ = 0; s_ < 4; ++s_) { const bool ok = st[k][s_].y > 0.f; const float w = ok ? st[k][s_].y * __builtin_amdgcn_exp2f((st[k][s_].x - M) * C2) : 0.f;
                    a0 += ok ? w * bflo(pw[k][s_]) : 0.f; a1 += ok ? w * bfhi(pw[k][s_]) : 0.f; den += w; }
                const float inv = 1.0f / den;
                *(unsigned*)(OAB + ((size_t)(bh >> 3) * SEQ + row) * 2048 + (bh & 7) * 128 + lane * 2) = pk2(a0 * inv, a1 * inv); } }
    }
    SEAM(6);
    if (IN(7)) {
        constexpr int NITEM = 32 * 32;
        int Lc = vcu;
        if (Lc < NITEM) {
            int head = Lc >> 5, xx = Lc & 31, pass = 0;
            ABlock cur = attn_ref(head, xx, ws, out);
            swa::Seam<swa::bf16> S;
            swa::causal_swa_prime<swa::bf16, swa::bf16>(cur, SEQ, (char*)lds, S);
            for (;;) {
                const bool more_pass = pass == 0, more_item = Lc + G < NITEM, last = !more_pass && !more_item;
                int headn = head, xn = xx, passn = pass + 1, Ln = Lc;
                if (!more_pass) { passn = 0; Ln = more_item ? Lc + G : Lc; headn = Ln >> 5; xn = Ln & 31; }
                const int qbn = passn ? 63 - xn : xn;
                ABlock nxt = cur;
                if (!last) nxt = attn_ref(headn, qbn, ws, out);
                swa::causal_swa_block<swa::bf16, swa::bf16>(cur, nxt, SEQ, SEQ, (char*)lds, S);
                if (last) break;
                cur = nxt; head = headn; xx = xn; pass = passn; Lc = Ln;
            }
        }
        __syncthreads();
    }
    SEAM(7);
    if (IN(8)) {
        float lam;
        { const float* q1 = args.in[6]; const float* k1 = args.in[7]; const float* q2 = args.in[8]; const float* k2 = args.in[9];
          const float s1 = wave_sum(q1[lane] * k1[lane] + q1[lane + 64] * k1[lane + 64]), s2 = wave_sum(q2[lane] * k2[lane] + q2[lane + 64] * k2[lane + 64]);
          lam = __expf(s1) - __expf(s2) + LAMBDA_INIT; }
        const bf16* AD = (const bf16*)out; const float* sg = args.in[10];
        const f32x4 gg = *(const f32x4*)(sg + lane * 4);
        for (int u0 = gw; u0 < T * 4; u0 += 4 * NGW) {
            v2u w0[4], w1[4];
#pragma unroll
            for (int k = 0; k < 4; ++k) { const int u = u0 + k * NGW, t = u >> 2, hd = u & 3; const bf16* a = AD + (size_t)t * 4096 + hd * 512 + lane * 4; w0[k] = ntload((const v2u*)a); w1[k] = ntload((const v2u*)(a + 256)); }
#pragma unroll
            for (int k = 0; k < 4; ++k) { const int u = u0 + k * NGW, t = u >> 2, hd = u & 3;
                f32x4 d; d.x = bflo(w0[k].x) - lam * bflo(w1[k].x); d.y = bfhi(w0[k].x) - lam * bfhi(w1[k].x); d.z = bflo(w0[k].y) - lam * bflo(w1[k].y); d.w = bfhi(w0[k].y) - lam * bfhi(w1[k].y);
                const float ss = wave_sum((d.x * d.x + d.y * d.y) + (d.z * d.z + d.w * d.w));
                const float r = (1.0f - LAMBDA_INIT) / sqrtf(ss * (1.f / 256.f) + NORM_EPS);
                v2u o; o.x = pk2(d.x * r * gg.x, d.y * r * gg.y); o.y = pk2(d.z * r * gg.z, d.w * r * gg.w);
                *(v2u*)(OAB + (size_t)t * 2048 + 1024 + hd * 256 + lane * 4) = o; } }
    }
    SEAM(8);
    if (IN(9)) { pg8::Gemm g{OAB, Wa_t, T, DM, 2048}; pg8::StaticOrder S; S.init(T, DM, G, bx); pg8::EpiGate2 E{MIX, SG};
        pg8::gemm_phase<pg8::EpiGate2, pg8::StaticOrder, true, true, true>(L, g, S, E); }
    SEAM(9);
    if (IN(11)) { pg8::Gemm g{MIX, Wout_t, T, DM, DM}; pg8::StaticOrder S; S.init(T, DM, G, bx); pg8::EpiT<0> E{Y, DM, nullptr, 0};
        pg8::gemm_phase<pg8::EpiT<0>, pg8::StaticOrder, true, true>(L, g, S, E); }
    SEAM(11);
    if (IN(12)) row_pass<false, true>(Y, x_in, args.in[12], out, args.in[15], XN, gw, NGW, lane);
    SEAM(12);
    if (IN(13)) { pg8::Gemm g{XN, Wup_t, T, DFF, DM}; pg8::StaticOrder S; S.init(T, DFF, G, bx); pg8::EpiT<1> E{HID, DFF, nullptr, 0};
        pg8::gemm_phase<pg8::EpiT<1>, pg8::StaticOrder, true, true>(L, g, S, E); }
    SEAM(13);
    if (IN(14)) { pg8::Gemm g{HID, Wdn_t, T, DM, DFF}; pg8::StaticOrder S; S.init(T, DM, G, bx); pg8::EpiT<0> E{Y, DM, nullptr, 0};
        pg8::gemm_phase<pg8::EpiT<0>, pg8::StaticOrder, true, true>(L, g, S, E); }
    SEAM(14);
    if (IN(15)) row_pass<true, true>(Y, out, args.in[16], ws + WS_H2, args.in[19], (bf16*)(ws + WS_XN3), gw, NGW, lane, DM + PLE, p_in);
    SEAM(15);
    if (IN(16)) { pg8::Gemm g{(bf16*)(ws + WS_XN3), Wpg_t, T, DM, DM + PLE}; pg8::StaticOrder S; S.init(T, DM, G, bx); pg8::EpiPle E{Y, G3};
        pg8::gemm_phase<pg8::EpiPle, pg8::StaticOrder, true, true, true>(L, g, S, E); }
    SEAM(17);
    if (IN(18)) row_pass<true, false>(Y, ws + WS_H2, args.in[20], out, nullptr, nullptr, gw, NGW, lane);
#undef IN
#undef SEAM
#undef x_in
#undef p_in
#undef Win_t
#undef Wa_t
#undef Wb_t
#undef Wout_t
#undef Wup_t
#undef Wdn_t
#undef Wpg_t
#undef Wpp_t
#undef XN
#undef PB
#undef QKV
#undef SG
#undef OAB
#undef MIX
#undef HID
#undef G3
#undef Y
#undef rope
#undef kmean
#undef out
}

extern "C" void kernel_launch(void* const* d_in, const int* in_sizes, int n_in, void* d_out, int out_size, void* d_ws, size_t ws_size, hipStream_t stream) {
    static int grid = 0;
    if (grid == 0) {
        if (n_in != 21 || out_size != T * DM || ws_size < WS_TOP) { fprintf(stderr, "kernel_launch: unexpected shapes n_in %d out %d ws %zu\n", n_in, out_size, ws_size); grid = -1; return; }
        int dev = 0, cus = 0, per_cu = 0;
        (void)hipGetDevice(&dev); (void)hipDeviceGetAttribute(&cus, hipDeviceAttributeMultiprocessorCount, dev);
        if (hipFuncSetAttribute((const void*)mk_fwd, hipFuncAttributeMaxDynamicSharedMemorySize, LDS_BYTES) != hipSuccess) { fprintf(stderr, "kernel_launch: hipFuncSetAttribute failed\n"); grid = -1; return; }
        if (hipOccupancyMaxActiveBlocksPerMultiprocessor(&per_cu, (const void*)mk_fwd, NWAVES * 64, LDS_BYTES) != hipSuccess || per_cu < 1) { fprintf(stderr, "kernel_launch: occupancy query says %d\n", per_cu); per_cu = 1; }
        (void)hipGetLastError();
        grid = cus * 1;
        if (grid <= 0) grid = 256;
    }
    if (grid < 0) return;
    (void)hipMemsetAsync((unsigned char*)d_ws + WS_BAR, 0, WS_BAR_BYTES, stream);
    Args a{};
    for (int i = 0; i < 21; ++i) a.in[i] = (const float*)d_in[i];
    a.out = (float*)d_out; a.ws = (unsigned char*)d_ws;
#if MK_ONE_LAUNCH
    a.ph_lo = 0; a.ph_hi = NPHASE; a.coop = 1;
    void* kargs[] = {&a};
    hipError_t e = hipLaunchCooperativeKernel((const void*)mk_fwd, dim3(grid), dim3(NWAVES * 64), kargs, LDS_BYTES, stream);
    if (e != hipSuccess) fprintf(stderr, "cooperative launch failed: %s (grid %d)\n", hipGetErrorString(e), grid);
#else
    for (int ph = 0; ph < NPHASE; ++ph) { a.ph_lo = ph; a.ph_hi = ph + 1; a.coop = 0;
        hipLaunchKernelGGL(mk_fwd, dim3(grid), dim3(NWAVES * 64), LDS_BYTES, stream, a); }
#endif
}
```

```cpp
#include <hip/hip_runtime.h>
#include <hip/hip_bf16.h>
#include <cstdio>
#include <cstdint>
#include <cmath>
namespace pg8 {
#define PG8_LAS __attribute__((address_space(3)))
typedef unsigned short bf16_t;
typedef short bf16x8 __attribute__((ext_vector_type(8)));
typedef float f32x4 __attribute__((ext_vector_type(4)));
typedef unsigned u32x4 __attribute__((ext_vector_type(4)));
constexpr int BM = 256, BK = 64, HALF = 128, HTB = HALF * BK * 2  , STAGE_BYTES = 8 * HTB, NXCD = 8, WGM = 8;

__host__ __device__ __forceinline__ int lds_byte(int r, int c) { const int st = (r >> 4) * 2 + (c >> 5), rr = r & 15, cc = c & 31, ob = rr * 64 + cc * 2; return st * 1024 + (ob ^ (((ob >> 9) & 1) << 5)); }
__host__ __device__ __forceinline__ void stage_rc(int b, int& R, int& C) { const int st = b / 1024, sb = b % 1024, swz = sb ^ (((sb >> 9) & 1) << 5); R = (st >> 1) * 16 + swz / 64; C = (st & 1) * 32 + (swz % 64) / 2; }
__host__ __device__ __forceinline__ int perm32(int rho) { const int n = rho >> 4, i = rho & 15; return 8 * (i >> 2) + 4 * n + (i & 3); }

struct Unit { int pm, pn; };
struct Gemm { const bf16_t* A; const bf16_t* Bt; int M, N, K; };

struct StaticOrder {
    int nM, nN, nwg, G, c;
    __host__ __device__ void init(int M, int N, int G_, int c_) { nM = M / BM; nN = N / BM; nwg = nM * nN; G = G_; c = c_; }
    __host__ __device__ bool next(int i, Unit& u) const {
        const long L = (long)i * G + c; if (L >= nwg) return false;
        int wgid = (int)L; { const int q = nwg / NXCD, r = nwg % NXCD, xcd = wgid % NXCD, off = wgid / NXCD; wgid = (xcd < r ? xcd * (q + 1) : r * (q + 1) + (xcd - r) * q) + off; }
        const int nig = WGM * nN, gid = wgid / nig, fm = gid * WGM, gsz = (nM - fm) < WGM ? (nM - fm) : WGM;
        u.pm = fm + ((wgid % nig) % gsz); u.pn = (wgid % nig) / gsz; return true;
    }
    __device__ __forceinline__ void a_ready(const Unit&) const {}
    __device__ __forceinline__ void done(const Unit&) const {}
};

typedef float f32x2_c __attribute__((ext_vector_type(2))); typedef __bf16 bf16x2_c __attribute__((ext_vector_type(2)));
__device__ __forceinline__ unsigned cvt_pk_bf16(float lo, float hi) { f32x2_c v = {lo, hi}; bf16x2_c b = __builtin_convertvector(v, bf16x2_c); return __builtin_bit_cast(unsigned, b); }
typedef float f32x2 __attribute__((ext_vector_type(2)));
__device__ __forceinline__ f32x2 gelu_pk(f32x2 v) {
    const f32x2 av = __builtin_elementwise_abs(v), d = av * 0.2316418882f + 1.0f;
    f32x2 t; t.x = __builtin_amdgcn_rcpf(d.x); t.y = __builtin_amdgcn_rcpf(d.y);
    f32x2 q = t * 0.5307027145f + (-0.7265760135f); q = q * t + 0.7107068705f; q = q * t + (-0.142248368f); q = q * t + 0.127414796f; q = q * t;
    const f32x2 s = (v * v) * (-0.72134752044f);
    f32x2 e; e.x = __builtin_amdgcn_exp2f(s.x); e.y = __builtin_amdgcn_exp2f(s.y);
    const f32x2 m = v * (q * e), r = v - m;
    f32x2 o; o.x = v.x < 0.f ? m.x : r.x; o.y = v.y < 0.f ? m.y : r.y; return o;
}

template <int ACT  > struct EpiBf16 {
    static constexpr bool PERM = true, AFTER_DRAIN = false; static_assert(ACT == 0 || ACT == 1, "EpiBf16: ACT is 0 (none) or 1 (gelu_pk)");
    bf16_t* O; int ldc; const float* bias; int split_cols; size_t split_stride; float scale0;
    __device__ __forceinline__ void operator()(const f32x4 (&acc)[2][2][4][2], const Unit& u, int wr, int wc, int fr, int fq) const {
        const int row0 = u.pm * BM + wr * 64 + fr; int colt = u.pn * BM; bf16_t* base = O;
        float sc = 1.f; if (split_cols) { const int t = colt / split_cols; base += (size_t)t * split_stride; colt -= t * split_cols; if (t == 0) sc = scale0; }
        const int col0 = colt + wc * 32 + 8 * fq, bcol0 = u.pn * BM + wc * 32 + 8 * fq;
        f32x4 bv[2][2];
#pragma unroll
        for (int bj = 0; bj < 2; ++bj)
#pragma unroll
            for (int n = 0; n < 2; ++n) bv[bj][n] = bias ? *(const f32x4*)(bias + bcol0 + bj * HALF + 4 * n) : (f32x4){0.f, 0.f, 0.f, 0.f};
#pragma unroll
        for (int ai = 0; ai < 2; ++ai)
#pragma unroll
            for (int m = 0; m < 4; ++m) { bf16_t* rowp = base + (size_t)(row0 + ai * HALF + m * 16) * ldc + col0;
#pragma unroll
                for (int bj = 0; bj < 2; ++bj) { f32x4 v0 = acc[ai][bj][m][0] + bv[bj][0], v1 = acc[ai][bj][m][1] + bv[bj][1];
                    if (ACT == 1) { f32x2 a = gelu_pk((f32x2){v0[0], v0[1]}), b = gelu_pk((f32x2){v0[2], v0[3]}), c = gelu_pk((f32x2){v1[0], v1[1]}), d = gelu_pk((f32x2){v1[2], v1[3]});
                        v0 = (f32x4){a.x, a.y, b.x, b.y}; v1 = (f32x4){c.x, c.y, d.x, d.y}; }
                    v0 = v0 * sc; v1 = v1 * sc; u32x4 w; w.x = cvt_pk_bf16(v0[0], v0[1]); w.y = cvt_pk_bf16(v0[2], v0[3]); w.z = cvt_pk_bf16(v1[0], v1[1]); w.w = cvt_pk_bf16(v1[2], v1[3]);
                    *(u32x4*)(rowp + bj * HALF) = w; } }
    }
};

template <class Epi, class Sched, bool ALIGN_EPI = false, bool SP2 = false, bool MID = false>
__device__ __forceinline__ void gemm_phase(PG8_LAS unsigned char* lds, const Gemm g, const Sched& S, const Epi& E) {
    const int tid = threadIdx.x, wid = __builtin_amdgcn_readfirstlane(tid >> 6), lane = tid & 63, wr = wid >> 2, wc = wid & 3, fr = lane & 15, fq = lane >> 4;
    const int K = g.K, nt = K / BK;
    unsigned voffA[2], voffB[2];
#pragma unroll
    for (int i = 0; i < 2; ++i) { int R, C; stage_rc(tid * 16 + i * 8192, R, C); const int Rb = Epi::PERM ? ((R & ~31) + perm32(R & 31)) : R;
        voffA[i] = (unsigned)(R * K + C) * 2u; voffB[i] = (unsigned)(Rb * K + C) * 2u; }
    const size_t kstep = (size_t)(BK * 2);
    const size_t hstep = (size_t)HALF * K * 2;
    const size_t tstep = 2 * hstep;
    const unsigned ldsw = (unsigned)wid * 1024u;
    const int aoff = lds_byte(wr * 64 + fr, fq * 8), boff = lds_byte(wc * 32 + fr, fq * 8);
#define PG8_SA(b, h) (((b) * 2 + (h)) * HTB)
#define PG8_SB(b, h) ((4 + (b) * 2 + (h)) * HTB)
#define PG8_STAGE(bufoff, gbase, voff) do { _Pragma("unroll") for (int _i = 0; _i < 2; ++_i) \
        __builtin_amdgcn_global_load_lds((const unsigned*)((const char*)(gbase) + (voff)[_i]), (PG8_LAS unsigned*)(lds + (bufoff) + ldsw + _i * 8192), 16, 0, 0); } while (0)
#define PG8_LDA(dst, b, h) do { _Pragma("unroll") for (int m = 0; m < 4; ++m) _Pragma("unroll") for (int k = 0; k < 2; ++k) dst[m][k] = *(const PG8_LAS bf16x8*)(lds + PG8_SA(b, h) + aoff + m * 2048 + k * 1024); } while (0)
#define PG8_LDB(dst, b, h) do { _Pragma("unroll") for (int n = 0; n < 2; ++n) _Pragma("unroll") for (int k = 0; k < 2; ++k) dst[n][k] = *(const PG8_LAS bf16x8*)(lds + PG8_SB(b, h) + boff + n * 2048 + k * 1024); } while (0)
#define PG8_MMA(ai, bj, At, Bt) do { __builtin_amdgcn_s_setprio(1); _Pragma("unroll") for (int m = 0; m < 4; ++m) _Pragma("unroll") for (int n = 0; n < 2; ++n) _Pragma("unroll") for (int k = 0; k < 2; ++k) \
        acc[ai][bj][m][n] = __builtin_amdgcn_mfma_f32_16x16x32_bf16(Bt[n][k], At[m][k], acc[ai][bj][m][n], 0, 0, 0); __builtin_amdgcn_s_setprio(0); } while (0)
#define PG8_WAIT_V(n) asm volatile("s_waitcnt vmcnt(" #n ")" ::: "memory")
#define PG8_WAIT_L(n) asm volatile("s_waitcnt lgkmcnt(" #n ")" ::: "memory")
#define PG8_BAR __builtin_amdgcn_s_barrier()
#define PG8_SCHED __builtin_amdgcn_sched_barrier(0)
    Unit cur, nxt; int ui = 0;
    if (!S.next(0, cur)) return;
    f32x4 acc[2][2][4][2];
#pragma unroll
    for (int a = 0; a < 2; ++a)
#pragma unroll
        for (int b = 0; b < 2; ++b)
#pragma unroll
            for (int m = 0; m < 4; ++m)
#pragma unroll
                for (int n = 0; n < 2; ++n) acc[a][b][m][n] = (f32x4){0.f, 0.f, 0.f, 0.f};
    bf16x8 At[4][2], B0[2][2], B1[2][2];
    const char* cA = (const char*)g.A + (size_t)cur.pm * tstep; const char* cB = (const char*)g.Bt + (size_t)cur.pn * tstep;
    S.a_ready(cur);
    if constexpr (SP2) {
        PG8_STAGE(PG8_SB(0, 0), cB, voffB); PG8_STAGE(PG8_SB(0, 1), cB + hstep, voffB); PG8_STAGE(PG8_SA(0, 0), cA, voffA); PG8_STAGE(PG8_SA(0, 1), cA + hstep, voffA);
        if (wr == 1) PG8_BAR;
        PG8_WAIT_V(2); PG8_BAR;
        PG8_STAGE(PG8_SB(1, 0), cB + kstep, voffB); PG8_STAGE(PG8_SA(1, 0), cA + kstep, voffA); PG8_STAGE(PG8_SB(1, 1), cB + hstep + kstep, voffB);
        PG8_WAIT_V(6); PG8_BAR;
    } else {
        PG8_STAGE(PG8_SB(0, 0), cB, voffB); PG8_STAGE(PG8_SA(0, 0), cA, voffA); PG8_STAGE(PG8_SB(0, 1), cB + hstep, voffB); PG8_STAGE(PG8_SA(0, 1), cA + hstep, voffA);
        if (wr == 1) PG8_BAR;
        PG8_WAIT_V(4); PG8_BAR;
        PG8_STAGE(PG8_SB(1, 0), cB + kstep, voffB); PG8_STAGE(PG8_SA(1, 0), cA + kstep, voffA); PG8_STAGE(PG8_SB(1, 1), cB + hstep + kstep, voffB);
        PG8_WAIT_V(6); PG8_BAR;
    }
    for (;;) {
        const bool has_next = S.next(ui + 1, nxt);
        const char* nA = has_next ? (const char*)g.A + (size_t)nxt.pm * tstep : cA; const char* nB = has_next ? (const char*)g.Bt + (size_t)nxt.pn * tstep : cB;
        for (int t = 0; t < nt; t += 2) {
            const bool last = (t == nt - 2);
            if constexpr (MID) { if (t == Epi::MID_T) { PG8_SCHED; E.mid(acc, cur, wr, wc, fr, fq); PG8_SCHED; } }
            const char* a1 = cA + (size_t)(t + 1) * kstep;
            const char* a2 = last ? nA : cA + (size_t)(t + 2) * kstep; const char* b2 = last ? nB : cB + (size_t)(t + 2) * kstep;
            const char* a3 = a2 + kstep; const char* b3 = b2 + kstep;
            if (last && has_next) S.a_ready(nxt);
            if constexpr (SP2) {
            PG8_LDB(B0, 0, 0); PG8_LDB(B1, 0, 1); PG8_SCHED; PG8_LDA(At, 0, 0); PG8_STAGE(PG8_SA(1, 1), a1 + hstep, voffA);
            PG8_WAIT_V(8); PG8_WAIT_L(0); PG8_BAR; PG8_MMA(0, 0, At, B0); PG8_MMA(0, 1, At, B1); PG8_BAR; PG8_SCHED;
            PG8_LDA(At, 0, 1); PG8_STAGE(PG8_SB(0, 0), b2, voffB); PG8_STAGE(PG8_SB(0, 1), b2 + hstep, voffB); PG8_STAGE(PG8_SA(0, 0), a2, voffA);
            PG8_WAIT_V(8); PG8_WAIT_L(0); PG8_BAR; PG8_MMA(1, 0, At, B0); PG8_MMA(1, 1, At, B1); PG8_BAR; PG8_SCHED;
            PG8_LDB(B0, 1, 0); PG8_LDB(B1, 1, 1); PG8_SCHED; PG8_LDA(At, 1, 0); PG8_STAGE(PG8_SA(0, 1), a2 + hstep, voffA);
            PG8_WAIT_V(8); PG8_WAIT_L(0); PG8_BAR; PG8_MMA(0, 0, At, B0); PG8_MMA(0, 1, At, B1); PG8_BAR; PG8_SCHED;
            PG8_LDA(At, 1, 1); PG8_STAGE(PG8_SB(1, 0), b3, voffB); PG8_STAGE(PG8_SB(1, 1), b3 + hstep, voffB); PG8_STAGE(PG8_SA(1, 0), a3, voffA);
            PG8_WAIT_V(8); PG8_WAIT_L(0); PG8_BAR; PG8_MMA(1, 0, At, B0); PG8_MMA(1, 1, At, B1); PG8_BAR; PG8_SCHED;
            } else {
            PG8_LDB(B0, 0, 0); PG8_SCHED; PG8_LDA(At, 0, 0); PG8_STAGE(PG8_SA(1, 1), a1 + hstep, voffA);
            PG8_WAIT_L(8); PG8_BAR; PG8_WAIT_L(0); PG8_MMA(0, 0, At, B0); PG8_BAR; PG8_SCHED;
            PG8_LDB(B1, 0, 1); PG8_STAGE(PG8_SB(0, 0), b2, voffB);
            PG8_BAR; PG8_WAIT_L(0); PG8_MMA(0, 1, At, B1); PG8_BAR;
            PG8_LDA(At, 0, 1); PG8_STAGE(PG8_SA(0, 0), a2, voffA);
            PG8_BAR; PG8_WAIT_L(0); PG8_MMA(1, 0, At, B0); PG8_BAR; PG8_SCHED;
            PG8_STAGE(PG8_SB(0, 1), b2 + hstep, voffB);
            PG8_WAIT_V(6); PG8_BAR; PG8_MMA(1, 1, At, B1); PG8_BAR;
            PG8_LDB(B0, 1, 0); PG8_SCHED; PG8_LDA(At, 1, 0); PG8_STAGE(PG8_SA(0, 1), a2 + hstep, voffA);
            PG8_WAIT_L(8); PG8_BAR; PG8_WAIT_L(0); PG8_MMA(0, 0, At, B0); PG8_BAR; PG8_SCHED;
            PG8_LDB(B1, 1, 1); PG8_STAGE(PG8_SB(1, 0), b3, voffB);
            PG8_BAR; PG8_WAIT_L(0); PG8_MMA(0, 1, At, B1); PG8_BAR;
            PG8_LDA(At, 1, 1); PG8_STAGE(PG8_SA(1, 0), a3, voffA);
            PG8_BAR; PG8_WAIT_L(0); PG8_MMA(1, 0, At, B0); PG8_BAR; PG8_SCHED;
            PG8_STAGE(PG8_SB(1, 1), b3 + hstep, voffB);
            PG8_WAIT_V(6); PG8_BAR; PG8_MMA(1, 1, At, B1); PG8_BAR;
            }
        }
        if constexpr (ALIGN_EPI) { if (wr == 0) PG8_BAR; }
        if constexpr (!Epi::AFTER_DRAIN) { E(acc, cur, wr, wc, fr, fq); S.done(cur); }
        if (!has_next) break;
#pragma unroll
        for (int a = 0; a < 2; ++a)
#pragma unroll
            for (int b = 0; b < 2; ++b)
#pragma unroll
                for (int m = 0; m < 4; ++m)
#pragma unroll
                    for (int n = 0; n < 2; ++n) acc[a][b][m][n] = (f32x4){0.f, 0.f, 0.f, 0.f};
        cur = nxt; cA = nA; cB = nB; ++ui;
        if constexpr (ALIGN_EPI) { if (wr == 1) PG8_BAR; }
    }
    PG8_WAIT_V(0);
    if constexpr (!ALIGN_EPI) { if (wr == 0) PG8_BAR; }
    PG8_BAR;
    if constexpr (Epi::AFTER_DRAIN) { E.fused(acc, cur, wr, wc, fr, fq, lds, wid, lane); S.done(cur); }
#undef PG8_SA
#undef PG8_SB
#undef PG8_STAGE
#undef PG8_LDA
#undef PG8_LDB
#undef PG8_MMA
#undef PG8_WAIT_V
#undef PG8_WAIT_L
#undef PG8_BAR
#undef PG8_SCHED
}
}
namespace swa {
constexpr int D = 128;
constexpr float THR = 8.f;
constexpr bool WSKIP = false;
constexpr float SCALE = 0.08838834764831845f;
constexpr int NW = 8, QBLK = 32, KVBLK = 64, QB = NW * QBLK;
constexpr int SHM_V = KVBLK * D * 2, SHM_K = KVBLK * D * 2;
constexpr int MSLOT_OFF = 2 * SHM_V + 2 * SHM_K + NW * 64 * 4, QLDS_OFF = MSLOT_OFF + 4096;
constexpr int LDS_BYTES = QLDS_OFF + NW * 8192;

using bf16 = __hip_bfloat16;
typedef short bf16x8 __attribute__((ext_vector_type(8)));
typedef short s16x4 __attribute__((ext_vector_type(4)));
typedef float f32x16 __attribute__((ext_vector_type(16)));
typedef float f32x4 __attribute__((ext_vector_type(4)));
typedef unsigned u32x4 __attribute__((ext_vector_type(4)));
template <class A, class Bt> struct same_t { static constexpr bool v = false; };
template <class A> struct same_t<A, A> { static constexpr bool v = true; };

#define KSWZ(row, colB) ((row) * 256 + ((colB) ^ (((row) & 7) << 4)))
#define SBAR() __builtin_amdgcn_sched_barrier(0)
__device__ __forceinline__ int v_st(int k, int c) { const int kk = (k & ~0xC) | ((k & 4) << 1) | ((k & 8) >> 1); return ((kk >> 3) * 4 + (c >> 5)) * 512 + ((kk & 7) * 32 + (c & 31)) * 2; }
__device__ __forceinline__ int v_rd_base(int lane) { return ((lane & 3) << 3) | (((lane >> 2) & 3) << 6) | (((lane >> 4) & 1) << 5) | (((lane >> 5) & 1) << 8); }
constexpr int v_rd_off(int d0, int ks, int half) { return d0 * 512 + ks * 4096 + half * 2048; }
__device__ __forceinline__ int crow(int r, int hi) { return (r & 3) + 8 * (r >> 2) + 4 * hi; }
typedef float f32x2_c __attribute__((ext_vector_type(2))); typedef __bf16 bf16x2_c __attribute__((ext_vector_type(2)));
__device__ __forceinline__ unsigned cvtpk(float lo, float hi) { f32x2_c v = {lo, hi}; bf16x2_c b = __builtin_convertvector(v, bf16x2_c); return __builtin_bit_cast(unsigned, b); }
__device__ __forceinline__ bf16x8 pack8(f32x4 a, f32x4 b) {
    u32x4 w = {cvtpk(a[0], a[1]), cvtpk(a[2], a[3]), cvtpk(b[0], b[1]), cvtpk(b[2], b[3])};
    return *reinterpret_cast<bf16x8*>(&w);
}
template <class T> __device__ __forceinline__ bf16x8 load8(const T* p) {
    if constexpr (same_t<T, float>::v) { return pack8(*(const f32x4*)p, *(const f32x4*)(p + 4)); }
    else { return *reinterpret_cast<const bf16x8*>(p); }
}
__device__ __forceinline__ void mask_tile(f32x16& p0, f32x16& p1, int dq, unsigned W) {
    const float NEG = -__builtin_inff();
#pragma unroll
    for (int r = 0; r < 16; ++r) {
        const int c = (r & 3) + 8 * (r >> 2);
        if ((unsigned)(dq - c) >= W) p0[r] = NEG;
        if ((unsigned)(dq - c - 32) >= W) p1[r] = NEG;
    }
}
__device__ __forceinline__ void partialSM(f32x16& p0, f32x16& p1, float& m_reg, float& mn, float& alpha) {
    float pmax = p0[0]; for (int r = 1; r < 16; ++r) pmax = fmaxf(pmax, p0[r]); for (int r = 0; r < 16; ++r) pmax = fmaxf(pmax, p1[r]);
    { auto rr = __builtin_amdgcn_permlane32_swap(__float_as_uint(pmax), __float_as_uint(pmax), false, false);
      pmax = fmaxf(__uint_as_float(rr[0]), __uint_as_float(rr[1])); }
    constexpr float C2 = 1.4426950408889634f * SCALE;
    if (__builtin_expect(__all((pmax - m_reg) * SCALE <= THR), 1)) { mn = m_reg; alpha = 1.f; }
    else { mn = fmaxf(m_reg, pmax); alpha = __builtin_amdgcn_exp2f((m_reg - mn) * C2); m_reg = mn; }
    const float mnL = -mn * C2;
    for (int r = 0; r < 16; ++r) p0[r] = fmaf(p0[r], C2, mnL); for (int r = 0; r < 16; ++r) p1[r] = fmaf(p1[r], C2, mnL);
    for (int r = 0; r < 16; ++r) p0[r] = __builtin_amdgcn_exp2f(p0[r]);
}
__device__ __forceinline__ void finishSM(f32x16& p0, f32x16& p1, float alpha, float& l_reg, bf16x8& pa0, bf16x8& pa1, bf16x8& pa2, bf16x8& pa3) {
    for (int r = 0; r < 16; ++r) p1[r] = __builtin_amdgcn_exp2f(p1[r]);
    float ps = 0; for (int r = 0; r < 16; ++r) ps += p0[r]; for (int r = 0; r < 16; ++r) ps += p1[r];
    { auto rr = __builtin_amdgcn_permlane32_swap(__float_as_uint(ps), __float_as_uint(ps), false, false);
      ps = __uint_as_float(rr[0]) + __uint_as_float(rr[1]); }
    l_reg = l_reg * alpha + ps;
#define PK4(P, B_, OUT) do { unsigned a0 = cvtpk(P[B_+0], P[B_+1]), a1 = cvtpk(P[B_+2], P[B_+3]);                          \
        unsigned b0 = cvtpk(P[B_+4], P[B_+5]), b1 = cvtpk(P[B_+6], P[B_+7]);                                             \
        auto r0 = __builtin_amdgcn_permlane32_swap(a0, b0, false, false); auto r1 = __builtin_amdgcn_permlane32_swap(a1, b1, false, false); \
        u32x4 w = {r0[0], r1[0], r0[1], r1[1]}; OUT = *reinterpret_cast<bf16x8*>(&w); } while (0)
    PK4(p0, 0, pa0); PK4(p0, 8, pa1); PK4(p1, 0, pa2); PK4(p1, 8, pa3);
#undef PK4
}
template <int KB, bool SK>
__device__ __forceinline__ void qkt(f32x16& p0, f32x16& p1, const char* K_lds, int r32, int hi, const bf16x8* qr, bool act) {
    if (SK && !act) { const float NEG = -__builtin_inff();
#pragma unroll
        for (int r = 0; r < 16; ++r) { p0[r] = NEG; p1[r] = NEG; } return; }
    p0 = f32x16{}; p1 = f32x16{};
    const char* kb[4];
#pragma unroll
    for (int dd = 0; dd < 4; ++dd) kb[dd] = K_lds + KB * SHM_K + KSWZ(r32, (dd * 16 + hi * 8) * 2);
#pragma unroll
    for (int d0 = 0; d0 < 8; ++d0) { const char* a = kb[d0 & 3] + (d0 >> 2) * 128;
        bf16x8 b0 = *reinterpret_cast<const bf16x8*>(a);
        bf16x8 b1 = *reinterpret_cast<const bf16x8*>(a + 32 * 256);
        const bf16x8 qf = qr[d0];
        p0 = __builtin_amdgcn_mfma_f32_32x32x16_bf16(b0, qf, p0, 0, 0, 0);
        p1 = __builtin_amdgcn_mfma_f32_32x32x16_bf16(b1, qf, p1, 0, 0, 0); }
}
template <int VB, bool SK>
__device__ __forceinline__ void pv_tile(f32x16* o, int vb0, bf16x8 pa0, bf16x8 pa1, bf16x8 pa2, bf16x8 pa3, bool act) {
    if (SK && !act) return;
#define TRRD(dst, off) asm volatile("ds_read_b64_tr_b16 %0, %1 offset:%2" : "=&v"(dst) : "v"(vb0), "i"(off) : "memory")
#define PV_D0(d0) do { s16x4 l0, l1, l2, l3, h0, h1, h2, h3; constexpr int b_ = VB * SHM_V + v_rd_off(d0, 0, 0);     \
        TRRD(l0, b_); TRRD(h0, b_ + 2048); TRRD(l1, b_ + 4096); TRRD(h1, b_ + 6144); TRRD(l2, b_ + 8192); TRRD(h2, b_ + 10240); TRRD(l3, b_ + 12288); TRRD(h3, b_ + 14336); \
        asm volatile("s_waitcnt lgkmcnt(0)" ::: "memory"); SBAR();                 \
        o[d0] = __builtin_amdgcn_mfma_f32_32x32x16_bf16(pa0, (bf16x8){l0[0], l0[1], l0[2], l0[3], h0[0], h0[1], h0[2], h0[3]}, o[d0], 0, 0, 0);   \
        o[d0] = __builtin_amdgcn_mfma_f32_32x32x16_bf16(pa1, (bf16x8){l1[0], l1[1], l1[2], l1[3], h1[0], h1[1], h1[2], h1[3]}, o[d0], 0, 0, 0);   \
        o[d0] = __builtin_amdgcn_mfma_f32_32x32x16_bf16(pa2, (bf16x8){l2[0], l2[1], l2[2], l2[3], h2[0], h2[1], h2[2], h2[3]}, o[d0], 0, 0, 0);   \
        o[d0] = __builtin_amdgcn_mfma_f32_32x32x16_bf16(pa3, (bf16x8){l3[0], l3[1], l3[2], l3[3], h3[0], h3[1], h3[2], h3[3]}, o[d0], 0, 0, 0); } while (0)
    PV_D0(0); PV_D0(1); PV_D0(2); PV_D0(3);
#undef PV_D0
#undef TRRD
}

template <class TIn, class TOut> struct BlockRef { const TIn* Q; const TIn* K; const TIn* V; TOut* O; int P0; int ldo; const int* rows; const int* dst; float* stat; };
template <class TIn> struct Seam {
    bf16x8 qr[8];
    bf16x8 st_v0, st_v1, st_k0, st_k1; f32x4 sf0, sf1, sf2, sf3;
    f32x4 tq[16];
};
__device__ __forceinline__ int swa_jlo(int P0, int W) { const int lowk = P0 - W + 1; return lowk > 0 ? lowk / KVBLK : 0; }
#define ROW(p, k0, rr) ((p) + (unsigned)(((k0) + (rr)) * D + sc))
#define VMW() asm volatile("s_waitcnt vmcnt(0)" ::: "memory")
#define VMWN(n) asm volatile("s_waitcnt vmcnt(%0)" :: "i"(n) : "memory")
#define SLOAD_H(Kp, Vp, k0) do { S.st_v0 = load8<TIn>(ROW(Vp, k0, sr)); S.st_v1 = load8<TIn>(ROW(Vp, k0, 32 + sr));              \
                         S.st_k0 = load8<TIn>(ROW(Kp, k0, sr)); S.st_k1 = load8<TIn>(ROW(Kp, k0, 32 + sr)); } while (0)
#define SWRITE_HK(bf) do { *(bf16x8*)(K_lds + (bf) * SHM_K + kws) = S.st_k0; *(bf16x8*)(K_lds + (bf) * SHM_K + kws + 32 * 256) = S.st_k1; } while (0)
#define SWRITE_HV(bf) do { *(bf16x8*)(V_lds + (bf) * SHM_V + vst0) = S.st_v0; *(bf16x8*)(V_lds + (bf) * SHM_V + vst1) = S.st_v1; } while (0)
#define SWRITE_H(bf) do { SWRITE_HV(bf); SWRITE_HK(bf); } while (0)
#define SLOAD_F(p, k0) do { S.sf0 = *(const f32x4*)ROW(p, k0, sr); S.sf1 = *(const f32x4*)(ROW(p, k0, sr) + 4);                \
                            S.sf2 = *(const f32x4*)ROW(p, k0, 32 + sr); S.sf3 = *(const f32x4*)(ROW(p, k0, 32 + sr) + 4); } while (0)
#define SWRITE_KF(bf) do { *(bf16x8*)(K_lds + (bf) * SHM_K + kws) = pack8(S.sf0, S.sf1); *(bf16x8*)(K_lds + (bf) * SHM_K + kws + 32 * 256) = pack8(S.sf2, S.sf3); } while (0)
#define SWRITE_VF(bf) do { *(bf16x8*)(V_lds + (bf) * SHM_V + vst0) = pack8(S.sf0, S.sf1); *(bf16x8*)(V_lds + (bf) * SHM_V + vst1) = pack8(S.sf2, S.sf3); } while (0)
template <class TIn, class TOut>
__device__ __forceinline__ void causal_swa_prime(const BlockRef<TIn, TOut>& cur, int W, char* lds, Seam<TIn>& S) {
    constexpr bool F32 = same_t<TIn, float>::v;
    const int tid = threadIdx.x, wid = __builtin_amdgcn_readfirstlane(tid >> 6), lane = tid & 63, r32 = lane & 31, hi = lane >> 5;
    const int sr = tid >> 4, sc = (tid & 15) * 8, kws = KSWZ(sr, sc * 2); char* K_lds = lds + 2 * SHM_V;
    const int kb0 = swa_jlo(cur.P0, W) * KVBLK;
    for (int d0 = 0; d0 < 8; ++d0) S.qr[d0] = load8<TIn>(cur.Q + (size_t)(wid * QBLK + r32) * D + d0 * 16 + hi * 8);
    if constexpr (F32) { SLOAD_F((const float*)cur.K, kb0); VMW(); SWRITE_KF(0); SBAR(); SLOAD_F((const float*)cur.V, kb0); }
    else { SLOAD_H(cur.K, cur.V, kb0); VMW(); SWRITE_HK(0); }
    __syncthreads();
}
template <class TIn, class TOut>
__device__ __forceinline__ void causal_swa_block(const BlockRef<TIn, TOut>& cur, const BlockRef<TIn, TOut>& nxt, int skv, int W, char* lds, Seam<TIn>& S) {
    constexpr bool F32 = same_t<TIn, float>::v;
    const int tid = threadIdx.x, wid = __builtin_amdgcn_readfirstlane(tid >> 6), lane = tid & 63, r32 = lane & 31, hi = lane >> 5;
    const int j_lo = swa_jlo(cur.P0, W);
    int j_hi = (cur.P0 + QB - 1) / KVBLK + 1; if (j_hi > skv / KVBLK) j_hi = skv / KVBLK;
    const int NT = j_hi - j_lo;
    const int kbn = swa_jlo(nxt.P0, W) * KVBLK;
    const int qlo = cur.P0 + wid * QBLK, qm = qlo + r32 - 4 * hi;
    char* V_lds = lds; char* K_lds = lds + 2 * SHM_V;
    float* ws = (float*)(lds + 2 * SHM_V + 2 * SHM_K) + wid * 64; float* li_l = ws, * al_l = ws + 32;
    float m_reg = -1e30f, l_reg = 0; f32x16 o[4] = {};
    const int sr = tid >> 4, sc = (tid & 15) * 8, vst0 = v_st(sr, sc), vst1 = v_st(32 + sr, sc), kws = KSWZ(sr, sc * 2);
    const int vb0 = (int)(uintptr_t)V_lds + v_rd_base(lane);
    const TIn* Kh = cur.K; const TIn* Vh = cur.V;
#define RESC(a) do { if (__any((a) < 1.f)) { if (hi == 0) al_l[r32] = (a); asm volatile("s_waitcnt lgkmcnt(0)" ::: "memory");              \
                     for (int d_ = 0; d_ < 4; ++d_) for (int r = 0; r < 16; ++r) o[d_][r] *= al_l[crow(r, hi)]; } } while (0)
#define KBASE(t) ((j_lo + (t)) * KVBLK)
#define ACT(t) (KBASE(t) <= qlo + QBLK - 1 && KBASE(t) + KVBLK - 1 >= qlo - W + 1)
#define MASKT(P0_, P1_, t) do { const int kb_ = KBASE(t); if ((!SK || ACT(t)) && (kb_ + KVBLK - 1 > qlo || kb_ <= qlo + QBLK - 1 - W)) mask_tile(P0_, P1_, qm - kb_, (unsigned)W); } while (0)
    constexpr int NQL = F32 ? 16 : 8;
    constexpr bool SK = WSKIP && !F32;
#define SEAM_K0() do { VMWN(NQL); if constexpr (F32) { SWRITE_KF(0); SBAR(); SLOAD_F((const float*)nxt.V, kbn); } else { SWRITE_HK(0); } SBAR(); } while (0)
    f32x16 pA0, pA1, pB0, pB1; float mnA, mnB, alA, alB; bf16x8 pa0, pa1, pa2, pa3;
    if constexpr (F32) { VMW(); SWRITE_VF(0); SBAR(); } else { SWRITE_HV(0); SBAR(); }
    if (NT > 1) { if constexpr (F32) SLOAD_F((const float*)Kh, KBASE(1)); else SLOAD_H(Kh, Vh, KBASE(1)); }
    SBAR(); qkt<0, SK>(pA0, pA1, K_lds, r32, hi, S.qr, ACT(0));
    if constexpr (F32) { if (NT > 1) { VMW(); SWRITE_KF(1); SBAR(); SLOAD_F((const float*)Vh, KBASE(1)); } }
    MASKT(pA0, pA1, 0); partialSM(pA0, pA1, m_reg, mnA, alA);
    if (NT > 1) { VMW(); if constexpr (F32) { SWRITE_VF(1); SBAR(); if (NT > 2) SLOAD_F((const float*)Kh, KBASE(2)); } else SWRITE_H(1); }
    __syncthreads();
#define HALF_STEP(PX0, PX1, mnX, alX, PY0, PY1, alY, t, KB, VB, SB) do {                                                      \
        SBAR(); qkt<KB, SK>(PX0, PX1, K_lds, r32, hi, S.qr, ACT(t));                                             \
        finishSM(PY0, PY1, alY, l_reg, pa0, pa1, pa2, pa3); SBAR();                                                           \
        if ((t) + 1 < NT) { if constexpr (F32) { VMW(); SWRITE_KF(SB); SBAR(); SLOAD_F((const float*)Vh, KBASE((t) + 1)); }  \
                            else { SLOAD_H(Kh, Vh, KBASE((t) + 1)); } SBAR(); }                                               \
        pv_tile<VB, SK>(o, vb0, pa0, pa1, pa2, pa3, ACT((t) - 1)); MASKT(PX0, PX1, (t)); partialSM(PX0, PX1, m_reg, mnX, alX);                                        \
        __syncthreads();                                                                                                      \
        if ((t) + 1 < NT) { VMW(); if constexpr (F32) { SWRITE_VF(SB); SBAR(); if ((t) + 2 < NT) SLOAD_F((const float*)Kh, KBASE((t) + 2)); } \
                            else { SWRITE_H(SB); } }                                                                          \
        RESC(alX); __syncthreads(); } while (0)
    for (int t = 1; t + 1 < NT; t += 2) {
        HALF_STEP(pB0, pB1, mnB, alB, pA0, pA1, alA, t, 1, 0, 0);
        HALF_STEP(pA0, pA1, mnA, alA, pB0, pB1, alB, t + 1, 0, 1, 1);
    }
    const bool even = (NT & 1) == 0;
    if (even) { SBAR(); qkt<1, SK>(pB0, pB1, K_lds, r32, hi, S.qr, ACT(NT - 1)); SBAR(); }
#define QROW(e) (nxt.Q + (size_t)(wid * QBLK + r32) * D + ((e) >> 1) * 16 + hi * 8 + ((e) & 1) * 4)
    if constexpr (F32) { SLOAD_F((const float*)nxt.K, kbn); SBAR();
#pragma unroll
        for (int e = 0; e < 8; ++e) S.tq[e] = *(const f32x4*)QROW(e); }
    else { const size_t qrown_ = (size_t)(wid * QBLK + r32);
        SLOAD_H(nxt.K, nxt.V, kbn); SBAR();
#pragma unroll
        for (int d0 = 0; d0 < 8; ++d0) S.qr[d0] = load8<TIn>(nxt.Q + qrown_ * D + d0 * 16 + hi * 8); }
    SBAR();
    finishSM(pA0, pA1, alA, l_reg, pa0, pa1, pa2, pa3); SBAR();
    if constexpr (F32) {
#pragma unroll
        for (int e = 8; e < 16; ++e) S.tq[e] = *(const f32x4*)QROW(e); SBAR(); }
#undef QROW
    pv_tile<0, SK>(o, vb0, pa0, pa1, pa2, pa3, ACT(even ? NT - 2 : NT - 1));
    if (even) { MASKT(pB0, pB1, NT - 1); partialSM(pB0, pB1, m_reg, mnB, alB); __syncthreads(); RESC(alB);
        finishSM(pB0, pB1, alB, l_reg, pa0, pa1, pa2, pa3); SBAR(); pv_tile<1, SK>(o, vb0, pa0, pa1, pa2, pa3, ACT(NT - 1)); }
    SBAR(); SEAM_K0();
    if (hi == 0) li_l[r32] = l_reg; asm volatile("s_waitcnt lgkmcnt(0)" ::: "memory");
    float rli[16];
#pragma unroll
    for (int r = 0; r < 16; ++r) rli[r] = __builtin_amdgcn_rcpf(li_l[crow(r, hi)]);
    {
    int ld_ = cur.ldo; asm volatile("" : "+s"(ld_));
    TOut* Ow = cur.O + (size_t)(wid * QBLK) * ld_;
#pragma unroll
    for (int r = 0; r < 16; ++r) { const unsigned ro = (unsigned)crow(r, hi) * (unsigned)ld_ + (unsigned)r32;
#pragma unroll
        for (int d0 = 0; d0 < 4; ++d0) { const float v = o[d0][r] * rli[r];
            if constexpr (same_t<TOut, float>::v) { Ow[ro + d0 * 32] = v; }
            else { const float vn = __shfl_xor(v, 1);
                   if ((r32 & 1) == 0) *(unsigned*)(Ow + ro + d0 * 32) = cvtpk(v, vn); } } }
    }
    if constexpr (F32) {
#pragma unroll
        for (int d0 = 0; d0 < 8; ++d0) S.qr[d0] = pack8(S.tq[2 * d0], S.tq[2 * d0 + 1]); }
    __syncthreads();
#undef RESC
#undef KBASE
#undef ACT
#undef MASKT
#undef SEAM_K0
#undef HALF_STEP
}
#undef ROW
#undef VMW
#undef VMWN
#undef SLOAD_H
#undef SWRITE_HK
#undef SWRITE_HV
#undef SWRITE_H
#undef SLOAD_F
#undef SWRITE_KF
#undef SWRITE_VF


template <int KB>
__device__ __forceinline__ void qkt_r(f32x16& p0, f32x16& p1, const char* K_lds, int r32, int hi, const bf16x8* qr) {
    p0 = f32x16{}; p1 = f32x16{};
    const char* kb[4];
#pragma unroll
    for (int dd = 0; dd < 4; ++dd) kb[dd] = K_lds + KB * SHM_K + KSWZ(r32, (dd * 16 + hi * 8) * 2);
#pragma unroll
    for (int d0 = 0; d0 < 8; ++d0) { const char* a = kb[d0 & 3] + (d0 >> 2) * 128;
        bf16x8 b0 = *reinterpret_cast<const bf16x8*>(a);
        bf16x8 b1 = *reinterpret_cast<const bf16x8*>(a + 32 * 256);
        p0 = __builtin_amdgcn_mfma_f32_32x32x16_bf16(b0, qr[d0], p0, 0, 0, 0);
        p1 = __builtin_amdgcn_mfma_f32_32x32x16_bf16(b1, qr[d0], p1, 0, 0, 0); }
}
constexpr int MOBA_LDS_BYTES = 4 * SHM_V + 4 * SHM_K + NW * 64 * 4;
struct MobaStage { bf16x8 qr[8]; bf16x8 k0[2], k1[2], v0[2], v1[2]; };
#define MOBA_LOAD_Q(B) do { const unsigned qoff_ = (unsigned)(B).rows[wid * QBLK + r32] * D + hi * 8;                                  \
        _Pragma("unroll") for (int d0 = 0; d0 < 8; ++d0) ST.qr[d0] = load8<bf16>((B).Q + qoff_ + d0 * 16); } while (0)
#define MOBA_LOAD_KV(B, T0) do { _Pragma("unroll") for (int t = 0; t < 2; ++t) { const unsigned eo_ = (unsigned)(((T0) + t) * KVBLK + sr) * D + sc; \
        ST.k0[t] = load8<bf16>((B).K + eo_); ST.k1[t] = load8<bf16>((B).K + eo_ + 32 * D); ST.v0[t] = load8<bf16>((B).V + eo_); ST.v1[t] = load8<bf16>((B).V + eo_ + 32 * D); } } while (0)
#define MOBA_WRITE_KV(T0) do { _Pragma("unroll") for (int t = 0; t < 2; ++t) { *(bf16x8*)(K_lds + ((T0) + t) * SHM_K + kws) = ST.k0[t]; *(bf16x8*)(K_lds + ((T0) + t) * SHM_K + kws + 32 * 256) = ST.k1[t]; \
        *(bf16x8*)(V_lds + ((T0) + t) * SHM_V + vst0) = ST.v0[t]; *(bf16x8*)(V_lds + ((T0) + t) * SHM_V + vst1) = ST.v1[t]; } } while (0)
__device__ __forceinline__ void moba_block(const BlockRef<bf16, bf16>& cur, const BlockRef<bf16, bf16>& nxt, bool has_next, char* lds, MobaStage& ST) {
    const int tid = threadIdx.x, wid = __builtin_amdgcn_readfirstlane(tid >> 6), lane = tid & 63, r32 = lane & 31, hi = lane >> 5;
    char* V_lds = lds; char* K_lds = lds + 4 * SHM_V;
    float* wsc = (float*)(lds + 4 * SHM_V + 4 * SHM_K) + wid * 64; float* li_l = wsc, * al_l = wsc + 32;
    const int sr = tid >> 4, sc = (tid & 15) * 8, vst0 = v_st(sr, sc), vst1 = v_st(32 + sr, sc), kws = KSWZ(sr, sc * 2);
    const int vb0 = (int)(uintptr_t)V_lds + v_rd_base(lane);
    __syncthreads();
    MOBA_WRITE_KV(0);
    __syncthreads();
    MOBA_LOAD_KV(cur, 2);
    SBAR();
    float m_reg = -1e30f, l_reg = 0; f32x16 o[4] = {};
    const bool causal = cur.P0 == 0; const int qlo = wid * QBLK, qm = qlo + r32 - 4 * hi;
    f32x16 p0, p1; float mn, al; bf16x8 pa0, pa1, pa2, pa3;
#define RESCM(a) do { if (__any((a) < 1.f)) { if (hi == 0) al_l[r32] = (a); asm volatile("s_waitcnt lgkmcnt(0)" ::: "memory");              \
                      for (int d_ = 0; d_ < 4; ++d_) for (int r = 0; r < 16; ++r) o[d_][r] *= al_l[crow(r, hi)]; } } while (0)
#define SKIPT(t) (causal && (t) * KVBLK > qlo + QBLK - 1)
#define MTA(t) do { if (!SKIPT(t)) { SBAR(); qkt_r<t>(p0, p1, K_lds, r32, hi, ST.qr); if (causal && (t) * KVBLK + KVBLK - 1 > qlo) mask_tile(p0, p1, qm - (t) * KVBLK, 1u << 30); } } while (0)
#define MTB(t) do { if (!SKIPT(t)) { partialSM(p0, p1, m_reg, mn, al); RESCM(al); finishSM(p0, p1, al, l_reg, pa0, pa1, pa2, pa3); SBAR(); pv_tile<t, false>(o, vb0, pa0, pa1, pa2, pa3, true); } } while (0)
    MTA(0); MTB(0); MTA(1); MTB(1);
    SBAR();
    MOBA_WRITE_KV(2);
    __syncthreads();
    if (has_next) MOBA_LOAD_KV(nxt, 0);
    SBAR();
    MTA(2); MTB(2); MTA(3);
    SBAR();
    if (has_next) MOBA_LOAD_Q(nxt);
    SBAR();
    MTB(3);
#undef MTA
#undef MTB
#undef SKIPT
#undef RESCM
    if (hi == 0) li_l[r32] = l_reg; asm volatile("s_waitcnt lgkmcnt(0)" ::: "memory");
    float rli[16];
#pragma unroll
    for (int r = 0; r < 16; ++r) rli[r] = __builtin_amdgcn_rcpf(li_l[crow(r, hi)]);
    { const int dme_ = cur.dst[wid * QBLK + r32]; if (hi == 0 && dme_ >= 0) { float2 st_; st_.x = m_reg; st_.y = l_reg; *(float2*)(cur.stat + 2 * (size_t)dme_) = st_; } }
#pragma unroll
    for (int r = 0; r < 16; ++r) { const int di_ = cur.dst[wid * QBLK + crow(r, hi)];
#pragma unroll
        for (int d0 = 0; d0 < 4; ++d0) { const float v = o[d0][r] * rli[r]; const float vn = __shfl_xor(v, 1);
            if ((r32 & 1) == 0 && di_ >= 0) *(unsigned*)(cur.O + (size_t)di_ * 128 + d0 * 32 + r32) = cvtpk(v, vn); } }
}
__device__ __forceinline__ void moba_prime(const BlockRef<bf16, bf16>& cur, MobaStage& ST) {
    const int tid = threadIdx.x, wid = __builtin_amdgcn_readfirstlane(tid >> 6), lane = tid & 63, r32 = lane & 31, hi = lane >> 5;
    const int sr = tid >> 4, sc = (tid & 15) * 8;
    MOBA_LOAD_Q(cur); MOBA_LOAD_KV(cur, 0);
}
#undef MOBA_LOAD_Q
#undef MOBA_LOAD_KV
#undef MOBA_WRITE_KV
}
#include <hip/hip_cooperative_groups.h>
namespace cg = cooperative_groups;

constexpr int NWAVES = 8;
#ifndef MK_ONE_LAUNCH
#define MK_ONE_LAUNCH 1
#endif
constexpr int BATCH = 2, SEQ = 16384, T = BATCH * SEQ, DM = 2048, INW = 10240, DFF = 8192, PLE = 256;
constexpr int NH8 = 8;
constexpr float NORM_EPS = 1e-6f;
constexpr float LAMBDA_INIT = 0.2f;
constexpr int NPHASE = 19;

constexpr size_t MiB = 1u << 20;
constexpr size_t WS_ROPE = 1 * MiB;
constexpr size_t WS_KMEAN = 3 * MiB;
constexpr size_t WS_CNT = 0, WS_NBLK = 8192, WS_TAB = 65536;
constexpr size_t WS_BAR = 131072, WS_BAR_BYTES = 16384;
constexpr size_t WS_SEL = 4 * MiB;
constexpr int LSTR = 65536 + SEQ;
constexpr size_t WS_ROWL = 986 * MiB, WS_DSTL = 992 * MiB;
constexpr size_t WS_STATS = 1000 * MiB;
constexpr size_t WS_TOP = 1008 * MiB;
constexpr size_t WS_WIN = 8 * MiB, WS_WA = 48 * MiB, WS_WB = 52 * MiB, WS_WOUT = 56 * MiB, WS_WUP = 64 * MiB, WS_WDN = 96 * MiB, WS_WPG = 128 * MiB, WS_WPP = 136 * MiB;
constexpr size_t WS_PB = 138 * MiB;
constexpr size_t WS_XN = 154 * MiB;
constexpr size_t WS_OB = 154 * MiB;
constexpr size_t WS_QKV = 282 * MiB;
constexpr size_t SEC_ELEMS = (size_t)T * 1024;
constexpr size_t WS_SG = 666 * MiB;
constexpr size_t WS_OA = 922 * MiB;
constexpr size_t WS_MIX = 282 * MiB;
constexpr size_t WS_HID = 282 * MiB;
constexpr size_t WS_G3 = 282 * MiB;
constexpr size_t WS_H2 = 554 * MiB;
constexpr size_t WS_XN3 = 410 * MiB;
constexpr size_t WS_Y = 794 * MiB;
constexpr size_t WS_END = 986 * MiB;
static_assert(WS_HID + (size_t)T * DFF * 2 <= WS_Y && WS_Y + (size_t)T * DM * 2 <= WS_OA && WS_OA + (size_t)T * 1024 * 2 == WS_END, "ws map");

constexpr int RING_BYTES = 131072, LDS_BYTES = 147456;

#define GAS __attribute__((address_space(1)))
#define LAS __attribute__((address_space(3)))
typedef unsigned short bf16;
typedef unsigned v4u __attribute__((ext_vector_type(4)));
typedef unsigned v2u __attribute__((ext_vector_type(2)));
typedef float f32x4 __attribute__((ext_vector_type(4)));
#define LDS_WAIT() asm volatile("s_waitcnt lgkmcnt(0)" ::: "memory")
__device__ __forceinline__ unsigned f2bf(float f) { unsigned u = __builtin_bit_cast(unsigned, f); return (u + 0x7fffu + ((u >> 16) & 1u)) >> 16; }
__device__ __forceinline__ unsigned pk2(float lo, float hi) { return f2bf(lo) | (f2bf(hi) << 16); }
__device__ __forceinline__ float bflo(unsigned w) { return __uint_as_float(w << 16); }
__device__ __forceinline__ float bfhi(unsigned w) { return __uint_as_float(w & 0xffff0000u); }
__device__ __forceinline__ float wave_sum(float v) {
#pragma unroll
    for (int o = 1; o < 64; o <<= 1) v += __shfl_xor(v, o);
    return v;
}
template <class Tv> __device__ __forceinline__ Tv ntload(const Tv* p) { return __builtin_nontemporal_load(p); }
template <class Tv> __device__ __forceinline__ void ntstore(Tv v, Tv* p) { __builtin_nontemporal_store(v, p); }
__device__ __forceinline__ float sigmoidf_(float x) { return __builtin_amdgcn_rcpf(1.0f + __expf(-x)); }

namespace pg8 {
template <int MODE> struct EpiT {
    static constexpr bool PERM = true, AFTER_DRAIN = false;
    bf16_t* O; int ldo; const bf16_t* G; int ldg;
    __device__ __forceinline__ void operator()(const f32x4 (&acc)[2][2][4][2], const Unit& u, int wr, int wc, int fr, int fq) const {
        const int row0 = u.pm * BM + wr * 64 + fr, col0 = u.pn * BM + wc * 32 + 8 * fq;
#pragma unroll
        for (int ai = 0; ai < 2; ++ai)
#pragma unroll
            for (int m = 0; m < 4; ++m) { const size_t r = (size_t)(row0 + ai * HALF + m * 16);
#pragma unroll
                for (int bj = 0; bj < 2; ++bj) { f32x4 v0 = acc[ai][bj][m][0], v1 = acc[ai][bj][m][1]; const int c = col0 + bj * HALF;
                    if (MODE == 1) {
#pragma unroll
                        for (int e = 0; e < 4; ++e) { float a = fmaxf(v0[e], 0.f), b = fmaxf(v1[e], 0.f); v0[e] = a * a; v1[e] = b * b; } }
                    if (MODE == 2) {
#pragma unroll
                        for (int e = 0; e < 4; ++e) { v0[e] = sigmoidf_(v0[e]); v1[e] = sigmoidf_(v1[e]); } }
                    if (MODE == 3 || MODE == 4) { const u32x4 g = *(const u32x4*)(G + r * ldg + c);
                        v0[0] *= bflo(g.x); v0[1] *= bfhi(g.x); v0[2] *= bflo(g.y); v0[3] *= bfhi(g.y); v1[0] *= bflo(g.z); v1[1] *= bfhi(g.z); v1[2] *= bflo(g.w); v1[3] *= bfhi(g.w); }
                    if (MODE == 4) { const u32x4 g = *(const u32x4*)(O + r * ldo + c);
                        v0[0] += bflo(g.x); v0[1] += bfhi(g.x); v0[2] += bflo(g.y); v0[3] += bfhi(g.y); v1[0] += bflo(g.z); v1[1] += bfhi(g.z); v1[2] += bflo(g.w); v1[3] += bfhi(g.w); }
                    u32x4 w; w.x = cvt_pk_bf16(v0[0], v0[1]); w.y = cvt_pk_bf16(v0[2], v0[3]); w.z = cvt_pk_bf16(v1[0], v1[1]); w.w = cvt_pk_bf16(v1[2], v1[3]);
                    *(u32x4*)(O + r * ldo + c) = w; } }
    }
};
struct EpiGate2 {
    static constexpr bool PERM = true, AFTER_DRAIN = false; static constexpr int MID_T = 16;
    bf16_t* O; const bf16_t* SGp;
    __device__ __forceinline__ void mid(f32x4 (&acc)[2][2][4][2], const Unit& u, int wr, int wc, int fr, int fq) const {
        int row0 = u.pm * BM + wr * 64 + fr; const int col0 = u.pn * BM + wc * 32 + 8 * fq;
        asm volatile("" : "+v"(row0));
        const bf16_t* gp = SGp + (size_t)row0 * 4096 + col0;
#pragma unroll
        for (int ai = 0; ai < 2; ++ai)
#pragma unroll
            for (int m = 0; m < 4; ++m) { const int ro = (ai * HALF + m * 16) * 4096;
#pragma unroll
                for (int bj = 0; bj < 2; ++bj) { const u32x4 a = *(const u32x4*)(gp + ro + bj * HALF), b = *(const u32x4*)(gp + ro + bj * HALF + 2048);
                    f32x4& v0 = acc[ai][bj][m][0]; f32x4& v1 = acc[ai][bj][m][1];
                    v0[0] *= bflo(a.x) * __builtin_amdgcn_rcpf(bflo(b.x)); v0[1] *= bfhi(a.x) * __builtin_amdgcn_rcpf(bfhi(b.x)); v0[2] *= bflo(a.y) * __builtin_amdgcn_rcpf(bflo(b.y)); v0[3] *= bfhi(a.y) * __builtin_amdgcn_rcpf(bfhi(b.y));
                    v1[0] *= bflo(a.z) * __builtin_amdgcn_rcpf(bflo(b.z)); v1[1] *= bfhi(a.z) * __builtin_amdgcn_rcpf(bfhi(b.z)); v1[2] *= bflo(a.w) * __builtin_amdgcn_rcpf(bflo(b.w)); v1[3] *= bfhi(a.w) * __builtin_amdgcn_rcpf(bfhi(b.w)); }
                if (m == 3) asm volatile("" ::: "memory"); }
    }
    __device__ __forceinline__ void operator()(const f32x4 (&acc)[2][2][4][2], const Unit& u, int wr, int wc, int fr, int fq) const {
        int row0 = u.pm * BM + wr * 64 + fr; const int col0 = u.pn * BM + wc * 32 + 8 * fq;
        asm volatile("" : "+v"(row0));
        const bf16_t* gp = SGp + (size_t)row0 * 4096 + 2048 + col0; bf16_t* op = O + (size_t)row0 * 2048 + col0;
#pragma unroll
        for (int ai = 0; ai < 2; ++ai)
#pragma unroll
            for (int m = 0; m < 4; ++m) { const int rr = ai * HALF + m * 16;
#pragma unroll
                for (int bj = 0; bj < 2; ++bj) { const u32x4 b = *(const u32x4*)(gp + rr * 4096 + bj * HALF); const f32x4 v0 = acc[ai][bj][m][0], v1 = acc[ai][bj][m][1];
                    u32x4 w; w.x = cvt_pk_bf16(v0[0] * bflo(b.x), v0[1] * bfhi(b.x)); w.y = cvt_pk_bf16(v0[2] * bflo(b.y), v0[3] * bfhi(b.y)); w.z = cvt_pk_bf16(v1[0] * bflo(b.z), v1[1] * bfhi(b.z)); w.w = cvt_pk_bf16(v1[2] * bflo(b.w), v1[3] * bfhi(b.w));
                    *(u32x4*)(op + rr * 2048 + bj * HALF) = w; } }
    }
};
struct EpiPle {
    static constexpr bool PERM = true, AFTER_DRAIN = false; static constexpr int MID_T = 32;
    bf16_t* O; bf16_t* Gp;
    __device__ __forceinline__ void mid(f32x4 (&acc)[2][2][4][2], const Unit& u, int wr, int wc, int fr, int fq) const {
        int row0 = u.pm * BM + wr * 64 + fr; const int col0 = u.pn * BM + wc * 32 + 8 * fq;
        asm volatile("" : "+v"(row0));
        bf16_t* gp = Gp + (size_t)row0 * 2048 + col0;
#pragma unroll
        for (int ai = 0; ai < 2; ++ai)
#pragma unroll
            for (int m = 0; m < 4; ++m) { const int rr = ai * HALF + m * 16;
#pragma unroll
                for (int bj = 0; bj < 2; ++bj) { f32x4& v0 = acc[ai][bj][m][0]; f32x4& v1 = acc[ai][bj][m][1];
                    u32x4 w; w.x = cvt_pk_bf16(sigmoidf_(v0[0]), sigmoidf_(v0[1])); w.y = cvt_pk_bf16(sigmoidf_(v0[2]), sigmoidf_(v0[3])); w.z = cvt_pk_bf16(sigmoidf_(v1[0]), sigmoidf_(v1[1])); w.w = cvt_pk_bf16(sigmoidf_(v1[2]), sigmoidf_(v1[3]));
                    *(u32x4*)(gp + rr * 2048 + bj * HALF) = w; v0 = (f32x4){0.f, 0.f, 0.f, 0.f}; v1 = (f32x4){0.f, 0.f, 0.f, 0.f}; } }
    }
    __device__ __forceinline__ void operator()(const f32x4 (&acc)[2][2][4][2], const Unit& u, int wr, int wc, int fr, int fq) const {
        int row0 = u.pm * BM + wr * 64 + fr; const int col0 = u.pn * BM + wc * 32 + 8 * fq;
        asm volatile("" : "+v"(row0));
        const bf16_t* gp = Gp + (size_t)row0 * 2048 + col0; bf16_t* op = O + (size_t)row0 * 2048 + col0;
#pragma unroll
        for (int ai = 0; ai < 2; ++ai)
#pragma unroll
            for (int m = 0; m < 4; ++m) { const int rr = ai * HALF + m * 16;
#pragma unroll
                for (int bj = 0; bj < 2; ++bj) { const u32x4 b = *(const u32x4*)(gp + rr * 2048 + bj * HALF); const f32x4 v0 = acc[ai][bj][m][0], v1 = acc[ai][bj][m][1];
                    u32x4 w; w.x = cvt_pk_bf16(v0[0] * bflo(b.x), v0[1] * bfhi(b.x)); w.y = cvt_pk_bf16(v0[2] * bflo(b.y), v0[3] * bfhi(b.y)); w.z = cvt_pk_bf16(v1[0] * bflo(b.z), v1[1] * bfhi(b.z)); w.w = cvt_pk_bf16(v1[2] * bflo(b.w), v1[3] * bfhi(b.w));
                    *(u32x4*)(op + rr * 2048 + bj * HALF) = w; } }
    }
};
struct EpiInProj {
    static constexpr bool PERM = false, AFTER_DRAIN = false;
    bf16_t* QKV; bf16_t* SG; const float* rope; float* km;
    __device__ __forceinline__ void operator()(const f32x4 (&acc)[2][2][4][2], const Unit& u, int wr, int wc, int fr, int fq) const {
        typedef unsigned u32x2 __attribute__((ext_vector_type(2)));
        const int pn = u.pn, row0 = u.pm * BM + wr * 64 + fr;
        if (pn < 24) {
            const int sec = pn >> 2; const bool rot = (sec != 2) && (sec != 5) && (wc == 0);
            const int b = (u.pm * BM) / SEQ;
            f32x4 ks[2][2] = {{(f32x4){0.f, 0.f, 0.f, 0.f}, (f32x4){0.f, 0.f, 0.f, 0.f}}, {(f32x4){0.f, 0.f, 0.f, 0.f}, (f32x4){0.f, 0.f, 0.f, 0.f}}};
#pragma unroll
            for (int ai = 0; ai < 2; ++ai)
#pragma unroll
                for (int m = 0; m < 4; ++m) { const int r = row0 + ai * HALF + m * 16, pos = r - b * SEQ;
                    f32x4 cs = (f32x4){1.f, 1.f, 1.f, 1.f}, sn = (f32x4){0.f, 0.f, 0.f, 0.f};
                    if (rot) { cs = *(const f32x4*)(rope + (size_t)pos * 32 + 4 * fq); sn = *(const f32x4*)(rope + (size_t)pos * 32 + 16 + 4 * fq); }
#pragma unroll
                    for (int bj = 0; bj < 2; ++bj) { const int h8 = (pn & 3) * 2 + bj; f32x4 v0 = acc[ai][bj][m][0], v1 = acc[ai][bj][m][1];
                        if (rot) { const f32x4 a = v0 * cs - v1 * sn, bb = v1 * cs + v0 * sn; v0 = a; v1 = bb; }
                        if (sec == 1) { ks[bj][0] += v0; ks[bj][1] += v1; }
                        bf16_t* dst = QKV + (size_t)sec * SEC_ELEMS + ((size_t)(b * NH8 + h8) * SEQ + pos) * 128 + wc * 32 + 4 * fq;
                        u32x2 w0, w1; w0.x = cvt_pk_bf16(v0[0], v0[1]); w0.y = cvt_pk_bf16(v0[2], v0[3]); w1.x = cvt_pk_bf16(v1[0], v1[1]); w1.y = cvt_pk_bf16(v1[2], v1[3]);
                        *(u32x2*)dst = w0; *(u32x2*)(dst + 16) = w1; } }
            if (sec == 1) {
                const int blk = u.pm - b * (SEQ / 256);
#pragma unroll
                for (int bj = 0; bj < 2; ++bj)
#pragma unroll
                    for (int n = 0; n < 2; ++n)
#pragma unroll
                        for (int e = 0; e < 4; ++e) { float v = ks[bj][n][e]; v += __shfl_xor(v, 1); v += __shfl_xor(v, 2); v += __shfl_xor(v, 4); v += __shfl_xor(v, 8);
                            if (fr == 0) atomicAdd(km + ((size_t)((b * NH8 + (pn & 3) * 2 + bj) * 64 + blk)) * 128 + wc * 32 + n * 16 + 4 * fq + e, v * (1.0f / 256.0f)); }
            }
        } else {
            const int col0 = (pn - 24) * BM + wc * 32 + 4 * fq;
#pragma unroll
            for (int ai = 0; ai < 2; ++ai)
#pragma unroll
                for (int m = 0; m < 4; ++m) { bf16_t* rowp = SG + (size_t)(row0 + ai * HALF + m * 16) * 4096 + col0;
#pragma unroll
                    for (int bj = 0; bj < 2; ++bj)
#pragma unroll
                        for (int n = 0; n < 2; ++n) { const f32x4 v = acc[ai][bj][m][n]; u32x2 w; w.x = cvt_pk_bf16(sigmoidf_(v[0]), sigmoidf_(v[1])); w.y = cvt_pk_bf16(sigmoidf_(v[2]), sigmoidf_(v[3]));
                            *(u32x2*)(rowp + bj * HALF + n * 16) = w; } }
        }
    }
};
}

#define XB_TMO      128
#define XB_XCNT(j)  (256  + 64 * (j))
#define XB_XSUB(j)  (1280 + 64 * (j))
#define XB_XGEN(j)  (2304 + 64 * (j))
#define XB_TOP      3328
#define XB_TOPGEN   3392
#define XCD_BAR_WORDS 3456
#define XB_SPIN_CAP (1u << 18)

__device__ __forceinline__ unsigned xb_ld(unsigned* p)              { return __hip_atomic_load(p, __ATOMIC_RELAXED, __HIP_MEMORY_SCOPE_AGENT); }
__device__ __forceinline__ unsigned xb_add(unsigned* p, unsigned v) { return __hip_atomic_fetch_add(p, v, __ATOMIC_RELAXED, __HIP_MEMORY_SCOPE_AGENT); }
__device__ __forceinline__ unsigned xb_xcc_id() { return (unsigned)__builtin_amdgcn_s_getreg((3 << 11) | 20) & 0xFu; }
#define XB_SPIN(cond, bar) do { unsigned _sp = 0; while (cond) { __builtin_amdgcn_s_sleep(1); \
    if ((++_sp & 255u) == 0u) { if (xb_ld(&(bar)[XB_TMO])) break; if (_sp > XB_SPIN_CAP) { atomicAdd(&(bar)[XB_TMO], 1u); break; } } } } while (0)

struct XcdBarrier {
    unsigned* bar; unsigned x;
    volatile LAS unsigned* st;
};

__device__ __forceinline__ XcdBarrier xcd_barrier_post(unsigned* bar, volatile LAS unsigned* st) {
    XcdBarrier b; b.bar = bar; b.x = xb_xcc_id(); b.st = st;
    if (threadIdx.x == 0) (void)xb_add(&bar[XB_XCNT(b.x)], 1u);
    return b;
}
__device__ __forceinline__ void xcd_barrier_complete(unsigned* bar, unsigned x, unsigned& nloc, unsigned& nx) {
    const unsigned G = gridDim.x * gridDim.y * gridDim.z;
    unsigned sum, cnt, mine, sp = 0u;
    for (;;) {
        sum = 0u; cnt = 0u; mine = 0u;
#pragma unroll
        for (unsigned j = 0; j < 16; ++j) { const unsigned c = xb_ld(&bar[XB_XCNT(j)]); sum += c; cnt += (c > 0u) ? 1u : 0u; mine = (j == x) ? c : mine; }
        if (sum == G) break;
        __builtin_amdgcn_s_sleep(1);
        if ((++sp & 255u) == 0u) { if (xb_ld(&bar[XB_TMO])) break; if (sp > XB_SPIN_CAP) { atomicAdd(&bar[XB_TMO], 1u); break; } }
    }
    nloc = mine > 0u ? mine : 1u; nx = cnt > 0u ? cnt : 1u;
}

__device__ __forceinline__ void xcd_barrier(const XcdBarrier& b) {
    asm volatile("s_waitcnt vmcnt(0)" ::: "memory");
    __syncthreads();
    if (threadIdx.x == 0) {
        unsigned* bar = b.bar;
        __builtin_amdgcn_s_waitcnt(0);
        unsigned nloc = b.st[0], nx = b.st[1];
        if (nloc == 0u) { xcd_barrier_complete(bar, b.x, nloc, nx); b.st[0] = nloc; b.st[1] = nx; }
        const unsigned old = xb_add(&bar[XB_XSUB(b.x)], 1u);
        const unsigned gen = old / nloc;
        if (old + 1u == (gen + 1u) * nloc) {
            __builtin_amdgcn_fence(__ATOMIC_RELEASE, "agent");
            asm volatile("s_waitcnt vmcnt(0)" ::: "memory");
            const unsigned og = xb_add(&bar[XB_TOP], 1u);
            const unsigned tg = og / nx;
            if (og + 1u == (tg + 1u) * nx) xb_add(&bar[XB_TOPGEN], 1u);
            else XB_SPIN(xb_ld(&bar[XB_TOPGEN]) == tg, bar);
            __builtin_amdgcn_fence(__ATOMIC_ACQUIRE, "agent");
            xb_add(&bar[XB_XGEN(b.x)], 1u);
            asm volatile("s_waitcnt vmcnt(0)" ::: "memory");
        } else {
            XB_SPIN(xb_ld(&bar[XB_XGEN(b.x)]) == gen, bar);
            __builtin_amdgcn_fence(__ATOMIC_ACQUIRE, "agent");
            asm volatile("s_waitcnt vmcnt(0)" ::: "memory");
        }
    }
    __syncthreads();
}

struct Args { const float* in[21]; float* out; unsigned char* ws; int ph_lo, ph_hi, coop, pad; };

__device__ __forceinline__ void p0_transpose_item(const float* W, int K, int N, bf16* WT, LAS float* scr, int item, int lane, int ldt = 0) {
    if (ldt == 0) ldt = K;
    const int nblk = N / 64, kb = item / nblk, nb = item % nblk, k0 = 64 * kb, n0 = 64 * nb;
    const int lr = lane >> 4, lc = (lane & 15) * 4;
    f32x4 v[16];
#pragma unroll
    for (int i = 0; i < 16; ++i) v[i] = ntload((const f32x4*)(W + (size_t)(k0 + 4 * i + lr) * N + n0 + lc));
#pragma unroll
    for (int i = 0; i < 16; ++i) { LAS float* d = scr + (4 * i + lr) * 65 + lc; d[0] = v[i].x; d[1] = v[i].y; d[2] = v[i].z; d[3] = v[i].w; }
    LDS_WAIT(); asm volatile("" ::: "memory");
    const int c = lane & 7;
#pragma unroll
    for (int j = 0; j < 8; ++j) { const int n = (lane >> 3) + 8 * j; const LAS float* sp = scr + (8 * c) * 65 + n;
        v4u o; o.x = pk2(sp[0 * 65], sp[1 * 65]); o.y = pk2(sp[2 * 65], sp[3 * 65]); o.z = pk2(sp[4 * 65], sp[5 * 65]); o.w = pk2(sp[6 * 65], sp[7 * 65]);
        *(GAS v4u*)(WT + (size_t)(n0 + n) * ldt + k0 + 8 * c) = o; }
    LDS_WAIT(); asm volatile("" ::: "memory");
}
__device__ __forceinline__ void rms_rows2_to_bf16(const float* xrow0, const float* xrow1, const float* g, bf16* orow0, bf16* orow1, int lane) {
    f32x4 v[2][8];
#pragma unroll
    for (int j = 0; j < 4; ++j) { const float* p0 = xrow0 + j * 512 + lane * 8; const float* p1 = xrow1 + j * 512 + lane * 8;
        v[0][2 * j] = ntload((const f32x4*)p0); v[0][2 * j + 1] = ntload((const f32x4*)(p0 + 4)); v[1][2 * j] = ntload((const f32x4*)p1); v[1][2 * j + 1] = ntload((const f32x4*)(p1 + 4)); }
#pragma unroll
    for (int k = 0; k < 2; ++k) { float s = 0.f; bf16* orow = k ? orow1 : orow0;
#pragma unroll
        for (int j = 0; j < 8; ++j) s += (v[k][j].x * v[k][j].x + v[k][j].y * v[k][j].y) + (v[k][j].z * v[k][j].z + v[k][j].w * v[k][j].w);
        const float rstd = 1.0f / sqrtf(wave_sum(s) * (1.f / DM) + NORM_EPS);
#pragma unroll
        for (int j = 0; j < 4; ++j) { const float* gp = g + j * 512 + lane * 8; const f32x4 g0 = *(const f32x4*)gp, g1 = *(const f32x4*)(gp + 4); const f32x4 a = v[k][2 * j] * rstd * g0, b = v[k][2 * j + 1] * rstd * g1;
            v4u o; o.x = pk2(a.x, a.y); o.y = pk2(a.z, a.w); o.z = pk2(b.x, b.y); o.w = pk2(b.z, b.w); *(v4u*)(orow + j * 512 + lane * 8) = o; } }
}
template <bool BASE_BF, bool OUT_BF>
__device__ __forceinline__ void row_pass(const bf16* Y, const void* basev, const float* gA, void* outv, const float* gB, bf16* xn, int gw, int NGW, int lane, int ldx = DM, const float* pin = nullptr) {
    const float* base = (const float*)basev; const bf16* baseb = (const bf16*)basev; float* outh = (float*)outv; bf16* outb = (bf16*)outv;
    for (int row0 = gw; row0 < T; row0 += 2 * NGW) {
        f32x4 h[2][8]; v4u yw[2][4];
#pragma unroll
        for (int k = 0; k < 2; ++k)
#pragma unroll
            for (int j = 0; j < 4; ++j) { const size_t off = (size_t)(row0 + k * NGW) * DM + j * 512 + lane * 8; yw[k][j] = ntload((const v4u*)(Y + off));
                if constexpr (BASE_BF) { const v4u bw = ntload((const v4u*)(baseb + off)); h[k][2 * j] = (f32x4){bflo(bw.x), bfhi(bw.x), bflo(bw.y), bfhi(bw.y)}; h[k][2 * j + 1] = (f32x4){bflo(bw.z), bfhi(bw.z), bflo(bw.w), bfhi(bw.w)}; }
                else { h[k][2 * j] = ntload((const f32x4*)(base + off)); h[k][2 * j + 1] = ntload((const f32x4*)(base + off + 4)); } }
#pragma unroll
        for (int k = 0; k < 2; ++k) { const int row = row0 + k * NGW;
            f32x4 y[8]; float s = 0.f;
#pragma unroll
            for (int j = 0; j < 4; ++j) { const v4u w = yw[k][j]; y[2 * j] = (f32x4){bflo(w.x), bfhi(w.x), bflo(w.y), bfhi(w.y)}; y[2 * j + 1] = (f32x4){bflo(w.z), bfhi(w.z), bflo(w.w), bfhi(w.w)}; }
#pragma unroll
            for (int j = 0; j < 8; ++j) s += (y[j].x * y[j].x + y[j].y * y[j].y) + (y[j].z * y[j].z + y[j].w * y[j].w);
            const float r1 = 1.0f / sqrtf(wave_sum(s) * (1.f / DM) + NORM_EPS); float s2 = 0.f;
#pragma unroll
            for (int j = 0; j < 4; ++j) { const int c = j * 512 + lane * 8; const f32x4 g0 = *(const f32x4*)(gA + c), g1 = *(const f32x4*)(gA + c + 4);
                h[k][2 * j] = h[k][2 * j] + y[2 * j] * r1 * g0; h[k][2 * j + 1] = h[k][2 * j + 1] + y[2 * j + 1] * r1 * g1;
                if constexpr (OUT_BF) { const f32x4 a = h[k][2 * j], b = h[k][2 * j + 1]; v4u o; o.x = pk2(a.x, a.y); o.y = pk2(a.z, a.w); o.z = pk2(b.x, b.y); o.w = pk2(b.z, b.w); ntstore(o, (v4u*)(outb + (size_t)row * DM + c)); }
                else { ntstore(h[k][2 * j], (f32x4*)(outh + (size_t)row * DM + c)); ntstore(h[k][2 * j + 1], (f32x4*)(outh + (size_t)row * DM + c + 4)); } }
            if (xn) {
#pragma unroll
                for (int j = 0; j < 8; ++j) s2 += (h[k][j].x * h[k][j].x + h[k][j].y * h[k][j].y) + (h[k][j].z * h[k][j].z + h[k][j].w * h[k][j].w);
                const float r2 = 1.0f / sqrtf(wave_sum(s2) * (1.f / DM) + NORM_EPS);
#pragma unroll
                for (int j = 0; j < 4; ++j) { const int c = j * 512 + lane * 8; const f32x4 g0 = *(const f32x4*)(gB + c), g1 = *(const f32x4*)(gB + c + 4); const f32x4 a = h[k][2 * j] * r2 * g0, b = h[k][2 * j + 1] * r2 * g1;
                    v4u o; o.x = pk2(a.x, a.y); o.y = pk2(a.z, a.w); o.z = pk2(b.x, b.y); o.w = pk2(b.z, b.w); *(v4u*)(xn + (size_t)row * ldx + c) = o; }
                if (pin) { const f32x4 pv = *(const f32x4*)(pin + (size_t)row * PLE + lane * 4); v2u o; o.x = pk2(pv.x, pv.y); o.y = pk2(pv.z, pv.w); *(v2u*)(xn + (size_t)row * ldx + DM + lane * 4) = o; }
            }
        }
    }
}

typedef swa::BlockRef<swa::bf16, swa::bf16> ABlock;
__device__ __forceinline__ ABlock attn_ref(int head, int qb, unsigned char* ws, float* dout) {
    const swa::bf16* QKVs = (const swa::bf16*)(ws + WS_QKV); ABlock r;
    const int b = head >> 4, hd = (head >> 2) & 3, c = (head >> 1) & 1, j = head & 1; const int sh = b * NH8 + hd * 2 + c, vh = b * NH8 + hd * 2 + j;
    r.Q = QKVs + 3 * SEC_ELEMS + ((size_t)sh * SEQ + (size_t)qb * 256) * 128; r.K = QKVs + 4 * SEC_ELEMS + (size_t)sh * SEQ * 128; r.V = QKVs + 5 * SEC_ELEMS + (size_t)vh * SEQ * 128;
    r.O = (swa::bf16*)dout + ((size_t)b * SEQ + (size_t)qb * 256) * 4096 + hd * 512 + c * 256 + j * 128;
    r.ldo = 4096; r.rows = nullptr; r.dst = nullptr; r.stat = nullptr; r.P0 = qb * 256;
    return r;
}
constexpr int MOBA_PER = 320, MOBA_ITEMS = 16 * MOBA_PER;
__device__ __forceinline__ bool moba_valid(int L, const int* nblk) { const int bh = L / MOBA_PER, k = L - bh * MOBA_PER; return k >= 256 || k < nblk[bh]; }
__device__ __forceinline__ int moba_next(int L, int G, const int* nblk) { do { L += G; } while (L < MOBA_ITEMS && !moba_valid(L, nblk)); return L; }
__device__ __forceinline__ ABlock moba_ref(int L, unsigned char* ws, float* dout) {
    const swa::bf16* QKVs = (const swa::bf16*)(ws + WS_QKV); ABlock r;
    const int bh = L / MOBA_PER, k = L - bh * MOBA_PER; int j, lp, p0;
    if (k < 256) { const int2 t = ((const int2*)(ws + WS_TAB))[bh * 256 + k]; j = t.x; lp = t.y; p0 = 256; } else { j = k - 256; lp = 65536 + j * 256; p0 = 0; }
    r.Q = QKVs + (size_t)bh * SEQ * 128; r.K = QKVs + 1 * SEC_ELEMS + ((size_t)bh * SEQ + (size_t)j * 256) * 128; r.V = QKVs + 2 * SEC_ELEMS + ((size_t)bh * SEQ + (size_t)j * 256) * 128;
    r.O = (swa::bf16*)dout; r.ldo = 128; r.rows = (const int*)(ws + WS_ROWL) + (size_t)bh * LSTR + lp; r.dst = (const int*)(ws + WS_DSTL) + (size_t)bh * LSTR + lp; r.stat = (float*)(ws + WS_STATS); r.P0 = p0;
    return r;
}

__global__ void __launch_bounds__(NWAVES * 64, 2) mk_fwd(Args args) {
    extern __shared__ __attribute__((aligned(16))) unsigned char lds[];
    LAS unsigned char* L = (LAS unsigned char*)lds;
    const int tid = threadIdx.x, lane = tid & 63, wave = __builtin_amdgcn_readfirstlane(tid >> 6);
    const int G = gridDim.x, bx = blockIdx.x;
    const int vcu = (G % 8 == 0) ? (bx % 8) * (G / 8) + bx / 8 : bx;
    const int gw = vcu * NWAVES + wave, NGW = G * NWAVES;
    unsigned char* ws = args.ws;
#define x_in (args.in[0])
#define p_in (args.in[1])
#define Win_t ((bf16*)(ws + WS_WIN))
#define Wa_t ((bf16*)(ws + WS_WA))
#define Wb_t ((bf16*)(ws + WS_WB))
#define Wout_t ((bf16*)(ws + WS_WOUT))
#define Wup_t ((bf16*)(ws + WS_WUP))
#define Wdn_t ((bf16*)(ws + WS_WDN))
#define Wpg_t ((bf16*)(ws + WS_WPG))
#define Wpp_t ((bf16*)(ws + WS_WPP))
#define XN ((bf16*)(ws + WS_XN))
#define PB ((bf16*)(ws + WS_PB))
#define QKV ((bf16*)(ws + WS_QKV))
#define SG ((bf16*)(ws + WS_SG))
#define OAB ((bf16*)(ws + WS_XN))
#define MIX ((bf16*)(ws + WS_MIX))
#define HID ((bf16*)(ws + WS_HID))
#define G3 ((bf16*)(ws + WS_G3))
#define Y ((bf16*)(ws + WS_Y))
#define rope ((float*)(ws + WS_ROPE))
#define kmean ((float*)(ws + WS_KMEAN))
#define out (args.out)
    const int lo = args.ph_lo, hi = args.ph_hi;
#define IN(k) (lo <= (k) && (k) < hi)
#define SEAM(k) do { if (IN(k) && IN((k) + 1)) { if (args.coop) { if (args.pad == 0x5eed) { asm volatile("s_waitcnt vmcnt(0) lgkmcnt(0)" ::: "memory"); cg::this_grid().sync(); }     \
        xcd_barrier(xbar); } } } while (0)
    volatile LAS unsigned* bst = (volatile LAS unsigned*)(L + LDS_BYTES - 64);
    if (tid < 2) bst[tid] = 0u;
    __syncthreads();
    XcdBarrier xbar; xbar.bar = (unsigned*)(ws + WS_BAR); xbar.x = 0; xbar.st = bst;
    if (args.coop) xbar = xcd_barrier_post((unsigned*)(ws + WS_BAR), bst);

    if (IN(0)) {
        LAS float* scr = (LAS float*)(L + wave * 16896);
        constexpr int I_IN = (DM / 64) * (INW / 64), I_BR = (1024 / 64) * (DM / 64), I_OUT = (DM / 64) * (DM / 64), I_UP = (DM / 64) * (DFF / 64), I_DN = (DFF / 64) * (DM / 64), I_PP = (PLE / 64) * (DM / 64);
        constexpr int NITEMS = I_IN + 2 * I_BR + I_OUT + I_UP + I_DN + I_OUT + I_PP;
        for (int it = gw; it < NITEMS; it += NGW) {
            int r = it;
            if (r < I_IN) { p0_transpose_item(args.in[2], DM, INW, Win_t, scr, r, lane); continue; } r -= I_IN;
            if (r < I_BR) { p0_transpose_item(args.in[3], 1024, DM, Wa_t, scr, r, lane, 2048); continue; } r -= I_BR;
            if (r < I_BR) { p0_transpose_item(args.in[4], 1024, DM, Wa_t + 1024, scr, r, lane, 2048); continue; } r -= I_BR;
            if (r < I_OUT) { p0_transpose_item(args.in[5], DM, DM, Wout_t, scr, r, lane); continue; } r -= I_OUT;
            if (r < I_UP) { p0_transpose_item(args.in[13], DM, DFF, Wup_t, scr, r, lane); continue; } r -= I_UP;
            if (r < I_DN) { p0_transpose_item(args.in[14], DFF, DM, Wdn_t, scr, r, lane); continue; } r -= I_DN;
            if (r < I_OUT) { p0_transpose_item(args.in[18], DM, DM, Wpg_t, scr, r, lane, DM + PLE); continue; } r -= I_OUT;
            p0_transpose_item(args.in[17], PLE, DM, Wpg_t + DM, scr, r, lane, DM + PLE);
        }
        for (int m = gw; m < T; m += 2 * NGW) rms_rows2_to_bf16(x_in + (size_t)m * DM, x_in + (size_t)(m + NGW) * DM, args.in[11], XN + (size_t)m * DM, XN + (size_t)(m + NGW) * DM, lane);
        if (bx == 0) { for (int i = tid; i < 16 * 64 + 16; i += 512) { if (i < 1024) ((int*)(ws + WS_CNT))[i] = 0; else ((int*)(ws + WS_NBLK))[i - 1024] = 0; } }
        for (int i = bx * 512 + tid; i < 16 * 64 * 128; i += G * 512) kmean[i] = 0.f;
        for (int i = bx * 512 + tid; i < SEQ * 16; i += G * 512) { const int pos = i >> 4, k = i & 15;
            double fr_ = 1.0; for (int j_ = 0; j_ < k; ++j_) fr_ *= 0.4403666026717805;
            const float angf = (float)pos * (float)fr_; const double a = (double)angf;
            const double TWO_PI = 6.283185307179586476925286766559; double q = __builtin_rint(a / TWO_PI); double r = a - q * TWO_PI;
            const double r2 = r * r; double sn = 1.0, cs = 1.0;
            sn = 1.0 - r2 / (22.0 * 23.0); sn = 1.0 - r2 / (20.0 * 21.0) * sn; sn = 1.0 - r2 / (18.0 * 19.0) * sn; sn = 1.0 - r2 / (16.0 * 17.0) * sn; sn = 1.0 - r2 / (14.0 * 15.0) * sn; sn = 1.0 - r2 / (12.0 * 13.0) * sn;
            sn = 1.0 - r2 / (10.0 * 11.0) * sn; sn = 1.0 - r2 / (8.0 * 9.0) * sn; sn = 1.0 - r2 / (6.0 * 7.0) * sn; sn = 1.0 - r2 / (4.0 * 5.0) * sn; sn = 1.0 - r2 / (2.0 * 3.0) * sn; sn = r * sn;
            cs = 1.0 - r2 / (21.0 * 22.0); cs = 1.0 - r2 / (19.0 * 20.0) * cs; cs = 1.0 - r2 / (17.0 * 18.0) * cs; cs = 1.0 - r2 / (15.0 * 16.0) * cs; cs = 1.0 - r2 / (13.0 * 14.0) * cs; cs = 1.0 - r2 / (11.0 * 12.0) * cs;
            cs = 1.0 - r2 / (9.0 * 10.0) * cs; cs = 1.0 - r2 / (7.0 * 8.0) * cs; cs = 1.0 - r2 / (5.0 * 6.0) * cs; cs = 1.0 - r2 / (3.0 * 4.0) * cs; cs = 1.0 - r2 / (1.0 * 2.0) * cs;
            rope[(size_t)pos * 32 + k] = (float)cs; rope[(size_t)pos * 32 + 16 + k] = (float)sn; }
    }
    SEAM(0);
    if (IN(1)) {
        pg8::Gemm g{XN, Win_t, T, INW, DM}; pg8::StaticOrder S; S.init(T, INW, G, bx);
        pg8::EpiInProj E{QKV, SG, (const float*)rope, kmean};
        pg8::gemm_phase<pg8::EpiInProj, pg8::StaticOrder, true, true>(L, g, S, E);
    }
    SEAM(1);
    if (IN(3)) {
        char* Kl = (char*)lds;
        const int lane_ = tid & 63, r32 = lane_ & 31, hi = lane_ >> 5;
        const int sr = tid >> 4, sc = (tid & 15) * 8, kws = KSWZ(sr, sc * 2);
        int bh_loaded = -1;
        for (int u = vcu; u < 16 * 64; u += G) {
            const int bh = u & 15, qb = u >> 4;
            if (bh != bh_loaded) {
                __syncthreads();
#pragma unroll
                for (int h2 = 0; h2 < 2; ++h2) { const float* kp = kmean + ((size_t)bh * 64 + sr + 32 * h2) * 128 + sc; const f32x4 a = *(const f32x4*)kp, b = *(const f32x4*)(kp + 4);
                    const float v[8] = {a.x, a.y, a.z, a.w, b.x, b.y, b.z, b.w}; unsigned hb[8], lb[8];
#pragma unroll
                    for (int e = 0; e < 8; ++e) { hb[e] = f2bf(v[e]); lb[e] = f2bf(v[e] - __uint_as_float(hb[e] << 16)); }
                    v4u wh, wl; wh.x = hb[0] | (hb[1] << 16); wh.y = hb[2] | (hb[3] << 16); wh.z = hb[4] | (hb[5] << 16); wh.w = hb[6] | (hb[7] << 16);
                    wl.x = lb[0] | (lb[1] << 16); wl.y = lb[2] | (lb[3] << 16); wl.z = lb[4] | (lb[5] << 16); wl.w = lb[6] | (lb[7] << 16);
                    *(v4u*)(Kl + kws + h2 * 32 * 256) = wh; *(v4u*)(Kl + swa::SHM_K + kws + h2 * 32 * 256) = wl; }
                __syncthreads();
                bh_loaded = bh;
            }
            const int row = wave * 32 + r32;
            swa::bf16x8 qr[8];
            { const swa::bf16* qp = (const swa::bf16*)QKV + ((size_t)bh * SEQ + (size_t)qb * 256 + row) * 128 + hi * 8;
#pragma unroll
              for (int d0 = 0; d0 < 8; ++d0) qr[d0] = swa::load8<swa::bf16>(qp + d0 * 16); }
            swa::f32x16 ph0, ph1, pl0, pl1;
            swa::qkt_r<0>(ph0, ph1, Kl, r32, hi, qr); swa::qkt_r<1>(pl0, pl1, Kl, r32, hi, qr);
            float g0 = -__builtin_inff(), g1 = g0, g2 = g0; int i0 = -1, i1 = -1, i2 = -1;
#define INS3(gv, iv) do { const float g_ = (gv); const int i_ = (iv); if (g_ > g0) { g2 = g1; i2 = i1; g1 = g0; i1 = i0; g0 = g_; i0 = i_; } else if (g_ > g1) { g2 = g1; i2 = i1; g1 = g_; i1 = i_; } else if (g_ > g2) { g2 = g_; i2 = i_; } } while (0)
#pragma unroll
            for (int r = 0; r < 16; ++r) { const int n = swa::crow(r, hi); if (n < qb) INS3(ph0[r] + pl0[r], n); }
#pragma unroll
            for (int r = 0; r < 16; ++r) { const int n = 32 + swa::crow(r, hi); if (n < qb) INS3(ph1[r] + pl1[r], n); }
            { const float pg0 = __shfl_xor(g0, 32), pg1 = __shfl_xor(g1, 32), pg2 = __shfl_xor(g2, 32); const int pi0 = __shfl_xor(i0, 32), pi1 = __shfl_xor(i1, 32), pi2 = __shfl_xor(i2, 32);
              INS3(pg0, pi0); INS3(pg1, pi1); INS3(pg2, pi2); }
#undef INS3
            if (hi == 0) {
                const int grow = qb * 256 + row; int s0 = -1, s1 = -1, s2 = -1; int* cnt = (int*)(ws + WS_CNT) + bh * 64; float2* stt = (float2*)(ws + WS_STATS);
                float2 none; none.x = -1e30f; none.y = 0.f;
                if (i0 >= 0) s0 = atomicAdd(cnt + i0, 1); else stt[(size_t)(bh * 4 + 0) * SEQ + grow] = none;
                if (i1 >= 0) s1 = atomicAdd(cnt + i1, 1); else stt[(size_t)(bh * 4 + 1) * SEQ + grow] = none;
                if (i2 >= 0) s2 = atomicAdd(cnt + i2, 1); else stt[(size_t)(bh * 4 + 2) * SEQ + grow] = none;
                int4 rec; rec.x = (i0 & 255) | ((i1 & 255) << 8) | ((i2 & 255) << 16); rec.y = s0; rec.z = s1; rec.w = s2;
                ((int4*)(ws + WS_SEL))[(size_t)bh * SEQ + grow] = rec; }
        }
        __syncthreads();
    }
    SEAM(3);
    if (IN(4)) {
        LAS int* cn = (LAS int*)L; LAS int* offs = cn + 64;
        int* ROWL = (int*)(ws + WS_ROWL); int* DSTL = (int*)(ws + WS_DSTL);
        for (int u = vcu; u < 16 * 64; u += G) {
            const int bh = u & 15, chunk = u >> 4;
            __syncthreads();
            if (tid < 64) cn[tid] = ((const int*)(ws + WS_CNT))[bh * 64 + tid];
            __syncthreads();
            if (tid == 0) { int a = 0; for (int j = 0; j < 64; ++j) { offs[j] = a; a += (cn[j] + 255) & ~255; } offs[64] = a; }
            __syncthreads();
            int* rl = ROWL + (size_t)bh * LSTR; int* dl = DSTL + (size_t)bh * LSTR;
            if (tid < 256) { const int row = chunk * 256 + tid; const int4 rec = ((const int4*)(ws + WS_SEL))[(size_t)bh * SEQ + row];
                const int j0 = rec.x & 255, j1 = (rec.x >> 8) & 255, j2 = (rec.x >> 16) & 255;
                if (j0 != 255) { const int gp = offs[j0] + rec.y; rl[gp] = row; dl[gp] = (bh * 4 + 0) * SEQ + row; }
                if (j1 != 255) { const int gp = offs[j1] + rec.z; rl[gp] = row; dl[gp] = (bh * 4 + 1) * SEQ + row; }
                if (j2 != 255) { const int gp = offs[j2] + rec.w; rl[gp] = row; dl[gp] = (bh * 4 + 2) * SEQ + row; }
                rl[65536 + row] = row; dl[65536 + row] = (bh * 4 + 3) * SEQ + row; }
            if (chunk == 0) {
                for (int idx = tid; idx < 64 * 256; idx += 512) { const int j = idx >> 8, c = cn[j], pos = c + (idx & 255);
                    if (pos < ((c + 255) & ~255)) { rl[offs[j] + pos] = 0; dl[offs[j] + pos] = -1; } }
                if (tid == 0) { int k = 0; int2* tab = (int2*)(ws + WS_TAB) + bh * 256;
                    for (int j = 0; j < 64; ++j) { const int nb = (cn[j] + 255) >> 8; for (int b_ = 0; b_ < nb; ++b_) { if (k < 256) { int2 t; t.x = j; t.y = offs[j] + 256 * b_; tab[k] = t; } ++k; } }
                    ((int*)(ws + WS_NBLK))[bh] = k < 256 ? k : 256; }
            }
        }
        __syncthreads();
    }
    SEAM(4);
    if (IN(5)) {
        const int* nblk = (const int*)(ws + WS_NBLK);
        static_assert(swa::MOBA_LDS_BYTES <= LDS_BYTES - 64, "MoBA short-block LDS");
        int Lc = vcu; if (!moba_valid(Lc, nblk)) Lc = moba_next(Lc, G, nblk);
        if (Lc < MOBA_ITEMS) {
            ABlock cur = moba_ref(Lc, ws, out); swa::MobaStage ST; swa::moba_prime(cur, ST);
            for (;;) { const int Ln = moba_next(Lc, G, nblk); const bool has_next = Ln < MOBA_ITEMS;
                ABlock nxt = cur; if (has_next) nxt = moba_ref(Ln, ws, out);
                swa::moba_block(cur, nxt, has_next, (char*)lds, ST);
                if (!has_next) break;
                cur = nxt; Lc = Ln; }
        }
        __syncthreads();
    }
    SEAM(5);
    if (IN(6)) {
        const float2* stt = (const float2*)(ws + WS_STATS); const bf16* PART = (const bf16*)out; constexpr float C2 = 1.4426950408889634f * 0.08838834764831845f;
        for (int u0 = gw; u0 < 16 * SEQ; u0 += 4 * NGW) {
            float2 st[4][4]; unsigned pw[4][4];
#pragma unroll
            for (int k = 0; k < 4; ++k) { const int u = u0 + k * NGW, bh = u >> 14, row = u & (SEQ - 1);
#pragma unroll
                for (int s_ = 0; s_ < 4; ++s_) { const size_t di = (size_t)(bh * 4 + s_) * SEQ + row; st[k][s_] = stt[di]; pw[k][s_] = ntload((const unsigned*)(PART + di * 128 + lane * 2)); } }
#pragma unroll
            for (int k = 0; k < 4; ++k) { const int u = u0 + k * NGW, bh = u >> 14, row = u & (SEQ - 1);
                float M = -1e30f;
#pragma unroll
                for (int s_ = 0; s_ < 4; ++s_) if (st[k][s_].y > 0.f) M = fmaxf(M, st[k][s_].x);
                float a0 = 0.f, a1 = 0.f, den = 0.f;
#pragma unroll
                for (int s_ = 0; s_ < 4; ++s_) { const bool ok = st[k][s_].y > 0.f; const float w = ok ? st[k][s_].y * __builtin_amdgcn_exp2f((st[k][s_].x - M) * C2) : 0.f;
                    a0 += ok ? w * bflo(pw[k][s_]) : 0.f; a1 += ok ? w * bfhi(pw[k][s_]) : 0.f; den += w; }
                const float inv = 1.0f / den;
                *(unsigned*)(OAB + ((size_t)(bh >> 3) * SEQ + row) * 2048 + (bh & 7) * 128 + lane * 2) = pk2(a0 * inv, a1 * inv); } }
    }
    SEAM(6);
    if (IN(7)) {
        constexpr int NITEM = 32 * 32;
        int Lc = vcu;
        if (Lc < NITEM) {
            int head = Lc >> 5, xx = Lc & 31, pass = 0;
            ABlock cur = attn_ref(head, xx, ws, out);
            swa::Seam<swa::bf16> S;
            swa::causal_swa_prime<swa::bf16, swa::bf16>(cur, SEQ, (char*)lds, S);
            for (;;) {
                const bool more_pass = pass == 0, more_item = Lc + G < NITEM, last = !more_pass && !more_item;
                int headn = head, xn = xx, passn = pass + 1, Ln = Lc;
                if (!more_pass) { passn = 0; Ln = more_item ? Lc + G : Lc; headn = Ln >> 5; xn = Ln & 31; }
                const int qbn = passn ? 63 - xn : xn;
                ABlock nxt = cur;
                if (!last) nxt = attn_ref(headn, qbn, ws, out);
                swa::causal_swa_block<swa::bf16, swa::bf16>(cur, nxt, SEQ, SEQ, (char*)lds, S);
                if (last) break;
                cur = nxt; head = headn; xx = xn; pass = passn; Lc = Ln;
            }
        }
        __syncthreads();
    }
    SEAM(7);
    if (IN(8)) {
        float lam;
        { const float* q1 = args.in[6]; const float* k1 = args.in[7]; const float* q2 = args.in[8]; const float* k2 = args.in[9];
          const float s1 = wave_sum(q1[lane] * k1[lane] + q1[lane + 64] * k1[lane + 64]), s2 = wave_sum(q2[lane] * k2[lane] + q2[lane + 64] * k2[lane + 64]);
          lam = __expf(s1) - __expf(s2) + LAMBDA_INIT; }
        const bf16* AD = (const bf16*)out; const float* sg = args.in[10];
        const f32x4 gg = *(const f32x4*)(sg + lane * 4);
        for (int u0 = gw; u0 < T * 4; u0 += 4 * NGW) {
            v2u w0[4], w1[4];
#pragma unroll
            for (int k = 0; k < 4; ++k) { const int u = u0 + k * NGW, t = u >> 2, hd = u & 3; const bf16* a = AD + (size_t)t * 4096 + hd * 512 + lane * 4; w0[k] = ntload((const v2u*)a); w1[k] = ntload((const v2u*)(a + 256)); }
#pragma unroll
            for (int k = 0; k < 4; ++k) { const int u = u0 + k * NGW, t = u >> 2, hd = u & 3;
                f32x4 d; d.x = bflo(w0[k].x) - lam * bflo(w1[k].x); d.y = bfhi(w0[k].x) - lam * bfhi(w1[k].x); d.z = bflo(w0[k].y) - lam * bflo(w1[k].y); d.w = bfhi(w0[k].y) - lam * bfhi(w1[k].y);
                const float ss = wave_sum((d.x * d.x + d.y * d.y) + (d.z * d.z + d.w * d.w));
                const float r = (1.0f - LAMBDA_INIT) / sqrtf(ss * (1.f / 256.f) + NORM_EPS);
                v2u o; o.x = pk2(d.x * r * gg.x, d.y * r * gg.y); o.y = pk2(d.z * r * gg.z, d.w * r * gg.w);
                *(v2u*)(OAB + (size_t)t * 2048 + 1024 + hd * 256 + lane * 4) = o; } }
    }
    SEAM(8);
    if (IN(9)) { pg8::Gemm g{OAB, Wa_t, T, DM, 2048}; pg8::StaticOrder S; S.init(T, DM, G, bx); pg8::EpiGate2 E{MIX, SG};
        pg8::gemm_phase<pg8::EpiGate2, pg8::StaticOrder, true, true, true>(L, g, S, E); }
    SEAM(9);
    if (IN(11)) { pg8::Gemm g{MIX, Wout_t, T, DM, DM}; pg8::StaticOrder S; S.init(T, DM, G, bx); pg8::EpiT<0> E{Y, DM, nullptr, 0};
        pg8::gemm_phase<pg8::EpiT<0>, pg8::StaticOrder, true, true>(L, g, S, E); }
    SEAM(11);
    if (IN(12)) row_pass<false, true>(Y, x_in, args.in[12], out, args.in[15], XN, gw, NGW, lane);
    SEAM(12);
    if (IN(13)) { pg8::Gemm g{XN, Wup_t, T, DFF, DM}; pg8::StaticOrder S; S.init(T, DFF, G, bx); pg8::EpiT<1> E{HID, DFF, nullptr, 0};
        pg8::gemm_phase<pg8::EpiT<1>, pg8::StaticOrder, true, true>(L, g, S, E); }
    SEAM(13);
    if (IN(14)) { pg8::Gemm g{HID, Wdn_t, T, DM, DFF}; pg8::StaticOrder S; S.init(T, DM, G, bx); pg8::EpiT<0> E{Y, DM, nullptr, 0};
        pg8::gemm_phase<pg8::EpiT<0>, pg8::StaticOrder, true, true>(L, g, S, E); }
    SEAM(14);
    if (IN(15)) row_pass<true, true>(Y, out, args.in[16], ws + WS_H2, args.in[19], (bf16*)(ws + WS_XN3), gw, NGW, lane, DM + PLE, p_in);
    SEAM(15);
    if (IN(16)) { pg8::Gemm g{(bf16*)(ws + WS_XN3), Wpg_t, T, DM, DM + PLE}; pg8::StaticOrder S; S.init(T, DM, G, bx); pg8::EpiPle E{Y, G3};
        pg8::gemm_phase<pg8::EpiPle, pg8::StaticOrder, true, true, true>(L, g, S, E); }
    SEAM(17);
    if (IN(18)) row_pass<true, false>(Y, ws + WS_H2, args.in[20], out, nullptr, nullptr, gw, NGW, lane);
#undef IN
#undef SEAM
#undef x_in
#undef p_in
#undef Win_t
#undef Wa_t
#undef Wb_t
#undef Wout_t
#undef Wup_t
#undef Wdn_t
#undef Wpg_t
#undef Wpp_t
#undef XN
#undef PB
#undef QKV
#undef SG
#undef OAB
#undef MIX
#undef HID
#undef G3
#undef Y
#undef rope
#undef kmean
#undef out
}

extern "C" void kernel_launch(void* const* d_in, const int* in_sizes, int n_in, void* d_out, int out_size, void* d_ws, size_t ws_size, hipStream_t stream) {
    static int grid = 0;
    if (grid == 0) {
        if (n_in != 21 || out_size != T * DM || ws_size < WS_TOP) { fprintf(stderr, "kernel_launch: unexpected shapes n_in %d out %d ws %zu\n", n_in, out_size, ws_size); grid = -1; return; }
        int dev = 0, cus = 0, per_cu = 0;
        (void)hipGetDevice(&dev); (void)hipDeviceGetAttribute(&cus, hipDeviceAttributeMultiprocessorCount, dev);
        if (hipFuncSetAttribute((const void*)mk_fwd, hipFuncAttributeMaxDynamicSharedMemorySize, LDS_BYTES) != hipSuccess) { fprintf(stderr, "kernel_launch: hipFuncSetAttribute failed\n"); grid = -1; return; }
        if (hipOccupancyMaxActiveBlocksPerMultiprocessor(&per_cu, (const void*)mk_fwd, NWAVES * 64, LDS_BYTES) != hipSuccess || per_cu < 1) { fprintf(stderr, "kernel_launch: occupancy query says %d\n", per_cu); per_cu = 1; }
        (void)hipGetLastError();
        grid = cus * 1;
        if (grid <= 0) grid = 256;
    }
    if (grid < 0) return;
    (void)hipMemsetAsync((unsigned char*)d_ws + WS_BAR, 0, WS_BAR_BYTES, stream);
    Args a{};
    for (int i = 0; i < 21; ++i) a.in[i] = (const float*)d_in[i];
    a.out = (float*)d_out; a.ws = (unsigned char*)d_ws;
#if MK_ONE_LAUNCH
    a.ph_lo = 0; a.ph_hi = NPHASE; a.coop = 1;
    void* kargs[] = {&a};
    hipError_t e = hipLaunchCooperativeKernel((const void*)mk_fwd, dim3(grid), dim3(NWAVES * 64), kargs, LDS_BYTES, stream);
    if (e != hipSuccess) fprintf(stderr, "cooperative launch failed: %s (grid %d)\n", hipGetErrorString(e), grid);
#else
    for (int ph = 0; ph < NPHASE; ++ph) { a.ph_lo = ph; a.ph_hi = ph + 1; a.coop = 0;
        hipLaunchKernelGGL(mk_fwd, dim3(grid), dim3(NWAVES * 64), LDS_BYTES, stream, a); }
#endif
}
```

```cpp
#include <hip/hip_runtime.h>
#include <hip/hip_bf16.h>
#include <cstdio>
#include <cstdint>
#include <cmath>
namespace pg8 {
#define PG8_LAS __attribute__((address_space(3)))
typedef unsigned short bf16_t;
typedef short bf16x8 __attribute__((ext_vector_type(8)));
typedef float f32x4 __attribute__((ext_vector_type(4)));
typedef unsigned u32x4 __attribute__((ext_vector_type(4)));
constexpr int BM = 256, BK = 64, HALF = 128, HTB = HALF * BK * 2  , STAGE_BYTES = 8 * HTB, NXCD = 8, WGM = 8;

__host__ __device__ __forceinline__ int lds_byte(int r, int c) { const int st = (r >> 4) * 2 + (c >> 5), rr = r & 15, cc = c & 31, ob = rr * 64 + cc * 2; return st * 1024 + (ob ^ (((ob >> 9) & 1) << 5)); }
__host__ __device__ __forceinline__ void stage_rc(int b, int& R, int& C) { const int st = b / 1024, sb = b % 1024, swz = sb ^ (((sb >> 9) & 1) << 5); R = (st >> 1) * 16 + swz / 64; C = (st & 1) * 32 + (swz % 64) / 2; }
__host__ __device__ __forceinline__ int perm32(int rho) { const int n = rho >> 4, i = rho & 15; return 8 * (i >> 2) + 4 * n + (i & 3); }

struct Unit { int pm, pn; };
struct Gemm { const bf16_t* A; const bf16_t* Bt; int M, N, K; };

struct StaticOrder {
    int nM, nN, nwg, G, c;
    __host__ __device__ void init(int M, int N, int G_, int c_) { nM = M / BM; nN = N / BM; nwg = nM * nN; G = G_; c = c_; }
    __host__ __device__ bool next(int i, Unit& u) const {
        const long L = (long)i * G + c; if (L >= nwg) return false;
        int wgid = (int)L; { const int q = nwg / NXCD, r = nwg % NXCD, xcd = wgid % NXCD, off = wgid / NXCD; wgid = (xcd < r ? xcd * (q + 1) : r * (q + 1) + (xcd - r) * q) + off; }
        const int nig = WGM * nN, gid = wgid / nig, fm = gid * WGM, gsz = (nM - fm) < WGM ? (nM - fm) : WGM;
        u.pm = fm + ((wgid % nig) % gsz); u.pn = (wgid % nig) / gsz; return true;
    }
    __device__ __forceinline__ void a_ready(const Unit&) const {}
    __device__ __forceinline__ void done(const Unit&) const {}
};

typedef float f32x2_c __attribute__((ext_vector_type(2))); typedef __bf16 bf16x2_c __attribute__((ext_vector_type(2)));
__device__ __forceinline__ unsigned cvt_pk_bf16(float lo, float hi) { f32x2_c v = {lo, hi}; bf16x2_c b = __builtin_convertvector(v, bf16x2_c); return __builtin_bit_cast(unsigned, b); }
typedef float f32x2 __attribute__((ext_vector_type(2)));
__device__ __forceinline__ f32x2 gelu_pk(f32x2 v) {
    const f32x2 av = __builtin_elementwise_abs(v), d = av * 0.2316418882f + 1.0f;
    f32x2 t; t.x = __builtin_amdgcn_rcpf(d.x); t.y = __builtin_amdgcn_rcpf(d.y);
    f32x2 q = t * 0.5307027145f + (-0.7265760135f); q = q * t + 0.7107068705f; q = q * t + (-0.142248368f); q = q * t + 0.127414796f; q = q * t;
    const f32x2 s = (v * v) * (-0.72134752044f);
    f32x2 e; e.x = __builtin_amdgcn_exp2f(s.x); e.y = __builtin_amdgcn_exp2f(s.y);
    const f32x2 m = v * (q * e), r = v - m;
    f32x2 o; o.x = v.x < 0.f ? m.x : r.x; o.y = v.y < 0.f ? m.y : r.y; return o;
}

template <int ACT  > struct EpiBf16 {
    static constexpr bool PERM = true, AFTER_DRAIN = false; static_assert(ACT == 0 || ACT == 1, "EpiBf16: ACT is 0 (none) or 1 (gelu_pk)");
    bf16_t* O; int ldc; const float* bias; int split_cols; size_t split_stride; float scale0;
    __device__ __forceinline__ void operator()(const f32x4 (&acc)[2][2][4][2], const Unit& u, int wr, int wc, int fr, int fq) const {
        const int row0 = u.pm * BM + wr * 64 + fr; int colt = u.pn * BM; bf16_t* base = O;
        float sc = 1.f; if (split_cols) { const int t = colt / split_cols; base += (size_t)t * split_stride; colt -= t * split_cols; if (t == 0) sc = scale0; }
        const int col0 = colt + wc * 32 + 8 * fq, bcol0 = u.pn * BM + wc * 32 + 8 * fq;
        f32x4 bv[2][2];
#pragma unroll
        for (int bj = 0; bj < 2; ++bj)
#pragma unroll
            for (int n = 0; n < 2; ++n) bv[bj][n] = bias ? *(const f32x4*)(bias + bcol0 + bj * HALF + 4 * n) : (f32x4){0.f, 0.f, 0.f, 0.f};
#pragma unroll
        for (int ai = 0; ai < 2; ++ai)
#pragma unroll
            for (int m = 0; m < 4; ++m) { bf16_t* rowp = base + (size_t)(row0 + ai * HALF + m * 16) * ldc + col0;
#pragma unroll
                for (int bj = 0; bj < 2; ++bj) { f32x4 v0 = acc[ai][bj][m][0] + bv[bj][0], v1 = acc[ai][bj][m][1] + bv[bj][1];
                    if (ACT == 1) { f32x2 a = gelu_pk((f32x2){v0[0], v0[1]}), b = gelu_pk((f32x2){v0[2], v0[3]}), c = gelu_pk((f32x2){v1[0], v1[1]}), d = gelu_pk((f32x2){v1[2], v1[3]});
                        v0 = (f32x4){a.x, a.y, b.x, b.y}; v1 = (f32x4){c.x, c.y, d.x, d.y}; }
                    v0 = v0 * sc; v1 = v1 * sc; u32x4 w; w.x = cvt_pk_bf16(v0[0], v0[1]); w.y = cvt_pk_bf16(v0[2], v0[3]); w.z = cvt_pk_bf16(v1[0], v1[1]); w.w = cvt_pk_bf16(v1[2], v1[3]);
                    *(u32x4*)(rowp + bj * HALF) = w; } }
    }
};

template <class Epi, class Sched, bool ALIGN_EPI = false, bool SP2 = false, bool MID = false>
__device__ __forceinline__ void gemm_phase(PG8_LAS unsigned char* lds, const Gemm g, const Sched& S, const Epi& E) {
    const int tid = threadIdx.x, wid = __builtin_amdgcn_readfirstlane(tid >> 6), lane = tid & 63, wr = wid >> 2, wc = wid & 3, fr = lane & 15, fq = lane >> 4;
    const int K = g.K, nt = K / BK;
    unsigned voffA[2], voffB[2];
#pragma unroll
    for (int i = 0; i < 2; ++i) { int R, C; stage_rc(tid * 16 + i * 8192, R, C); const int Rb = Epi::PERM ? ((R & ~31) + perm32(R & 31)) : R;
        voffA[i] = (unsigned)(R * K + C) * 2u; voffB[i] = (unsigned)(Rb * K + C) * 2u; }
    const size_t kstep = (size_t)(BK * 2);
    const size_t hstep = (size_t)HALF * K * 2;
    const size_t tstep = 2 * hstep;
    const unsigned ldsw = (unsigned)wid * 1024u;
    const int aoff = lds_byte(wr * 64 + fr, fq * 8), boff = lds_byte(wc * 32 + fr, fq * 8);
#define PG8_SA(b, h) (((b) * 2 + (h)) * HTB)
#define PG8_SB(b, h) ((4 + (b) * 2 + (h)) * HTB)
#define PG8_STAGE(bufoff, gbase, voff) do { _Pragma("unroll") for (int _i = 0; _i < 2; ++_i) \
        __builtin_amdgcn_global_load_lds((const unsigned*)((const char*)(gbase) + (voff)[_i]), (PG8_LAS unsigned*)(lds + (bufoff) + ldsw + _i * 8192), 16, 0, 0); } while (0)
#define PG8_LDA(dst, b, h) do { _Pragma("unroll") for (int m = 0; m < 4; ++m) _Pragma("unroll") for (int k = 0; k < 2; ++k) dst[m][k] = *(const PG8_LAS bf16x8*)(lds + PG8_SA(b, h) + aoff + m * 2048 + k * 1024); } while (0)
#define PG8_LDB(dst, b, h) do { _Pragma("unroll") for (int n = 0; n < 2; ++n) _Pragma("unroll") for (int k = 0; k < 2; ++k) dst[n][k] = *(const PG8_LAS bf16x8*)(lds + PG8_SB(b, h) + boff + n * 2048 + k * 1024); } while (0)
#define PG8_MMA(ai, bj, At, Bt) do { __builtin_amdgcn_s_setprio(1); _Pragma("unroll") for (int m = 0; m < 4; ++m) _Pragma("unroll") for (int n = 0; n < 2; ++n) _Pragma("unroll") for (int k = 0; k < 2; ++k) \
        acc[ai][bj][m][n] = __builtin_amdgcn_mfma_f32_16x16x32_bf16(Bt[n][k], At[m][k], acc[ai][bj][m][n], 0, 0, 0); __builtin_amdgcn_s_setprio(0); } while (0)
#define PG8_WAIT_V(n) asm volatile("s_waitcnt vmcnt(" #n ")" ::: "memory")
#define PG8_WAIT_L(n) asm volatile("s_waitcnt lgkmcnt(" #n ")" ::: "memory")
#define PG8_BAR __builtin_amdgcn_s_barrier()
#define PG8_SCHED __builtin_amdgcn_sched_barrier(0)
    Unit cur, nxt; int ui = 0;
    if (!S.next(0, cur)) return;
    f32x4 acc[2][2][4][2];
#pragma unroll
    for (int a = 0; a < 2; ++a)
#pragma unroll
        for (int b = 0; b < 2; ++b)
#pragma unroll
            for (int m = 0; m < 4; ++m)
#pragma unroll
                for (int n = 0; n < 2; ++n) acc[a][b][m][n] = (f32x4){0.f, 0.f, 0.f, 0.f};
    bf16x8 At[4][2], B0[2][2], B1[2][2];
    const char* cA = (const char*)g.A + (size_t)cur.pm * tstep; const char* cB = (const char*)g.Bt + (size_t)cur.pn * tstep;
    S.a_ready(cur);
    if constexpr (SP2) {
        PG8_STAGE(PG8_SB(0, 0), cB, voffB); PG8_STAGE(PG8_SB(0, 1), cB + hstep, voffB); PG8_STAGE(PG8_SA(0, 0), cA, voffA); PG8_STAGE(PG8_SA(0, 1), cA + hstep, voffA);
        if (wr == 1) PG8_BAR;
        PG8_WAIT_V(2); PG8_BAR;
        PG8_STAGE(PG8_SB(1, 0), cB + kstep, voffB); PG8_STAGE(PG8_SA(1, 0), cA + kstep, voffA); PG8_STAGE(PG8_SB(1, 1), cB + hstep + kstep, voffB);
        PG8_WAIT_V(6); PG8_BAR;
    } else {
        PG8_STAGE(PG8_SB(0, 0), cB, voffB); PG8_STAGE(PG8_SA(0, 0), cA, voffA); PG8_STAGE(PG8_SB(0, 1), cB + hstep, voffB); PG8_STAGE(PG8_SA(0, 1), cA + hstep, voffA);
        if (wr == 1) PG8_BAR;
        PG8_WAIT_V(4); PG8_BAR;
        PG8_STAGE(PG8_SB(1, 0), cB + kstep, voffB); PG8_STAGE(PG8_SA(1, 0), cA + kstep, voffA); PG8_STAGE(PG8_SB(1, 1), cB + hstep + kstep, voffB);
        PG8_WAIT_V(6); PG8_BAR;
    }
    for (;;) {
        const bool has_next = S.next(ui + 1, nxt);
        const char* nA = has_next ? (const char*)g.A + (size_t)nxt.pm * tstep : cA; const char* nB = has_next ? (const char*)g.Bt + (size_t)nxt.pn * tstep : cB;
        for (int t = 0; t < nt; t += 2) {
            const bool last = (t == nt - 2);
            if constexpr (MID) { if (t == Epi::MID_T) { PG8_SCHED; E.mid(acc, cur, wr, wc, fr, fq); PG8_SCHED; } }
            const char* a1 = cA + (size_t)(t + 1) * kstep;
            const char* a2 = last ? nA : cA + (size_t)(t + 2) * kstep; const char* b2 = last ? nB : cB + (size_t)(t + 2) * kstep;
            const char* a3 = a2 + kstep; const char* b3 = b2 + kstep;
            if (last && has_next) S.a_ready(nxt);
            if constexpr (SP2) {
            PG8_LDB(B0, 0, 0); PG8_LDB(B1, 0, 1); PG8_SCHED; PG8_LDA(At, 0, 0); PG8_STAGE(PG8_SA(1, 1), a1 + hstep, voffA);
            PG8_WAIT_V(8); PG8_WAIT_L(0); PG8_BAR; PG8_MMA(0, 0, At, B0); PG8_MMA(0, 1, At, B1); PG8_BAR; PG8_SCHED;
            PG8_LDA(At, 0, 1); PG8_STAGE(PG8_SB(0, 0), b2, voffB); PG8_STAGE(PG8_SB(0, 1), b2 + hstep, voffB); PG8_STAGE(PG8_SA(0, 0), a2, voffA);
            PG8_WAIT_V(8); PG8_WAIT_L(0); PG8_BAR; PG8_MMA(1, 0, At, B0); PG8_MMA(1, 1, At, B1); PG8_BAR; PG8_SCHED;
            PG8_LDB(B0, 1, 0); PG8_LDB(B1, 1, 1); PG8_SCHED; PG8_LDA(At, 1, 0); PG8_STAGE(PG8_SA(0, 1), a2 + hstep, voffA);
            PG8_WAIT_V(8); PG8_WAIT_L(0); PG8_BAR; PG8_MMA(0, 0, At, B0); PG8_MMA(0, 1, At, B1); PG8_BAR; PG8_SCHED;
            PG8_LDA(At, 1, 1); PG8_STAGE(PG8_SB(1, 0), b3, voffB); PG8_STAGE(PG8_SB(1, 1), b3 + hstep, voffB); PG8_STAGE(PG8_SA(1, 0), a3, voffA);
            PG8_WAIT_V(8); PG8_WAIT_L(0); PG8_BAR; PG8_MMA(1, 0, At, B0); PG8_MMA(1, 1, At, B1); PG8_BAR; PG8_SCHED;
            } else {
            PG8_LDB(B0, 0, 0); PG8_SCHED; PG8_LDA(At, 0, 0); PG8_STAGE(PG8_SA(1, 1), a1 + hstep, voffA);
            PG8_WAIT_L(8); PG8_BAR; PG8_WAIT_L(0); PG8_MMA(0, 0, At, B0); PG8_BAR; PG8_SCHED;
            PG8_LDB(B1, 0, 1); PG8_STAGE(PG8_SB(0, 0), b2, voffB);
            PG8_BAR; PG8_WAIT_L(0); PG8_MMA(0, 1, At, B1); PG8_BAR;
            PG8_LDA(At, 0, 1); PG8_STAGE(PG8_SA(0, 0), a2, voffA);
            PG8_BAR; PG8_WAIT_L(0); PG8_MMA(1, 0, At, B0); PG8_BAR; PG8_SCHED;
            PG8_STAGE(PG8_SB(0, 1), b2 + hstep, voffB);
            PG8_WAIT_V(6); PG8_BAR; PG8_MMA(1, 1, At, B1); PG8_BAR;
            PG8_LDB(B0, 1, 0); PG8_SCHED; PG8_LDA(At, 1, 0); PG8_STAGE(PG8_SA(0, 1), a2 + hstep, voffA);
            PG8_WAIT_L(8); PG8_BAR; PG8_WAIT_L(0); PG8_MMA(0, 0, At, B0); PG8_BAR; PG8_SCHED;
            PG8_LDB(B1, 1, 1); PG8_STAGE(PG8_SB(1, 0), b3, voffB);
            PG8_BAR; PG8_WAIT_L(0); PG8_MMA(0, 1, At, B1); PG8_BAR;
            PG8_LDA(At, 1, 1); PG8_STAGE(PG8_SA(1, 0), a3, voffA);
            PG8_BAR; PG8_WAIT_L(0); PG8_MMA(1, 0, At, B0); PG8_BAR; PG8_SCHED;
            PG8_STAGE(PG8_SB(1, 1), b3 + hstep, voffB);
            PG8_WAIT_V(6); PG8_BAR; PG8_MMA(1, 1, At, B1); PG8_BAR;
            }
        }
        if constexpr (ALIGN_EPI) { if (wr == 0) PG8_BAR; }
        if constexpr (!Epi::AFTER_DRAIN) { E(acc, cur, wr, wc, fr, fq); S.done(cur); }
        if (!has_next) break;
#pragma unroll
        for (int a = 0; a < 2; ++a)
#pragma unroll
            for (int b = 0; b < 2; ++b)
#pragma unroll
                for (int m = 0; m < 4; ++m)
#pragma unroll
                    for (int n = 0; n < 2; ++n) acc[a][b][m][n] = (f32x4){0.f, 0.f, 0.f, 0.f};
        cur = nxt; cA = nA; cB = nB; ++ui;
        if constexpr (ALIGN_EPI) { if (wr == 1) PG8_BAR; }
    }
    PG8_WAIT_V(0);
    if constexpr (!ALIGN_EPI) { if (wr == 0) PG8_BAR; }
    PG8_BAR;
    if constexpr (Epi::AFTER_DRAIN) { E.fused(acc, cur, wr, wc, fr, fq, lds, wid, lane); S.done(cur); }
#undef PG8_SA
#undef PG8_SB
#undef PG8_STAGE
#undef PG8_LDA
#undef PG8_LDB
#undef PG8_MMA
#undef PG8_WAIT_V
#undef PG8_WAIT_L
#undef PG8_BAR
#undef PG8_SCHED
}
}
namespace swa {
constexpr int D = 128;
constexpr float THR = 8.f;
constexpr bool WSKIP = false;
constexpr float SCALE = 0.08838834764831845f;
constexpr int NW = 8, QBLK = 32, KVBLK = 64, QB = NW * QBLK;
constexpr int SHM_V = KVBLK * D * 2, SHM_K = KVBLK * D * 2;
constexpr int MSLOT_OFF = 2 * SHM_V + 2 * SHM_K + NW * 64 * 4, QLDS_OFF = MSLOT_OFF + 4096;
constexpr int LDS_BYTES = QLDS_OFF + NW * 8192;

using bf16 = __hip_bfloat16;
typedef short bf16x8 __attribute__((ext_vector_type(8)));
typedef short s16x4 __attribute__((ext_vector_type(4)));
typedef float f32x16 __attribute__((ext_vector_type(16)));
typedef float f32x4 __attribute__((ext_vector_type(4)));
typedef unsigned u32x4 __attribute__((ext_vector_type(4)));
template <class A, class Bt> struct same_t { static constexpr bool v = false; };
template <class A> struct same_t<A, A> { static constexpr bool v = true; };

#define KSWZ(row, colB) ((row) * 256 + ((colB) ^ (((row) & 7) << 4)))
#define SBAR() __builtin_amdgcn_sched_barrier(0)
__device__ __forceinline__ int v_st(int k, int c) { const int kk = (k & ~0xC) | ((k & 4) << 1) | ((k & 8) >> 1); return ((kk >> 3) * 4 + (c >> 5)) * 512 + ((kk & 7) * 32 + (c & 31)) * 2; }
__device__ __forceinline__ int v_rd_base(int lane) { return ((lane & 3) << 3) | (((lane >> 2) & 3) << 6) | (((lane >> 4) & 1) << 5) | (((lane >> 5) & 1) << 8); }
constexpr int v_rd_off(int d0, int ks, int half) { return d0 * 512 + ks * 4096 + half * 2048; }
__device__ __forceinline__ int crow(int r, int hi) { return (r & 3) + 8 * (r >> 2) + 4 * hi; }
typedef float f32x2_c __attribute__((ext_vector_type(2))); typedef __bf16 bf16x2_c __attribute__((ext_vector_type(2)));
__device__ __forceinline__ unsigned cvtpk(float lo, float hi) { f32x2_c v = {lo, hi}; bf16x2_c b = __builtin_convertvector(v, bf16x2_c); return __builtin_bit_cast(unsigned, b); }
__device__ __forceinline__ bf16x8 pack8(f32x4 a, f32x4 b) {
    u32x4 w = {cvtpk(a[0], a[1]), cvtpk(a[2], a[3]), cvtpk(b[0], b[1]), cvtpk(b[2], b[3])};
    return *reinterpret_cast<bf16x8*>(&w);
}
template <class T> __device__ __forceinline__ bf16x8 load8(const T* p) {
    if constexpr (same_t<T, float>::v) { return pack8(*(const f32x4*)p, *(const f32x4*)(p + 4)); }
    else { return *reinterpret_cast<const bf16x8*>(p); }
}
__device__ __forceinline__ void mask_tile(f32x16& p0, f32x16& p1, int dq, unsigned W) {
    const float NEG = -__builtin_inff();
#pragma unroll
    for (int r = 0; r < 16; ++r) {
        const int c = (r & 3) + 8 * (r >> 2);
        if ((unsigned)(dq - c) >= W) p0[r] = NEG;
        if ((unsigned)(dq - c - 32) >= W) p1[r] = NEG;
    }
}
__device__ __forceinline__ void partialSM(f32x16& p0, f32x16& p1, float& m_reg, float& mn, float& alpha) {
    float pmax = p0[0]; for (int r = 1; r < 16; ++r) pmax = fmaxf(pmax, p0[r]); for (int r = 0; r < 16; ++r) pmax = fmaxf(pmax, p1[r]);
    { auto rr = __builtin_amdgcn_permlane32_swap(__float_as_uint(pmax), __float_as_uint(pmax), false, false);
      pmax = fmaxf(__uint_as_float(rr[0]), __uint_as_float(rr[1])); }
    constexpr float C2 = 1.4426950408889634f * SCALE;
    if (__builtin_expect(__all((pmax - m_reg) * SCALE <= THR), 1)) { mn = m_reg; alpha = 1.f; }
    else { mn = fmaxf(m_reg, pmax); alpha = __builtin_amdgcn_exp2f((m_reg - mn) * C2); m_reg = mn; }
    const float mnL = -mn * C2;
    for (int r = 0; r < 16; ++r) p0[r] = fmaf(p0[r], C2, mnL); for (int r = 0; r < 16; ++r) p1[r] = fmaf(p1[r], C2, mnL);
    for (int r = 0; r < 16; ++r) p0[r] = __builtin_amdgcn_exp2f(p0[r]);
}
__device__ __forceinline__ void finishSM(f32x16& p0, f32x16& p1, float alpha, float& l_reg, bf16x8& pa0, bf16x8& pa1, bf16x8& pa2, bf16x8& pa3) {
    for (int r = 0; r < 16; ++r) p1[r] = __builtin_amdgcn_exp2f(p1[r]);
    float ps = 0; for (int r = 0; r < 16; ++r) ps += p0[r]; for (int r = 0; r < 16; ++r) ps += p1[r];
    { auto rr = __builtin_amdgcn_permlane32_swap(__float_as_uint(ps), __float_as_uint(ps), false, false);
      ps = __uint_as_float(rr[0]) + __uint_as_float(rr[1]); }
    l_reg = l_reg * alpha + ps;
#define PK4(P, B_, OUT) do { unsigned a0 = cvtpk(P[B_+0], P[B_+1]), a1 = cvtpk(P[B_+2], P[B_+3]);                          \
        unsigned b0 = cvtpk(P[B_+4], P[B_+5]), b1 = cvtpk(P[B_+6], P[B_+7]);                                             \
        auto r0 = __builtin_amdgcn_permlane32_swap(a0, b0, false, false); auto r1 = __builtin_amdgcn_permlane32_swap(a1, b1, false, false); \
        u32x4 w = {r0[0], r1[0], r0[1], r1[1]}; OUT = *reinterpret_cast<bf16x8*>(&w); } while (0)
    PK4(p0, 0, pa0); PK4(p0, 8, pa1); PK4(p1, 0, pa2); PK4(p1, 8, pa3);
#undef PK4
}
template <int KB, bool SK>
__device__ __forceinline__ void qkt(f32x16& p0, f32x16& p1, const char* K_lds, int r32, int hi, const bf16x8* qr, bool act) {
    if (SK && !act) { const float NEG = -__builtin_inff();
#pragma unroll
        for (int r = 0; r < 16; ++r) { p0[r] = NEG; p1[r] = NEG; } return; }
    p0 = f32x16{}; p1 = f32x16{};
    const char* kb[4];
#pragma unroll
    for (int dd = 0; dd < 4; ++dd) kb[dd] = K_lds + KB * SHM_K + KSWZ(r32, (dd * 16 + hi * 8) * 2);
#pragma unroll
    for (int d0 = 0; d0 < 8; ++d0) { const char* a = kb[d0 & 3] + (d0 >> 2) * 128;
        bf16x8 b0 = *reinterpret_cast<const bf16x8*>(a);
        bf16x8 b1 = *reinterpret_cast<const bf16x8*>(a + 32 * 256);
        const bf16x8 qf = qr[d0];
        p0 = __builtin_amdgcn_mfma_f32_32x32x16_bf16(b0, qf, p0, 0, 0, 0);
        p1 = __builtin_amdgcn_mfma_f32_32x32x16_bf16(b1, qf, p1, 0, 0, 0); }
}
template <int VB, bool SK>
__device__ __forceinline__ void pv_tile(f32x16* o, int vb0, bf16x8 pa0, bf16x8 pa1, bf16x8 pa2, bf16x8 pa3, bool act) {
    if (SK && !act) return;
#define TRRD(dst, off) asm volatile("ds_read_b64_tr_b16 %0, %1 offset:%2" : "=&v"(dst) : "v"(vb0), "i"(off) : "memory")
#define PV_D0(d0) do { s16x4 l0, l1, l2, l3, h0, h1, h2, h3; constexpr int b_ = VB * SHM_V + v_rd_off(d0, 0, 0);     \
        TRRD(l0, b_); TRRD(h0, b_ + 2048); TRRD(l1, b_ + 4096); TRRD(h1, b_ + 6144); TRRD(l2, b_ + 8192); TRRD(h2, b_ + 10240); TRRD(l3, b_ + 12288); TRRD(h3, b_ + 14336); \
        asm volatile("s_waitcnt lgkmcnt(0)" ::: "memory"); SBAR();                 \
        o[d0] = __builtin_amdgcn_mfma_f32_32x32x16_bf16(pa0, (bf16x8){l0[0], l0[1], l0[2], l0[3], h0[0], h0[1], h0[2], h0[3]}, o[d0], 0, 0, 0);   \
        o[d0] = __builtin_amdgcn_mfma_f32_32x32x16_bf16(pa1, (bf16x8){l1[0], l1[1], l1[2], l1[3], h1[0], h1[1], h1[2], h1[3]}, o[d0], 0, 0, 0);   \
        o[d0] = __builtin_amdgcn_mfma_f32_32x32x16_bf16(pa2, (bf16x8){l2[0], l2[1], l2[2], l2[3], h2[0], h2[1], h2[2], h2[3]}, o[d0], 0, 0, 0);   \
        o[d0] = __builtin_amdgcn_mfma_f32_32x32x16_bf16(pa3, (bf16x8){l3[0], l3[1], l3[2], l3[3], h3[0], h3[1], h3[2], h3[3]}, o[d0], 0, 0, 0); } while (0)
    PV_D0(0); PV_D0(1); PV_D0(2); PV_D0(3);
#undef PV_D0
#undef TRRD
}

template <class TIn, class TOut> struct BlockRef { const TIn* Q; const TIn* K; const TIn* V; TOut* O; int P0; int ldo; const int* rows; const int* dst; float* stat; };
template <class TIn> struct Seam {
    bf16x8 qr[8];
    bf16x8 st_v0, st_v1, st_k0, st_k1; f32x4 sf0, sf1, sf2, sf3;
    f32x4 tq[16];
};
__device__ __forceinline__ int swa_jlo(int P0, int W) { const int lowk = P0 - W + 1; return lowk > 0 ? lowk / KVBLK : 0; }
#define ROW(p, k0, rr) ((p) + (unsigned)(((k0) + (rr)) * D + sc))
#define VMW() asm volatile("s_waitcnt vmcnt(0)" ::: "memory")
#define VMWN(n) asm volatile("s_waitcnt vmcnt(%0)" :: "i"(n) : "memory")
#define SLOAD_H(Kp, Vp, k0) do { S.st_v0 = load8<TIn>(ROW(Vp, k0, sr)); S.st_v1 = load8<TIn>(ROW(Vp, k0, 32 + sr));              \
                         S.st_k0 = load8<TIn>(ROW(Kp, k0, sr)); S.st_k1 = load8<TIn>(ROW(Kp, k0, 32 + sr)); } while (0)
#define SWRITE_HK(bf) do { *(bf16x8*)(K_lds + (bf) * SHM_K + kws) = S.st_k0; *(bf16x8*)(K_lds + (bf) * SHM_K + kws + 32 * 256) = S.st_k1; } while (0)
#define SWRITE_HV(bf) do { *(bf16x8*)(V_lds + (bf) * SHM_V + vst0) = S.st_v0; *(bf16x8*)(V_lds + (bf) * SHM_V + vst1) = S.st_v1; } while (0)
#define SWRITE_H(bf) do { SWRITE_HV(bf); SWRITE_HK(bf); } while (0)
#define SLOAD_F(p, k0) do { S.sf0 = *(const f32x4*)ROW(p, k0, sr); S.sf1 = *(const f32x4*)(ROW(p, k0, sr) + 4);                \
                            S.sf2 = *(const f32x4*)ROW(p, k0, 32 + sr); S.sf3 = *(const f32x4*)(ROW(p, k0, 32 + sr) + 4); } while (0)
#define SWRITE_KF(bf) do { *(bf16x8*)(K_lds + (bf) * SHM_K + kws) = pack8(S.sf0, S.sf1); *(bf16x8*)(K_lds + (bf) * SHM_K + kws + 32 * 256) = pack8(S.sf2, S.sf3); } while (0)
#define SWRITE_VF(bf) do { *(bf16x8*)(V_lds + (bf) * SHM_V + vst0) = pack8(S.sf0, S.sf1); *(bf16x8*)(V_lds + (bf) * SHM_V + vst1) = pack8(S.sf2, S.sf3); } while (0)
template <class TIn, class TOut>
__device__ __forceinline__ void causal_swa_prime(const BlockRef<TIn, TOut>& cur, int W, char* lds, Seam<TIn>& S) {
    constexpr bool F32 = same_t<TIn, float>::v;
    const int tid = threadIdx.x, wid = __builtin_amdgcn_readfirstlane(tid >> 6), lane = tid & 63, r32 = lane & 31, hi = lane >> 5;
    const int sr = tid >> 4, sc = (tid & 15) * 8, kws = KSWZ(sr, sc * 2); char* K_lds = lds + 2 * SHM_V;
    const int kb0 = swa_jlo(cur.P0, W) * KVBLK;
    for (int d0 = 0; d0 < 8; ++d0) S.qr[d0] = load8<TIn>(cur.Q + (size_t)(wid * QBLK + r32) * D + d0 * 16 + hi * 8);
    if constexpr (F32) { SLOAD_F((const float*)cur.K, kb0); VMW(); SWRITE_KF(0); SBAR(); SLOAD_F((const float*)cur.V, kb0); }
    else { SLOAD_H(cur.K, cur.V, kb0); VMW(); SWRITE_HK(0); }
    __syncthreads();
}
template <class TIn, class TOut>
__device__ __forceinline__ void causal_swa_block(const BlockRef<TIn, TOut>& cur, const BlockRef<TIn, TOut>& nxt, int skv, int W, char* lds, Seam<TIn>& S) {
    constexpr bool F32 = same_t<TIn, float>::v;
    const int tid = threadIdx.x, wid = __builtin_amdgcn_readfirstlane(tid >> 6), lane = tid & 63, r32 = lane & 31, hi = lane >> 5;
    const int j_lo = swa_jlo(cur.P0, W);
    int j_hi = (cur.P0 + QB - 1) / KVBLK + 1; if (j_hi > skv / KVBLK) j_hi = skv / KVBLK;
    const int NT = j_hi - j_lo;
    const int kbn = swa_jlo(nxt.P0, W) * KVBLK;
    const int qlo = cur.P0 + wid * QBLK, qm = qlo + r32 - 4 * hi;
    char* V_lds = lds; char* K_lds = lds + 2 * SHM_V;
    float* ws = (float*)(lds + 2 * SHM_V + 2 * SHM_K) + wid * 64; float* li_l = ws, * al_l = ws + 32;
    float m_reg = -1e30f, l_reg = 0; f32x16 o[4] = {};
    const int sr = tid >> 4, sc = (tid & 15) * 8, vst0 = v_st(sr, sc), vst1 = v_st(32 + sr, sc), kws = KSWZ(sr, sc * 2);
    const int vb0 = (int)(uintptr_t)V_lds + v_rd_base(lane);
    const TIn* Kh = cur.K; const TIn* Vh = cur.V;
#define RESC(a) do { if (__any((a) < 1.f)) { if (hi == 0) al_l[r32] = (a); asm volatile("s_waitcnt lgkmcnt(0)" ::: "memory");              \
                     for (int d_ = 0; d_ < 4; ++d_) for (int r = 0; r < 16; ++r) o[d_][r] *= al_l[crow(r, hi)]; } } while (0)
#define KBASE(t) ((j_lo + (t)) * KVBLK)
#define ACT(t) (KBASE(t) <= qlo + QBLK - 1 && KBASE(t) + KVBLK - 1 >= qlo - W + 1)
#define MASKT(P0_, P1_, t) do { const int kb_ = KBASE(t); if ((!SK || ACT(t)) && (kb_ + KVBLK - 1 > qlo || kb_ <= qlo + QBLK - 1 - W)) mask_tile(P0_, P1_, qm - kb_, (unsigned)W); } while (0)
    constexpr int NQL = F32 ? 16 : 8;
    constexpr bool SK = WSKIP && !F32;
#define SEAM_K0() do { VMWN(NQL); if constexpr (F32) { SWRITE_KF(0); SBAR(); SLOAD_F((const float*)nxt.V, kbn); } else { SWRITE_HK(0); } SBAR(); } while (0)
    f32x16 pA0, pA1, pB0, pB1; float mnA, mnB, alA, alB; bf16x8 pa0, pa1, pa2, pa3;
    if constexpr (F32) { VMW(); SWRITE_VF(0); SBAR(); } else { SWRITE_HV(0); SBAR(); }
    if (NT > 1) { if constexpr (F32) SLOAD_F((const float*)Kh, KBASE(1)); else SLOAD_H(Kh, Vh, KBASE(1)); }
    SBAR(); qkt<0, SK>(pA0, pA1, K_lds, r32, hi, S.qr, ACT(0));
    if constexpr (F32) { if (NT > 1) { VMW(); SWRITE_KF(1); SBAR(); SLOAD_F((const float*)Vh, KBASE(1)); } }
    MASKT(pA0, pA1, 0); partialSM(pA0, pA1, m_reg, mnA, alA);
    if (NT > 1) { VMW(); if constexpr (F32) { SWRITE_VF(1); SBAR(); if (NT > 2) SLOAD_F((const float*)Kh, KBASE(2)); } else SWRITE_H(1); }
    __syncthreads();
#define HALF_STEP(PX0, PX1, mnX, alX, PY0, PY1, alY, t, KB, VB, SB) do {                                                      \
        SBAR(); qkt<KB, SK>(PX0, PX1, K_lds, r32, hi, S.qr, ACT(t));                                             \
        finishSM(PY0, PY1, alY, l_reg, pa0, pa1, pa2, pa3); SBAR();                                                           \
        if ((t) + 1 < NT) { if constexpr (F32) { VMW(); SWRITE_KF(SB); SBAR(); SLOAD_F((const float*)Vh, KBASE((t) + 1)); }  \
                            else { SLOAD_H(Kh, Vh, KBASE((t) + 1)); } SBAR(); }                                               \
        pv_tile<VB, SK>(o, vb0, pa0, pa1, pa2, pa3, ACT((t) - 1)); MASKT(PX0, PX1, (t)); partialSM(PX0, PX1, m_reg, mnX, alX);                                        \
        __syncthreads();                                                                                                      \
        if ((t) + 1 < NT) { VMW(); if constexpr (F32) { SWRITE_VF(SB); SBAR(); if ((t) + 2 < NT) SLOAD_F((const float*)Kh, KBASE((t) + 2)); } \
                            else { SWRITE_H(SB); } }                                                                          \
        RESC(alX); __syncthreads(); } while (0)
    for (int t = 1; t + 1 < NT; t += 2) {
        HALF_STEP(pB0, pB1, mnB, alB, pA0, pA1, alA, t, 1, 0, 0);
        HALF_STEP(pA0, pA1, mnA, alA, pB0, pB1, alB, t + 1, 0, 1, 1);
    }
    const bool even = (NT & 1) == 0;
    if (even) { SBAR(); qkt<1, SK>(pB0, pB1, K_lds, r32, hi, S.qr, ACT(NT - 1)); SBAR(); }
#define QROW(e) (nxt.Q + (size_t)(wid * QBLK + r32) * D + ((e) >> 1) * 16 + hi * 8 + ((e) & 1) * 4)
    if constexpr (F32) { SLOAD_F((const float*)nxt.K, kbn); SBAR();
#pragma unroll
        for (int e = 0; e < 8; ++e) S.tq[e] = *(const f32x4*)QROW(e); }
    else { const size_t qrown_ = (size_t)(wid * QBLK + r32);
        SLOAD_H(nxt.K, nxt.V, kbn); SBAR();
#pragma unroll
        for (int d0 = 0; d0 < 8; ++d0) S.qr[d0] = load8<TIn>(nxt.Q + qrown_ * D + d0 * 16 + hi * 8); }
    SBAR();
    finishSM(pA0, pA1, alA, l_reg, pa0, pa1, pa2, pa3); SBAR();
    if constexpr (F32) {
#pragma unroll
        for (int e = 8; e < 16; ++e) S.tq[e] = *(const f32x4*)QROW(e); SBAR(); }
#undef QROW
    pv_tile<0, SK>(o, vb0, pa0, pa1, pa2, pa3, ACT(even ? NT - 2 : NT - 1));
    if (even) { MASKT(pB0, pB1, NT - 1); partialSM(pB0, pB1, m_reg, mnB, alB); __syncthreads(); RESC(alB);
        finishSM(pB0, pB1, alB, l_reg, pa0, pa1, pa2, pa3); SBAR(); pv_tile<1, SK>(o, vb0, pa0, pa1, pa2, pa3, ACT(NT - 1)); }
    SBAR(); SEAM_K0();
    if (hi == 0) li_l[r32] = l_reg; asm volatile("s_waitcnt lgkmcnt(0)" ::: "memory");
    float rli[16];
#pragma unroll
    for (int r = 0; r < 16; ++r) rli[r] = __builtin_amdgcn_rcpf(li_l[crow(r, hi)]);
    {
    int ld_ = cur.ldo; asm volatile("" : "+s"(ld_));
    TOut* Ow = cur.O + (size_t)(wid * QBLK) * ld_;
#pragma unroll
    for (int r = 0; r < 16; ++r) { const unsigned ro = (unsigned)crow(r, hi) * (unsigned)ld_ + (unsigned)r32;
#pragma unroll
        for (int d0 = 0; d0 < 4; ++d0) { const float v = o[d0][r] * rli[r];
            if constexpr (same_t<TOut, float>::v) { Ow[ro + d0 * 32] = v; }
            else { const float vn = __shfl_xor(v, 1);
                   if ((r32 & 1) == 0) *(unsigned*)(Ow + ro + d0 * 32) = cvtpk(v, vn); } } }
    }
    if constexpr (F32) {
#pragma unroll
        for (int d0 = 0; d0 < 8; ++d0) S.qr[d0] = pack8(S.tq[2 * d0], S.tq[2 * d0 + 1]); }
    __syncthreads();
#undef RESC
#undef KBASE
#undef ACT
#undef MASKT
#undef SEAM_K0
#undef HALF_STEP
}
#undef ROW
#undef VMW
#undef VMWN
#undef SLOAD_H
#undef SWRITE_HK
#undef SWRITE_HV
#undef SWRITE_H
#undef SLOAD_F
#undef SWRITE_KF
#undef SWRITE_VF


template <int KB>
__device__ __forceinline__ void qkt_r(f32x16& p0, f32x16& p1, const char* K_lds, int r32, int hi, const bf16x8* qr) {
    p0 = f32x16{}; p1 = f32x16{};
    const char* kb[4];
#pragma unroll
    for (int dd = 0; dd < 4; ++dd) kb[dd] = K_lds + KB * SHM_K + KSWZ(r32, (dd * 16 + hi * 8) * 2);
#pragma unroll
    for (int d0 = 0; d0 < 8; ++d0) { const char* a = kb[d0 & 3] + (d0 >> 2) * 128;
        bf16x8 b0 = *reinterpret_cast<const bf16x8*>(a);
        bf16x8 b1 = *reinterpret_cast<const bf16x8*>(a + 32 * 256);
        p0 = __builtin_amdgcn_mfma_f32_32x32x16_bf16(b0, qr[d0], p0, 0, 0, 0);
        p1 = __builtin_amdgcn_mfma_f32_32x32x16_bf16(b1, qr[d0], p1, 0, 0, 0); }
}
constexpr int MOBA_LDS_BYTES = 4 * SHM_V + 4 * SHM_K + NW * 64 * 4;
struct MobaStage { bf16x8 qr[8]; bf16x8 k0[2], k1[2], v0[2], v1[2]; };
#define MOBA_LOAD_Q(B) do { const unsigned qoff_ = (unsigned)(B).rows[wid * QBLK + r32] * D + hi * 8;                                  \
        _Pragma("unroll") for (int d0 = 0; d0 < 8; ++d0) ST.qr[d0] = load8<bf16>((B).Q + qoff_ + d0 * 16); } while (0)
#define MOBA_LOAD_KV(B, T0) do { _Pragma("unroll") for (int t = 0; t < 2; ++t) { const unsigned eo_ = (unsigned)(((T0) + t) * KVBLK + sr) * D + sc; \
        ST.k0[t] = load8<bf16>((B).K + eo_); ST.k1[t] = load8<bf16>((B).K + eo_ + 32 * D); ST.v0[t] = load8<bf16>((B).V + eo_); ST.v1[t] = load8<bf16>((B).V + eo_ + 32 * D); } } while (0)
#define MOBA_WRITE_KV(T0) do { _Pragma("unroll") for (int t = 0; t < 2; ++t) { *(bf16x8*)(K_lds + ((T0) + t) * SHM_K + kws) = ST.k0[t]; *(bf16x8*)(K_lds + ((T0) + t) * SHM_K + kws + 32 * 256) = ST.k1[t]; \
        *(bf16x8*)(V_lds + ((T0) + t) * SHM_V + vst0) = ST.v0[t]; *(bf16x8*)(V_lds + ((T0) + t) * SHM_V + vst1) = ST.v1[t]; } } while (0)
__device__ __forceinline__ void moba_block(const BlockRef<bf16, bf16>& cur, const BlockRef<bf16, bf16>& nxt, bool has_next, char* lds, MobaStage& ST) {
    const int tid = threadIdx.x, wid = __builtin_amdgcn_readfirstlane(tid >> 6), lane = tid & 63, r32 = lane & 31, hi = lane >> 5;
    char* V_lds = lds; char* K_lds = lds + 4 * SHM_V;
    float* wsc = (float*)(lds + 4 * SHM_V + 4 * SHM_K) + wid * 64; float* li_l = wsc, * al_l = wsc + 32;
    const int sr = tid >> 4, sc = (tid & 15) * 8, vst0 = v_st(sr, sc), vst1 = v_st(32 + sr, sc), kws = KSWZ(sr, sc * 2);
    const int vb0 = (int)(uintptr_t)V_lds + v_rd_base(lane);
    __syncthreads();
    MOBA_WRITE_KV(0);
    __syncthreads();
    MOBA_LOAD_KV(cur, 2);
    SBAR();
    float m_reg = -1e30f, l_reg = 0; f32x16 o[4] = {};
    const bool causal = cur.P0 == 0; const int qlo = wid * QBLK, qm = qlo + r32 - 4 * hi;
    f32x16 p0, p1; float mn, al; bf16x8 pa0, pa1, pa2, pa3;
#define RESCM(a) do { if (__any((a) < 1.f)) { if (hi == 0) al_l[r32] = (a); asm volatile("s_waitcnt lgkmcnt(0)" ::: "memory");              \
                      for (int d_ = 0; d_ < 4; ++d_) for (int r = 0; r < 16; ++r) o[d_][r] *= al_l[crow(r, hi)]; } } while (0)
#define SKIPT(t) (causal && (t) * KVBLK > qlo + QBLK - 1)
#define MTA(t) do { if (!SKIPT(t)) { SBAR(); qkt_r<t>(p0, p1, K_lds, r32, hi, ST.qr); if (causal && (t) * KVBLK + KVBLK - 1 > qlo) mask_tile(p0, p1, qm - (t) * KVBLK, 1u << 30); } } while (0)
#define MTB(t) do { if (!SKIPT(t)) { partialSM(p0, p1, m_reg, mn, al); RESCM(al); finishSM(p0, p1, al, l_reg, pa0, pa1, pa2, pa3); SBAR(); pv_tile<t, false>(o, vb0, pa0, pa1, pa2, pa3, true); } } while (0)
    MTA(0); MTB(0); MTA(1); MTB(1);
    SBAR();
    MOBA_WRITE_KV(2);
    __syncthreads();
    if (has_next) MOBA_LOAD_KV(nxt, 0);
    SBAR();
    MTA(2); MTB(2); MTA(3);
    SBAR();
    if (has_next) MOBA_LOAD_Q(nxt);
    SBAR();
    MTB(3);
#undef MTA
#undef MTB
#undef SKIPT
#undef RESCM
    if (hi == 0) li_l[r32] = l_reg; asm volatile("s_waitcnt lgkmcnt(0)" ::: "memory");
    float rli[16];
#pragma unroll
    for (int r = 0; r < 16; ++r) rli[r] = __builtin_amdgcn_rcpf(li_l[crow(r, hi)]);
    { const int dme_ = cur.dst[wid * QBLK + r32]; if (hi == 0 && dme_ >= 0) { float2 st_; st_.x = m_reg; st_.y = l_reg; *(float2*)(cur.stat + 2 * (size_t)dme_) = st_; } }
#pragma unroll
    for (int r = 0; r < 16; ++r) { const int di_ = cur.dst[wid * QBLK + crow(r, hi)];
#pragma unroll
        for (int d0 = 0; d0 < 4; ++d0) { const float v = o[d0][r] * rli[r]; const float vn = __shfl_xor(v, 1);
            if ((r32 & 1) == 0 && di_ >= 0) *(unsigned*)(cur.O + (size_t)di_ * 128 + d0 * 32 + r32) = cvtpk(v, vn); } }
}
__device__ __forceinline__ void moba_prime(const BlockRef<bf16, bf16>& cur, MobaStage& ST) {
    const int tid = threadIdx.x, wid = __builtin_amdgcn_readfirstlane(tid >> 6), lane = tid & 63, r32 = lane & 31, hi = lane >> 5;
    const int sr = tid >> 4, sc = (tid & 15) * 8;
    MOBA_LOAD_Q(cur); MOBA_LOAD_KV(cur, 0);
}
#undef MOBA_LOAD_Q
#undef MOBA_LOAD_KV
#undef MOBA_WRITE_KV
}
#include <hip/hip_cooperative_groups.h>
namespace cg = cooperative_groups;

constexpr int NWAVES = 8;
#ifndef MK_ONE_LAUNCH
#define MK_ONE_LAUNCH 1
#endif
constexpr int BATCH = 2, SEQ = 16384, T = BATCH * SEQ, DM = 2048, INW = 10240, DFF = 8192, PLE = 256;
constexpr int NH8 = 8;
constexpr float NORM_EPS = 1e-6f;
constexpr float LAMBDA_INIT = 0.2f;
constexpr int NPHASE = 19;

constexpr size_t MiB = 1u << 20;
constexpr size_t WS_ROPE = 1 * MiB;
constexpr size_t WS_KMEAN = 3 * MiB;
constexpr size_t WS_CNT = 0, WS_NBLK = 8192, WS_TAB = 65536;
constexpr size_t WS_BAR = 131072, WS_BAR_BYTES = 16384;
constexpr size_t WS_SEL = 4 * MiB;
constexpr int LSTR = 65536 + SEQ;
constexpr size_t WS_ROWL = 986 * MiB, WS_DSTL = 992 * MiB;
constexpr size_t WS_STATS = 1000 * MiB;
constexpr size_t WS_TOP = 1008 * MiB;
constexpr size_t WS_WIN = 8 * MiB, WS_WA = 48 * MiB, WS_WB = 52 * MiB, WS_WOUT = 56 * MiB, WS_WUP = 64 * MiB, WS_WDN = 96 * MiB, WS_WPG = 128 * MiB, WS_WPP = 136 * MiB;
constexpr size_t WS_PB = 138 * MiB;
constexpr size_t WS_XN = 154 * MiB;
constexpr size_t WS_OB = 154 * MiB;
constexpr size_t WS_QKV = 282 * MiB;
constexpr size_t SEC_ELEMS = (size_t)T * 1024;
constexpr size_t WS_SG = 666 * MiB;
constexpr size_t WS_OA = 922 * MiB;
constexpr size_t WS_MIX = 282 * MiB;
constexpr size_t WS_HID = 282 * MiB;
constexpr size_t WS_G3 = 282 * MiB;
constexpr size_t WS_H2 = 554 * MiB;
constexpr size_t WS_XN3 = 410 * MiB;
constexpr size_t WS_Y = 794 * MiB;
constexpr size_t WS_END = 986 * MiB;
static_assert(WS_HID + (size_t)T * DFF * 2 <= WS_Y && WS_Y + (size_t)T * DM * 2 <= WS_OA && WS_OA + (size_t)T * 1024 * 2 == WS_END, "ws map");

constexpr int RING_BYTES = 131072, LDS_BYTES = 147456;

#define GAS __attribute__((address_space(1)))
#define LAS __attribute__((address_space(3)))
typedef unsigned short bf16;
typedef unsigned v4u __attribute__((ext_vector_type(4)));
typedef unsigned v2u __attribute__((ext_vector_type(2)));
typedef float f32x4 __attribute__((ext_vector_type(4)));
#define LDS_WAIT() asm volatile("s_waitcnt lgkmcnt(0)" ::: "memory")
__device__ __forceinline__ unsigned f2bf(float f) { unsigned u = __builtin_bit_cast(unsigned, f); return (u + 0x7fffu + ((u >> 16) & 1u)) >> 16; }
__device__ __forceinline__ unsigned pk2(float lo, float hi) { return f2bf(lo) | (f2bf(hi) << 16); }
__device__ __forceinline__ float bflo(unsigned w) { return __uint_as_float(w << 16); }
__device__ __forceinline__ float bfhi(unsigned w) { return __uint_as_float(w & 0xffff0000u); }
__device__ __forceinline__ float wave_sum(float v) {
#pragma unroll
    for (int o = 1; o < 64; o <<= 1) v += __shfl_xor(v, o);
    return v;
}
template <class Tv> __device__ __forceinline__ Tv ntload(const Tv* p) { return __builtin_nontemporal_load(p); }
template <class Tv> __device__ __forceinline__ void ntstore(Tv v, Tv* p) { __builtin_nontemporal_store(v, p); }
__device__ __forceinline__ float sigmoidf_(float x) { return __builtin_amdgcn_rcpf(1.0f + __expf(-x)); }

namespace pg8 {
template <int MODE> struct EpiT {
    static constexpr bool PERM = true, AFTER_DRAIN = false;
    bf16_t* O; int ldo; const bf16_t* G; int ldg;
    __device__ __forceinline__ void operator()(const f32x4 (&acc)[2][2][4][2], const Unit& u, int wr, int wc, int fr, int fq) const {
        const int row0 = u.pm * BM + wr * 64 + fr, col0 = u.pn * BM + wc * 32 + 8 * fq;
#pragma unroll
        for (int ai = 0; ai < 2; ++ai)
#pragma unroll
            for (int m = 0; m < 4; ++m) { const size_t r = (size_t)(row0 + ai * HALF + m * 16);
#pragma unroll
                for (int bj = 0; bj < 2; ++bj) { f32x4 v0 = acc[ai][bj][m][0], v1 = acc[ai][bj][m][1]; const int c = col0 + bj * HALF;
                    if (MODE == 1) {
#pragma unroll
                        for (int e = 0; e < 4; ++e) { float a = fmaxf(v0[e], 0.f), b = fmaxf(v1[e], 0.f); v0[e] = a * a; v1[e] = b * b; } }
                    if (MODE == 2) {
#pragma unroll
                        for (int e = 0; e < 4; ++e) { v0[e] = sigmoidf_(v0[e]); v1[e] = sigmoidf_(v1[e]); } }
                    if (MODE == 3 || MODE == 4) { const u32x4 g = *(const u32x4*)(G + r * ldg + c);
                        v0[0] *= bflo(g.x); v0[1] *= bfhi(g.x); v0[2] *= bflo(g.y); v0[3] *= bfhi(g.y); v1[0] *= bflo(g.z); v1[1] *= bfhi(g.z); v1[2] *= bflo(g.w); v1[3] *= bfhi(g.w); }
                    if (MODE == 4) { const u32x4 g = *(const u32x4*)(O + r * ldo + c);
                        v0[0] += bflo(g.x); v0[1] += bfhi(g.x); v0[2] += bflo(g.y); v0[3] += bfhi(g.y); v1[0] += bflo(g.z); v1[1] += bfhi(g.z); v1[2] += bflo(g.w); v1[3] += bfhi(g.w); }
                    u32x4 w; w.x = cvt_pk_bf16(v0[0], v0[1]); w.y = cvt_pk_bf16(v0[2], v0[3]); w.z = cvt_pk_bf16(v1[0], v1[1]); w.w = cvt_pk_bf16(v1[2], v1[3]);
                    *(u32x4*)(O + r * ldo + c) = w; } }
    }
};
struct EpiGate2 {
    static constexpr bool PERM = true, AFTER_DRAIN = false; static constexpr int MID_T = 16;
    bf16_t* O; const bf16_t* SGp;
    __device__ __forceinline__ void mid(f32x4 (&acc)[2][2][4][2], const Unit& u, int wr, int wc, int fr, int fq) const {
        int row0 = u.pm * BM + wr * 64 + fr; const int col0 = u.pn * BM + wc * 32 + 8 * fq;
        asm volatile("" : "+v"(row0));
        const bf16_t* gp = SGp + (size_t)row0 * 4096 + col0;
#pragma unroll
        for (int ai = 0; ai < 2; ++ai)
#pragma unroll
            for (int m = 0; m < 4; ++m) { const int ro = (ai * HALF + m * 16) * 4096;
#pragma unroll
                for (int bj = 0; bj < 2; ++bj) { const u32x4 a = *(const u32x4*)(gp + ro + bj * HALF), b = *(const u32x4*)(gp + ro + bj * HALF + 2048);
                    f32x4& v0 = acc[ai][bj][m][0]; f32x4& v1 = acc[ai][bj][m][1];
                    v0[0] *= bflo(a.x) * __builtin_amdgcn_rcpf(bflo(b.x)); v0[1] *= bfhi(a.x) * __builtin_amdgcn_rcpf(bfhi(b.x)); v0[2] *= bflo(a.y) * __builtin_amdgcn_rcpf(bflo(b.y)); v0[3] *= bfhi(a.y) * __builtin_amdgcn_rcpf(bfhi(b.y));
                    v1[0] *= bflo(a.z) * __builtin_amdgcn_rcpf(bflo(b.z)); v1[1] *= bfhi(a.z) * __builtin_amdgcn_rcpf(bfhi(b.z)); v1[2] *= bflo(a.w) * __builtin_amdgcn_rcpf(bflo(b.w)); v1[3] *= bfhi(a.w) * __builtin_amdgcn_rcpf(bfhi(b.w)); }
                if (m == 3) asm volatile("" ::: "memory"); }
    }
    __device__ __forceinline__ void operator()(const f32x4 (&acc)[2][2][4][2], const Unit& u, int wr, int wc, int fr, int fq) const {
        int row0 = u.pm * BM + wr * 64 + fr; const int col0 = u.pn * BM + wc * 32 + 8 * fq;
        asm volatile("" : "+v"(row0));
        const bf16_t* gp = SGp + (size_t)row0 * 4096 + 2048 + col0; bf16_t* op = O + (size_t)row0 * 2048 + col0;
#pragma unroll
        for (int ai = 0; ai < 2; ++ai)
#pragma unroll
            for (int m = 0; m < 4; ++m) { const int rr = ai * HALF + m * 16;
#pragma unroll
                for (int bj = 0; bj < 2; ++bj) { const u32x4 b = *(const u32x4*)(gp + rr * 4096 + bj * HALF); const f32x4 v0 = acc[ai][bj][m][0], v1 = acc[ai][bj][m][1];
                    u32x4 w; w.x = cvt_pk_bf16(v0[0] * bflo(b.x), v0[1] * bfhi(b.x)); w.y = cvt_pk_bf16(v0[2] * bflo(b.y), v0[3] * bfhi(b.y)); w.z = cvt_pk_bf16(v1[0] * bflo(b.z), v1[1] * bfhi(b.z)); w.w = cvt_pk_bf16(v1[2] * bflo(b.w), v1[3] * bfhi(b.w));
                    *(u32x4*)(op + rr * 2048 + bj * HALF) = w; } }
    }
};
struct EpiPle {
    static constexpr bool PERM = true, AFTER_DRAIN = false; static constexpr int MID_T = 32;
    bf16_t* O; bf16_t* Gp;
    __device__ __forceinline__ void mid(f32x4 (&acc)[2][2][4][2], const Unit& u, int wr, int wc, int fr, int fq) const {
        int row0 = u.pm * BM + wr * 64 + fr; const int col0 = u.pn * BM + wc * 32 + 8 * fq;
        asm volatile("" : "+v"(row0));
        bf16_t* gp = Gp + (size_t)row0 * 2048 + col0;
#pragma unroll
        for (int ai = 0; ai < 2; ++ai)
#pragma unroll
            for (int m = 0; m < 4; ++m) { const int rr = ai * HALF + m * 16;
#pragma unroll
                for (int bj = 0; bj < 2; ++bj) { f32x4& v0 = acc[ai][bj][m][0]; f32x4& v1 = acc[ai][bj][m][1];
                    u32x4 w; w.x = cvt_pk_bf16(sigmoidf_(v0[0]), sigmoidf_(v0[1])); w.y = cvt_pk_bf16(sigmoidf_(v0[2]), sigmoidf_(v0[3])); w.z = cvt_pk_bf16(sigmoidf_(v1[0]), sigmoidf_(v1[1])); w.w = cvt_pk_bf16(sigmoidf_(v1[2]), sigmoidf_(v1[3]));
                    *(u32x4*)(gp + rr * 2048 + bj * HALF) = w; v0 = (f32x4){0.f, 0.f, 0.f, 0.f}; v1 = (f32x4){0.f, 0.f, 0.f, 0.f}; } }
    }
    __device__ __forceinline__ void operator()(const f32x4 (&acc)[2][2][4][2], const Unit& u, int wr, int wc, int fr, int fq) const {
        int row0 = u.pm * BM + wr * 64 + fr; const int col0 = u.pn * BM + wc * 32 + 8 * fq;
        asm volatile("" : "+v"(row0));
        const bf16_t* gp = Gp + (size_t)row0 * 2048 + col0; bf16_t* op = O + (size_t)row0 * 2048 + col0;
#pragma unroll
        for (int ai = 0; ai < 2; ++ai)
#pragma unroll
            for (int m = 0; m < 4; ++m) { const int rr = ai * HALF + m * 16;
#pragma unroll
                for (int bj = 0; bj < 2; ++bj) { const u32x4 b = *(const u32x4*)(gp + rr * 2048 + bj * HALF); const f32x4 v0 = acc[ai][bj][m][0], v1 = acc[ai][bj][m][1];
                    u32x4 w; w.x = cvt_pk_bf16(v0[0] * bflo(b.x), v0[1] * bfhi(b.x)); w.y = cvt_pk_bf16(v0[2] * bflo(b.y), v0[3] * bfhi(b.y)); w.z = cvt_pk_bf16(v1[0] * bflo(b.z), v1[1] * bfhi(b.z)); w.w = cvt_pk_bf16(v1[2] * bflo(b.w), v1[3] * bfhi(b.w));
                    *(u32x4*)(op + rr * 2048 + bj * HALF) = w; } }
    }
};
struct EpiInProj {
    static constexpr bool PERM = false, AFTER_DRAIN = false;
    bf16_t* QKV; bf16_t* SG; const float* rope; float* km;
    __device__ __forceinline__ void operator()(const f32x4 (&acc)[2][2][4][2], const Unit& u, int wr, int wc, int fr, int fq) const {
        typedef unsigned u32x2 __attribute__((ext_vector_type(2)));
        const int pn = u.pn, row0 = u.pm * BM + wr * 64 + fr;
        if (pn < 24) {
            const int sec = pn >> 2; const bool rot = (sec != 2) && (sec != 5) && (wc == 0);
            const int b = (u.pm * BM) / SEQ;
            f32x4 ks[2][2] = {{(f32x4){0.f, 0.f, 0.f, 0.f}, (f32x4){0.f, 0.f, 0.f, 0.f}}, {(f32x4){0.f, 0.f, 0.f, 0.f}, (f32x4){0.f, 0.f, 0.f, 0.f}}};
#pragma unroll
            for (int ai = 0; ai < 2; ++ai)
#pragma unroll
                for (int m = 0; m < 4; ++m) { const int r = row0 + ai * HALF + m * 16, pos = r - b * SEQ;
                    f32x4 cs = (f32x4){1.f, 1.f, 1.f, 1.f}, sn = (f32x4){0.f, 0.f, 0.f, 0.f};
                    if (rot) { cs = *(const f32x4*)(rope + (size_t)pos * 32 + 4 * fq); sn = *(const f32x4*)(rope + (size_t)pos * 32 + 16 + 4 * fq); }
#pragma unroll
                    for (int bj = 0; bj < 2; ++bj) { const int h8 = (pn & 3) * 2 + bj; f32x4 v0 = acc[ai][bj][m][0], v1 = acc[ai][bj][m][1];
                        if (rot) { const f32x4 a = v0 * cs - v1 * sn, bb = v1 * cs + v0 * sn; v0 = a; v1 = bb; }
                        if (sec == 1) { ks[bj][0] += v0; ks[bj][1] += v1; }
                        bf16_t* dst = QKV + (size_t)sec * SEC_ELEMS + ((size_t)(b * NH8 + h8) * SEQ + pos) * 128 + wc * 32 + 4 * fq;
                        u32x2 w0, w1; w0.x = cvt_pk_bf16(v0[0], v0[1]); w0.y = cvt_pk_bf16(v0[2], v0[3]); w1.x = cvt_pk_bf16(v1[0], v1[1]); w1.y = cvt_pk_bf16(v1[2], v1[3]);
                        *(u32x2*)dst = w0; *(u32x2*)(dst + 16) = w1; } }
            if (sec == 1) {
                const int blk = u.pm - b * (SEQ / 256);
#pragma unroll
                for (int bj = 0; bj < 2; ++bj)
#pragma unroll
                    for (int n = 0; n < 2; ++n)
#pragma unroll
                        for (int e = 0; e < 4; ++e) { float v = ks[bj][n][e]; v += __shfl_xor(v, 1); v += __shfl_xor(v, 2); v += __shfl_xor(v, 4); v += __shfl_xor(v, 8);
                            if (fr == 0) atomicAdd(km + ((size_t)((b * NH8 + (pn & 3) * 2 + bj) * 64 + blk)) * 128 + wc * 32 + n * 16 + 4 * fq + e, v * (1.0f / 256.0f)); }
            }
        } else {
            const int col0 = (pn - 24) * BM + wc * 32 + 4 * fq;
#pragma unroll
            for (int ai = 0; ai < 2; ++ai)
#pragma unroll
                for (int m = 0; m < 4; ++m) { bf16_t* rowp = SG + (size_t)(row0 + ai * HALF + m * 16) * 4096 + col0;
#pragma unroll
                    for (int bj = 0; bj < 2; ++bj)
#pragma unroll
                        for (int n = 0; n < 2; ++n) { const f32x4 v = acc[ai][bj][m][n]; u32x2 w; w.x = cvt_pk_bf16(sigmoidf_(v[0]), sigmoidf_(v[1])); w.y = cvt_pk_bf16(sigmoidf_(v[2]), sigmoidf_(v[3]));
                            *(u32x2*)(rowp + bj * HALF + n * 16) = w; } }
        }
    }
};
}

#define XB_TMO      128
#define XB_XCNT(j)  (256  + 64 * (j))
#define XB_XSUB(j)  (1280 + 64 * (j))
#define XB_XGEN(j)  (2304 + 64 * (j))
#define XB_TOP      3328
#define XB_TOPGEN   3392
#define XCD_BAR_WORDS 3456
#define XB_SPIN_CAP (1u << 18)

__device__ __forceinline__ unsigned xb_ld(unsigned* p)              { return __hip_atomic_load(p, __ATOMIC_RELAXED, __HIP_MEMORY_SCOPE_AGENT); }
__device__ __forceinline__ unsigned xb_add(unsigned* p, unsigned v) { return __hip_atomic_fetch_add(p, v, __ATOMIC_RELAXED, __HIP_MEMORY_SCOPE_AGENT); }
__device__ __forceinline__ unsigned xb_xcc_id() { return (unsigned)__builtin_amdgcn_s_getreg((3 << 11) | 20) & 0xFu; }
#define XB_SPIN(cond, bar) do { unsigned _sp = 0; while (cond) { __builtin_amdgcn_s_sleep(1); \
    if ((++_sp & 255u) == 0u) { if (xb_ld(&(bar)[XB_TMO])) break; if (_sp > XB_SPIN_CAP) { atomicAdd(&(bar)[XB_TMO], 1u); break; } } } } while (0)

struct XcdBarrier {
    unsigned* bar; unsigned x;
    volatile LAS unsigned* st;
};

__device__ __forceinline__ XcdBarrier xcd_barrier_post(unsigned* bar, volatile LAS unsigned* st) {
    XcdBarrier b; b.bar = bar; b.x = xb_xcc_id(); b.st = st;
    if (threadIdx.x == 0) (void)xb_add(&bar[XB_XCNT(b.x)], 1u);
    return b;
}
__device__ __forceinline__ void xcd_barrier_complete(unsigned* bar, unsigned x, unsigned& nloc, unsigned& nx) {
    const unsigned G = gridDim.x * gridDim.y * gridDim.z;
    unsigned sum, cnt, mine, sp = 0u;
    for (;;) {
        sum = 0u; cnt = 0u; mine = 0u;
#pragma unroll
        for (unsigned j = 0; j < 16; ++j) { const unsigned c = xb_ld(&bar[XB_XCNT(j)]); sum += c; cnt += (c > 0u) ? 1u : 0u; mine = (j == x) ? c : mine; }
        if (sum == G) break;
        __builtin_amdgcn_s_sleep(1);
        if ((++sp & 255u) == 0u) { if (xb_ld(&bar[XB_TMO])) break; if (sp > XB_SPIN_CAP) { atomicAdd(&bar[XB_TMO], 1u); break; } }
    }
    nloc = mine > 0u ? mine : 1u; nx = cnt > 0u ? cnt : 1u;
}

__device__ __forceinline__ void xcd_barrier(const XcdBarrier& b) {
    asm volatile("s_waitcnt vmcnt(0)" ::: "memory");
    __syncthreads();
    if (threadIdx.x == 0) {
        unsigned* bar = b.bar;
        __builtin_amdgcn_s_waitcnt(0);
        unsigned nloc = b.st[0], nx = b.st[1];
        if (nloc == 0u) { xcd_barrier_complete(bar, b.x, nloc, nx); b.st[0] = nloc; b.st[1] = nx; }
        const unsigned old = xb_add(&bar[XB_XSUB(b.x)], 1u);
        const unsigned gen = old / nloc;
        if (old + 1u == (gen + 1u) * nloc) {
            __builtin_amdgcn_fence(__ATOMIC_RELEASE, "agent");
            asm volatile("s_waitcnt vmcnt(0)" ::: "memory");
            const unsigned og = xb_add(&bar[XB_TOP], 1u);
            const unsigned tg = og / nx;
            if (og + 1u == (tg + 1u) * nx) xb_add(&bar[XB_TOPGEN], 1u);
            else XB_SPIN(xb_ld(&bar[XB_TOPGEN]) == tg, bar);
            __builtin_amdgcn_fence(__ATOMIC_ACQUIRE, "agent");
            xb_add(&bar[XB_XGEN(b.x)], 1u);
            asm volatile("s_waitcnt vmcnt(0)" ::: "memory");
        } else {
            XB_SPIN(xb_ld(&bar[XB_XGEN(b.x)]) == gen, bar);
            __builtin_amdgcn_fence(__ATOMIC_ACQUIRE, "agent");
            asm volatile("s_waitcnt vmcnt(0)" ::: "memory");
        }
    }
    __syncthreads();
}

struct Args { const float* in[21]; float* out; unsigned char* ws; int ph_lo, ph_hi, coop, pad; };

__device__ __forceinline__ void p0_transpose_item(const float* W, int K, int N, bf16* WT, LAS float* scr, int item, int lane, int ldt = 0) {
    if (ldt == 0) ldt = K;
    const int nblk = N / 64, kb = item / nblk, nb = item % nblk, k0 = 64 * kb, n0 = 64 * nb;
    const int lr = lane >> 4, lc = (lane & 15) * 4;
    f32x4 v[16];
#pragma unroll
    for (int i = 0; i < 16; ++i) v[i] = ntload((const f32x4*)(W + (size_t)(k0 + 4 * i + lr) * N + n0 + lc));
#pragma unroll
    for (int i = 0; i < 16; ++i) { LAS float* d = scr + (4 * i + lr) * 65 + lc; d[0] = v[i].x; d[1] = v[i].y; d[2] = v[i].z; d[3] = v[i].w; }
    LDS_WAIT(); asm volatile("" ::: "memory");
    const int c = lane & 7;
#pragma unroll
    for (int j = 0; j < 8; ++j) { const int n = (lane >> 3) + 8 * j; const LAS float* sp = scr + (8 * c) * 65 + n;
        v4u o; o.x = pk2(sp[0 * 65], sp[1 * 65]); o.y = pk2(sp[2 * 65], sp[3 * 65]); o.z = pk2(sp[4 * 65], sp[5 * 65]); o.w = pk2(sp[6 * 65], sp[7 * 65]);
        *(GAS v4u*)(WT + (size_t)(n0 + n) * ldt + k0 + 8 * c) = o; }
    LDS_WAIT(); asm volatile("" ::: "memory");
}
__device__ __forceinline__ void rms_rows2_to_bf16(const float* xrow0, const float* xrow1, const float* g, bf16* orow0, bf16* orow1, int lane) {
    f32x4 v[2][8];
#pragma unroll
    for (int j = 0; j < 4; ++j) { const float* p0 = xrow0 + j * 512 + lane * 8; const float* p1 = xrow1 + j * 512 + lane * 8;
        v[0][2 * j] = ntload((const f32x4*)p0); v[0][2 * j + 1] = ntload((const f32x4*)(p0 + 4)); v[1][2 * j] = ntload((const f32x4*)p1); v[1][2 * j + 1] = ntload((const f32x4*)(p1 + 4)); }
#pragma unroll
    for (int k = 0; k < 2; ++k) { float s = 0.f; bf16* orow = k ? orow1 : orow0;
#pragma unroll
        for (int j = 0; j < 8; ++j) s += (v[k][j].x * v[k][j].x + v[k][j].y * v[k][j].y) + (v[k][j].z * v[k][j].z + v[k][j].w * v[k][j].w);
        const float rstd = 1.0f / sqrtf(wave_sum(s) * (1.f / DM) + NORM_EPS);
#pragma unroll
        for (int j = 0; j < 4; ++j) { const float* gp = g + j * 512 + lane * 8; const f32x4 g0 = *(const f32x4*)gp, g1 = *(const f32x4*)(gp + 4); const f32x4 a = v[k][2 * j] * rstd * g0, b = v[k][2 * j + 1] * rstd * g1;
            v4u o; o.x = pk2(a.x, a.y); o.y = pk2(a.z, a.w); o.z = pk2(b.x, b.y); o.w = pk2(b.z, b.w); *(v4u*)(orow + j * 512 + lane * 8) = o; } }
}
template <bool BASE_BF, bool OUT_BF>
__device__ __forceinline__ void row_pass(const bf16* Y, const void* basev, const float* gA, void* outv, const float* gB, bf16* xn, int gw, int NGW, int lane, int ldx = DM, const float* pin = nullptr) {
    const float* base = (const float*)basev; const bf16* baseb = (const bf16*)basev; float* outh = (float*)outv; bf16* outb = (bf16*)outv;
    for (int row0 = gw; row0 < T; row0 += 2 * NGW) {
        f32x4 h[2][8]; v4u yw[2][4];
#pragma unroll
        for (int k = 0; k < 2; ++k)
#pragma unroll
            for (int j = 0; j < 4; ++j) { const size_t off = (size_t)(row0 + k * NGW) * DM + j * 512 + lane * 8; yw[k][j] = ntload((const v4u*)(Y + off));
                if constexpr (BASE_BF) { const v4u bw = ntload((const v4u*)(baseb + off)); h[k][2 * j] = (f32x4){bflo(bw.x), bfhi(bw.x), bflo(bw.y), bfhi(bw.y)}; h[k][2 * j + 1] = (f32x4){bflo(bw.z), bfhi(bw.z), bflo(bw.w), bfhi(bw.w)}; }
                else { h[k][2 * j] = ntload((const f32x4*)(base + off)); h[k][2 * j + 1] = ntload((const f32x4*)(base + off + 4)); } }
#pragma unroll
        for (int k = 0; k < 2; ++k) { const int row = row0 + k * NGW;
            f32x4 y[8]; float s = 0.f;
#pragma unroll
            for (int j = 0; j < 4; ++j) { const v4u w = yw[k][j]; y[2 * j] = (f32x4){bflo(w.x), bfhi(w.x), bflo(w.y), bfhi(w.y)}; y[2 * j + 1] = (f32x4){bflo(w.z), bfhi(w.z), bflo(w.w), bfhi(w.w)}; }
#pragma unroll
            for (int j = 0; j < 8; ++j) s += (y[j].x * y[j].x + y[j].y * y[j].y) + (y[j].z * y[j].z + y[j].w * y[j].w);
            const float r1 = 1.0f / sqrtf(wave_sum(s) * (1.f / DM) + NORM_EPS); float s2 = 0.f;
#pragma unroll
            for (int j = 0; j < 4; ++j) { const int c = j * 512 + lane * 8; const f32x4 g0 = *(const f32x4*)(gA + c), g1 = *(const f32x4*)(gA + c + 4);
                h[k][2 * j] = h[k][2 * j] + y[2 * j] * r1 * g0; h[k][2 * j + 1] = h[k][2 * j + 1] + y[2 * j + 1] * r1 * g1;
                if constexpr (OUT_BF) { const f32x4 a = h[k][2 * j], b = h[k][2 * j + 1]; v4u o; o.x = pk2(a.x, a.y); o.y = pk2(a.z, a.w); o.z = pk2(b.x, b.y); o.w = pk2(b.z, b.w); ntstore(o, (v4u*)(outb + (size_t)row * DM + c)); }
                else { ntstore(h[k][2 * j], (f32x4*)(outh + (size_t)row * DM + c)); ntstore(h[k][2 * j + 1], (f32x4*)(outh + (size_t)row * DM + c + 4)); } }
            if (xn) {
#pragma unroll
                for (int j = 0; j < 8; ++j) s2 += (h[k][j].x * h[k][j].x + h[k][j].y * h[k][j].y) + (h[k][j].z * h[k][j].z + h[k][j].w * h[k][j].w);
                const float r2 = 1.0f / sqrtf(wave_sum(s2) * (1.f / DM) + NORM_EPS);
#pragma unroll
                for (int j = 0; j < 4; ++j) { const int c = j * 512 + lane * 8; const f32x4 g0 = *(const f32x4*)(gB + c), g1 = *(const f32x4*)(gB + c + 4); const f32x4 a = h[k][2 * j] * r2 * g0, b = h[k][2 * j + 1] * r2 * g1;
                    v4u o; o.x = pk2(a.x, a.y); o.y = pk2(a.z, a.w); o.z = pk2(b.x, b.y); o.w = pk2(b.z, b.w); *(v4u*)(xn + (size_t)row * ldx + c) = o; }
                if (pin) { const f32x4 pv = *(const f32x4*)(pin + (size_t)row * PLE + lane * 4); v2u o; o.x = pk2(pv.x, pv.y); o.y = pk2(pv.z, pv.w); *(v2u*)(xn + (size_t)row * ldx + DM + lane * 4) = o; }
            }
        }
    }
}

typedef swa::BlockRef<swa::bf16, swa::bf16> ABlock;
__device__ __forceinline__ ABlock attn_ref(int head, int qb, unsigned char* ws, float* dout) {
    const swa::bf16* QKVs = (const swa::bf16*)(ws + WS_QKV); ABlock r;
    const int b = head >> 4, hd = (head >> 2) & 3, c = (head >> 1) & 1, j = head & 1; const int sh = b * NH8 + hd * 2 + c, vh = b * NH8 + hd * 2 + j;
    r.Q = QKVs + 3 * SEC_ELEMS + ((size_t)sh * SEQ + (size_t)qb * 256) * 128; r.K = QKVs + 4 * SEC_ELEMS + (size_t)sh * SEQ * 128; r.V = QKVs + 5 * SEC_ELEMS + (size_t)vh * SEQ * 128;
    r.O = (swa::bf16*)dout + ((size_t)b * SEQ + (size_t)qb * 256) * 4096 + hd * 512 + c * 256 + j * 128;
    r.ldo = 4096; r.rows = nullptr; r.dst = nullptr; r.stat = nullptr; r.P0 = qb * 256;
    return r;
}
constexpr int MOBA_PER = 320, MOBA_ITEMS = 16 * MOBA_PER;
__device__ __forceinline__ bool moba_valid(int L, const int* nblk) { const int bh = L / MOBA_PER, k = L - bh * MOBA_PER; return k >= 256 || k < nblk[bh]; }
__device__ __forceinline__ int moba_next(int L, int G, const int* nblk) { do { L += G; } while (L < MOBA_ITEMS && !moba_valid(L, nblk)); return L; }
__device__ __forceinline__ ABlock moba_ref(int L, unsigned char* ws, float* dout) {
    const swa::bf16* QKVs = (const swa::bf16*)(ws + WS_QKV); ABlock r;
    const int bh = L / MOBA_PER, k = L - bh * MOBA_PER; int j, lp, p0;
    if (k < 256) { const int2 t = ((const int2*)(ws + WS_TAB))[bh * 256 + k]; j = t.x; lp = t.y; p0 = 256; } else { j = k - 256; lp = 65536 + j * 256; p0 = 0; }
    r.Q = QKVs + (size_t)bh * SEQ * 128; r.K = QKVs + 1 * SEC_ELEMS + ((size_t)bh * SEQ + (size_t)j * 256) * 128; r.V = QKVs + 2 * SEC_ELEMS + ((size_t)bh * SEQ + (size_t)j * 256) * 128;
    r.O = (swa::bf16*)dout; r.ldo = 128; r.rows = (const int*)(ws + WS_ROWL) + (size_t)bh * LSTR + lp; r.dst = (const int*)(ws + WS_DSTL) + (size_t)bh * LSTR + lp; r.stat = (float*)(ws + WS_STATS); r.P0 = p0;
    return r;
}

__global__ void __launch_bounds__(NWAVES * 64, 2) mk_fwd(Args args) {
    extern __shared__ __attribute__((aligned(16))) unsigned char lds[];
    LAS unsigned char* L = (LAS unsigned char*)lds;
    const int tid = threadIdx.x, lane = tid & 63, wave = __builtin_amdgcn_readfirstlane(tid >> 6);
    const int G = gridDim.x, bx = blockIdx.x;
    const int vcu = (G % 8 == 0) ? (bx % 8) * (G / 8) + bx / 8 : bx;
    const int gw = vcu * NWAVES + wave, NGW = G * NWAVES;
    unsigned char* ws = args.ws;
#define x_in (args.in[0])
#define p_in (args.in[1])
#define Win_t ((bf16*)(ws + WS_WIN))
#define Wa_t ((bf16*)(ws + WS_WA))
#define Wb_t ((bf16*)(ws + WS_WB))
#define Wout_t ((bf16*)(ws + WS_WOUT))
#define Wup_t ((bf16*)(ws + WS_WUP))
#define Wdn_t ((bf16*)(ws + WS_WDN))
#define Wpg_t ((bf16*)(ws + WS_WPG))
#define Wpp_t ((bf16*)(ws + WS_WPP))
#define XN ((bf16*)(ws + WS_XN))
#define PB ((bf16*)(ws + WS_PB))
#define QKV ((bf16*)(ws + WS_QKV))
#define SG ((bf16*)(ws + WS_SG))
#define OAB ((bf16*)(ws + WS_XN))
#define MIX ((bf16*)(ws + WS_MIX))
#define HID ((bf16*)(ws + WS_HID))
#define G3 ((bf16*)(ws + WS_G3))
#define Y ((bf16*)(ws + WS_Y))
#define rope ((float*)(ws + WS_ROPE))
#define kmean ((float*)(ws + WS_KMEAN))
#define out (args.out)
    const int lo = args.ph_lo, hi = args.ph_hi;
#define IN(k) (lo <= (k) && (k) < hi)
#define SEAM(k) do { if (IN(k) && IN((k) + 1)) { if (args.coop) { if (args.pad == 0x5eed) { asm volatile("s_waitcnt vmcnt(0) lgkmcnt(0)" ::: "memory"); cg::this_grid().sync(); }     \
        xcd_barrier(xbar); } } } while (0)
    volatile LAS unsigned* bst = (volatile LAS unsigned*)(L + LDS_BYTES - 64);
    if (tid < 2) bst[tid] = 0u;
    __syncthreads();
    XcdBarrier xbar; xbar.bar = (unsigned*)(ws + WS_BAR); xbar.x = 0; xbar.st = bst;
    if (args.coop) xbar = xcd_barrier_post((unsigned*)(ws + WS_BAR), bst);

    if (IN(0)) {
        LAS float* scr = (LAS float*)(L + wave * 16896);
        constexpr int I_IN = (DM / 64) * (INW / 64), I_BR = (1024 / 64) * (DM / 64), I_OUT = (DM / 64) * (DM / 64), I_UP = (DM / 64) * (DFF / 64), I_DN = (DFF / 64) * (DM / 64), I_PP = (PLE / 64) * (DM / 64);
        constexpr int NITEMS = I_IN + 2 * I_BR + I_OUT + I_UP + I_DN + I_OUT + I_PP;
        for (int it = gw; it < NITEMS; it += NGW) {
            int r = it;
            if (r < I_IN) { p0_transpose_item(args.in[2], DM, INW, Win_t, scr, r, lane); continue; } r -= I_IN;
            if (r < I_BR) { p0_transpose_item(args.in[3], 1024, DM, Wa_t, scr, r, lane, 2048); continue; } r -= I_BR;
            if (r < I_BR) { p0_transpose_item(args.in[4], 1024, DM, Wa_t + 1024, scr, r, lane, 2048); continue; } r -= I_BR;
            if (r < I_OUT) { p0_transpose_item(args.in[5], DM, DM, Wout_t, scr, r, lane); continue; } r -= I_OUT;
            if (r < I_UP) { p0_transpose_item(args.in[13], DM, DFF, Wup_t, scr, r, lane); continue; } r -= I_UP;
            if (r < I_DN) { p0_transpose_item(args.in[14], DFF, DM, Wdn_t, scr, r, lane); continue; } r -= I_DN;
            if (r < I_OUT) { p0_transpose_item(args.in[18], DM, DM, Wpg_t, scr, r, lane, DM + PLE); continue; } r -= I_OUT;
            p0_transpose_item(args.in[17], PLE, DM, Wpg_t + DM, scr, r, lane, DM + PLE);
        }
        for (int m = gw; m < T; m += 2 * NGW) rms_rows2_to_bf16(x_in + (size_t)m * DM, x_in + (size_t)(m + NGW) * DM, args.in[11], XN + (size_t)m * DM, XN + (size_t)(m + NGW) * DM, lane);
        if (bx == 0) { for (int i = tid; i < 16 * 64 + 16; i += 512) { if (i < 1024) ((int*)(ws + WS_CNT))[i] = 0; else ((int*)(ws + WS_NBLK))[i - 1024] = 0; } }
        for (int i = bx * 512 + tid; i < 16 * 64 * 128; i += G * 512) kmean[i] = 0.f;
        for (int i = bx * 512 + tid; i < SEQ * 16; i += G * 512) { const int pos = i >> 4, k = i & 15;
            double fr_ = 1.0; for (int j_ = 0; j_ < k; ++j_) fr_ *= 0.4403666026717805;
            const float angf = (float)pos * (float)fr_; const double a = (double)angf;
            const double TWO_PI = 6.283185307179586476925286766559; double q = __builtin_rint(a / TWO_PI); double r = a - q * TWO_PI;
            const double r2 = r * r; double sn = 1.0, cs = 1.0;
            sn = 1.0 - r2 / (22.0 * 23.0); sn = 1.0 - r2 / (20.0 * 21.0) * sn; sn = 1.0 - r2 / (18.0 * 19.0) * sn; sn = 1.0 - r2 / (16.0 * 17.0) * sn; sn = 1.0 - r2 / (14.0 * 15.0) * sn; sn = 1.0 - r2 / (12.0 * 13.0) * sn;
            sn = 1.0 - r2 / (10.0 * 11.0) * sn; sn = 1.0 - r2 / (8.0 * 9.0) * sn; sn = 1.0 - r2 / (6.0 * 7.0) * sn; sn = 1.0 - r2 / (4.0 * 5.0) * sn; sn = 1.0 - r2 / (2.0 * 3.0) * sn; sn = r * sn;
            cs = 1.0 - r2 / (21.0 * 22.0); cs = 1.0 - r2 / (19.0 * 20.0) * cs; cs = 1.0 - r2 / (17.0 * 18.0) * cs; cs = 1.0 - r2 / (15.0 * 16.0) * cs; cs = 1.0 - r2 / (13.0 * 14.0) * cs; cs = 1.0 - r2 / (11.0 * 12.0) * cs;
            cs = 1.0 - r2 / (9.0 * 10.0) * cs; cs = 1.0 - r2 / (7.0 * 8.0) * cs; cs = 1.0 - r2 / (5.0 * 6.0) * cs; cs = 1.0 - r2 / (3.0 * 4.0) * cs; cs = 1.0 - r2 / (1.0 * 2.0) * cs;
            rope[(size_t)pos * 32 + k] = (float)cs; rope[(size_t)pos * 32 + 16 + k] = (float)sn; }
    }
    SEAM(0);
    if (IN(1)) {
        pg8::Gemm g{XN, Win_t, T, INW, DM}; pg8::StaticOrder S; S.init(T, INW, G, bx);
        pg8::EpiInProj E{QKV, SG, (const float*)rope, kmean};
        pg8::gemm_phase<pg8::EpiInProj, pg8::StaticOrder, true, true>(L, g, S, E);
    }
    SEAM(1);
    if (IN(3)) {
        char* Kl = (char*)lds;
        const int lane_ = tid & 63, r32 = lane_ & 31, hi = lane_ >> 5;
        const int sr = tid >> 4, sc = (tid & 15) * 8, kws = KSWZ(sr, sc * 2);
        int bh_loaded = -1;
        for (int u = vcu; u < 16 * 64; u += G) {
            const int bh = u & 15, qb = u >> 4;
            if (bh != bh_loaded) {
                __syncthreads();
#pragma unroll
                for (int h2 = 0; h2 < 2; ++h2) { const float* kp = kmean + ((size_t)bh * 64 + sr + 32 * h2) * 128 + sc; const f32x4 a = *(const f32x4*)kp, b = *(const f32x4*)(kp + 4);
                    const float v[8] = {a.x, a.y, a.z, a.w, b.x, b.y, b.z, b.w}; unsigned hb[8], lb[8];
#pragma unroll
                    for (int e = 0; e < 8; ++e) { hb[e] = f2bf(v[e]); lb[e] = f2bf(v[e] - __uint_as_float(hb[e] << 16)); }
                    v4u wh, wl; wh.x = hb[0] | (hb[1] << 16); wh.y = hb[2] | (hb[3] << 16); wh.z = hb[4] | (hb[5] << 16); wh.w = hb[6] | (hb[7] << 16);
                    wl.x = lb[0] | (lb[1] << 16); wl.y = lb[2] | (lb[3] << 16); wl.z = lb[4] | (lb[5] << 16); wl.w = lb[6] | (lb[7] << 16);
                    *(v4u*)(Kl + kws + h2 * 32 * 256) = wh; *(v4u*)(Kl + swa::SHM_K + kws + h2 * 32 * 256) = wl; }
                __syncthreads();
                bh_loaded = bh;
            }
            const int row = wave * 32 + r32;
            swa::bf16x8 qr[8];
            { const swa::bf16* qp = (const swa::bf16*)QKV + ((size_t)bh * SEQ + (size_t)qb * 256 + row) * 128 + hi * 8;
#pragma unroll
              for (int d0 = 0; d0 < 8; ++d0) qr[d0] = swa::load8<swa::bf16>(qp + d0 * 16); }
            swa::f32x16 ph0, ph1, pl0, pl1;
            swa::qkt_r<0>(ph0, ph1, Kl, r32, hi, qr); swa::qkt_r<1>(pl0, pl1, Kl, r32, hi, qr);
            float g0 = -__builtin_inff(), g1 = g0, g2 = g0; int i0 = -1, i1 = -1, i2 = -1;
#define INS3(gv, iv) do { const float g_ = (gv); const int i_ = (iv); if (g_ > g0) { g2 = g1; i2 = i1; g1 = g0; i1 = i0; g0 = g_; i0 = i_; } else if (g_ > g1) { g2 = g1; i2 = i1; g1 = g_; i1 = i_; } else if (g_ > g2) { g2 = g_; i2 = i_; } } while (0)
#pragma unroll
            for (int r = 0; r < 16; ++r) { const int n = swa::crow(r, hi); if (n < qb) INS3(ph0[r] + pl0[r], n); }
#pragma unroll
            for (int r = 0; r < 16; ++r) { const int n = 32 + swa::crow(r, hi); if (n < qb) INS3(ph1[r] + pl1[r], n); }
            { const float pg0 = __shfl_xor(g0, 32), pg1 = __shfl_xor(g1, 32), pg2 = __shfl_xor(g2, 32); const int pi0 = __shfl_xor(i0, 32), pi1 = __shfl_xor(i1, 32), pi2 = __shfl_xor(i2, 32);
              INS3(pg0, pi0); INS3(pg1, pi1); INS3(pg2, pi2); }
#undef INS3
            if (hi == 0) {
                const int grow = qb * 256 + row; int s0 = -1, s1 = -1, s2 = -1; int* cnt = (int*)(ws + WS_CNT) + bh * 64; float2* stt = (float2*)(ws + WS_STATS);
                float2 none; none.x = -1e30f; none.y = 0.f;
                if (i0 >= 0) s0 = atomicAdd(cnt + i0, 1); else stt[(size_t)(bh * 4 + 0) * SEQ + grow] = none;
                if (i1 >= 0) s1 = atomicAdd(cnt + i1, 1); else stt[(size_t)(bh * 4 + 1) * SEQ + grow] = none;
                if (i2 >= 0) s2 = atomicAdd(cnt + i2, 1); else stt[(size_t)(bh * 4 + 2) * SEQ + grow] = none;
                int4 rec; rec.x = (i0 & 255) | ((i1 & 255) << 8) | ((i2 & 255) << 16); rec.y = s0; rec.z = s1; rec.w = s2;
                ((int4*)(ws + WS_SEL))[(size_t)bh * SEQ + grow] = rec; }
        }
        __syncthreads();
    }
    SEAM(3);
    if (IN(4)) {
        LAS int* cn = (LAS int*)L; LAS int* offs = cn + 64;
        int* ROWL = (int*)(ws + WS_ROWL); int* DSTL = (int*)(ws + WS_DSTL);
        for (int u = vcu; u < 16 * 64; u += G) {
            const int bh = u & 15, chunk = u >> 4;
            __syncthreads();
            if (tid < 64) cn[tid] = ((const int*)(ws + WS_CNT))[bh * 64 + tid];
            __syncthreads();
            if (tid == 0) { int a = 0; for (int j = 0; j < 64; ++j) { offs[j] = a; a += (cn[j] + 255) & ~255; } offs[64] = a; }
            __syncthreads();
            int* rl = ROWL + (size_t)bh * LSTR; int* dl = DSTL + (size_t)bh * LSTR;
            if (tid < 256) { const int row = chunk * 256 + tid; const int4 rec = ((const int4*)(ws + WS_SEL))[(size_t)bh * SEQ + row];
                const int j0 = rec.x & 255, j1 = (rec.x >> 8) & 255, j2 = (rec.x >> 16) & 255;
                if (j0 != 255) { const int gp = offs[j0] + rec.y; rl[gp] = row; dl[gp] = (bh * 4 + 0) * SEQ + row; }
                if (j1 != 255) { const int gp = offs[j1] + rec.z; rl[gp] = row; dl[gp] = (bh * 4 + 1) * SEQ + row; }
                if (j2 != 255) { const int gp = offs[j2] + rec.w; rl[gp] = row; dl[gp] = (bh * 4 + 2) * SEQ + row; }
                rl[65536 + row] = row; dl[65536 + row] = (bh * 4 + 3) * SEQ + row; }
            if (chunk == 0) {
                for (int idx = tid; idx < 64 * 256; idx += 512) { const int j = idx >> 8, c = cn[j], pos = c + (idx & 255);
                    if (pos < ((c + 255) & ~255)) { rl[offs[j] + pos] = 0; dl[offs[j] + pos] = -1; } }
                if (tid == 0) { int k = 0; int2* tab = (int2*)(ws + WS_TAB) + bh * 256;
                    for (int j = 0; j < 64; ++j) { const int nb = (cn[j] + 255) >> 8; for (int b_ = 0; b_ < nb; ++b_) { if (k < 256) { int2 t; t.x = j; t.y = offs[j] + 256 * b_; tab[k] = t; } ++k; } }
                    ((int*)(ws + WS_NBLK))[bh] = k < 256 ? k : 256; }
            }
        }
        __syncthreads();
    }
    SEAM(4);
    if (IN(5)) {
        const int* nblk = (const int*)(ws + WS_NBLK);
        static_assert(swa::MOBA_LDS_BYTES <= LDS_BYTES - 64, "MoBA short-block LDS");
        int Lc = vcu; if (!moba_valid(Lc, nblk)) Lc = moba_next(Lc, G, nblk);
        if (Lc < MOBA_ITEMS) {
            ABlock cur = moba_ref(Lc, ws, out); swa::MobaStage ST; swa::moba_prime(cur, ST);
            for (;;) { const int Ln = moba_next(Lc, G, nblk); const bool has_next = Ln < MOBA_ITEMS;
                ABlock nxt = cur; if (has_next) nxt = moba_ref(Ln, ws, out);
                swa::moba_block(cur, nxt, has_next, (char*)lds, ST);
                if (!has_next) break;
                cur = nxt; Lc = Ln; }
        }
        __syncthreads();
    }
    SEAM(5);
    if (IN(6)) {
        const float2* stt = (const float2*)(ws + WS_STATS); const bf16* PART = (const bf16*)out; constexpr float C2 = 1.4426950408889634f * 0.08838834764831845f;
        for (int u0 = gw; u0 < 16 * SEQ; u0 += 4 * NGW) {
            float2 st[4][4]; unsigned pw[4][4];
#pragma unroll
            for (int k = 0; k < 4; ++k) { const int u = u0 + k * NGW, bh = u >> 14, row = u & (SEQ - 1);
#pragma unroll
                for (int s_ = 0; s_ < 4; ++s_) { const size_t di = (size_t)(bh * 4 + s_) * SEQ + row; st[k][s_] = stt[di]; pw[k][s_] = ntload((const unsigned*)(PART + di * 128 + lane * 2)); } }
#pragma unroll
            for (int k = 0; k < 4; ++k) { const int u = u0 + k * NGW, bh = u >> 14, row = u & (SEQ - 1);
                float M = -1e30f;
#pragma unroll
                for (int s_ = 0; s_ < 4; ++s_) if (st[k][s_].y > 0.f) M = fmaxf(M, st[k][s_].x);
                float a0 = 0.f, a1 = 0.f, den = 0.f;
#pragma unroll
                for (int s_ = 0; s_ < 4; ++s_) { const bool ok = st[k][s_].y > 0.f; const float w = ok ? st[k][s_].y * __builtin_amdgcn_exp2f((st[k][s_].x - M) * C2) : 0.f;
                    a0 += ok ? w * bflo(pw[k][s_]) : 0.f; a1 += ok ? w * bfhi(pw[k][s_]) : 0.f; den += w; }
                const float inv = 1.0f / den;
                *(unsigned*)(OAB + ((size_t)(bh >> 3) * SEQ + row) * 2048 + (bh & 7) * 128 + lane * 2) = pk2(a0 * inv, a1 * inv); } }
    }
    SEAM(6);
    const bool fuse_dc = (G == 256);
    if (IN(7)) {
        constexpr int NITEM = 32 * 32;
        int Lc = vcu;
#define DHEAD(L_) (((((L_) >> 5) & 7) << 2) + ((L_) >> 8))
        if (Lc < NITEM) {
            int head = DHEAD(Lc), xx = Lc & 31, pass = 0;
            ABlock cur = attn_ref(head, xx, ws, out);
            swa::Seam<swa::bf16> S;
            swa::causal_swa_prime<swa::bf16, swa::bf16>(cur, SEQ, (char*)lds, S);
            for (;;) {
                const bool more_pass = pass == 0, more_item = Lc + G < NITEM, last = !more_pass && !more_item;
                int headn = head, xn = xx, passn = pass + 1, Ln = Lc;
                if (!more_pass) { passn = 0; Ln = more_item ? Lc + G : Lc; headn = DHEAD(Ln); xn = Ln & 31; }
                const int qbn = passn ? 63 - xn : xn;
                ABlock nxt = cur;
                if (!last) nxt = attn_ref(headn, qbn, ws, out);
                swa::causal_swa_block<swa::bf16, swa::bf16>(cur, nxt, SEQ, SEQ, (char*)lds, S);
                if (last) break;
                cur = nxt; head = headn; xx = xn; pass = passn; Lc = Ln;
            }
        }
#undef DHEAD
        asm volatile("s_waitcnt vmcnt(0)" ::: "memory");
        __syncthreads();
        if (fuse_dc) {
            float lam;
            { const float* q1 = args.in[6]; const float* k1 = args.in[7]; const float* q2 = args.in[8]; const float* k2 = args.in[9];
              const float s1 = wave_sum(q1[lane] * k1[lane] + q1[lane + 64] * k1[lane + 64]), s2 = wave_sum(q2[lane] * k2[lane] + q2[lane + 64] * k2[lane + 64]);
              lam = __expf(s1) - __expf(s2) + LAMBDA_INIT; }
            const bf16* AD = (const bf16*)out; const f32x4 gg = *(const f32x4*)(args.in[10] + lane * 4);
            const int bhd = (vcu >> 5) & 7, b = bhd >> 2, hd = bhd & 3, x0 = vcu & 31;
            for (int r0 = wave * 64; r0 < wave * 64 + 64; r0 += 4) {
                v2u w0[4], w1[4]; size_t tt[4];
#pragma unroll
                for (int k = 0; k < 4; ++k) { const int r = r0 + k; const int qb = (r < 256) ? x0 : 63 - x0; tt[k] = (size_t)b * SEQ + (size_t)qb * 256 + (r & 255);
                    const bf16* a = AD + tt[k] * 4096 + hd * 512 + lane * 4; w0[k] = *(const v2u*)a; w1[k] = *(const v2u*)(a + 256); }
#pragma unroll
                for (int k = 0; k < 4; ++k) {
                    f32x4 d; d.x = bflo(w0[k].x) - lam * bflo(w1[k].x); d.y = bfhi(w0[k].x) - lam * bfhi(w1[k].x); d.z = bflo(w0[k].y) - lam * bflo(w1[k].y); d.w = bfhi(w0[k].y) - lam * bfhi(w1[k].y);
                    const float ss = wave_sum((d.x * d.x + d.y * d.y) + (d.z * d.z + d.w * d.w));
                    const float r = (1.0f - LAMBDA_INIT) / sqrtf(ss * (1.f / 256.f) + NORM_EPS);
                    v2u o; o.x = pk2(d.x * r * gg.x, d.y * r * gg.y); o.y = pk2(d.z * r * gg.z, d.w * r * gg.w);
                    *(v2u*)(OAB + tt[k] * 2048 + 1024 + hd * 256 + lane * 4) = o; } }
        }
    }
    SEAM(7);
    if (IN(8) && !fuse_dc) {
        float lam;
        { const float* q1 = args.in[6]; const float* k1 = args.in[7]; const float* q2 = args.in[8]; const float* k2 = args.in[9];
          const float s1 = wave_sum(q1[lane] * k1[lane] + q1[lane + 64] * k1[lane + 64]), s2 = wave_sum(q2[lane] * k2[lane] + q2[lane + 64] * k2[lane + 64]);
          lam = __expf(s1) - __expf(s2) + LAMBDA_INIT; }
        const bf16* AD = (const bf16*)out; const float* sg = args.in[10];
        const f32x4 gg = *(const f32x4*)(sg + lane * 4);
        for (int u0 = gw; u0 < T * 4; u0 += 4 * NGW) {
            v2u w0[4], w1[4];
#pragma unroll
            for (int k = 0; k < 4; ++k) { const int u = u0 + k * NGW, t = u >> 2, hd = u & 3; const bf16* a = AD + (size_t)t * 4096 + hd * 512 + lane * 4; w0[k] = ntload((const v2u*)a); w1[k] = ntload((const v2u*)(a + 256)); }
#pragma unroll
            for (int k = 0; k < 4; ++k) { const int u = u0 + k * NGW, t = u >> 2, hd = u & 3;
                f32x4 d; d.x = bflo(w0[k].x) - lam * bflo(w1[k].x); d.y = bfhi(w0[k].x) - lam * bfhi(w1[k].x); d.z = bflo(w0[k].y) - lam * bflo(w1[k].y); d.w = bfhi(w0[k].y) - lam * bfhi(w1[k].y);
                const float ss = wave_sum((d.x * d.x + d.y * d.y) + (d.z * d.z + d.w * d.w));
                const float r = (1.0f - LAMBDA_INIT) / sqrtf(ss * (1.f / 256.f) + NORM_EPS);
                v2u o; o.x = pk2(d.x * r * gg.x, d.y * r * gg.y); o.y = pk2(d.z * r * gg.z, d.w * r * gg.w);
                *(v2u*)(OAB + (size_t)t * 2048 + 1024 + hd * 256 + lane * 4) = o; } }
    }
    if (!fuse_dc) SEAM(8);
    if (IN(9)) { pg8::Gemm g{OAB, Wa_t, T, DM, 2048}; pg8::StaticOrder S; S.init(T, DM, G, bx); pg8::EpiGate2 E{MIX, SG};
        pg8::gemm_phase<pg8::EpiGate2, pg8::StaticOrder, true, true, true>(L, g, S, E); }
    SEAM(9);
    if (IN(11)) { pg8::Gemm g{MIX, Wout_t, T, DM, DM}; pg8::StaticOrder S; S.init(T, DM, G, bx); pg8::EpiT<0> E{Y, DM, nullptr, 0};
        pg8::gemm_phase<pg8::EpiT<0>, pg8::StaticOrder, true, true>(L, g, S, E); }
    SEAM(11);
    if (IN(12)) row_pass<false, true>(Y, x_in, args.in[12], out, args.in[15], XN, gw, NGW, lane);
    SEAM(12);
    if (IN(13)) { pg8::Gemm g{XN, Wup_t, T, DFF, DM}; pg8::StaticOrder S; S.init(T, DFF, G, bx); pg8::EpiT<1> E{HID, DFF, nullptr, 0};
        pg8::gemm_phase<pg8::EpiT<1>, pg8::StaticOrder, true, true>(L, g, S, E); }
    SEAM(13);
    if (IN(14)) { pg8::Gemm g{HID, Wdn_t, T, DM, DFF}; pg8::StaticOrder S; S.init(T, DM, G, bx); pg8::EpiT<0> E{Y, DM, nullptr, 0};
        pg8::gemm_phase<pg8::EpiT<0>, pg8::StaticOrder, true, true>(L, g, S, E); }
    SEAM(14);
    if (IN(15)) row_pass<true, true>(Y, out, args.in[16], ws + WS_H2, args.in[19], (bf16*)(ws + WS_XN3), gw, NGW, lane, DM + PLE, p_in);
    SEAM(15);
    if (IN(16)) { pg8::Gemm g{(bf16*)(ws + WS_XN3), Wpg_t, T, DM, DM + PLE}; pg8::StaticOrder S; S.init(T, DM, G, bx); pg8::EpiPle E{Y, G3};
        pg8::gemm_phase<pg8::EpiPle, pg8::StaticOrder, true, true, true>(L, g, S, E); }
    SEAM(17);
    if (IN(18)) row_pass<true, false>(Y, ws + WS_H2, args.in[20], out, nullptr, nullptr, gw, NGW, lane);
#undef IN
#undef SEAM
#undef x_in
#undef p_in
#undef Win_t
#undef Wa_t
#undef Wb_t
#undef Wout_t
#undef Wup_t
#undef Wdn_t
#undef Wpg_t
#undef Wpp_t
#undef XN
#undef PB
#undef QKV
#undef SG
#undef OAB
#undef MIX
#undef HID
#undef G3
#undef Y
#undef rope
#undef kmean
#undef out
}

extern "C" void kernel_launch(void* const* d_in, const int* in_sizes, int n_in, void* d_out, int out_size, void* d_ws, size_t ws_size, hipStream_t stream) {
    static int grid = 0;
    if (grid == 0) {
        if (n_in != 21 || out_size != T * DM || ws_size < WS_TOP) { fprintf(stderr, "kernel_launch: unexpected shapes n_in %d out %d ws %zu\n", n_in, out_size, ws_size); grid = -1; return; }
        int dev = 0, cus = 0, per_cu = 0;
        (void)hipGetDevice(&dev); (void)hipDeviceGetAttribute(&cus, hipDeviceAttributeMultiprocessorCount, dev);
        if (hipFuncSetAttribute((const void*)mk_fwd, hipFuncAttributeMaxDynamicSharedMemorySize, LDS_BYTES) != hipSuccess) { fprintf(stderr, "kernel_launch: hipFuncSetAttribute failed\n"); grid = -1; return; }
        if (hipOccupancyMaxActiveBlocksPerMultiprocessor(&per_cu, (const void*)mk_fwd, NWAVES * 64, LDS_BYTES) != hipSuccess || per_cu < 1) { fprintf(stderr, "kernel_launch: occupancy query says %d\n", per_cu); per_cu = 1; }
        (void)hipGetLastError();
        grid = cus * 1;
        if (grid <= 0) grid = 256;
    }
    if (grid < 0) return;
    (void)hipMemsetAsync((unsigned char*)d_ws + WS_BAR, 0, WS_BAR_BYTES, stream);
    Args a{};
    for (int i = 0; i < 21; ++i) a.in[i] = (const float*)d_in[i];
    a.out = (float*)d_out; a.ws = (unsigned char*)d_ws;
#if MK_ONE_LAUNCH
    a.ph_lo = 0; a.ph_hi = NPHASE; a.coop = 1;
    void* kargs[] = {&a};
    hipError_t e = hipLaunchCooperativeKernel((const void*)mk_fwd, dim3(grid), dim3(NWAVES * 64), kargs, LDS_BYTES, stream);
    if (e != hipSuccess) fprintf(stderr, "cooperative launch failed: %s (grid %d)\n", hipGetErrorString(e), grid);
#else
    for (int ph = 0; ph < NPHASE; ++ph) { a.ph_lo = ph; a.ph_hi = ph + 1; a.coop = 0;
        hipLaunchKernelGGL(mk_fwd, dim3(grid), dim3(NWAVES * 64), LDS_BYTES, stream, a); }
#endif
}
```

```cpp
#include <hip/hip_runtime.h>
#include <hip/hip_bf16.h>
#include <cstdio>
#include <cstdint>
#include <cmath>
namespace pg8 {
#define PG8_LAS __attribute__((address_space(3)))
typedef unsigned short bf16_t;
typedef short bf16x8 __attribute__((ext_vector_type(8)));
typedef float f32x4 __attribute__((ext_vector_type(4)));
typedef unsigned u32x4 __attribute__((ext_vector_type(4)));
constexpr int BM = 256, BK = 64, HALF = 128, HTB = HALF * BK * 2  , STAGE_BYTES = 8 * HTB, NXCD = 8, WGM = 8;

__host__ __device__ __forceinline__ int lds_byte(int r, int c) { const int st = (r >> 4) * 2 + (c >> 5), rr = r & 15, cc = c & 31, ob = rr * 64 + cc * 2; return st * 1024 + (ob ^ (((ob >> 9) & 1) << 5)); }
__host__ __device__ __forceinline__ void stage_rc(int b, int& R, int& C) { const int st = b / 1024, sb = b % 1024, swz = sb ^ (((sb >> 9) & 1) << 5); R = (st >> 1) * 16 + swz / 64; C = (st & 1) * 32 + (swz % 64) / 2; }
__host__ __device__ __forceinline__ int perm32(int rho) { const int n = rho >> 4, i = rho & 15; return 8 * (i >> 2) + 4 * n + (i & 3); }

struct Unit { int pm, pn; };
struct Gemm { const bf16_t* A; const bf16_t* Bt; int M, N, K; };

struct StaticOrder {
    int nM, nN, nwg, G, c;
    __host__ __device__ void init(int M, int N, int G_, int c_) { nM = M / BM; nN = N / BM; nwg = nM * nN; G = G_; c = c_; }
    __host__ __device__ bool next(int i, Unit& u) const {
        const long L = (long)i * G + c; if (L >= nwg) return false;
        int wgid = (int)L; { const int q = nwg / NXCD, r = nwg % NXCD, xcd = wgid % NXCD, off = wgid / NXCD; wgid = (xcd < r ? xcd * (q + 1) : r * (q + 1) + (xcd - r) * q) + off; }
        const int nig = WGM * nN, gid = wgid / nig, fm = gid * WGM, gsz = (nM - fm) < WGM ? (nM - fm) : WGM;
        u.pm = fm + ((wgid % nig) % gsz); u.pn = (wgid % nig) / gsz; return true;
    }
    __device__ __forceinline__ void a_ready(const Unit&) const {}
    __device__ __forceinline__ void done(const Unit&) const {}
};

typedef float f32x2_c __attribute__((ext_vector_type(2))); typedef __bf16 bf16x2_c __attribute__((ext_vector_type(2)));
__device__ __forceinline__ unsigned cvt_pk_bf16(float lo, float hi) { f32x2_c v = {lo, hi}; bf16x2_c b = __builtin_convertvector(v, bf16x2_c); return __builtin_bit_cast(unsigned, b); }
typedef float f32x2 __attribute__((ext_vector_type(2)));
__device__ __forceinline__ f32x2 gelu_pk(f32x2 v) {
    const f32x2 av = __builtin_elementwise_abs(v), d = av * 0.2316418882f + 1.0f;
    f32x2 t; t.x = __builtin_amdgcn_rcpf(d.x); t.y = __builtin_amdgcn_rcpf(d.y);
    f32x2 q = t * 0.5307027145f + (-0.7265760135f); q = q * t + 0.7107068705f; q = q * t + (-0.142248368f); q = q * t + 0.127414796f; q = q * t;
    const f32x2 s = (v * v) * (-0.72134752044f);
    f32x2 e; e.x = __builtin_amdgcn_exp2f(s.x); e.y = __builtin_amdgcn_exp2f(s.y);
    const f32x2 m = v * (q * e), r = v - m;
    f32x2 o; o.x = v.x < 0.f ? m.x : r.x; o.y = v.y < 0.f ? m.y : r.y; return o;
}

template <int ACT  > struct EpiBf16 {
    static constexpr bool PERM = true, AFTER_DRAIN = false; static_assert(ACT == 0 || ACT == 1, "EpiBf16: ACT is 0 (none) or 1 (gelu_pk)");
    bf16_t* O; int ldc; const float* bias; int split_cols; size_t split_stride; float scale0;
    __device__ __forceinline__ void operator()(const f32x4 (&acc)[2][2][4][2], const Unit& u, int wr, int wc, int fr, int fq) const {
        const int row0 = u.pm * BM + wr * 64 + fr; int colt = u.pn * BM; bf16_t* base = O;
        float sc = 1.f; if (split_cols) { const int t = colt / split_cols; base += (size_t)t * split_stride; colt -= t * split_cols; if (t == 0) sc = scale0; }
        const int col0 = colt + wc * 32 + 8 * fq, bcol0 = u.pn * BM + wc * 32 + 8 * fq;
        f32x4 bv[2][2];
#pragma unroll
        for (int bj = 0; bj < 2; ++bj)
#pragma unroll
            for (int n = 0; n < 2; ++n) bv[bj][n] = bias ? *(const f32x4*)(bias + bcol0 + bj * HALF + 4 * n) : (f32x4){0.f, 0.f, 0.f, 0.f};
#pragma unroll
        for (int ai = 0; ai < 2; ++ai)
#pragma unroll
            for (int m = 0; m < 4; ++m) { bf16_t* rowp = base + (size_t)(row0 + ai * HALF + m * 16) * ldc + col0;
#pragma unroll
                for (int bj = 0; bj < 2; ++bj) { f32x4 v0 = acc[ai][bj][m][0] + bv[bj][0], v1 = acc[ai][bj][m][1] + bv[bj][1];
                    if (ACT == 1) { f32x2 a = gelu_pk((f32x2){v0[0], v0[1]}), b = gelu_pk((f32x2){v0[2], v0[3]}), c = gelu_pk((f32x2){v1[0], v1[1]}), d = gelu_pk((f32x2){v1[2], v1[3]});
                        v0 = (f32x4){a.x, a.y, b.x, b.y}; v1 = (f32x4){c.x, c.y, d.x, d.y}; }
                    v0 = v0 * sc; v1 = v1 * sc; u32x4 w; w.x = cvt_pk_bf16(v0[0], v0[1]); w.y = cvt_pk_bf16(v0[2], v0[3]); w.z = cvt_pk_bf16(v1[0], v1[1]); w.w = cvt_pk_bf16(v1[2], v1[3]);
                    *(u32x4*)(rowp + bj * HALF) = w; } }
    }
};

template <class Epi, class Sched, bool ALIGN_EPI = false, bool SP2 = false, bool MID = false>
__device__ __forceinline__ void gemm_phase(PG8_LAS unsigned char* lds, const Gemm g, const Sched& S, const Epi& E) {
    const int tid = threadIdx.x, wid = __builtin_amdgcn_readfirstlane(tid >> 6), lane = tid & 63, wr = wid >> 2, wc = wid & 3, fr = lane & 15, fq = lane >> 4;
    const int K = g.K, nt = K / BK;
    unsigned voffA[2], voffB[2];
#pragma unroll
    for (int i = 0; i < 2; ++i) { int R, C; stage_rc(tid * 16 + i * 8192, R, C); const int Rb = Epi::PERM ? ((R & ~31) + perm32(R & 31)) : R;
        voffA[i] = (unsigned)(R * K + C) * 2u; voffB[i] = (unsigned)(Rb * K + C) * 2u; }
    const size_t kstep = (size_t)(BK * 2);
    const size_t hstep = (size_t)HALF * K * 2;
    const size_t tstep = 2 * hstep;
    const unsigned ldsw = (unsigned)wid * 1024u;
    const int aoff = lds_byte(wr * 64 + fr, fq * 8), boff = lds_byte(wc * 32 + fr, fq * 8);
#define PG8_SA(b, h) (((b) * 2 + (h)) * HTB)
#define PG8_SB(b, h) ((4 + (b) * 2 + (h)) * HTB)
#define PG8_STAGE(bufoff, gbase, voff) do { _Pragma("unroll") for (int _i = 0; _i < 2; ++_i) \
        __builtin_amdgcn_global_load_lds((const unsigned*)((const char*)(gbase) + (voff)[_i]), (PG8_LAS unsigned*)(lds + (bufoff) + ldsw + _i * 8192), 16, 0, 0); } while (0)
#define PG8_LDA(dst, b, h) do { _Pragma("unroll") for (int m = 0; m < 4; ++m) _Pragma("unroll") for (int k = 0; k < 2; ++k) dst[m][k] = *(const PG8_LAS bf16x8*)(lds + PG8_SA(b, h) + aoff + m * 2048 + k * 1024); } while (0)
#define PG8_LDB(dst, b, h) do { _Pragma("unroll") for (int n = 0; n < 2; ++n) _Pragma("unroll") for (int k = 0; k < 2; ++k) dst[n][k] = *(const PG8_LAS bf16x8*)(lds + PG8_SB(b, h) + boff + n * 2048 + k * 1024); } while (0)
#define PG8_MMA(ai, bj, At, Bt) do { __builtin_amdgcn_s_setprio(1); _Pragma("unroll") for (int m = 0; m < 4; ++m) _Pragma("unroll") for (int n = 0; n < 2; ++n) _Pragma("unroll") for (int k = 0; k < 2; ++k) \
        acc[ai][bj][m][n] = __builtin_amdgcn_mfma_f32_16x16x32_bf16(Bt[n][k], At[m][k], acc[ai][bj][m][n], 0, 0, 0); __builtin_amdgcn_s_setprio(0); } while (0)
#define PG8_WAIT_V(n) asm volatile("s_waitcnt vmcnt(" #n ")" ::: "memory")
#define PG8_WAIT_L(n) asm volatile("s_waitcnt lgkmcnt(" #n ")" ::: "memory")
#define PG8_BAR __builtin_amdgcn_s_barrier()
#define PG8_SCHED __builtin_amdgcn_sched_barrier(0)
    Unit cur, nxt; int ui = 0;
    if (!S.next(0, cur)) return;
    f32x4 acc[2][2][4][2];
#pragma unroll
    for (int a = 0; a < 2; ++a)
#pragma unroll
        for (int b = 0; b < 2; ++b)
#pragma unroll
            for (int m = 0; m < 4; ++m)
#pragma unroll
                for (int n = 0; n < 2; ++n) acc[a][b][m][n] = (f32x4){0.f, 0.f, 0.f, 0.f};
    bf16x8 At[4][2], B0[2][2], B1[2][2];
    const char* cA = (const char*)g.A + (size_t)cur.pm * tstep; const char* cB = (const char*)g.Bt + (size_t)cur.pn * tstep;
    S.a_ready(cur);
    if constexpr (SP2) {
        PG8_STAGE(PG8_SB(0, 0), cB, voffB); PG8_STAGE(PG8_SB(0, 1), cB + hstep, voffB); PG8_STAGE(PG8_SA(0, 0), cA, voffA); PG8_STAGE(PG8_SA(0, 1), cA + hstep, voffA);
        if (wr == 1) PG8_BAR;
        PG8_WAIT_V(2); PG8_BAR;
        PG8_STAGE(PG8_SB(1, 0), cB + kstep, voffB); PG8_STAGE(PG8_SA(1, 0), cA + kstep, voffA); PG8_STAGE(PG8_SB(1, 1), cB + hstep + kstep, voffB);
        PG8_WAIT_V(6); PG8_BAR;
    } else {
        PG8_STAGE(PG8_SB(0, 0), cB, voffB); PG8_STAGE(PG8_SA(0, 0), cA, voffA); PG8_STAGE(PG8_SB(0, 1), cB + hstep, voffB); PG8_STAGE(PG8_SA(0, 1), cA + hstep, voffA);
        if (wr == 1) PG8_BAR;
        PG8_WAIT_V(4); PG8_BAR;
        PG8_STAGE(PG8_SB(1, 0), cB + kstep, voffB); PG8_STAGE(PG8_SA(1, 0), cA + kstep, voffA); PG8_STAGE(PG8_SB(1, 1), cB + hstep + kstep, voffB);
        PG8_WAIT_V(6); PG8_BAR;
    }
    for (;;) {
        const bool has_next = S.next(ui + 1, nxt);
        const char* nA = has_next ? (const char*)g.A + (size_t)nxt.pm * tstep : cA; const char* nB = has_next ? (const char*)g.Bt + (size_t)nxt.pn * tstep : cB;
        for (int t = 0; t < nt; t += 2) {
            const bool last = (t == nt - 2);
            if constexpr (MID) { if (t == Epi::MID_T) { PG8_SCHED; E.mid(acc, cur, wr, wc, fr, fq); PG8_SCHED; } }
            const char* a1 = cA + (size_t)(t + 1) * kstep;
            const char* a2 = last ? nA : cA + (size_t)(t + 2) * kstep; const char* b2 = last ? nB : cB + (size_t)(t + 2) * kstep;
            const char* a3 = a2 + kstep; const char* b3 = b2 + kstep;
            if (last && has_next) S.a_ready(nxt);
            if constexpr (SP2) {
            PG8_LDB(B0, 0, 0); PG8_LDB(B1, 0, 1); PG8_SCHED; PG8_LDA(At, 0, 0); PG8_STAGE(PG8_SA(1, 1), a1 + hstep, voffA);
            PG8_WAIT_V(8); PG8_WAIT_L(0); PG8_BAR; PG8_MMA(0, 0, At, B0); PG8_MMA(0, 1, At, B1); PG8_BAR; PG8_SCHED;
            PG8_LDA(At, 0, 1); PG8_STAGE(PG8_SB(0, 0), b2, voffB); PG8_STAGE(PG8_SB(0, 1), b2 + hstep, voffB); PG8_STAGE(PG8_SA(0, 0), a2, voffA);
            PG8_WAIT_V(8); PG8_WAIT_L(0); PG8_BAR; PG8_MMA(1, 0, At, B0); PG8_MMA(1, 1, At, B1); PG8_BAR; PG8_SCHED;
            PG8_LDB(B0, 1, 0); PG8_LDB(B1, 1, 1); PG8_SCHED; PG8_LDA(At, 1, 0); PG8_STAGE(PG8_SA(0, 1), a2 + hstep, voffA);
            PG8_WAIT_V(8); PG8_WAIT_L(0); PG8_BAR; PG8_MMA(0, 0, At, B0); PG8_MMA(0, 1, At, B1); PG8_BAR; PG8_SCHED;
            PG8_LDA(At, 1, 1); PG8_STAGE(PG8_SB(1, 0), b3, voffB); PG8_STAGE(PG8_SB(1, 1), b3 + hstep, voffB); PG8_STAGE(PG8_SA(1, 0), a3, voffA);
            PG8_WAIT_V(8); PG8_WAIT_L(0); PG8_BAR; PG8_MMA(1, 0, At, B0); PG8_MMA(1, 1, At, B1); PG8_BAR; PG8_SCHED;
            } else {
            PG8_LDB(B0, 0, 0); PG8_SCHED; PG8_LDA(At, 0, 0); PG8_STAGE(PG8_SA(1, 1), a1 + hstep, voffA);
            PG8_WAIT_L(8); PG8_BAR; PG8_WAIT_L(0); PG8_MMA(0, 0, At, B0); PG8_BAR; PG8_SCHED;
            PG8_LDB(B1, 0, 1); PG8_STAGE(PG8_SB(0, 0), b2, voffB);
            PG8_BAR; PG8_WAIT_L(0); PG8_MMA(0, 1, At, B1); PG8_BAR;
            PG8_LDA(At, 0, 1); PG8_STAGE(PG8_SA(0, 0), a2, voffA);
            PG8_BAR; PG8_WAIT_L(0); PG8_MMA(1, 0, At, B0); PG8_BAR; PG8_SCHED;
            PG8_STAGE(PG8_SB(0, 1), b2 + hstep, voffB);
            PG8_WAIT_V(6); PG8_BAR; PG8_MMA(1, 1, At, B1); PG8_BAR;
            PG8_LDB(B0, 1, 0); PG8_SCHED; PG8_LDA(At, 1, 0); PG8_STAGE(PG8_SA(0, 1), a2 + hstep, voffA);
            PG8_WAIT_L(8); PG8_BAR; PG8_WAIT_L(0); PG8_MMA(0, 0, At, B0); PG8_BAR; PG8_SCHED;
            PG8_LDB(B1, 1, 1); PG8_STAGE(PG8_SB(1, 0), b3, voffB);
            PG8_BAR; PG8_WAIT_L(0); PG8_MMA(0, 1, At, B1); PG8_BAR;
            PG8_LDA(At, 1, 1); PG8_STAGE(PG8_SA(1, 0), a3, voffA);
            PG8_BAR; PG8_WAIT_L(0); PG8_MMA(1, 0, At, B0); PG8_BAR; PG8_SCHED;
            PG8_STAGE(PG8_SB(1, 1), b3 + hstep, voffB);
            PG8_WAIT_V(6); PG8_BAR; PG8_MMA(1, 1, At, B1); PG8_BAR;
            }
        }
        if constexpr (ALIGN_EPI) { if (wr == 0) PG8_BAR; }
        if constexpr (!Epi::AFTER_DRAIN) { E(acc, cur, wr, wc, fr, fq); S.done(cur); }
        if (!has_next) break;
#pragma unroll
        for (int a = 0; a < 2; ++a)
#pragma unroll
            for (int b = 0; b < 2; ++b)
#pragma unroll
                for (int m = 0; m < 4; ++m)
#pragma unroll
                    for (int n = 0; n < 2; ++n) acc[a][b][m][n] = (f32x4){0.f, 0.f, 0.f, 0.f};
        cur = nxt; cA = nA; cB = nB; ++ui;
        if constexpr (ALIGN_EPI) { if (wr == 1) PG8_BAR; }
    }
    PG8_WAIT_V(0);
    if constexpr (!ALIGN_EPI) { if (wr == 0) PG8_BAR; }
    PG8_BAR;
    if constexpr (Epi::AFTER_DRAIN) { E.fused(acc, cur, wr, wc, fr, fq, lds, wid, lane); S.done(cur); }
#undef PG8_SA
#undef PG8_SB
#undef PG8_STAGE
#undef PG8_LDA
#undef PG8_LDB
#undef PG8_MMA
#undef PG8_WAIT_V
#undef PG8_WAIT_L
#undef PG8_BAR
#undef PG8_SCHED
}
}
namespace swa {
constexpr int D = 128;
constexpr float THR = 8.f;
constexpr bool WSKIP = false;
constexpr float SCALE = 0.08838834764831845f;
constexpr int NW = 8, QBLK = 32, KVBLK = 64, QB = NW * QBLK;
constexpr int SHM_V = KVBLK * D * 2, SHM_K = KVBLK * D * 2;
constexpr int MSLOT_OFF = 2 * SHM_V + 2 * SHM_K + NW * 64 * 4, QLDS_OFF = MSLOT_OFF + 4096;
constexpr int LDS_BYTES = QLDS_OFF + NW * 8192;

using bf16 = __hip_bfloat16;
typedef short bf16x8 __attribute__((ext_vector_type(8)));
typedef short s16x4 __attribute__((ext_vector_type(4)));
typedef float f32x16 __attribute__((ext_vector_type(16)));
typedef float f32x4 __attribute__((ext_vector_type(4)));
typedef unsigned u32x4 __attribute__((ext_vector_type(4)));
template <class A, class Bt> struct same_t { static constexpr bool v = false; };
template <class A> struct same_t<A, A> { static constexpr bool v = true; };

#define KSWZ(row, colB) ((row) * 256 + ((colB) ^ (((row) & 7) << 4)))
#define SBAR() __builtin_amdgcn_sched_barrier(0)
__device__ __forceinline__ int v_st(int k, int c) { const int kk = (k & ~0xC) | ((k & 4) << 1) | ((k & 8) >> 1); return ((kk >> 3) * 4 + (c >> 5)) * 512 + ((kk & 7) * 32 + (c & 31)) * 2; }
__device__ __forceinline__ int v_rd_base(int lane) { return ((lane & 3) << 3) | (((lane >> 2) & 3) << 6) | (((lane >> 4) & 1) << 5) | (((lane >> 5) & 1) << 8); }
constexpr int v_rd_off(int d0, int ks, int half) { return d0 * 512 + ks * 4096 + half * 2048; }
__device__ __forceinline__ int crow(int r, int hi) { return (r & 3) + 8 * (r >> 2) + 4 * hi; }
typedef float f32x2_c __attribute__((ext_vector_type(2))); typedef __bf16 bf16x2_c __attribute__((ext_vector_type(2)));
__device__ __forceinline__ unsigned cvtpk(float lo, float hi) { f32x2_c v = {lo, hi}; bf16x2_c b = __builtin_convertvector(v, bf16x2_c); return __builtin_bit_cast(unsigned, b); }
__device__ __forceinline__ bf16x8 pack8(f32x4 a, f32x4 b) {
    u32x4 w = {cvtpk(a[0], a[1]), cvtpk(a[2], a[3]), cvtpk(b[0], b[1]), cvtpk(b[2], b[3])};
    return *reinterpret_cast<bf16x8*>(&w);
}
template <class T> __device__ __forceinline__ bf16x8 load8(const T* p) {
    if constexpr (same_t<T, float>::v) { return pack8(*(const f32x4*)p, *(const f32x4*)(p + 4)); }
    else { return *reinterpret_cast<const bf16x8*>(p); }
}
__device__ __forceinline__ void mask_tile(f32x16& p0, f32x16& p1, int dq, unsigned W) {
    const float NEG = -__builtin_inff();
#pragma unroll
    for (int r = 0; r < 16; ++r) {
        const int c = (r & 3) + 8 * (r >> 2);
        if ((unsigned)(dq - c) >= W) p0[r] = NEG;
        if ((unsigned)(dq - c - 32) >= W) p1[r] = NEG;
    }
}
__device__ __forceinline__ void partialSM(f32x16& p0, f32x16& p1, float& m_reg, float& mn, float& alpha) {
    float pmax = p0[0]; for (int r = 1; r < 16; ++r) pmax = fmaxf(pmax, p0[r]); for (int r = 0; r < 16; ++r) pmax = fmaxf(pmax, p1[r]);
    { auto rr = __builtin_amdgcn_permlane32_swap(__float_as_uint(pmax), __float_as_uint(pmax), false, false);
      pmax = fmaxf(__uint_as_float(rr[0]), __uint_as_float(rr[1])); }
    constexpr float C2 = 1.4426950408889634f * SCALE;
    if (__builtin_expect(__all((pmax - m_reg) * SCALE <= THR), 1)) { mn = m_reg; alpha = 1.f; }
    else { mn = fmaxf(m_reg, pmax); alpha = __builtin_amdgcn_exp2f((m_reg - mn) * C2); m_reg = mn; }
    const float mnL = -mn * C2;
    for (int r = 0; r < 16; ++r) p0[r] = fmaf(p0[r], C2, mnL); for (int r = 0; r < 16; ++r) p1[r] = fmaf(p1[r], C2, mnL);
    for (int r = 0; r < 16; ++r) p0[r] = __builtin_amdgcn_exp2f(p0[r]);
}
__device__ __forceinline__ void finishSM(f32x16& p0, f32x16& p1, float alpha, float& l_reg, bf16x8& pa0, bf16x8& pa1, bf16x8& pa2, bf16x8& pa3) {
    for (int r = 0; r < 16; ++r) p1[r] = __builtin_amdgcn_exp2f(p1[r]);
    float ps = 0; for (int r = 0; r < 16; ++r) ps += p0[r]; for (int r = 0; r < 16; ++r) ps += p1[r];
    { auto rr = __builtin_amdgcn_permlane32_swap(__float_as_uint(ps), __float_as_uint(ps), false, false);
      ps = __uint_as_float(rr[0]) + __uint_as_float(rr[1]); }
    l_reg = l_reg * alpha + ps;
#define PK4(P, B_, OUT) do { unsigned a0 = cvtpk(P[B_+0], P[B_+1]), a1 = cvtpk(P[B_+2], P[B_+3]);                          \
        unsigned b0 = cvtpk(P[B_+4], P[B_+5]), b1 = cvtpk(P[B_+6], P[B_+7]);                                             \
        auto r0 = __builtin_amdgcn_permlane32_swap(a0, b0, false, false); auto r1 = __builtin_amdgcn_permlane32_swap(a1, b1, false, false); \
        u32x4 w = {r0[0], r1[0], r0[1], r1[1]}; OUT = *reinterpret_cast<bf16x8*>(&w); } while (0)
    PK4(p0, 0, pa0); PK4(p0, 8, pa1); PK4(p1, 0, pa2); PK4(p1, 8, pa3);
#undef PK4
}
template <int KB, bool SK>
__device__ __forceinline__ void qkt(f32x16& p0, f32x16& p1, const char* K_lds, int r32, int hi, const bf16x8* qr, bool act) {
    if (SK && !act) { const float NEG = -__builtin_inff();
#pragma unroll
        for (int r = 0; r < 16; ++r) { p0[r] = NEG; p1[r] = NEG; } return; }
    p0 = f32x16{}; p1 = f32x16{};
    const char* kb[4];
#pragma unroll
    for (int dd = 0; dd < 4; ++dd) kb[dd] = K_lds + KB * SHM_K + KSWZ(r32, (dd * 16 + hi * 8) * 2);
#pragma unroll
    for (int d0 = 0; d0 < 8; ++d0) { const char* a = kb[d0 & 3] + (d0 >> 2) * 128;
        bf16x8 b0 = *reinterpret_cast<const bf16x8*>(a);
        bf16x8 b1 = *reinterpret_cast<const bf16x8*>(a + 32 * 256);
        const bf16x8 qf = qr[d0];
        p0 = __builtin_amdgcn_mfma_f32_32x32x16_bf16(b0, qf, p0, 0, 0, 0);
        p1 = __builtin_amdgcn_mfma_f32_32x32x16_bf16(b1, qf, p1, 0, 0, 0); }
}
template <int VB, bool SK>
__device__ __forceinline__ void pv_tile(f32x16* o, int vb0, bf16x8 pa0, bf16x8 pa1, bf16x8 pa2, bf16x8 pa3, bool act) {
    if (SK && !act) return;
#define TRRD(dst, off) asm volatile("ds_read_b64_tr_b16 %0, %1 offset:%2" : "=&v"(dst) : "v"(vb0), "i"(off) : "memory")
#define PV_D0(d0) do { s16x4 l0, l1, l2, l3, h0, h1, h2, h3; constexpr int b_ = VB * SHM_V + v_rd_off(d0, 0, 0);     \
        TRRD(l0, b_); TRRD(h0, b_ + 2048); TRRD(l1, b_ + 4096); TRRD(h1, b_ + 6144); TRRD(l2, b_ + 8192); TRRD(h2, b_ + 10240); TRRD(l3, b_ + 12288); TRRD(h3, b_ + 14336); \
        asm volatile("s_waitcnt lgkmcnt(0)" ::: "memory"); SBAR();                 \
        o[d0] = __builtin_amdgcn_mfma_f32_32x32x16_bf16(pa0, (bf16x8){l0[0], l0[1], l0[2], l0[3], h0[0], h0[1], h0[2], h0[3]}, o[d0], 0, 0, 0);   \
        o[d0] = __builtin_amdgcn_mfma_f32_32x32x16_bf16(pa1, (bf16x8){l1[0], l1[1], l1[2], l1[3], h1[0], h1[1], h1[2], h1[3]}, o[d0], 0, 0, 0);   \
        o[d0] = __builtin_amdgcn_mfma_f32_32x32x16_bf16(pa2, (bf16x8){l2[0], l2[1], l2[2], l2[3], h2[0], h2[1], h2[2], h2[3]}, o[d0], 0, 0, 0);   \
        o[d0] = __builtin_amdgcn_mfma_f32_32x32x16_bf16(pa3, (bf16x8){l3[0], l3[1], l3[2], l3[3], h3[0], h3[1], h3[2], h3[3]}, o[d0], 0, 0, 0); } while (0)
    PV_D0(0); PV_D0(1); PV_D0(2); PV_D0(3);
#undef PV_D0
#undef TRRD
}

template <class TIn, class TOut> struct BlockRef { const TIn* Q; const TIn* K; const TIn* V; TOut* O; int P0; int ldo; const int* rows; const int* dst; float* stat; };
template <class TIn> struct Seam {
    bf16x8 qr[8];
    bf16x8 st_v0, st_v1, st_k0, st_k1; f32x4 sf0, sf1, sf2, sf3;
    f32x4 tq[16];
};
__device__ __forceinline__ int swa_jlo(int P0, int W) { const int lowk = P0 - W + 1; return lowk > 0 ? lowk / KVBLK : 0; }
#define ROW(p, k0, rr) ((p) + (unsigned)(((k0) + (rr)) * D + sc))
#define VMW() asm volatile("s_waitcnt vmcnt(0)" ::: "memory")
#define VMWN(n) asm volatile("s_waitcnt vmcnt(%0)" :: "i"(n) : "memory")
#define SLOAD_H(Kp, Vp, k0) do { S.st_v0 = load8<TIn>(ROW(Vp, k0, sr)); S.st_v1 = load8<TIn>(ROW(Vp, k0, 32 + sr));              \
                         S.st_k0 = load8<TIn>(ROW(Kp, k0, sr)); S.st_k1 = load8<TIn>(ROW(Kp, k0, 32 + sr)); } while (0)
#define SWRITE_HK(bf) do { *(bf16x8*)(K_lds + (bf) * SHM_K + kws) = S.st_k0; *(bf16x8*)(K_lds + (bf) * SHM_K + kws + 32 * 256) = S.st_k1; } while (0)
#define SWRITE_HV(bf) do { *(bf16x8*)(V_lds + (bf) * SHM_V + vst0) = S.st_v0; *(bf16x8*)(V_lds + (bf) * SHM_V + vst1) = S.st_v1; } while (0)
#define SWRITE_H(bf) do { SWRITE_HV(bf); SWRITE_HK(bf); } while (0)
#define SLOAD_F(p, k0) do { S.sf0 = *(const f32x4*)ROW(p, k0, sr); S.sf1 = *(const f32x4*)(ROW(p, k0, sr) + 4);                \
                            S.sf2 = *(const f32x4*)ROW(p, k0, 32 + sr); S.sf3 = *(const f32x4*)(ROW(p, k0, 32 + sr) + 4); } while (0)
#define SWRITE_KF(bf) do { *(bf16x8*)(K_lds + (bf) * SHM_K + kws) = pack8(S.sf0, S.sf1); *(bf16x8*)(K_lds + (bf) * SHM_K + kws + 32 * 256) = pack8(S.sf2, S.sf3); } while (0)
#define SWRITE_VF(bf) do { *(bf16x8*)(V_lds + (bf) * SHM_V + vst0) = pack8(S.sf0, S.sf1); *(bf16x8*)(V_lds + (bf) * SHM_V + vst1) = pack8(S.sf2, S.sf3); } while (0)
template <class TIn, class TOut>
__device__ __forceinline__ void causal_swa_prime(const BlockRef<TIn, TOut>& cur, int W, char* lds, Seam<TIn>& S) {
    constexpr bool F32 = same_t<TIn, float>::v;
    const int tid = threadIdx.x, wid = __builtin_amdgcn_readfirstlane(tid >> 6), lane = tid & 63, r32 = lane & 31, hi = lane >> 5;
    const int sr = tid >> 4, sc = (tid & 15) * 8, kws = KSWZ(sr, sc * 2); char* K_lds = lds + 2 * SHM_V;
    const int kb0 = swa_jlo(cur.P0, W) * KVBLK;
    for (int d0 = 0; d0 < 8; ++d0) S.qr[d0] = load8<TIn>(cur.Q + (size_t)(wid * QBLK + r32) * D + d0 * 16 + hi * 8);
    if constexpr (F32) { SLOAD_F((const float*)cur.K, kb0); VMW(); SWRITE_KF(0); SBAR(); SLOAD_F((const float*)cur.V, kb0); }
    else { SLOAD_H(cur.K, cur.V, kb0); VMW(); SWRITE_HK(0); }
    __syncthreads();
}
template <class TIn, class TOut>
__device__ __forceinline__ void causal_swa_block(const BlockRef<TIn, TOut>& cur, const BlockRef<TIn, TOut>& nxt, int skv, int W, char* lds, Seam<TIn>& S) {
    constexpr bool F32 = same_t<TIn, float>::v;
    const int tid = threadIdx.x, wid = __builtin_amdgcn_readfirstlane(tid >> 6), lane = tid & 63, r32 = lane & 31, hi = lane >> 5;
    const int j_lo = swa_jlo(cur.P0, W);
    int j_hi = (cur.P0 + QB - 1) / KVBLK + 1; if (j_hi > skv / KVBLK) j_hi = skv / KVBLK;
    const int NT = j_hi - j_lo;
    const int kbn = swa_jlo(nxt.P0, W) * KVBLK;
    const int qlo = cur.P0 + wid * QBLK, qm = qlo + r32 - 4 * hi;
    char* V_lds = lds; char* K_lds = lds + 2 * SHM_V;
    float* ws = (float*)(lds + 2 * SHM_V + 2 * SHM_K) + wid * 64; float* li_l = ws, * al_l = ws + 32;
    float m_reg = -1e30f, l_reg = 0; f32x16 o[4] = {};
    const int sr = tid >> 4, sc = (tid & 15) * 8, vst0 = v_st(sr, sc), vst1 = v_st(32 + sr, sc), kws = KSWZ(sr, sc * 2);
    const int vb0 = (int)(uintptr_t)V_lds + v_rd_base(lane);
    const TIn* Kh = cur.K; const TIn* Vh = cur.V;
#define RESC(a) do { if (__any((a) < 1.f)) { if (hi == 0) al_l[r32] = (a); asm volatile("s_waitcnt lgkmcnt(0)" ::: "memory");              \
                     for (int d_ = 0; d_ < 4; ++d_) for (int r = 0; r < 16; ++r) o[d_][r] *= al_l[crow(r, hi)]; } } while (0)
#define KBASE(t) ((j_lo + (t)) * KVBLK)
#define ACT(t) (KBASE(t) <= qlo + QBLK - 1 && KBASE(t) + KVBLK - 1 >= qlo - W + 1)
#define MASKT(P0_, P1_, t) do { const int kb_ = KBASE(t); if ((!SK || ACT(t)) && (kb_ + KVBLK - 1 > qlo || kb_ <= qlo + QBLK - 1 - W)) mask_tile(P0_, P1_, qm - kb_, (unsigned)W); } while (0)
    constexpr int NQL = F32 ? 16 : 8;
    constexpr bool SK = WSKIP && !F32;
#define SEAM_K0() do { VMWN(NQL); if constexpr (F32) { SWRITE_KF(0); SBAR(); SLOAD_F((const float*)nxt.V, kbn); } else { SWRITE_HK(0); } SBAR(); } while (0)
    f32x16 pA0, pA1, pB0, pB1; float mnA, mnB, alA, alB; bf16x8 pa0, pa1, pa2, pa3;
    if constexpr (F32) { VMW(); SWRITE_VF(0); SBAR(); } else { SWRITE_HV(0); SBAR(); }
    if (NT > 1) { if constexpr (F32) SLOAD_F((const float*)Kh, KBASE(1)); else SLOAD_H(Kh, Vh, KBASE(1)); }
    SBAR(); qkt<0, SK>(pA0, pA1, K_lds, r32, hi, S.qr, ACT(0));
    if constexpr (F32) { if (NT > 1) { VMW(); SWRITE_KF(1); SBAR(); SLOAD_F((const float*)Vh, KBASE(1)); } }
    MASKT(pA0, pA1, 0); partialSM(pA0, pA1, m_reg, mnA, alA);
    if (NT > 1) { VMW(); if constexpr (F32) { SWRITE_VF(1); SBAR(); if (NT > 2) SLOAD_F((const float*)Kh, KBASE(2)); } else SWRITE_H(1); }
    __syncthreads();
#define HALF_STEP(PX0, PX1, mnX, alX, PY0, PY1, alY, t, KB, VB, SB) do {                                                      \
        SBAR(); qkt<KB, SK>(PX0, PX1, K_lds, r32, hi, S.qr, ACT(t));                                             \
        finishSM(PY0, PY1, alY, l_reg, pa0, pa1, pa2, pa3); SBAR();                                                           \
        if ((t) + 1 < NT) { if constexpr (F32) { VMW(); SWRITE_KF(SB); SBAR(); SLOAD_F((const float*)Vh, KBASE((t) + 1)); }  \
                            else { SLOAD_H(Kh, Vh, KBASE((t) + 1)); } SBAR(); }                                               \
        pv_tile<VB, SK>(o, vb0, pa0, pa1, pa2, pa3, ACT((t) - 1)); MASKT(PX0, PX1, (t)); partialSM(PX0, PX1, m_reg, mnX, alX);                                        \
        __syncthreads();                                                                                                      \
        if ((t) + 1 < NT) { VMW(); if constexpr (F32) { SWRITE_VF(SB); SBAR(); if ((t) + 2 < NT) SLOAD_F((const float*)Kh, KBASE((t) + 2)); } \
                            else { SWRITE_H(SB); } }                                                                          \
        RESC(alX); __syncthreads(); } while (0)
    for (int t = 1; t + 1 < NT; t += 2) {
        HALF_STEP(pB0, pB1, mnB, alB, pA0, pA1, alA, t, 1, 0, 0);
        HALF_STEP(pA0, pA1, mnA, alA, pB0, pB1, alB, t + 1, 0, 1, 1);
    }
    const bool even = (NT & 1) == 0;
    if (even) { SBAR(); qkt<1, SK>(pB0, pB1, K_lds, r32, hi, S.qr, ACT(NT - 1)); SBAR(); }
#define QROW(e) (nxt.Q + (size_t)(wid * QBLK + r32) * D + ((e) >> 1) * 16 + hi * 8 + ((e) & 1) * 4)
    if constexpr (F32) { SLOAD_F((const float*)nxt.K, kbn); SBAR();
#pragma unroll
        for (int e = 0; e < 8; ++e) S.tq[e] = *(const f32x4*)QROW(e); }
    else { const size_t qrown_ = (size_t)(wid * QBLK + r32);
        SLOAD_H(nxt.K, nxt.V, kbn); SBAR();
#pragma unroll
        for (int d0 = 0; d0 < 8; ++d0) S.qr[d0] = load8<TIn>(nxt.Q + qrown_ * D + d0 * 16 + hi * 8); }
    SBAR();
    finishSM(pA0, pA1, alA, l_reg, pa0, pa1, pa2, pa3); SBAR();
    if constexpr (F32) {
#pragma unroll
        for (int e = 8; e < 16; ++e) S.tq[e] = *(const f32x4*)QROW(e); SBAR(); }
#undef QROW
    pv_tile<0, SK>(o, vb0, pa0, pa1, pa2, pa3, ACT(even ? NT - 2 : NT - 1));
    if (even) { MASKT(pB0, pB1, NT - 1); partialSM(pB0, pB1, m_reg, mnB, alB); __syncthreads(); RESC(alB);
        finishSM(pB0, pB1, alB, l_reg, pa0, pa1, pa2, pa3); SBAR(); pv_tile<1, SK>(o, vb0, pa0, pa1, pa2, pa3, ACT(NT - 1)); }
    SBAR(); SEAM_K0();
    if (hi == 0) li_l[r32] = l_reg; asm volatile("s_waitcnt lgkmcnt(0)" ::: "memory");
    float rli[16];
#pragma unroll
    for (int r = 0; r < 16; ++r) rli[r] = __builtin_amdgcn_rcpf(li_l[crow(r, hi)]);
    {
    int ld_ = cur.ldo; asm volatile("" : "+s"(ld_));
    TOut* Ow = cur.O + (size_t)(wid * QBLK) * ld_;
#pragma unroll
    for (int r = 0; r < 16; ++r) { const unsigned ro = (unsigned)crow(r, hi) * (unsigned)ld_ + (unsigned)r32;
#pragma unroll
        for (int d0 = 0; d0 < 4; ++d0) { const float v = o[d0][r] * rli[r];
            if constexpr (same_t<TOut, float>::v) { Ow[ro + d0 * 32] = v; }
            else { const float vn = __shfl_xor(v, 1);
                   if ((r32 & 1) == 0) *(unsigned*)(Ow + ro + d0 * 32) = cvtpk(v, vn); } } }
    }
    if constexpr (F32) {
#pragma unroll
        for (int d0 = 0; d0 < 8; ++d0) S.qr[d0] = pack8(S.tq[2 * d0], S.tq[2 * d0 + 1]); }
    __syncthreads();
#undef RESC
#undef KBASE
#undef ACT
#undef MASKT
#undef SEAM_K0
#undef HALF_STEP
}
#undef ROW
#undef VMW
#undef VMWN
#undef SLOAD_H
#undef SWRITE_HK
#undef SWRITE_HV
#undef SWRITE_H
#undef SLOAD_F
#undef SWRITE_KF
#undef SWRITE_VF


template <int KB>
__device__ __forceinline__ void qkt_r(f32x16& p0, f32x16& p1, const char* K_lds, int r32, int hi, const bf16x8* qr) {
    p0 = f32x16{}; p1 = f32x16{};
    const char* kb[4];
#pragma unroll
    for (int dd = 0; dd < 4; ++dd) kb[dd] = K_lds + KB * SHM_K + KSWZ(r32, (dd * 16 + hi * 8) * 2);
#pragma unroll
    for (int d0 = 0; d0 < 8; ++d0) { const char* a = kb[d0 & 3] + (d0 >> 2) * 128;
        bf16x8 b0 = *reinterpret_cast<const bf16x8*>(a);
        bf16x8 b1 = *reinterpret_cast<const bf16x8*>(a + 32 * 256);
        p0 = __builtin_amdgcn_mfma_f32_32x32x16_bf16(b0, qr[d0], p0, 0, 0, 0);
        p1 = __builtin_amdgcn_mfma_f32_32x32x16_bf16(b1, qr[d0], p1, 0, 0, 0); }
}
constexpr int MOBA_LDS_BYTES = 4 * SHM_V + 4 * SHM_K + NW * 64 * 4;
struct MobaStage { bf16x8 qr[8]; bf16x8 k0[2], k1[2], v0[2], v1[2]; };
#define MOBA_LOAD_Q(B) do { const unsigned qoff_ = (unsigned)(B).rows[wid * QBLK + r32] * D + hi * 8;                                  \
        _Pragma("unroll") for (int d0 = 0; d0 < 8; ++d0) ST.qr[d0] = load8<bf16>((B).Q + qoff_ + d0 * 16); } while (0)
#define MOBA_LOAD_KV(B, T0) do { _Pragma("unroll") for (int t = 0; t < 2; ++t) { const unsigned eo_ = (unsigned)(((T0) + t) * KVBLK + sr) * D + sc; \
        ST.k0[t] = load8<bf16>((B).K + eo_); ST.k1[t] = load8<bf16>((B).K + eo_ + 32 * D); ST.v0[t] = load8<bf16>((B).V + eo_); ST.v1[t] = load8<bf16>((B).V + eo_ + 32 * D); } } while (0)
#define MOBA_WRITE_KV(T0) do { _Pragma("unroll") for (int t = 0; t < 2; ++t) { *(bf16x8*)(K_lds + ((T0) + t) * SHM_K + kws) = ST.k0[t]; *(bf16x8*)(K_lds + ((T0) + t) * SHM_K + kws + 32 * 256) = ST.k1[t]; \
        *(bf16x8*)(V_lds + ((T0) + t) * SHM_V + vst0) = ST.v0[t]; *(bf16x8*)(V_lds + ((T0) + t) * SHM_V + vst1) = ST.v1[t]; } } while (0)
__device__ __forceinline__ void moba_block(const BlockRef<bf16, bf16>& cur, const BlockRef<bf16, bf16>& nxt, bool has_next, char* lds, MobaStage& ST) {
    const int tid = threadIdx.x, wid = __builtin_amdgcn_readfirstlane(tid >> 6), lane = tid & 63, r32 = lane & 31, hi = lane >> 5;
    char* V_lds = lds; char* K_lds = lds + 4 * SHM_V;
    float* wsc = (float*)(lds + 4 * SHM_V + 4 * SHM_K) + wid * 64; float* li_l = wsc, * al_l = wsc + 32;
    const int sr = tid >> 4, sc = (tid & 15) * 8, vst0 = v_st(sr, sc), vst1 = v_st(32 + sr, sc), kws = KSWZ(sr, sc * 2);
    const int vb0 = (int)(uintptr_t)V_lds + v_rd_base(lane);
    __syncthreads();
    MOBA_WRITE_KV(0);
    __syncthreads();
    MOBA_LOAD_KV(cur, 2);
    SBAR();
    float m_reg = -1e30f, l_reg = 0; f32x16 o[4] = {};
    const bool causal = cur.P0 == 0; const int qlo = wid * QBLK, qm = qlo + r32 - 4 * hi;
    f32x16 p0, p1; float mn, al; bf16x8 pa0, pa1, pa2, pa3;
#define RESCM(a) do { if (__any((a) < 1.f)) { if (hi == 0) al_l[r32] = (a); asm volatile("s_waitcnt lgkmcnt(0)" ::: "memory");              \
                      for (int d_ = 0; d_ < 4; ++d_) for (int r = 0; r < 16; ++r) o[d_][r] *= al_l[crow(r, hi)]; } } while (0)
#define SKIPT(t) (causal && (t) * KVBLK > qlo + QBLK - 1)
#define MTA(t) do { if (!SKIPT(t)) { SBAR(); qkt_r<t>(p0, p1, K_lds, r32, hi, ST.qr); if (causal && (t) * KVBLK + KVBLK - 1 > qlo) mask_tile(p0, p1, qm - (t) * KVBLK, 1u << 30); } } while (0)
#define MTB(t) do { if (!SKIPT(t)) { partialSM(p0, p1, m_reg, mn, al); RESCM(al); finishSM(p0, p1, al, l_reg, pa0, pa1, pa2, pa3); SBAR(); pv_tile<t, false>(o, vb0, pa0, pa1, pa2, pa3, true); } } while (0)
    MTA(0); MTB(0); MTA(1); MTB(1);
    SBAR();
    MOBA_WRITE_KV(2);
    __syncthreads();
    if (has_next) MOBA_LOAD_KV(nxt, 0);
    SBAR();
    MTA(2); MTB(2); MTA(3);
    SBAR();
    if (has_next) MOBA_LOAD_Q(nxt);
    SBAR();
    MTB(3);
#undef MTA
#undef MTB
#undef SKIPT
#undef RESCM
    if (hi == 0) li_l[r32] = l_reg; asm volatile("s_waitcnt lgkmcnt(0)" ::: "memory");
    float rli[16];
#pragma unroll
    for (int r = 0; r < 16; ++r) rli[r] = __builtin_amdgcn_rcpf(li_l[crow(r, hi)]);
    { const int dme_ = cur.dst[wid * QBLK + r32]; if (hi == 0 && dme_ >= 0) { float2 st_; st_.x = m_reg; st_.y = l_reg; *(float2*)(cur.stat + 2 * (size_t)dme_) = st_; } }
#pragma unroll
    for (int r = 0; r < 16; ++r) { const int di_ = cur.dst[wid * QBLK + crow(r, hi)];
#pragma unroll
        for (int d0 = 0; d0 < 4; ++d0) { const float v = o[d0][r] * rli[r]; const float vn = __shfl_xor(v, 1);
            if ((r32 & 1) == 0 && di_ >= 0) *(unsigned*)(cur.O + (size_t)di_ * 128 + d0 * 32 + r32) = cvtpk(v, vn); } }
}
__device__ __forceinline__ void moba_prime(const BlockRef<bf16, bf16>& cur, MobaStage& ST) {
    const int tid = threadIdx.x, wid = __builtin_amdgcn_readfirstlane(tid >> 6), lane = tid & 63, r32 = lane & 31, hi = lane >> 5;
    const int sr = tid >> 4, sc = (tid & 15) * 8;
    MOBA_LOAD_Q(cur); MOBA_LOAD_KV(cur, 0);
}
#undef MOBA_LOAD_Q
#undef MOBA_LOAD_KV
#undef MOBA_WRITE_KV
}
#include <hip/hip_cooperative_groups.h>
namespace cg = cooperative_groups;

constexpr int NWAVES = 8;
#ifndef MK_ONE_LAUNCH
#define MK_ONE_LAUNCH 1
#endif
constexpr int BATCH = 2, SEQ = 16384, T = BATCH * SEQ, DM = 2048, INW = 10240, DFF = 8192, PLE = 256;
constexpr int NH8 = 8;
constexpr float NORM_EPS = 1e-6f;
constexpr float LAMBDA_INIT = 0.2f;
constexpr int NPHASE = 19;

constexpr size_t MiB = 1u << 20;
constexpr size_t WS_ROPE = 1 * MiB;
constexpr size_t WS_KMEAN = 3 * MiB;
constexpr size_t WS_CNT = 0, WS_NBLK = 8192, WS_TAB = 65536;
constexpr size_t WS_BAR = 131072, WS_BAR_BYTES = 16384;
constexpr size_t WS_SEL = 4 * MiB;
constexpr int LSTR = 65536 + SEQ;
constexpr size_t WS_ROWL = 986 * MiB, WS_DSTL = 992 * MiB;
constexpr size_t WS_STATS = 1000 * MiB;
constexpr size_t WS_TOP = 1008 * MiB;
constexpr size_t WS_WIN = 8 * MiB, WS_WA = 48 * MiB, WS_WB = 52 * MiB, WS_WOUT = 56 * MiB, WS_WUP = 64 * MiB, WS_WDN = 96 * MiB, WS_WPG = 128 * MiB, WS_WPP = 136 * MiB;
constexpr size_t WS_PB = 138 * MiB;
constexpr size_t WS_XN = 154 * MiB;
constexpr size_t WS_OB = 154 * MiB;
constexpr size_t WS_QKV = 282 * MiB;
constexpr size_t SEC_ELEMS = (size_t)T * 1024;
constexpr size_t WS_SG = 666 * MiB;
constexpr size_t WS_OA = 922 * MiB;
constexpr size_t WS_MIX = 282 * MiB;
constexpr size_t WS_HID = 282 * MiB;
constexpr size_t WS_G3 = 282 * MiB;
constexpr size_t WS_RS2 = 138 * MiB, WS_RS3 = 139 * MiB;
constexpr size_t WS_H2 = 554 * MiB;
constexpr size_t WS_XN3 = 410 * MiB;
constexpr size_t WS_Y = 794 * MiB;
constexpr size_t WS_END = 986 * MiB;
static_assert(WS_HID + (size_t)T * DFF * 2 <= WS_Y && WS_Y + (size_t)T * DM * 2 <= WS_OA && WS_OA + (size_t)T * 1024 * 2 == WS_END, "ws map");

constexpr int RING_BYTES = 131072, LDS_BYTES = 147456;

#define GAS __attribute__((address_space(1)))
#define LAS __attribute__((address_space(3)))
typedef unsigned short bf16;
typedef unsigned v4u __attribute__((ext_vector_type(4)));
typedef unsigned v2u __attribute__((ext_vector_type(2)));
typedef float f32x4 __attribute__((ext_vector_type(4)));
#define LDS_WAIT() asm volatile("s_waitcnt lgkmcnt(0)" ::: "memory")
__device__ __forceinline__ unsigned f2bf(float f) { unsigned u = __builtin_bit_cast(unsigned, f); return (u + 0x7fffu + ((u >> 16) & 1u)) >> 16; }
__device__ __forceinline__ unsigned pk2(float lo, float hi) { return f2bf(lo) | (f2bf(hi) << 16); }
__device__ __forceinline__ float bflo(unsigned w) { return __uint_as_float(w << 16); }
__device__ __forceinline__ float bfhi(unsigned w) { return __uint_as_float(w & 0xffff0000u); }
__device__ __forceinline__ float wave_sum(float v) {
#pragma unroll
    for (int o = 1; o < 64; o <<= 1) v += __shfl_xor(v, o);
    return v;
}
template <class Tv> __device__ __forceinline__ Tv ntload(const Tv* p) { return __builtin_nontemporal_load(p); }
template <class Tv> __device__ __forceinline__ void ntstore(Tv v, Tv* p) { __builtin_nontemporal_store(v, p); }
__device__ __forceinline__ float sigmoidf_(float x) { return __builtin_amdgcn_rcpf(1.0f + __expf(-x)); }

namespace pg8 {
template <int MODE> struct EpiT {
    static constexpr bool PERM = true, AFTER_DRAIN = false;
    bf16_t* O; int ldo; const bf16_t* G; int ldg;
    __device__ __forceinline__ void operator()(const f32x4 (&acc)[2][2][4][2], const Unit& u, int wr, int wc, int fr, int fq) const {
        const int row0 = u.pm * BM + wr * 64 + fr, col0 = u.pn * BM + wc * 32 + 8 * fq;
#pragma unroll
        for (int ai = 0; ai < 2; ++ai)
#pragma unroll
            for (int m = 0; m < 4; ++m) { const size_t r = (size_t)(row0 + ai * HALF + m * 16);
#pragma unroll
                for (int bj = 0; bj < 2; ++bj) { f32x4 v0 = acc[ai][bj][m][0], v1 = acc[ai][bj][m][1]; const int c = col0 + bj * HALF;
                    if (MODE == 1) {
#pragma unroll
                        for (int e = 0; e < 4; ++e) { float a = fmaxf(v0[e], 0.f), b = fmaxf(v1[e], 0.f); v0[e] = a * a; v1[e] = b * b; } }
                    if (MODE == 2) {
#pragma unroll
                        for (int e = 0; e < 4; ++e) { v0[e] = sigmoidf_(v0[e]); v1[e] = sigmoidf_(v1[e]); } }
                    if (MODE == 3 || MODE == 4) { const u32x4 g = *(const u32x4*)(G + r * ldg + c);
                        v0[0] *= bflo(g.x); v0[1] *= bfhi(g.x); v0[2] *= bflo(g.y); v0[3] *= bfhi(g.y); v1[0] *= bflo(g.z); v1[1] *= bfhi(g.z); v1[2] *= bflo(g.w); v1[3] *= bfhi(g.w); }
                    if (MODE == 4) { const u32x4 g = *(const u32x4*)(O + r * ldo + c);
                        v0[0] += bflo(g.x); v0[1] += bfhi(g.x); v0[2] += bflo(g.y); v0[3] += bfhi(g.y); v1[0] += bflo(g.z); v1[1] += bfhi(g.z); v1[2] += bflo(g.w); v1[3] += bfhi(g.w); }
                    u32x4 w; w.x = cvt_pk_bf16(v0[0], v0[1]); w.y = cvt_pk_bf16(v0[2], v0[3]); w.z = cvt_pk_bf16(v1[0], v1[1]); w.w = cvt_pk_bf16(v1[2], v1[3]);
                    *(u32x4*)(O + r * ldo + c) = w; } }
    }
};
struct EpiGate2 {
    static constexpr bool PERM = true, AFTER_DRAIN = false; static constexpr int MID_T = 16;
    bf16_t* O; const bf16_t* SGp;
    __device__ __forceinline__ void mid(f32x4 (&acc)[2][2][4][2], const Unit& u, int wr, int wc, int fr, int fq) const {
        int row0 = u.pm * BM + wr * 64 + fr; const int col0 = u.pn * BM + wc * 32 + 8 * fq;
        asm volatile("" : "+v"(row0));
        const bf16_t* gp = SGp + (size_t)row0 * 4096 + col0;
#pragma unroll
        for (int ai = 0; ai < 2; ++ai)
#pragma unroll
            for (int m = 0; m < 4; ++m) { const int ro = (ai * HALF + m * 16) * 4096;
#pragma unroll
                for (int bj = 0; bj < 2; ++bj) { const u32x4 a = *(const u32x4*)(gp + ro + bj * HALF), b = *(const u32x4*)(gp + ro + bj * HALF + 2048);
                    f32x4& v0 = acc[ai][bj][m][0]; f32x4& v1 = acc[ai][bj][m][1];
                    v0[0] *= bflo(a.x) * __builtin_amdgcn_rcpf(bflo(b.x)); v0[1] *= bfhi(a.x) * __builtin_amdgcn_rcpf(bfhi(b.x)); v0[2] *= bflo(a.y) * __builtin_amdgcn_rcpf(bflo(b.y)); v0[3] *= bfhi(a.y) * __builtin_amdgcn_rcpf(bfhi(b.y));
                    v1[0] *= bflo(a.z) * __builtin_amdgcn_rcpf(bflo(b.z)); v1[1] *= bfhi(a.z) * __builtin_amdgcn_rcpf(bfhi(b.z)); v1[2] *= bflo(a.w) * __builtin_amdgcn_rcpf(bflo(b.w)); v1[3] *= bfhi(a.w) * __builtin_amdgcn_rcpf(bfhi(b.w)); }
                if (m == 3) asm volatile("" ::: "memory"); }
    }
    __device__ __forceinline__ void operator()(const f32x4 (&acc)[2][2][4][2], const Unit& u, int wr, int wc, int fr, int fq) const {
        int row0 = u.pm * BM + wr * 64 + fr; const int col0 = u.pn * BM + wc * 32 + 8 * fq;
        asm volatile("" : "+v"(row0));
        const bf16_t* gp = SGp + (size_t)row0 * 4096 + 2048 + col0; bf16_t* op = O + (size_t)row0 * 2048 + col0;
#pragma unroll
        for (int ai = 0; ai < 2; ++ai)
#pragma unroll
            for (int m = 0; m < 4; ++m) { const int rr = ai * HALF + m * 16;
#pragma unroll
                for (int bj = 0; bj < 2; ++bj) { const u32x4 b = *(const u32x4*)(gp + rr * 4096 + bj * HALF); const f32x4 v0 = acc[ai][bj][m][0], v1 = acc[ai][bj][m][1];
                    u32x4 w; w.x = cvt_pk_bf16(v0[0] * bflo(b.x), v0[1] * bfhi(b.x)); w.y = cvt_pk_bf16(v0[2] * bflo(b.y), v0[3] * bfhi(b.y)); w.z = cvt_pk_bf16(v1[0] * bflo(b.z), v1[1] * bfhi(b.z)); w.w = cvt_pk_bf16(v1[2] * bflo(b.w), v1[3] * bfhi(b.w));
                    *(u32x4*)(op + rr * 2048 + bj * HALF) = w; } }
    }
};
struct EpiUp {
    static constexpr bool PERM = true, AFTER_DRAIN = false;
    bf16_t* O; int ldo; const float* rs;
    __device__ __forceinline__ void operator()(const f32x4 (&acc)[2][2][4][2], const Unit& u, int wr, int wc, int fr, int fq) const {
        const int row0 = u.pm * BM + wr * 64 + fr, col0 = u.pn * BM + wc * 32 + 8 * fq;
#pragma unroll
        for (int ai = 0; ai < 2; ++ai)
#pragma unroll
            for (int m = 0; m < 4; ++m) { const size_t r = (size_t)(row0 + ai * HALF + m * 16); const float sc = rs[r];
#pragma unroll
                for (int bj = 0; bj < 2; ++bj) { f32x4 v0 = acc[ai][bj][m][0] * sc, v1 = acc[ai][bj][m][1] * sc; const int c = col0 + bj * HALF;
#pragma unroll
                    for (int e = 0; e < 4; ++e) { const float a = fmaxf(v0[e], 0.f), b = fmaxf(v1[e], 0.f); v0[e] = a * a; v1[e] = b * b; }
                    u32x4 w; w.x = cvt_pk_bf16(v0[0], v0[1]); w.y = cvt_pk_bf16(v0[2], v0[3]); w.z = cvt_pk_bf16(v1[0], v1[1]); w.w = cvt_pk_bf16(v1[2], v1[3]);
                    *(u32x4*)(O + r * ldo + c) = w; } }
    }
};
struct EpiPle {
    static constexpr bool PERM = true, AFTER_DRAIN = false; static constexpr int MID_T = 32;
    bf16_t* O; bf16_t* Gp; const float* rs;
    __device__ __forceinline__ void mid(f32x4 (&acc)[2][2][4][2], const Unit& u, int wr, int wc, int fr, int fq) const {
        int row0 = u.pm * BM + wr * 64 + fr; const int col0 = u.pn * BM + wc * 32 + 8 * fq;
        asm volatile("" : "+v"(row0));
        bf16_t* gp = Gp + (size_t)row0 * 2048 + col0;
#pragma unroll
        for (int ai = 0; ai < 2; ++ai)
#pragma unroll
            for (int m = 0; m < 4; ++m) { const int rr = ai * HALF + m * 16; const float sc = rs[row0 + rr];
#pragma unroll
                for (int bj = 0; bj < 2; ++bj) { f32x4& v0 = acc[ai][bj][m][0]; f32x4& v1 = acc[ai][bj][m][1];
                    u32x4 w; w.x = cvt_pk_bf16(sigmoidf_(v0[0] * sc), sigmoidf_(v0[1] * sc)); w.y = cvt_pk_bf16(sigmoidf_(v0[2] * sc), sigmoidf_(v0[3] * sc)); w.z = cvt_pk_bf16(sigmoidf_(v1[0] * sc), sigmoidf_(v1[1] * sc)); w.w = cvt_pk_bf16(sigmoidf_(v1[2] * sc), sigmoidf_(v1[3] * sc));
                    *(u32x4*)(gp + rr * 2048 + bj * HALF) = w; v0 = (f32x4){0.f, 0.f, 0.f, 0.f}; v1 = (f32x4){0.f, 0.f, 0.f, 0.f}; } }
    }
    __device__ __forceinline__ void operator()(const f32x4 (&acc)[2][2][4][2], const Unit& u, int wr, int wc, int fr, int fq) const {
        int row0 = u.pm * BM + wr * 64 + fr; const int col0 = u.pn * BM + wc * 32 + 8 * fq;
        asm volatile("" : "+v"(row0));
        const bf16_t* gp = Gp + (size_t)row0 * 2048 + col0; bf16_t* op = O + (size_t)row0 * 2048 + col0;
#pragma unroll
        for (int ai = 0; ai < 2; ++ai)
#pragma unroll
            for (int m = 0; m < 4; ++m) { const int rr = ai * HALF + m * 16;
#pragma unroll
                for (int bj = 0; bj < 2; ++bj) { const u32x4 b = *(const u32x4*)(gp + rr * 2048 + bj * HALF); const f32x4 v0 = acc[ai][bj][m][0], v1 = acc[ai][bj][m][1];
                    u32x4 w; w.x = cvt_pk_bf16(v0[0] * bflo(b.x), v0[1] * bfhi(b.x)); w.y = cvt_pk_bf16(v0[2] * bflo(b.y), v0[3] * bfhi(b.y)); w.z = cvt_pk_bf16(v1[0] * bflo(b.z), v1[1] * bfhi(b.z)); w.w = cvt_pk_bf16(v1[2] * bflo(b.w), v1[3] * bfhi(b.w));
                    *(u32x4*)(op + rr * 2048 + bj * HALF) = w; } }
    }
};
struct EpiInProj {
    static constexpr bool PERM = false, AFTER_DRAIN = false;
    bf16_t* QKV; bf16_t* SG; const float* rope; float* km;
    __device__ __forceinline__ void operator()(const f32x4 (&acc)[2][2][4][2], const Unit& u, int wr, int wc, int fr, int fq) const {
        typedef unsigned u32x2 __attribute__((ext_vector_type(2)));
        const int pn = u.pn, row0 = u.pm * BM + wr * 64 + fr;
        if (pn < 24) {
            const int sec = pn >> 2; const bool rot = (sec != 2) && (sec != 5) && (wc == 0);
            const int b = (u.pm * BM) / SEQ;
            f32x4 ks[2][2] = {{(f32x4){0.f, 0.f, 0.f, 0.f}, (f32x4){0.f, 0.f, 0.f, 0.f}}, {(f32x4){0.f, 0.f, 0.f, 0.f}, (f32x4){0.f, 0.f, 0.f, 0.f}}};
#pragma unroll
            for (int ai = 0; ai < 2; ++ai)
#pragma unroll
                for (int m = 0; m < 4; ++m) { const int r = row0 + ai * HALF + m * 16, pos = r - b * SEQ;
                    f32x4 cs = (f32x4){1.f, 1.f, 1.f, 1.f}, sn = (f32x4){0.f, 0.f, 0.f, 0.f};
                    if (rot) { cs = *(const f32x4*)(rope + (size_t)pos * 32 + 4 * fq); sn = *(const f32x4*)(rope + (size_t)pos * 32 + 16 + 4 * fq); }
#pragma unroll
                    for (int bj = 0; bj < 2; ++bj) { const int h8 = (pn & 3) * 2 + bj; f32x4 v0 = acc[ai][bj][m][0], v1 = acc[ai][bj][m][1];
                        if (rot) { const f32x4 a = v0 * cs - v1 * sn, bb = v1 * cs + v0 * sn; v0 = a; v1 = bb; }
                        if (sec == 1) { ks[bj][0] += v0; ks[bj][1] += v1; }
                        bf16_t* dst = QKV + (size_t)sec * SEC_ELEMS + ((size_t)(b * NH8 + h8) * SEQ + pos) * 128 + wc * 32 + 4 * fq;
                        u32x2 w0, w1; w0.x = cvt_pk_bf16(v0[0], v0[1]); w0.y = cvt_pk_bf16(v0[2], v0[3]); w1.x = cvt_pk_bf16(v1[0], v1[1]); w1.y = cvt_pk_bf16(v1[2], v1[3]);
                        *(u32x2*)dst = w0; *(u32x2*)(dst + 16) = w1; } }
            if (sec == 1) {
                const int blk = u.pm - b * (SEQ / 256);
#pragma unroll
                for (int bj = 0; bj < 2; ++bj)
#pragma unroll
                    for (int n = 0; n < 2; ++n)
#pragma unroll
                        for (int e = 0; e < 4; ++e) { float v = ks[bj][n][e]; v += __shfl_xor(v, 1); v += __shfl_xor(v, 2); v += __shfl_xor(v, 4); v += __shfl_xor(v, 8);
                            if (fr == 0) atomicAdd(km + ((size_t)((b * NH8 + (pn & 3) * 2 + bj) * 64 + blk)) * 128 + wc * 32 + n * 16 + 4 * fq + e, v * (1.0f / 256.0f)); }
            }
        } else {
            const int col0 = (pn - 24) * BM + wc * 32 + 4 * fq;
#pragma unroll
            for (int ai = 0; ai < 2; ++ai)
#pragma unroll
                for (int m = 0; m < 4; ++m) { bf16_t* rowp = SG + (size_t)(row0 + ai * HALF + m * 16) * 4096 + col0;
#pragma unroll
                    for (int bj = 0; bj < 2; ++bj)
#pragma unroll
                        for (int n = 0; n < 2; ++n) { const f32x4 v = acc[ai][bj][m][n]; u32x2 w; w.x = cvt_pk_bf16(sigmoidf_(v[0]), sigmoidf_(v[1])); w.y = cvt_pk_bf16(sigmoidf_(v[2]), sigmoidf_(v[3]));
                            *(u32x2*)(rowp + bj * HALF + n * 16) = w; } }
        }
    }
};
}

#define XB_TMO      128
#define XB_XCNT(j)  (256  + 64 * (j))
#define XB_XSUB(j)  (1280 + 64 * (j))
#define XB_XGEN(j)  (2304 + 64 * (j))
#define XB_TOP      3328
#define XB_TOPGEN   3392
#define XCD_BAR_WORDS 3456
#define XB_SPIN_CAP (1u << 18)

__device__ __forceinline__ unsigned xb_ld(unsigned* p)              { return __hip_atomic_load(p, __ATOMIC_RELAXED, __HIP_MEMORY_SCOPE_AGENT); }
__device__ __forceinline__ unsigned xb_add(unsigned* p, unsigned v) { return __hip_atomic_fetch_add(p, v, __ATOMIC_RELAXED, __HIP_MEMORY_SCOPE_AGENT); }
__device__ __forceinline__ unsigned xb_xcc_id() { return (unsigned)__builtin_amdgcn_s_getreg((3 << 11) | 20) & 0xFu; }
#define XB_SPIN(cond, bar) do { unsigned _sp = 0; while (cond) { __builtin_amdgcn_s_sleep(1); \
    if ((++_sp & 255u) == 0u) { if (xb_ld(&(bar)[XB_TMO])) break; if (_sp > XB_SPIN_CAP) { atomicAdd(&(bar)[XB_TMO], 1u); break; } } } } while (0)

struct XcdBarrier {
    unsigned* bar; unsigned x;
    volatile LAS unsigned* st;
};

__device__ __forceinline__ XcdBarrier xcd_barrier_post(unsigned* bar, volatile LAS unsigned* st) {
    XcdBarrier b; b.bar = bar; b.x = xb_xcc_id(); b.st = st;
    if (threadIdx.x == 0) (void)xb_add(&bar[XB_XCNT(b.x)], 1u);
    return b;
}
__device__ __forceinline__ void xcd_barrier_complete(unsigned* bar, unsigned x, unsigned& nloc, unsigned& nx) {
    const unsigned G = gridDim.x * gridDim.y * gridDim.z;
    unsigned sum, cnt, mine, sp = 0u;
    for (;;) {
        sum = 0u; cnt = 0u; mine = 0u;
#pragma unroll
        for (unsigned j = 0; j < 16; ++j) { const unsigned c = xb_ld(&bar[XB_XCNT(j)]); sum += c; cnt += (c > 0u) ? 1u : 0u; mine = (j == x) ? c : mine; }
        if (sum == G) break;
        __builtin_amdgcn_s_sleep(1);
        if ((++sp & 255u) == 0u) { if (xb_ld(&bar[XB_TMO])) break; if (sp > XB_SPIN_CAP) { atomicAdd(&bar[XB_TMO], 1u); break; } }
    }
    nloc = mine > 0u ? mine : 1u; nx = cnt > 0u ? cnt : 1u;
}

__device__ __forceinline__ void xcd_barrier(const XcdBarrier& b) {
    asm volatile("s_waitcnt vmcnt(0)" ::: "memory");
    __syncthreads();
    if (threadIdx.x == 0) {
        unsigned* bar = b.bar;
        __builtin_amdgcn_s_waitcnt(0);
        unsigned nloc = b.st[0], nx = b.st[1];
        if (nloc == 0u) { xcd_barrier_complete(bar, b.x, nloc, nx); b.st[0] = nloc; b.st[1] = nx; }
        const unsigned old = xb_add(&bar[XB_XSUB(b.x)], 1u);
        const unsigned gen = old / nloc;
        if (old + 1u == (gen + 1u) * nloc) {
            __builtin_amdgcn_fence(__ATOMIC_RELEASE, "agent");
            asm volatile("s_waitcnt vmcnt(0)" ::: "memory");
            const unsigned og = xb_add(&bar[XB_TOP], 1u);
            const unsigned tg = og / nx;
            if (og + 1u == (tg + 1u) * nx) xb_add(&bar[XB_TOPGEN], 1u);
            else XB_SPIN(xb_ld(&bar[XB_TOPGEN]) == tg, bar);
            __builtin_amdgcn_fence(__ATOMIC_ACQUIRE, "agent");
            xb_add(&bar[XB_XGEN(b.x)], 1u);
            asm volatile("s_waitcnt vmcnt(0)" ::: "memory");
        } else {
            XB_SPIN(xb_ld(&bar[XB_XGEN(b.x)]) == gen, bar);
            __builtin_amdgcn_fence(__ATOMIC_ACQUIRE, "agent");
            asm volatile("s_waitcnt vmcnt(0)" ::: "memory");
        }
    }
    __syncthreads();
}

struct Args { const float* in[21]; float* out; unsigned char* ws; int ph_lo, ph_hi, coop, pad; };

__device__ __forceinline__ void p0_transpose_item(const float* W, int K, int N, bf16* WT, LAS float* scr, int item, int lane, int ldt = 0, const float* gk = nullptr) {
    if (ldt == 0) ldt = K;
    const int nblk = N / 64, kb = item / nblk, nb = item % nblk, k0 = 64 * kb, n0 = 64 * nb;
    const int lr = lane >> 4, lc = (lane & 15) * 4;
    f32x4 v[16];
#pragma unroll
    for (int i = 0; i < 16; ++i) v[i] = ntload((const f32x4*)(W + (size_t)(k0 + 4 * i + lr) * N + n0 + lc));
#pragma unroll
    for (int i = 0; i < 16; ++i) { LAS float* d = scr + (4 * i + lr) * 65 + lc; const float gs = gk ? gk[k0 + 4 * i + lr] : 1.0f; d[0] = v[i].x * gs; d[1] = v[i].y * gs; d[2] = v[i].z * gs; d[3] = v[i].w * gs; }
    LDS_WAIT(); asm volatile("" ::: "memory");
    const int c = lane & 7;
#pragma unroll
    for (int j = 0; j < 8; ++j) { const int n = (lane >> 3) + 8 * j; const LAS float* sp = scr + (8 * c) * 65 + n;
        v4u o; o.x = pk2(sp[0 * 65], sp[1 * 65]); o.y = pk2(sp[2 * 65], sp[3 * 65]); o.z = pk2(sp[4 * 65], sp[5 * 65]); o.w = pk2(sp[6 * 65], sp[7 * 65]);
        *(GAS v4u*)(WT + (size_t)(n0 + n) * ldt + k0 + 8 * c) = o; }
    LDS_WAIT(); asm volatile("" ::: "memory");
}
__device__ __forceinline__ void rms_rows2_to_bf16(const float* xrow0, const float* xrow1, const float* g, bf16* orow0, bf16* orow1, int lane) {
    f32x4 v[2][8];
#pragma unroll
    for (int j = 0; j < 4; ++j) { const float* p0 = xrow0 + j * 512 + lane * 8; const float* p1 = xrow1 + j * 512 + lane * 8;
        v[0][2 * j] = ntload((const f32x4*)p0); v[0][2 * j + 1] = ntload((const f32x4*)(p0 + 4)); v[1][2 * j] = ntload((const f32x4*)p1); v[1][2 * j + 1] = ntload((const f32x4*)(p1 + 4)); }
#pragma unroll
    for (int k = 0; k < 2; ++k) { float s = 0.f; bf16* orow = k ? orow1 : orow0;
#pragma unroll
        for (int j = 0; j < 8; ++j) s += (v[k][j].x * v[k][j].x + v[k][j].y * v[k][j].y) + (v[k][j].z * v[k][j].z + v[k][j].w * v[k][j].w);
        const float rstd = 1.0f / sqrtf(wave_sum(s) * (1.f / DM) + NORM_EPS);
#pragma unroll
        for (int j = 0; j < 4; ++j) { const float* gp = g + j * 512 + lane * 8; const f32x4 g0 = *(const f32x4*)gp, g1 = *(const f32x4*)(gp + 4); const f32x4 a = v[k][2 * j] * rstd * g0, b = v[k][2 * j + 1] * rstd * g1;
            v4u o; o.x = pk2(a.x, a.y); o.y = pk2(a.z, a.w); o.z = pk2(b.x, b.y); o.w = pk2(b.z, b.w); *(v4u*)(orow + j * 512 + lane * 8) = o; } }
}
template <bool BASE_BF, bool OUT_BF>
__device__ __forceinline__ void row_pass(const bf16* Y, const void* basev, int ldb, const float* gA, void* outv, int ldo, float* rs, const float* pin, int gw, int NGW, int lane) {
    const float* base = (const float*)basev; const bf16* baseb = (const bf16*)basev; float* outh = (float*)outv; bf16* outb = (bf16*)outv;
    for (int row0 = gw; row0 < T; row0 += 2 * NGW) {
        f32x4 h[2][8]; v4u yw[2][4];
#pragma unroll
        for (int k = 0; k < 2; ++k)
#pragma unroll
            for (int j = 0; j < 4; ++j) { const size_t row = (size_t)(row0 + k * NGW); const int c = j * 512 + lane * 8; yw[k][j] = ntload((const v4u*)(Y + row * DM + c));
                if constexpr (BASE_BF) { const v4u bw = ntload((const v4u*)(baseb + row * ldb + c)); h[k][2 * j] = (f32x4){bflo(bw.x), bfhi(bw.x), bflo(bw.y), bfhi(bw.y)}; h[k][2 * j + 1] = (f32x4){bflo(bw.z), bfhi(bw.z), bflo(bw.w), bfhi(bw.w)}; }
                else { h[k][2 * j] = ntload((const f32x4*)(base + row * ldb + c)); h[k][2 * j + 1] = ntload((const f32x4*)(base + row * ldb + c + 4)); } }
#pragma unroll
        for (int k = 0; k < 2; ++k) { const size_t row = (size_t)(row0 + k * NGW);
            f32x4 y[8]; float s = 0.f;
#pragma unroll
            for (int j = 0; j < 4; ++j) { const v4u w = yw[k][j]; y[2 * j] = (f32x4){bflo(w.x), bfhi(w.x), bflo(w.y), bfhi(w.y)}; y[2 * j + 1] = (f32x4){bflo(w.z), bfhi(w.z), bflo(w.w), bfhi(w.w)}; }
#pragma unroll
            for (int j = 0; j < 8; ++j) s += (y[j].x * y[j].x + y[j].y * y[j].y) + (y[j].z * y[j].z + y[j].w * y[j].w);
            const float r1 = 1.0f / sqrtf(wave_sum(s) * (1.f / DM) + NORM_EPS); float s2 = 0.f;
#pragma unroll
            for (int j = 0; j < 4; ++j) { const int c = j * 512 + lane * 8; const f32x4 g0 = *(const f32x4*)(gA + c), g1 = *(const f32x4*)(gA + c + 4);
                h[k][2 * j] = h[k][2 * j] + y[2 * j] * r1 * g0; h[k][2 * j + 1] = h[k][2 * j + 1] + y[2 * j + 1] * r1 * g1;
                if constexpr (OUT_BF) { const f32x4 a = h[k][2 * j], b = h[k][2 * j + 1]; v4u o; o.x = pk2(a.x, a.y); o.y = pk2(a.z, a.w); o.z = pk2(b.x, b.y); o.w = pk2(b.z, b.w); ntstore(o, (v4u*)(outb + row * ldo + c)); }
                else { ntstore(h[k][2 * j], (f32x4*)(outh + row * ldo + c)); ntstore(h[k][2 * j + 1], (f32x4*)(outh + row * ldo + c + 4)); } }
            if (rs) {
#pragma unroll
                for (int j = 0; j < 8; ++j) s2 += (h[k][j].x * h[k][j].x + h[k][j].y * h[k][j].y) + (h[k][j].z * h[k][j].z + h[k][j].w * h[k][j].w);
                const float r2 = 1.0f / sqrtf(wave_sum(s2) * (1.f / DM) + NORM_EPS);
                if (lane == 0) rs[row] = r2;
            }
            if (OUT_BF && pin) { const f32x4 pv = *(const f32x4*)(pin + row * PLE + lane * 4); v2u o; o.x = pk2(pv.x, pv.y); o.y = pk2(pv.z, pv.w); *(v2u*)(outb + row * ldo + DM + lane * 4) = o; }
        }
    }
}

typedef swa::BlockRef<swa::bf16, swa::bf16> ABlock;
__device__ __forceinline__ ABlock attn_ref(int head, int qb, unsigned char* ws, float* dout) {
    const swa::bf16* QKVs = (const swa::bf16*)(ws + WS_QKV); ABlock r;
    const int b = head >> 4, hd = (head >> 2) & 3, c = (head >> 1) & 1, j = head & 1; const int sh = b * NH8 + hd * 2 + c, vh = b * NH8 + hd * 2 + j;
    r.Q = QKVs + 3 * SEC_ELEMS + ((size_t)sh * SEQ + (size_t)qb * 256) * 128; r.K = QKVs + 4 * SEC_ELEMS + (size_t)sh * SEQ * 128; r.V = QKVs + 5 * SEC_ELEMS + (size_t)vh * SEQ * 128;
    r.O = (swa::bf16*)dout + ((size_t)b * SEQ + (size_t)qb * 256) * 4096 + hd * 512 + c * 256 + j * 128;
    r.ldo = 4096; r.rows = nullptr; r.dst = nullptr; r.stat = nullptr; r.P0 = qb * 256;
    return r;
}
constexpr int MOBA_PER = 320, MOBA_ITEMS = 16 * MOBA_PER;
__device__ __forceinline__ bool moba_valid(int L, const int* nblk) { const int bh = L / MOBA_PER, k = L - bh * MOBA_PER; return k >= 256 || k < nblk[bh]; }
__device__ __forceinline__ int moba_next(int L, int G, const int* nblk) { do { L += G; } while (L < MOBA_ITEMS && !moba_valid(L, nblk)); return L; }
__device__ __forceinline__ ABlock moba_ref(int L, unsigned char* ws, float* dout) {
    const swa::bf16* QKVs = (const swa::bf16*)(ws + WS_QKV); ABlock r;
    const int bh = L / MOBA_PER, k = L - bh * MOBA_PER; int j, lp, p0;
    if (k < 256) { const int2 t = ((const int2*)(ws + WS_TAB))[bh * 256 + k]; j = t.x; lp = t.y; p0 = 256; } else { j = k - 256; lp = 65536 + j * 256; p0 = 0; }
    r.Q = QKVs + (size_t)bh * SEQ * 128; r.K = QKVs + 1 * SEC_ELEMS + ((size_t)bh * SEQ + (size_t)j * 256) * 128; r.V = QKVs + 2 * SEC_ELEMS + ((size_t)bh * SEQ + (size_t)j * 256) * 128;
    r.O = (swa::bf16*)dout; r.ldo = 128; r.rows = (const int*)(ws + WS_ROWL) + (size_t)bh * LSTR + lp; r.dst = (const int*)(ws + WS_DSTL) + (size_t)bh * LSTR + lp; r.stat = (float*)(ws + WS_STATS); r.P0 = p0;
    return r;
}

__global__ void __launch_bounds__(NWAVES * 64, 2) mk_fwd(Args args) {
    extern __shared__ __attribute__((aligned(16))) unsigned char lds[];
    LAS unsigned char* L = (LAS unsigned char*)lds;
    const int tid = threadIdx.x, lane = tid & 63, wave = __builtin_amdgcn_readfirstlane(tid >> 6);
    const int G = gridDim.x, bx = blockIdx.x;
    const int vcu = (G % 8 == 0) ? (bx % 8) * (G / 8) + bx / 8 : bx;
    const int gw = vcu * NWAVES + wave, NGW = G * NWAVES;
    unsigned char* ws = args.ws;
#define x_in (args.in[0])
#define p_in (args.in[1])
#define Win_t ((bf16*)(ws + WS_WIN))
#define Wa_t ((bf16*)(ws + WS_WA))
#define Wb_t ((bf16*)(ws + WS_WB))
#define Wout_t ((bf16*)(ws + WS_WOUT))
#define Wup_t ((bf16*)(ws + WS_WUP))
#define Wdn_t ((bf16*)(ws + WS_WDN))
#define Wpg_t ((bf16*)(ws + WS_WPG))
#define Wpp_t ((bf16*)(ws + WS_WPP))
#define XN ((bf16*)(ws + WS_XN))
#define PB ((bf16*)(ws + WS_PB))
#define QKV ((bf16*)(ws + WS_QKV))
#define SG ((bf16*)(ws + WS_SG))
#define OAB ((bf16*)(ws + WS_XN))
#define MIX ((bf16*)(ws + WS_MIX))
#define HID ((bf16*)(ws + WS_HID))
#define G3 ((bf16*)(ws + WS_G3))
#define Y ((bf16*)(ws + WS_Y))
#define rope ((float*)(ws + WS_ROPE))
#define kmean ((float*)(ws + WS_KMEAN))
#define out (args.out)
    const int lo = args.ph_lo, hi = args.ph_hi;
#define IN(k) (lo <= (k) && (k) < hi)
#define SEAM(k) do { if (IN(k) && IN((k) + 1)) { if (args.coop) { if (args.pad == 0x5eed) { asm volatile("s_waitcnt vmcnt(0) lgkmcnt(0)" ::: "memory"); cg::this_grid().sync(); }     \
        xcd_barrier(xbar); } } } while (0)
    volatile LAS unsigned* bst = (volatile LAS unsigned*)(L + LDS_BYTES - 64);
    if (tid < 2) bst[tid] = 0u;
    __syncthreads();
    XcdBarrier xbar; xbar.bar = (unsigned*)(ws + WS_BAR); xbar.x = 0; xbar.st = bst;
    if (args.coop) xbar = xcd_barrier_post((unsigned*)(ws + WS_BAR), bst);

    if (IN(0)) {
        LAS float* scr = (LAS float*)(L + wave * 16896);
        constexpr int I_IN = (DM / 64) * (INW / 64), I_BR = (1024 / 64) * (DM / 64), I_OUT = (DM / 64) * (DM / 64), I_UP = (DM / 64) * (DFF / 64), I_DN = (DFF / 64) * (DM / 64), I_PP = (PLE / 64) * (DM / 64);
        constexpr int NITEMS = I_IN + 2 * I_BR + I_OUT + I_UP + I_DN + I_OUT + I_PP;
        for (int it = gw; it < NITEMS; it += NGW) {
            int r = it;
            if (r < I_IN) { p0_transpose_item(args.in[2], DM, INW, Win_t, scr, r, lane); continue; } r -= I_IN;
            if (r < I_BR) { p0_transpose_item(args.in[3], 1024, DM, Wa_t, scr, r, lane, 2048); continue; } r -= I_BR;
            if (r < I_BR) { p0_transpose_item(args.in[4], 1024, DM, Wa_t + 1024, scr, r, lane, 2048); continue; } r -= I_BR;
            if (r < I_OUT) { p0_transpose_item(args.in[5], DM, DM, Wout_t, scr, r, lane); continue; } r -= I_OUT;
            if (r < I_UP) { p0_transpose_item(args.in[13], DM, DFF, Wup_t, scr, r, lane, 0, args.in[15]); continue; } r -= I_UP;
            if (r < I_DN) { p0_transpose_item(args.in[14], DFF, DM, Wdn_t, scr, r, lane); continue; } r -= I_DN;
            if (r < I_OUT) { p0_transpose_item(args.in[18], DM, DM, Wpg_t, scr, r, lane, DM + PLE, args.in[19]); continue; } r -= I_OUT;
            p0_transpose_item(args.in[17], PLE, DM, Wpg_t + DM, scr, r, lane, DM + PLE);
        }
        for (int m = gw; m < T; m += 2 * NGW) rms_rows2_to_bf16(x_in + (size_t)m * DM, x_in + (size_t)(m + NGW) * DM, args.in[11], XN + (size_t)m * DM, XN + (size_t)(m + NGW) * DM, lane);
        if (bx == 0) { for (int i = tid; i < 16 * 64 + 16; i += 512) { if (i < 1024) ((int*)(ws + WS_CNT))[i] = 0; else ((int*)(ws + WS_NBLK))[i - 1024] = 0; } }
        for (int i = bx * 512 + tid; i < 16 * 64 * 128; i += G * 512) kmean[i] = 0.f;
        for (int i = bx * 512 + tid; i < SEQ * 16; i += G * 512) { const int pos = i >> 4, k = i & 15;
            double fr_ = 1.0; for (int j_ = 0; j_ < k; ++j_) fr_ *= 0.4403666026717805;
            const float angf = (float)pos * (float)fr_; const double a = (double)angf;
            const double TWO_PI = 6.283185307179586476925286766559; double q = __builtin_rint(a / TWO_PI); double r = a - q * TWO_PI;
            const double r2 = r * r; double sn = 1.0, cs = 1.0;
            sn = 1.0 - r2 / (22.0 * 23.0); sn = 1.0 - r2 / (20.0 * 21.0) * sn; sn = 1.0 - r2 / (18.0 * 19.0) * sn; sn = 1.0 - r2 / (16.0 * 17.0) * sn; sn = 1.0 - r2 / (14.0 * 15.0) * sn; sn = 1.0 - r2 / (12.0 * 13.0) * sn;
            sn = 1.0 - r2 / (10.0 * 11.0) * sn; sn = 1.0 - r2 / (8.0 * 9.0) * sn; sn = 1.0 - r2 / (6.0 * 7.0) * sn; sn = 1.0 - r2 / (4.0 * 5.0) * sn; sn = 1.0 - r2 / (2.0 * 3.0) * sn; sn = r * sn;
            cs = 1.0 - r2 / (21.0 * 22.0); cs = 1.0 - r2 / (19.0 * 20.0) * cs; cs = 1.0 - r2 / (17.0 * 18.0) * cs; cs = 1.0 - r2 / (15.0 * 16.0) * cs; cs = 1.0 - r2 / (13.0 * 14.0) * cs; cs = 1.0 - r2 / (11.0 * 12.0) * cs;
            cs = 1.0 - r2 / (9.0 * 10.0) * cs; cs = 1.0 - r2 / (7.0 * 8.0) * cs; cs = 1.0 - r2 / (5.0 * 6.0) * cs; cs = 1.0 - r2 / (3.0 * 4.0) * cs; cs = 1.0 - r2 / (1.0 * 2.0) * cs;
            rope[(size_t)pos * 32 + k] = (float)cs; rope[(size_t)pos * 32 + 16 + k] = (float)sn; }
    }
    SEAM(0);
    if (IN(1)) {
        pg8::Gemm g{XN, Win_t, T, INW, DM}; pg8::StaticOrder S; S.init(T, INW, G, bx);
        pg8::EpiInProj E{QKV, SG, (const float*)rope, kmean};
        pg8::gemm_phase<pg8::EpiInProj, pg8::StaticOrder, true, true>(L, g, S, E);
    }
    SEAM(1);
    if (IN(3)) {
        char* Kl = (char*)lds;
        const int lane_ = tid & 63, r32 = lane_ & 31, hi = lane_ >> 5;
        const int sr = tid >> 4, sc = (tid & 15) * 8, kws = KSWZ(sr, sc * 2);
        int bh_loaded = -1;
        for (int u = vcu; u < 16 * 64; u += G) {
            const int bh = u & 15, qb = u >> 4;
            if (bh != bh_loaded) {
                __syncthreads();
#pragma unroll
                for (int h2 = 0; h2 < 2; ++h2) { const float* kp = kmean + ((size_t)bh * 64 + sr + 32 * h2) * 128 + sc; const f32x4 a = *(const f32x4*)kp, b = *(const f32x4*)(kp + 4);
                    const float v[8] = {a.x, a.y, a.z, a.w, b.x, b.y, b.z, b.w}; unsigned hb[8], lb[8];
#pragma unroll
                    for (int e = 0; e < 8; ++e) { hb[e] = f2bf(v[e]); lb[e] = f2bf(v[e] - __uint_as_float(hb[e] << 16)); }
                    v4u wh, wl; wh.x = hb[0] | (hb[1] << 16); wh.y = hb[2] | (hb[3] << 16); wh.z = hb[4] | (hb[5] << 16); wh.w = hb[6] | (hb[7] << 16);
                    wl.x = lb[0] | (lb[1] << 16); wl.y = lb[2] | (lb[3] << 16); wl.z = lb[4] | (lb[5] << 16); wl.w = lb[6] | (lb[7] << 16);
                    *(v4u*)(Kl + kws + h2 * 32 * 256) = wh; *(v4u*)(Kl + swa::SHM_K + kws + h2 * 32 * 256) = wl; }
                __syncthreads();
                bh_loaded = bh;
            }
            const int row = wave * 32 + r32;
            swa::bf16x8 qr[8];
            { const swa::bf16* qp = (const swa::bf16*)QKV + ((size_t)bh * SEQ + (size_t)qb * 256 + row) * 128 + hi * 8;
#pragma unroll
              for (int d0 = 0; d0 < 8; ++d0) qr[d0] = swa::load8<swa::bf16>(qp + d0 * 16); }
            swa::f32x16 ph0, ph1, pl0, pl1;
            swa::qkt_r<0>(ph0, ph1, Kl, r32, hi, qr); swa::qkt_r<1>(pl0, pl1, Kl, r32, hi, qr);
            float g0 = -__builtin_inff(), g1 = g0, g2 = g0; int i0 = -1, i1 = -1, i2 = -1;
#define INS3(gv, iv) do { const float g_ = (gv); const int i_ = (iv); if (g_ > g0) { g2 = g1; i2 = i1; g1 = g0; i1 = i0; g0 = g_; i0 = i_; } else if (g_ > g1) { g2 = g1; i2 = i1; g1 = g_; i1 = i_; } else if (g_ > g2) { g2 = g_; i2 = i_; } } while (0)
#pragma unroll
            for (int r = 0; r < 16; ++r) { const int n = swa::crow(r, hi); if (n < qb) INS3(ph0[r] + pl0[r], n); }
#pragma unroll
            for (int r = 0; r < 16; ++r) { const int n = 32 + swa::crow(r, hi); if (n < qb) INS3(ph1[r] + pl1[r], n); }
            { const float pg0 = __shfl_xor(g0, 32), pg1 = __shfl_xor(g1, 32), pg2 = __shfl_xor(g2, 32); const int pi0 = __shfl_xor(i0, 32), pi1 = __shfl_xor(i1, 32), pi2 = __shfl_xor(i2, 32);
              INS3(pg0, pi0); INS3(pg1, pi1); INS3(pg2, pi2); }
#undef INS3
            if (hi == 0) {
                const int grow = qb * 256 + row; int s0 = -1, s1 = -1, s2 = -1; int* cnt = (int*)(ws + WS_CNT) + bh * 64; float2* stt = (float2*)(ws + WS_STATS);
                float2 none; none.x = -1e30f; none.y = 0.f;
                if (i0 >= 0) s0 = atomicAdd(cnt + i0, 1); else stt[(size_t)(bh * 4 + 0) * SEQ + grow] = none;
                if (i1 >= 0) s1 = atomicAdd(cnt + i1, 1); else stt[(size_t)(bh * 4 + 1) * SEQ + grow] = none;
                if (i2 >= 0) s2 = atomicAdd(cnt + i2, 1); else stt[(size_t)(bh * 4 + 2) * SEQ + grow] = none;
                int4 rec; rec.x = (i0 & 255) | ((i1 & 255) << 8) | ((i2 & 255) << 16); rec.y = s0; rec.z = s1; rec.w = s2;
                ((int4*)(ws + WS_SEL))[(size_t)bh * SEQ + grow] = rec; }
        }
        __syncthreads();
    }
    SEAM(3);
    if (IN(4)) {
        LAS int* cn = (LAS int*)L; LAS int* offs = cn + 64;
        int* ROWL = (int*)(ws + WS_ROWL); int* DSTL = (int*)(ws + WS_DSTL);
        for (int u = vcu; u < 16 * 64; u += G) {
            const int bh = u & 15, chunk = u >> 4;
            __syncthreads();
            if (tid < 64) cn[tid] = ((const int*)(ws + WS_CNT))[bh * 64 + tid];
            __syncthreads();
            if (tid == 0) { int a = 0; for (int j = 0; j < 64; ++j) { offs[j] = a; a += (cn[j] + 255) & ~255; } offs[64] = a; }
            __syncthreads();
            int* rl = ROWL + (size_t)bh * LSTR; int* dl = DSTL + (size_t)bh * LSTR;
            if (tid < 256) { const int row = chunk * 256 + tid; const int4 rec = ((const int4*)(ws + WS_SEL))[(size_t)bh * SEQ + row];
                const int j0 = rec.x & 255, j1 = (rec.x >> 8) & 255, j2 = (rec.x >> 16) & 255;
                if (j0 != 255) { const int gp = offs[j0] + rec.y; rl[gp] = row; dl[gp] = (bh * 4 + 0) * SEQ + row; }
                if (j1 != 255) { const int gp = offs[j1] + rec.z; rl[gp] = row; dl[gp] = (bh * 4 + 1) * SEQ + row; }
                if (j2 != 255) { const int gp = offs[j2] + rec.w; rl[gp] = row; dl[gp] = (bh * 4 + 2) * SEQ + row; }
                rl[65536 + row] = row; dl[65536 + row] = (bh * 4 + 3) * SEQ + row; }
            if (chunk == 0) {
                for (int idx = tid; idx < 64 * 256; idx += 512) { const int j = idx >> 8, c = cn[j], pos = c + (idx & 255);
                    if (pos < ((c + 255) & ~255)) { rl[offs[j] + pos] = 0; dl[offs[j] + pos] = -1; } }
                if (tid == 0) { int k = 0; int2* tab = (int2*)(ws + WS_TAB) + bh * 256;
                    for (int j = 0; j < 64; ++j) { const int nb = (cn[j] + 255) >> 8; for (int b_ = 0; b_ < nb; ++b_) { if (k < 256) { int2 t; t.x = j; t.y = offs[j] + 256 * b_; tab[k] = t; } ++k; } }
                    ((int*)(ws + WS_NBLK))[bh] = k < 256 ? k : 256; }
            }
        }
        __syncthreads();
    }
    SEAM(4);
    if (IN(5)) {
        const int* nblk = (const int*)(ws + WS_NBLK);
        static_assert(swa::MOBA_LDS_BYTES <= LDS_BYTES - 64, "MoBA short-block LDS");
        int Lc = vcu; if (!moba_valid(Lc, nblk)) Lc = moba_next(Lc, G, nblk);
        if (Lc < MOBA_ITEMS) {
            ABlock cur = moba_ref(Lc, ws, out); swa::MobaStage ST; swa::moba_prime(cur, ST);
            for (;;) { const int Ln = moba_next(Lc, G, nblk); const bool has_next = Ln < MOBA_ITEMS;
                ABlock nxt = cur; if (has_next) nxt = moba_ref(Ln, ws, out);
                swa::moba_block(cur, nxt, has_next, (char*)lds, ST);
                if (!has_next) break;
                cur = nxt; Lc = Ln; }
        }
        __syncthreads();
    }
    SEAM(5);
    if (IN(6)) {
        const float2* stt = (const float2*)(ws + WS_STATS); const bf16* PART = (const bf16*)out; constexpr float C2 = 1.4426950408889634f * 0.08838834764831845f;
        for (int u0 = gw; u0 < 16 * SEQ; u0 += 4 * NGW) {
            float2 st[4][4]; unsigned pw[4][4];
#pragma unroll
            for (int k = 0; k < 4; ++k) { const int u = u0 + k * NGW, bh = u >> 14, row = u & (SEQ - 1);
#pragma unroll
                for (int s_ = 0; s_ < 4; ++s_) { const size_t di = (size_t)(bh * 4 + s_) * SEQ + row; st[k][s_] = stt[di]; pw[k][s_] = ntload((const unsigned*)(PART + di * 128 + lane * 2)); } }
#pragma unroll
            for (int k = 0; k < 4; ++k) { const int u = u0 + k * NGW, bh = u >> 14, row = u & (SEQ - 1);
                float M = -1e30f;
#pragma unroll
                for (int s_ = 0; s_ < 4; ++s_) if (st[k][s_].y > 0.f) M = fmaxf(M, st[k][s_].x);
                float a0 = 0.f, a1 = 0.f, den = 0.f;
#pragma unroll
                for (int s_ = 0; s_ < 4; ++s_) { const bool ok = st[k][s_].y > 0.f; const float w = ok ? st[k][s_].y * __builtin_amdgcn_exp2f((st[k][s_].x - M) * C2) : 0.f;
                    a0 += ok ? w * bflo(pw[k][s_]) : 0.f; a1 += ok ? w * bfhi(pw[k][s_]) : 0.f; den += w; }
                const float inv = 1.0f / den;
                *(unsigned*)(OAB + ((size_t)(bh >> 3) * SEQ + row) * 2048 + (bh & 7) * 128 + lane * 2) = pk2(a0 * inv, a1 * inv); } }
    }
    SEAM(6);
    const bool fuse_dc = (G == 256);
    if (IN(7)) {
        constexpr int NITEM = 32 * 32;
        int Lc = vcu;
#define DHEAD(L_) (((((L_) >> 5) & 7) << 2) + ((L_) >> 8))
        if (Lc < NITEM) {
            int head = DHEAD(Lc), xx = Lc & 31, pass = 0;
            ABlock cur = attn_ref(head, xx, ws, out);
            swa::Seam<swa::bf16> S;
            swa::causal_swa_prime<swa::bf16, swa::bf16>(cur, SEQ, (char*)lds, S);
            for (;;) {
                const bool more_pass = pass == 0, more_item = Lc + G < NITEM, last = !more_pass && !more_item;
                int headn = head, xn = xx, passn = pass + 1, Ln = Lc;
                if (!more_pass) { passn = 0; Ln = more_item ? Lc + G : Lc; headn = DHEAD(Ln); xn = Ln & 31; }
                const int qbn = passn ? 63 - xn : xn;
                ABlock nxt = cur;
                if (!last) nxt = attn_ref(headn, qbn, ws, out);
                swa::causal_swa_block<swa::bf16, swa::bf16>(cur, nxt, SEQ, SEQ, (char*)lds, S);
                if (last) break;
                cur = nxt; head = headn; xx = xn; pass = passn; Lc = Ln;
            }
        }
#undef DHEAD
        asm volatile("s_waitcnt vmcnt(0)" ::: "memory");
        __syncthreads();
        if (fuse_dc) {
            float lam;
            { const float* q1 = args.in[6]; const float* k1 = args.in[7]; const float* q2 = args.in[8]; const float* k2 = args.in[9];
              const float s1 = wave_sum(q1[lane] * k1[lane] + q1[lane + 64] * k1[lane + 64]), s2 = wave_sum(q2[lane] * k2[lane] + q2[lane + 64] * k2[lane + 64]);
              lam = __expf(s1) - __expf(s2) + LAMBDA_INIT; }
            const bf16* AD = (const bf16*)out; const f32x4 gg = *(const f32x4*)(args.in[10] + lane * 4);
            const int bhd = (vcu >> 5) & 7, b = bhd >> 2, hd = bhd & 3, x0 = vcu & 31;
            for (int r0 = wave * 64; r0 < wave * 64 + 64; r0 += 4) {
                v2u w0[4], w1[4]; size_t tt[4];
#pragma unroll
                for (int k = 0; k < 4; ++k) { const int r = r0 + k; const int qb = (r < 256) ? x0 : 63 - x0; tt[k] = (size_t)b * SEQ + (size_t)qb * 256 + (r & 255);
                    const bf16* a = AD + tt[k] * 4096 + hd * 512 + lane * 4; w0[k] = *(const v2u*)a; w1[k] = *(const v2u*)(a + 256); }
#pragma unroll
                for (int k = 0; k < 4; ++k) {
                    f32x4 d; d.x = bflo(w0[k].x) - lam * bflo(w1[k].x); d.y = bfhi(w0[k].x) - lam * bfhi(w1[k].x); d.z = bflo(w0[k].y) - lam * bflo(w1[k].y); d.w = bfhi(w0[k].y) - lam * bfhi(w1[k].y);
                    const float ss = wave_sum((d.x * d.x + d.y * d.y) + (d.z * d.z + d.w * d.w));
                    const float r = (1.0f - LAMBDA_INIT) / sqrtf(ss * (1.f / 256.f) + NORM_EPS);
                    v2u o; o.x = pk2(d.x * r * gg.x, d.y * r * gg.y); o.y = pk2(d.z * r * gg.z, d.w * r * gg.w);
                    *(v2u*)(OAB + tt[k] * 2048 + 1024 + hd * 256 + lane * 4) = o; } }
        }
    }
    SEAM(7);
    if (IN(8) && !fuse_dc) {
        float lam;
        { const float* q1 = args.in[6]; const float* k1 = args.in[7]; const float* q2 = args.in[8]; const float* k2 = args.in[9];
          const float s1 = wave_sum(q1[lane] * k1[lane] + q1[lane + 64] * k1[lane + 64]), s2 = wave_sum(q2[lane] * k2[lane] + q2[lane + 64] * k2[lane + 64]);
          lam = __expf(s1) - __expf(s2) + LAMBDA_INIT; }
        const bf16* AD = (const bf16*)out; const float* sg = args.in[10];
        const f32x4 gg = *(const f32x4*)(sg + lane * 4);
        for (int u0 = gw; u0 < T * 4; u0 += 4 * NGW) {
            v2u w0[4], w1[4];
#pragma unroll
            for (int k = 0; k < 4; ++k) { const int u = u0 + k * NGW, t = u >> 2, hd = u & 3; const bf16* a = AD + (size_t)t * 4096 + hd * 512 + lane * 4; w0[k] = ntload((const v2u*)a); w1[k] = ntload((const v2u*)(a + 256)); }
#pragma unroll
            for (int k = 0; k < 4; ++k) { const int u = u0 + k * NGW, t = u >> 2, hd = u & 3;
                f32x4 d; d.x = bflo(w0[k].x) - lam * bflo(w1[k].x); d.y = bfhi(w0[k].x) - lam * bfhi(w1[k].x); d.z = bflo(w0[k].y) - lam * bflo(w1[k].y); d.w = bfhi(w0[k].y) - lam * bfhi(w1[k].y);
                const float ss = wave_sum((d.x * d.x + d.y * d.y) + (d.z * d.z + d.w * d.w));
                const float r = (1.0f - LAMBDA_INIT) / sqrtf(ss * (1.f / 256.f) + NORM_EPS);
                v2u o; o.x = pk2(d.x * r * gg.x, d.y * r * gg.y); o.y = pk2(d.z * r * gg.z, d.w * r * gg.w);
                *(v2u*)(OAB + (size_t)t * 2048 + 1024 + hd * 256 + lane * 4) = o; } }
    }
    if (!fuse_dc) SEAM(8);
    if (IN(9)) { pg8::Gemm g{OAB, Wa_t, T, DM, 2048}; pg8::StaticOrder S; S.init(T, DM, G, bx); pg8::EpiGate2 E{MIX, SG};
        pg8::gemm_phase<pg8::EpiGate2, pg8::StaticOrder, true, true, true>(L, g, S, E); }
    SEAM(9);
    if (IN(11)) { pg8::Gemm g{MIX, Wout_t, T, DM, DM}; pg8::StaticOrder S; S.init(T, DM, G, bx); pg8::EpiT<0> E{Y, DM, nullptr, 0};
        pg8::gemm_phase<pg8::EpiT<0>, pg8::StaticOrder, true, true>(L, g, S, E); }
    SEAM(11);
    if (IN(12)) row_pass<false, true>(Y, x_in, DM, args.in[12], out, DM, (float*)(ws + WS_RS2), nullptr, gw, NGW, lane);
    SEAM(12);
    if (IN(13)) { pg8::Gemm g{(const bf16*)out, Wup_t, T, DFF, DM}; pg8::StaticOrder S; S.init(T, DFF, G, bx); pg8::EpiUp E{HID, DFF, (const float*)(ws + WS_RS2)};
        pg8::gemm_phase<pg8::EpiUp, pg8::StaticOrder, true, true>(L, g, S, E); }
    SEAM(13);
    if (IN(14)) { pg8::Gemm g{HID, Wdn_t, T, DM, DFF}; pg8::StaticOrder S; S.init(T, DM, G, bx); pg8::EpiT<0> E{Y, DM, nullptr, 0};
        pg8::gemm_phase<pg8::EpiT<0>, pg8::StaticOrder, true, true>(L, g, S, E); }
    SEAM(14);
    if (IN(15)) row_pass<true, true>(Y, out, DM, args.in[16], ws + WS_XN3, DM + PLE, (float*)(ws + WS_RS3), p_in, gw, NGW, lane);
    SEAM(15);
    if (IN(16)) { pg8::Gemm g{(bf16*)(ws + WS_XN3), Wpg_t, T, DM, DM + PLE}; pg8::StaticOrder S; S.init(T, DM, G, bx); pg8::EpiPle E{Y, G3, (const float*)(ws + WS_RS3)};
        pg8::gemm_phase<pg8::EpiPle, pg8::StaticOrder, true, true, true>(L, g, S, E); }
    SEAM(17);
    if (IN(18)) row_pass<true, false>(Y, ws + WS_XN3, DM + PLE, args.in[20], out, DM, nullptr, nullptr, gw, NGW, lane);
#undef IN
#undef SEAM
#undef x_in
#undef p_in
#undef Win_t
#undef Wa_t
#undef Wb_t
#undef Wout_t
#undef Wup_t
#undef Wdn_t
#undef Wpg_t
#undef Wpp_t
#undef XN
#undef PB
#undef QKV
#undef SG
#undef OAB
#undef MIX
#undef HID
#undef G3
#undef Y
#undef rope
#undef kmean
#undef out
}

extern "C" void kernel_launch(void* const* d_in, const int* in_sizes, int n_in, void* d_out, int out_size, void* d_ws, size_t ws_size, hipStream_t stream) {
    static int grid = 0;
    if (grid == 0) {
        if (n_in != 21 || out_size != T * DM || ws_size < WS_TOP) { fprintf(stderr, "kernel_launch: unexpected shapes n_in %d out %d ws %zu\n", n_in, out_size, ws_size); grid = -1; return; }
        int dev = 0, cus = 0, per_cu = 0;
        (void)hipGetDevice(&dev); (void)hipDeviceGetAttribute(&cus, hipDeviceAttributeMultiprocessorCount, dev);
        if (hipFuncSetAttribute((const void*)mk_fwd, hipFuncAttributeMaxDynamicSharedMemorySize, LDS_BYTES) != hipSuccess) { fprintf(stderr, "kernel_launch: hipFuncSetAttribute failed\n"); grid = -1; return; }
        if (hipOccupancyMaxActiveBlocksPerMultiprocessor(&per_cu, (const void*)mk_fwd, NWAVES * 64, LDS_BYTES) != hipSuccess || per_cu < 1) { fprintf(stderr, "kernel_launch: occupancy query says %d\n", per_cu); per_cu = 1; }
        (void)hipGetLastError();
        grid = cus * 1;
        if (grid <= 0) grid = 256;
    }
    if (grid < 0) return;
    (void)hipMemsetAsync((unsigned char*)d_ws + WS_BAR, 0, WS_BAR_BYTES, stream);
    Args a{};
    for (int i = 0; i < 21; ++i) a.in[i] = (const float*)d_in[i];
    a.out = (float*)d_out; a.ws = (unsigned char*)d_ws;
#if MK_ONE_LAUNCH
    a.ph_lo = 0; a.ph_hi = NPHASE; a.coop = 1;
    void* kargs[] = {&a};
    hipError_t e = hipLaunchCooperativeKernel((const void*)mk_fwd, dim3(grid), dim3(NWAVES * 64), kargs, LDS_BYTES, stream);
    if (e != hipSuccess) fprintf(stderr, "cooperative launch failed: %s (grid %d)\n", hipGetErrorString(e), grid);
#else
    for (int ph = 0; ph < NPHASE; ++ph) { a.ph_lo = ph; a.ph_hi = ph + 1; a.coop = 0;
        hipLaunchKernelGGL(mk_fwd, dim3(grid), dim3(NWAVES * 64), LDS_BYTES, stream, a); }
#endif
}
```
